# Optimizing an MI355X kernel written in HIP

```python
import math
import jax, jax.numpy as jnp
from jax import lax
import numpy as np

D_MODEL = 1024
BATCH = 4
SEQ = 8192
DEPTH = 2

HGRN_HEADS = 4
HGRN_DK = D_MODEL // (2 * HGRN_HEADS)
HGRN_DV = D_MODEL // (2 * HGRN_HEADS)
RET_HEADS = 4
RET_DK = D_MODEL // (2 * RET_HEADS)
RET_DV = D_MODEL // (2 * RET_HEADS)
LIN_CHUNK = 64
EVEN_COLS = [HGRN_HEADS * HGRN_DK, HGRN_HEADS * HGRN_DK, HGRN_HEADS * HGRN_DV, HGRN_HEADS * HGRN_DV,
             RET_HEADS * RET_DK, RET_HEADS * RET_DK, RET_HEADS * RET_DV, RET_HEADS * RET_DV]
EVEN_MIX_OUT = HGRN_HEADS * HGRN_DV + RET_HEADS * RET_DV

NSA_HD = 64
NSA_HEADS = D_MODEL // NSA_HD
NSA_KV_GROUPS = 2
CMP_BLOCK = 32
CMP_STRIDE = 16
SLC_BLOCK = 64
SLC_TOPN = 16
WINDOW = 512
Q_BLOCK = 128
KVW = NSA_KV_GROUPS * NSA_HD
ODD_COLS = [NSA_HEADS * NSA_HD, KVW, KVW, KVW, KVW, KVW, KVW, 3 * NSA_HEADS]

FFN_HIDDEN = ((8 * D_MODEL // 3 + 255) // 256) * 256
N_EVEN = (DEPTH + 1) // 2
N_ODD = DEPTH // 2
RMS_EPS = 1e-6
NEG_INF = -1e30
FORCE_SCORE = 1e9

kernel_name = "hgrn2_retention_nsa_hybrid"


def rmsnorm(x, g):
    xf = x.astype(jnp.float32)
    y = xf * lax.rsqrt(jnp.mean(xf * xf, axis=-1, keepdims=True) + RMS_EPS)
    return (y * g.astype(jnp.float32)).astype(x.dtype)


def split_cols(a, sizes):
    return jnp.split(a, np.cumsum(sizes)[:-1].tolist(), axis=-1)


def to_chunks(a, c):
    b, t, h, d = a.shape
    return a.reshape(b, t // c, c, h, d).transpose(1, 0, 3, 2, 4)


def from_chunks(a):
    n, b, h, c, d = a.shape
    return a.transpose(1, 0, 3, 2, 4).reshape(b, n * c, h, d)


def hgrn2_chunked(q, k, v, log_f):
    b_, t_, h_, dk = q.shape
    dv = v.shape[-1]
    c = LIN_CHUNK
    causal = jnp.tril(jnp.ones((c, c), dtype=bool))[:, :, None]

    def step(state, inp):
        qi, ki, vi, gi = inp
        cum = jnp.cumsum(gi, axis=2)
        diff = cum[:, :, :, None, :] - cum[:, :, None, :, :]
        decay = jnp.exp(jnp.where(causal, diff, NEG_INF))
        attn = jnp.einsum('bhid,bhjd,bhijd->bhij', qi, ki, decay)
        out = jnp.einsum('bhij,bhjv->bhiv', attn, vi) + jnp.einsum('bhid,bhdv->bhiv', qi * jnp.exp(cum), state)
        last = cum[:, :, -1:, :]
        state = jnp.exp(last[:, :, 0, :])[..., None] * state + jnp.einsum('bhjd,bhjv->bhdv', ki * jnp.exp(last - cum), vi)
        return state, out

    s0 = jnp.zeros((b_, h_, dk, dv), jnp.float32)
    xs = tuple(to_chunks(a.astype(jnp.float32), c) for a in (q, k, v, log_f))
    _, o = lax.scan(step, s0, xs)
    return from_chunks(o)


def retention_chunked(q, k, v, log_gamma):
    b_, t_, h_, dk = q.shape
    dv = v.shape[-1]
    c = LIN_CHUNK
    pos = jnp.arange(c, dtype=jnp.float32)
    rel = pos[:, None] - pos[None, :]
    decay = jnp.where(rel[None] >= 0, jnp.exp(jnp.maximum(rel, 0.0)[None] * log_gamma[:, None, None]), 0.0)
    q_decay = jnp.exp((pos + 1.0)[None, :] * log_gamma[:, None])[..., None]
    k_decay = jnp.exp((c - 1.0 - pos)[None, :] * log_gamma[:, None])[..., None]
    chunk_decay = jnp.exp(c * log_gamma)[:, None, None]

    def step(state, inp):
        qi, ki, vi = inp
        attn = jnp.einsum('bhid,bhjd->bhij', qi, ki) * decay
        out = jnp.einsum('bhij,bhjv->bhiv', attn, vi) + jnp.einsum('bhid,bhdv->bhiv', qi * q_decay, state)
        state = chunk_decay * state + jnp.einsum('bhjd,bhjv->bhdv', ki * k_decay, vi)
        return state, out

    s0 = jnp.zeros((b_, h_, dk, dv), jnp.float32)
    xs = tuple(to_chunks(a.astype(jnp.float32), c) for a in (q, k, v))
    _, o = lax.scan(step, s0, xs)
    return from_chunks(o)


def even_mixer(h, w_in, lower_bound, hgrn_norm, ret_norm, w_out):
    b_, t_, _ = h.shape
    hq, hf, hi, hg, rq, rk, rv, rg = split_cols(h @ w_in, EVEN_COLS)
    heads = lambda a, n: a.reshape(b_, t_, n, -1)
    f = lower_bound + (1.0 - lower_bound) * jax.nn.sigmoid(hf.astype(jnp.float32))
    o_h = hgrn2_chunked(heads(jax.nn.silu(hq), HGRN_HEADS), heads(1.0 - f, HGRN_HEADS),
                        heads(hi, HGRN_HEADS), heads(jnp.log(f), HGRN_HEADS))
    o_h = rmsnorm(o_h, hgrn_norm) * jax.nn.silu(heads(hg, HGRN_HEADS).astype(jnp.float32))
    log_gamma = jnp.log(1.0 - jnp.exp2(-5.0 - jnp.arange(RET_HEADS, dtype=jnp.float32)))
    o_r = retention_chunked(heads(rq, RET_HEADS), heads(rk, RET_HEADS) * (RET_DK ** -0.5),
                            heads(rv, RET_HEADS), log_gamma)
    o_r = rmsnorm(o_r, ret_norm) * jax.nn.silu(heads(rg, RET_HEADS).astype(jnp.float32))
    o = jnp.concatenate([o_h.reshape(b_, t_, -1), o_r.reshape(b_, t_, -1)], axis=-1)
    return o.astype(h.dtype) @ w_out


def alibi_slopes(n):
    return jnp.exp2(-8.0 * jnp.arange(1, n + 1, dtype=jnp.float32) / n)


def compress_blocks(k, pos_emb, w1, w2):
    b_, t_, g_, d = k.shape
    r = CMP_BLOCK // CMP_STRIDE
    ch = k.reshape(b_, t_ // CMP_STRIDE, CMP_STRIDE, g_, d)
    nc = t_ // CMP_STRIDE - r + 1
    blocks = jnp.concatenate([ch[:, j:j + nc] for j in range(r)], axis=2)
    blocks = blocks + pos_emb[None, None, :, None, :]
    flat = blocks.transpose(0, 1, 3, 2, 4).reshape(b_, nc, g_, CMP_BLOCK * d)
    return jax.nn.silu(flat @ w1) @ w2


def cmp_to_slc_overlap(nc, ns):
    c0 = jnp.arange(nc) * CMP_STRIDE
    s0 = jnp.arange(ns) * SLC_BLOCK
    lo = jnp.maximum(c0[:, None], s0[None, :])
    hi = jnp.minimum(c0[:, None] + CMP_BLOCK, s0[None, :] + SLC_BLOCK)
    return (jnp.maximum(hi - lo, 0) / CMP_BLOCK).astype(jnp.float32)


def odd_mixer(h, w_in, cmp_pos_k, cmp_pos_v, cmp_w1_k, cmp_w2_k, cmp_w1_v, cmp_w2_v, w_out):
    b_, t_, _ = h.shape
    H, G, d = NSA_HEADS, NSA_KV_GROUPS, NSA_HD
    R = H // G
    q, kc, vc, ks, vs, kw, vw, gl = split_cols(h @ w_in, ODD_COLS)
    q = q.reshape(b_, t_, H, d) * (d ** -0.5)
    kvh = lambda a: a.reshape(b_, t_, G, d)
    k_cmp = compress_blocks(kvh(kc), cmp_pos_k, cmp_w1_k, cmp_w2_k)
    v_cmp = compress_blocks(kvh(vc), cmp_pos_v, cmp_w1_v, cmp_w2_v)
    nc = k_cmp.shape[1]
    ns = t_ // SLC_BLOCK
    n_sel = min(SLC_TOPN, ns)
    overlap = cmp_to_slc_overlap(nc, ns)
    c_end = jnp.arange(nc) * CMP_STRIDE + CMP_BLOCK - 1
    k_sb = kvh(ks).reshape(b_, ns, SLC_BLOCK, G, d).transpose(0, 3, 1, 2, 4)
    v_sb = kvh(vs).reshape(b_, ns, SLC_BLOCK, G, d).transpose(0, 3, 1, 2, 4)
    kw_pad = jnp.pad(kvh(kw), ((0, 0), (WINDOW, 0), (0, 0), (0, 0)))
    vw_pad = jnp.pad(kvh(vw), ((0, 0), (WINDOW, 0), (0, 0), (0, 0)))
    slopes = alibi_slopes(H).reshape(G, R)
    gates = jax.nn.sigmoid(gl.astype(jnp.float32)).reshape(b_, t_, H, 3)
    gather = jax.vmap(jax.vmap(lambda tbl, ix: tbl[ix]))
    nq = t_ // Q_BLOCK
    f32 = jnp.float32

    def block(args):
        n, qb, gb = args
        qg = qb.reshape(b_, Q_BLOCK, G, R, d)
        t = n * Q_BLOCK + jnp.arange(Q_BLOCK)
        s_c = jnp.einsum('bqgrd,bcgd->bgrqc', qg, k_cmp, preferred_element_type=f32)
        dist_c = (t[:, None] - c_end[None, :]).astype(f32)
        valid_c = dist_c >= 0
        s_c = jnp.where(valid_c, s_c - slopes[None, :, :, None, None] * dist_c, NEG_INF)
        p_c = jax.nn.softmax(s_c, axis=-1) * valid_c
        o_c = jnp.einsum('bgrqc,bcgd->bqgrd', p_c, v_cmp.astype(f32))
        p_slc = jnp.einsum('bgrqc,cj->bgqj', p_c, overlap)
        qblk = t // SLC_BLOCK
        js = jnp.arange(ns)
        forced = (js[None, :] == 0) | (js[None, :] == qblk[:, None]) | (js[None, :] == qblk[:, None] - 1)
        allowed = js[None, :] <= qblk[:, None]
        score = jnp.where(forced, FORCE_SCORE, jnp.where(allowed, p_slc, NEG_INF))
        _, idx = lax.top_k(score, n_sel)
        kg = gather(k_sb, idx)
        vg = gather(v_sb, idx)
        s_s = jnp.einsum('bqgrd,bgqnld->bgrqnl', qg, kg, preferred_element_type=f32)
        spos = idx[..., None] * SLC_BLOCK + jnp.arange(SLC_BLOCK)
        dist_s = (t[None, None, :, None, None] - spos).astype(f32)[:, :, None]
        s_s = jnp.where(dist_s >= 0, s_s - slopes[None, :, :, None, None, None] * dist_s, NEG_INF)
        p_s = jax.nn.softmax(s_s.reshape(b_, G, R, Q_BLOCK, -1), axis=-1).reshape(s_s.shape)
        o_s = jnp.einsum('bgrqnl,bgqnld->bqgrd', p_s, vg.astype(f32))
        kwb = lax.dynamic_slice_in_dim(kw_pad, n * Q_BLOCK, WINDOW + Q_BLOCK, axis=1)
        vwb = lax.dynamic_slice_in_dim(vw_pad, n * Q_BLOCK, WINDOW + Q_BLOCK, axis=1)
        wpos = n * Q_BLOCK - WINDOW + jnp.arange(WINDOW + Q_BLOCK)
        dist_w = t[:, None] - wpos[None, :]
        valid_w = (dist_w >= 0) & (dist_w < WINDOW) & (wpos[None, :] >= 0)
        s_w = jnp.einsum('bqgrd,bkgd->bgrqk', qg, kwb, preferred_element_type=f32)
        s_w = jnp.where(valid_w, s_w - slopes[None, :, :, None, None] * dist_w.astype(f32), NEG_INF)
        p_w = jax.nn.softmax(s_w, axis=-1)
        o_w = jnp.einsum('bgrqk,bkgd->bqgrd', p_w, vwb.astype(f32))
        g5 = gb.reshape(b_, Q_BLOCK, G, R, 3)
        o = g5[..., 0:1] * o_c + g5[..., 1:2] * o_s + g5[..., 2:3] * o_w
        return o.reshape(b_, Q_BLOCK, H * d)

    qblocks = q.reshape(b_, nq, Q_BLOCK, H, d).transpose(1, 0, 2, 3, 4)
    gblocks = gates.reshape(b_, nq, Q_BLOCK, H, 3).transpose(1, 0, 2, 3, 4)
    out = lax.map(block, (jnp.arange(nq), qblocks, gblocks))
    out = out.transpose(1, 0, 2, 3).reshape(b_, t_, H * d)
    return out.astype(h.dtype) @ w_out


def swiglu(h, w_gate_up, w_down):
    g, u = jnp.split(h @ w_gate_up, 2, axis=-1)
    return (jax.nn.silu(g) * u) @ w_down


def setup_inputs(seed: int = 0) -> dict:
    key = jax.random.key(seed)
    ks = jax.random.split(key, 20)
    f32 = jnp.float32
    w = lambda k, shape, fan_in: jax.random.normal(k, shape, f32) * (fan_in ** -0.5)
    gain = lambda k, shape: 1.0 + 0.02 * jax.random.normal(k, shape, f32)
    even_in = sum(EVEN_COLS)
    odd_in = sum(ODD_COLS)
    return {
        'x': jax.random.normal(ks[0], (BATCH, SEQ, D_MODEL), f32),
        'mix_norm': gain(ks[1], (DEPTH, D_MODEL)),
        'ffn_norm': gain(ks[2], (DEPTH, D_MODEL)),
        'final_norm': gain(ks[3], (D_MODEL,)),
        'even_w_in': w(ks[4], (N_EVEN, D_MODEL, even_in), D_MODEL),
        'hgrn_lower_bounds': 0.1 * jax.random.normal(ks[5], (N_EVEN + 1, HGRN_HEADS * HGRN_DK), f32),
        'hgrn_out_norm': gain(ks[6], (N_EVEN, HGRN_DV)),
        'ret_out_norm': gain(ks[7], (N_EVEN, RET_DV)),
        'even_w_out': w(ks[8], (N_EVEN, EVEN_MIX_OUT, D_MODEL), EVEN_MIX_OUT),
        'odd_w_in': w(ks[9], (N_ODD, D_MODEL, odd_in), D_MODEL),
        'cmp_pos_k': 0.1 * jax.random.normal(ks[10], (N_ODD, CMP_BLOCK, NSA_HD), f32),
        'cmp_pos_v': 0.1 * jax.random.normal(ks[11], (N_ODD, CMP_BLOCK, NSA_HD), f32),
        'cmp_w1_k': w(ks[12], (N_ODD, CMP_BLOCK * NSA_HD, NSA_HD), CMP_BLOCK * NSA_HD),
        'cmp_w2_k': w(ks[13], (N_ODD, NSA_HD, NSA_HD), NSA_HD),
        'cmp_w1_v': w(ks[14], (N_ODD, CMP_BLOCK * NSA_HD, NSA_HD), CMP_BLOCK * NSA_HD),
        'cmp_w2_v': w(ks[15], (N_ODD, NSA_HD, NSA_HD), NSA_HD),
        'odd_w_out': w(ks[16], (N_ODD, NSA_HEADS * NSA_HD, D_MODEL), NSA_HEADS * NSA_HD),
        'ffn_w_gate_up': w(ks[17], (DEPTH, D_MODEL, 2 * FFN_HIDDEN), D_MODEL),
        'ffn_w_down': w(ks[18], (DEPTH, FFN_HIDDEN, D_MODEL), FFN_HIDDEN),
    }


def reference(x, mix_norm, ffn_norm, final_norm, even_w_in, hgrn_lower_bounds, hgrn_out_norm,
              ret_out_norm, even_w_out, odd_w_in, cmp_pos_k, cmp_pos_v, cmp_w1_k, cmp_w2_k,
              cmp_w1_v, cmp_w2_v, odd_w_out, ffn_w_gate_up, ffn_w_down):
    lb_all = jnp.cumsum(jax.nn.softmax(hgrn_lower_bounds.astype(jnp.float32), axis=0), axis=0)
    h = x
    for layer in range(DEPTH):
        hn = rmsnorm(h, mix_norm[layer])
        if layer % 2 == 0:
            e = layer // 2
            h = h + even_mixer(hn, even_w_in[e], lb_all[e], hgrn_out_norm[e], ret_out_norm[e], even_w_out[e])
        else:
            o = layer // 2
            h = h + odd_mixer(hn, odd_w_in[o], cmp_pos_k[o], cmp_pos_v[o], cmp_w1_k[o], cmp_w2_k[o],
                              cmp_w1_v[o], cmp_w2_v[o], odd_w_out[o])
        h = h + swiglu(rmsnorm(h, ffn_norm[layer]), ffn_w_gate_up[layer], ffn_w_down[layer])
    return rmsnorm(h, final_norm)
```

```cpp
#include <hip/hip_runtime.h>
#include <hip/hip_cooperative_groups.h>
#include <cstdio>
#include <cstdint>
namespace cg = cooperative_groups;
namespace pg8 {
#define PG8_LAS __attribute__((address_space(3)))
typedef unsigned short bf16_t;
typedef short bf16x8 __attribute__((ext_vector_type(8)));
typedef float f32x4 __attribute__((ext_vector_type(4)));
typedef unsigned u32x4 __attribute__((ext_vector_type(4)));
constexpr int BM = 256, BK = 64, HALF = 128, HTB = HALF * BK * 2  , STAGE_BYTES = 8 * HTB, NXCD = 8, WGM = 8;

__host__ __device__ __forceinline__ int lds_byte(int r, int c) { const int st = (r >> 4) * 2 + (c >> 5), rr = r & 15, cc = c & 31, ob = rr * 64 + cc * 2; return st * 1024 + (ob ^ (((ob >> 9) & 1) << 5)); }
__host__ __device__ __forceinline__ void stage_rc(int b, int& R, int& C) { const int st = b / 1024, sb = b % 1024, swz = sb ^ (((sb >> 9) & 1) << 5); R = (st >> 1) * 16 + swz / 64; C = (st & 1) * 32 + (swz % 64) / 2; }
__host__ __device__ __forceinline__ int perm32(int rho) { const int n = rho >> 4, i = rho & 15; return 8 * (i >> 2) + 4 * n + (i & 3); }

struct Unit { int pm, pn; };
struct Gemm { const bf16_t* A; const bf16_t* Bt; int M, N, K; };

struct StaticOrder {
    int nM, nN, nwg, G, c;
    __host__ __device__ void init(int M, int N, int G_, int c_) { nM = M / BM; nN = N / BM; nwg = nM * nN; G = G_; c = c_; }
    __host__ __device__ bool next(int i, Unit& u) const {
        const long L = (long)i * G + c; if (L >= nwg) return false;
        int wgid = (int)L; { const int q = nwg / NXCD, r = nwg % NXCD, xcd = wgid % NXCD, off = wgid / NXCD; wgid = (xcd < r ? xcd * (q + 1) : r * (q + 1) + (xcd - r) * q) + off; }
        const int nig = WGM * nN, gid = wgid / nig, fm = gid * WGM, gsz = (nM - fm) < WGM ? (nM - fm) : WGM;
        u.pm = fm + ((wgid % nig) % gsz); u.pn = (wgid % nig) / gsz; return true;
    }
    __device__ __forceinline__ void a_ready(const Unit&) const {}
    __device__ __forceinline__ void done(const Unit&) const {}
};

__device__ __forceinline__ unsigned cvt_pk_bf16(float lo, float hi) { unsigned r; asm volatile("v_cvt_pk_bf16_f32 %0, %1, %2" : "=v"(r) : "v"(lo), "v"(hi)); return r; }
template <class Epi, class Sched, bool ALIGN_EPI = false, bool SP2 = false>
__device__ __forceinline__ void gemm_phase(PG8_LAS unsigned char* lds, const Gemm g, const Sched& S, const Epi& E) {
    const int tid = threadIdx.x, wid = __builtin_amdgcn_readfirstlane(tid >> 6), lane = tid & 63, wr = wid >> 2, wc = wid & 3, fr = lane & 15, fq = lane >> 4;
    const int K = g.K, nt = K / BK;
    unsigned voffA[2], voffB[2];
#pragma unroll
    for (int i = 0; i < 2; ++i) { int R, C; stage_rc(tid * 16 + i * 8192, R, C); const int Rb = Epi::PERM ? ((R & ~31) + perm32(R & 31)) : R;
        voffA[i] = (unsigned)(R * K + C) * 2u; voffB[i] = (unsigned)(Rb * K + C) * 2u; }
    const size_t kstep = (size_t)(BK * 2);
    const size_t hstep = (size_t)HALF * K * 2;
    const size_t tstep = 2 * hstep;
    const unsigned ldsw = (unsigned)wid * 1024u;
    const int aoff = lds_byte(wr * 64 + fr, fq * 8), boff = lds_byte(wc * 32 + fr, fq * 8);
#define PG8_SA(b, h) (((b) * 2 + (h)) * HTB)
#define PG8_SB(b, h) ((4 + (b) * 2 + (h)) * HTB)
#define PG8_STAGE(bufoff, gbase, voff) do { _Pragma("unroll") for (int _i = 0; _i < 2; ++_i) \
        __builtin_amdgcn_global_load_lds((const unsigned*)((const char*)(gbase) + (voff)[_i]), (PG8_LAS unsigned*)(lds + (bufoff) + ldsw + _i * 8192), 16, 0, 0); } while (0)
#define PG8_LDA(dst, b, h) do { _Pragma("unroll") for (int m = 0; m < 4; ++m) _Pragma("unroll") for (int k = 0; k < 2; ++k) dst[m][k] = *(const PG8_LAS bf16x8*)(lds + PG8_SA(b, h) + aoff + m * 2048 + k * 1024); } while (0)
#define PG8_LDB(dst, b, h) do { _Pragma("unroll") for (int n = 0; n < 2; ++n) _Pragma("unroll") for (int k = 0; k < 2; ++k) dst[n][k] = *(const PG8_LAS bf16x8*)(lds + PG8_SB(b, h) + boff + n * 2048 + k * 1024); } while (0)
#define PG8_MMA(ai, bj, At, Bt) do { __builtin_amdgcn_s_setprio(1); _Pragma("unroll") for (int m = 0; m < 4; ++m) _Pragma("unroll") for (int n = 0; n < 2; ++n) _Pragma("unroll") for (int k = 0; k < 2; ++k) \
        acc[ai][bj][m][n] = __builtin_amdgcn_mfma_f32_16x16x32_bf16(Bt[n][k], At[m][k], acc[ai][bj][m][n], 0, 0, 0); __builtin_amdgcn_s_setprio(0); } while (0)
#define PG8_WAIT_V(n) asm volatile("s_waitcnt vmcnt(" #n ")" ::: "memory")
#define PG8_WAIT_L(n) asm volatile("s_waitcnt lgkmcnt(" #n ")" ::: "memory")
#define PG8_BAR __builtin_amdgcn_s_barrier()
#define PG8_SCHED __builtin_amdgcn_sched_barrier(0)
    Unit cur, nxt; int ui = 0;
    if (!S.next(0, cur)) return;
    f32x4 acc[2][2][4][2];
#pragma unroll
    for (int a = 0; a < 2; ++a)
#pragma unroll
        for (int b = 0; b < 2; ++b)
#pragma unroll
            for (int m = 0; m < 4; ++m)
#pragma unroll
                for (int n = 0; n < 2; ++n) acc[a][b][m][n] = (f32x4){0.f, 0.f, 0.f, 0.f};
    bf16x8 At[4][2], B0[2][2], B1[2][2];
    const char* cA = (const char*)g.A + (size_t)cur.pm * tstep; const char* cB = (const char*)g.Bt + (size_t)cur.pn * tstep;
    S.a_ready(cur);
    if constexpr (SP2) {
        PG8_STAGE(PG8_SB(0, 0), cB, voffB); PG8_STAGE(PG8_SB(0, 1), cB + hstep, voffB); PG8_STAGE(PG8_SA(0, 0), cA, voffA); PG8_STAGE(PG8_SA(0, 1), cA + hstep, voffA);
        if (wr == 1) PG8_BAR;
        PG8_WAIT_V(2); PG8_BAR;
        PG8_STAGE(PG8_SB(1, 0), cB + kstep, voffB); PG8_STAGE(PG8_SA(1, 0), cA + kstep, voffA); PG8_STAGE(PG8_SB(1, 1), cB + hstep + kstep, voffB);
        PG8_WAIT_V(6); PG8_BAR;
    } else {
        PG8_STAGE(PG8_SB(0, 0), cB, voffB); PG8_STAGE(PG8_SA(0, 0), cA, voffA); PG8_STAGE(PG8_SB(0, 1), cB + hstep, voffB); PG8_STAGE(PG8_SA(0, 1), cA + hstep, voffA);
        if (wr == 1) PG8_BAR;
        PG8_WAIT_V(4); PG8_BAR;
        PG8_STAGE(PG8_SB(1, 0), cB + kstep, voffB); PG8_STAGE(PG8_SA(1, 0), cA + kstep, voffA); PG8_STAGE(PG8_SB(1, 1), cB + hstep + kstep, voffB);
        PG8_WAIT_V(6); PG8_BAR;
    }
    for (;;) {
        const bool has_next = S.next(ui + 1, nxt);
        const char* nA = has_next ? (const char*)g.A + (size_t)nxt.pm * tstep : cA; const char* nB = has_next ? (const char*)g.Bt + (size_t)nxt.pn * tstep : cB;
        for (int t = 0; t < nt; t += 2) {
            const bool last = (t == nt - 2);
            const char* a1 = cA + (size_t)(t + 1) * kstep;
            const char* a2 = last ? nA : cA + (size_t)(t + 2) * kstep; const char* b2 = last ? nB : cB + (size_t)(t + 2) * kstep;
            const char* a3 = a2 + kstep; const char* b3 = b2 + kstep;
            if (last && has_next) S.a_ready(nxt);
            if constexpr (SP2) {
            PG8_LDB(B0, 0, 0); PG8_LDB(B1, 0, 1); PG8_SCHED; PG8_LDA(At, 0, 0); PG8_STAGE(PG8_SA(1, 1), a1 + hstep, voffA);
            PG8_WAIT_V(8); PG8_WAIT_L(0); PG8_BAR; PG8_MMA(0, 0, At, B0); PG8_MMA(0, 1, At, B1); PG8_BAR; PG8_SCHED;
            PG8_LDA(At, 0, 1); PG8_STAGE(PG8_SB(0, 0), b2, voffB); PG8_STAGE(PG8_SB(0, 1), b2 + hstep, voffB); PG8_STAGE(PG8_SA(0, 0), a2, voffA);
            PG8_WAIT_V(8); PG8_WAIT_L(0); PG8_BAR; PG8_MMA(1, 0, At, B0); PG8_MMA(1, 1, At, B1); PG8_BAR; PG8_SCHED;
            PG8_LDB(B0, 1, 0); PG8_LDB(B1, 1, 1); PG8_SCHED; PG8_LDA(At, 1, 0); PG8_STAGE(PG8_SA(0, 1), a2 + hstep, voffA);
            PG8_WAIT_V(8); PG8_WAIT_L(0); PG8_BAR; PG8_MMA(0, 0, At, B0); PG8_MMA(0, 1, At, B1); PG8_BAR; PG8_SCHED;
            PG8_LDA(At, 1, 1); PG8_STAGE(PG8_SB(1, 0), b3, voffB); PG8_STAGE(PG8_SB(1, 1), b3 + hstep, voffB); PG8_STAGE(PG8_SA(1, 0), a3, voffA);
            PG8_WAIT_V(8); PG8_WAIT_L(0); PG8_BAR; PG8_MMA(1, 0, At, B0); PG8_MMA(1, 1, At, B1); PG8_BAR; PG8_SCHED;
            } else {
            PG8_LDB(B0, 0, 0); PG8_SCHED; PG8_LDA(At, 0, 0); PG8_STAGE(PG8_SA(1, 1), a1 + hstep, voffA);
            PG8_WAIT_L(8); PG8_BAR; PG8_WAIT_L(0); PG8_MMA(0, 0, At, B0); PG8_BAR; PG8_SCHED;
            PG8_LDB(B1, 0, 1); PG8_STAGE(PG8_SB(0, 0), b2, voffB);
            PG8_BAR; PG8_WAIT_L(0); PG8_MMA(0, 1, At, B1); PG8_BAR;
            PG8_LDA(At, 0, 1); PG8_STAGE(PG8_SA(0, 0), a2, voffA);
            PG8_BAR; PG8_WAIT_L(0); PG8_MMA(1, 0, At, B0); PG8_BAR; PG8_SCHED;
            PG8_STAGE(PG8_SB(0, 1), b2 + hstep, voffB);
            PG8_WAIT_V(6); PG8_BAR; PG8_MMA(1, 1, At, B1); PG8_BAR;
            PG8_LDB(B0, 1, 0); PG8_SCHED; PG8_LDA(At, 1, 0); PG8_STAGE(PG8_SA(0, 1), a2 + hstep, voffA);
            PG8_WAIT_L(8); PG8_BAR; PG8_WAIT_L(0); PG8_MMA(0, 0, At, B0); PG8_BAR; PG8_SCHED;
            PG8_LDB(B1, 1, 1); PG8_STAGE(PG8_SB(1, 0), b3, voffB);
            PG8_BAR; PG8_WAIT_L(0); PG8_MMA(0, 1, At, B1); PG8_BAR;
            PG8_LDA(At, 1, 1); PG8_STAGE(PG8_SA(1, 0), a3, voffA);
            PG8_BAR; PG8_WAIT_L(0); PG8_MMA(1, 0, At, B0); PG8_BAR; PG8_SCHED;
            PG8_STAGE(PG8_SB(1, 1), b3 + hstep, voffB);
            PG8_WAIT_V(6); PG8_BAR; PG8_MMA(1, 1, At, B1); PG8_BAR;
            }
        }
        if constexpr (ALIGN_EPI) { if (wr == 0) PG8_BAR; }
        if constexpr (!Epi::AFTER_DRAIN) { E(acc, cur, wr, wc, fr, fq); S.done(cur); }
        if (!has_next) break;
#pragma unroll
        for (int a = 0; a < 2; ++a)
#pragma unroll
            for (int b = 0; b < 2; ++b)
#pragma unroll
                for (int m = 0; m < 4; ++m)
#pragma unroll
                    for (int n = 0; n < 2; ++n) acc[a][b][m][n] = (f32x4){0.f, 0.f, 0.f, 0.f};
        cur = nxt; cA = nA; cB = nB; ++ui;
        if constexpr (ALIGN_EPI) { if (wr == 1) PG8_BAR; }
    }
    PG8_WAIT_V(0);
    if constexpr (!ALIGN_EPI) { if (wr == 0) PG8_BAR; }
    PG8_BAR;
    if constexpr (Epi::AFTER_DRAIN) { E.fused(acc, cur, wr, wc, fr, fq, lds, wid, lane); S.done(cur); }
#undef PG8_SA
#undef PG8_SB
#undef PG8_STAGE
#undef PG8_LDA
#undef PG8_LDB
#undef PG8_MMA
#undef PG8_WAIT_V
#undef PG8_WAIT_L
#undef PG8_BAR
#undef PG8_SCHED
}
}
#define GAS __attribute__((address_space(1)))
#define LAS __attribute__((address_space(3)))
#define DI __device__ __forceinline__
typedef unsigned short bf16;
typedef short bf16x8 __attribute__((ext_vector_type(8)));
typedef short s16x4 __attribute__((ext_vector_type(4)));
typedef float f32x4 __attribute__((ext_vector_type(4)));
typedef float f32x2 __attribute__((ext_vector_type(2)));
typedef unsigned u32x4 __attribute__((ext_vector_type(4)));
typedef unsigned u32x2 __attribute__((ext_vector_type(2)));
typedef __bf16 bf16x2_t __attribute__((ext_vector_type(2)));
#define MFMA16(a, b, c) __builtin_amdgcn_mfma_f32_16x16x32_bf16((a), (b), (c), 0, 0, 0)

constexpr int NB = 4, T = 8192, D = 1024, M = NB * T, FF = 2816;
constexpr int EIN = 4096, OIN = 1840, OINP = 2048;
constexpr float RMS_EPS = 1e-6f, LOG2E = 1.4426950408889634f;
constexpr size_t MiB = 1u << 20;
constexpr size_t WS_EIN = 0, WS_EOUT = 8 * MiB, WS_OIN = 10 * MiB, WS_OOUT = 14 * MiB, WS_GU = 16 * MiB, WS_DN = 38 * MiB;
constexpr size_t WS_W1K = 49 * MiB, WS_W1V = WS_W1K + 256 * 1024, WS_W2K = WS_W1V + 256 * 1024, WS_W2V = WS_W2K + 8192;
constexpr size_t WS_DEC = 52 * MiB, WS_KCMP = 54 * MiB, WS_VCMPT = WS_KCMP + 512 * 1024;
constexpr size_t WS_Y = 64 * MiB;
constexpr size_t WS_VST = 192 * MiB, WS_VWT = 200 * MiB;
constexpr size_t WS_HN = 320 * MiB, WS_END = 384 * MiB;
constexpr size_t GU_STRIDE = (size_t)2 * FF * D, DN_STRIDE = (size_t)D * FF;
constexpr int LDS_BYTES = 147456;

DI unsigned pk2(float lo, float hi) { f32x2 v = {lo, hi}; return __builtin_bit_cast(unsigned, __builtin_convertvector(v, bf16x2_t)); }
DI bf16 f2bf(float f) { return (bf16)(pk2(f, 0.f) & 0xffffu); }
DI float bf2f(bf16 x) { return __uint_as_float(((unsigned)x) << 16); }
DI float bflo(unsigned w) { return __uint_as_float(w << 16); }
DI float bfhi(unsigned w) { return __uint_as_float(w & 0xffff0000u); }
DI float wave_sum(float v) {
#pragma unroll
    for (int o = 1; o < 64; o <<= 1) v += __shfl_xor(v, o);
    return v;
}
DI float sigmoidf_(float x) { return 1.0f / (1.0f + __expf(-x)); }
DI float siluf_(float x) { return x / (1.0f + __expf(-x)); }

struct EpiStore {
    static constexpr bool PERM = true, AFTER_DRAIN = false;
    bf16* O; int ldc;
    DI void operator()(const pg8::f32x4 (&acc)[2][2][4][2], const pg8::Unit& u, int wr, int wc, int fr, int fq) const {
        const int row0 = u.pm * 256 + wr * 64 + fr, col0 = u.pn * 256 + wc * 32 + 8 * fq;
#pragma unroll
        for (int ai = 0; ai < 2; ++ai)
#pragma unroll
            for (int m = 0; m < 4; ++m) { bf16* rowp = O + (size_t)(row0 + ai * 128 + m * 16) * ldc + col0;
#pragma unroll
                for (int bj = 0; bj < 2; ++bj) { const pg8::f32x4 v0 = acc[ai][bj][m][0], v1 = acc[ai][bj][m][1];
                    u32x4 w; w.x = pk2(v0[0], v0[1]); w.y = pk2(v0[2], v0[3]); w.z = pk2(v1[0], v1[1]); w.w = pk2(v1[2], v1[3]);
                    *(u32x4*)(rowp + bj * 128) = w; } }
    }
};
struct EpiSwiglu {
    static constexpr bool PERM = true, AFTER_DRAIN = false;
    bf16* O;
    DI void operator()(const pg8::f32x4 (&acc)[2][2][4][2], const pg8::Unit& u, int wr, int wc, int fr, int fq) const {
        const int row0 = u.pm * 256 + wr * 64 + fr, col0 = u.pn * 128 + wc * 32 + 8 * fq;
#pragma unroll
        for (int ai = 0; ai < 2; ++ai)
#pragma unroll
            for (int m = 0; m < 4; ++m) { bf16* rowp = O + (size_t)(row0 + ai * 128 + m * 16) * FF + col0;
                float r[8];
#pragma unroll
                for (int n = 0; n < 2; ++n)
#pragma unroll
                    for (int e = 0; e < 4; ++e) { const float g = acc[ai][0][m][n][e], up = acc[ai][1][m][n][e]; r[n * 4 + e] = g * __builtin_amdgcn_rcpf(1.0f + __expf(-g)) * up; }
                u32x4 w; w.x = pk2(r[0], r[1]); w.y = pk2(r[2], r[3]); w.z = pk2(r[4], r[5]); w.w = pk2(r[6], r[7]);
                *(u32x4*)rowp = w; }
    }
};
struct EpiResid {
    static constexpr bool PERM = false, AFTER_DRAIN = false;
    const float* base; float* out;
    DI void operator()(const pg8::f32x4 (&acc)[2][2][4][2], const pg8::Unit& u, int wr, int wc, int fr, int fq) const {
        const int row0 = u.pm * 256 + wr * 64 + fr, col0 = u.pn * 256 + wc * 32 + 4 * fq;
#pragma unroll
        for (int ai = 0; ai < 2; ++ai)
#pragma unroll
            for (int m = 0; m < 4; ++m) { const size_t off = (size_t)(row0 + ai * 128 + m * 16) * D + col0;
#pragma unroll
                for (int bj = 0; bj < 2; ++bj)
#pragma unroll
                    for (int n = 0; n < 2; ++n) { const f32x4 bs = *(const f32x4*)(base + off + bj * 128 + n * 16); const pg8::f32x4 a = acc[ai][bj][m][n];
                        f32x4 o; o.x = bs.x + a[0]; o.y = bs.y + a[1]; o.z = bs.z + a[2]; o.w = bs.w + a[3]; *(f32x4*)(out + off + bj * 128 + n * 16) = o; } }
    }
};

DI void transpose_item(const float* W, int K, int N, int Npad, bf16* WT, int mode, LAS float* scr, int item, int lane) {
    const int nblk = Npad / 32, kb = item / nblk, nb = item % nblk, k0 = 64 * kb, n0 = 32 * nb;
    const int nl = n0 + (lane & 31);
#pragma unroll 8
    for (int i = 0; i < 32; ++i) { const int kk = 2 * i + (lane >> 5); scr[kk * 33 + (lane & 31)] = (nl < N) ? W[(size_t)(k0 + kk) * N + nl] : 0.f; }
    asm volatile("s_waitcnt lgkmcnt(0)" ::: "memory");
    const int c = lane & 7;
    int drow0 = n0;
    if (mode == 1) { drow0 = (n0 < FF) ? (256 * (n0 >> 7) + (n0 & 127)) : (256 * ((n0 - FF) >> 7) + 128 + ((n0 - FF) & 127)); }
#pragma unroll
    for (int j = 0; j < 4; ++j) { const int n = (lane >> 3) + 8 * j; const LAS float* s = scr + (8 * c) * 33 + n;
        u32x4 o; o.x = pk2(s[0 * 33], s[1 * 33]); o.y = pk2(s[2 * 33], s[3 * 33]); o.z = pk2(s[4 * 33], s[5 * 33]); o.w = pk2(s[6 * 33], s[7 * 33]);
        *(u32x4*)(WT + (size_t)(drow0 + n) * K + k0 + 8 * c) = o; }
    asm volatile("s_waitcnt lgkmcnt(0)" ::: "memory");
}
DI void norm_rows_bf16(const float* h, const float* g, bf16* out, int gw, int ngw, int lane) {
    f32x4 gv[4];
#pragma unroll
    for (int j = 0; j < 4; ++j) gv[j] = *((const f32x4*)g + lane + 64 * j);
    for (int m = gw; m < M; m += ngw) {
        const f32x4* xr = (const f32x4*)(h + (size_t)m * D) + lane; f32x4 v[4]; float s = 0.f;
#pragma unroll
        for (int j = 0; j < 4; ++j) { v[j] = xr[64 * j]; s += (v[j].x * v[j].x + v[j].y * v[j].y) + (v[j].z * v[j].z + v[j].w * v[j].w); }
        const float r = rsqrtf(wave_sum(s) * (1.f / D) + RMS_EPS);
        u32x2* o8 = (u32x2*)(out + (size_t)m * D) + lane;
#pragma unroll
        for (int j = 0; j < 4; ++j) { u32x2 w; w.x = pk2(v[j].x * r * gv[j].x, v[j].y * r * gv[j].y); w.y = pk2(v[j].z * r * gv[j].z, v[j].w * r * gv[j].w); o8[64 * j] = w; }
    }
}
DI void norm_rows_f32_inplace(float* h, const float* g, int gw, int ngw, int lane) {
    f32x4 gv[4];
#pragma unroll
    for (int j = 0; j < 4; ++j) gv[j] = *((const f32x4*)g + lane + 64 * j);
    for (int m = gw; m < M; m += ngw) {
        f32x4* xr = (f32x4*)(h + (size_t)m * D) + lane; f32x4 v[4]; float s = 0.f;
#pragma unroll
        for (int j = 0; j < 4; ++j) { v[j] = xr[64 * j]; s += (v[j].x * v[j].x + v[j].y * v[j].y) + (v[j].z * v[j].z + v[j].w * v[j].w); }
        const float r = rsqrtf(wave_sum(s) * (1.f / D) + RMS_EPS);
#pragma unroll
        for (int j = 0; j < 4; ++j) { f32x4 o; o.x = v[j].x * r * gv[j].x; o.y = v[j].y * r * gv[j].y; o.z = v[j].z * r * gv[j].z; o.w = v[j].w * r * gv[j].w; xr[64 * j] = o; }
    }
}
constexpr int LA_UNITS = NB * 8 * 128;
constexpr int KT_LD = 72, QT_LD = 136;
template <bool WANT_Q>
DI void la_load_col(const bf16* Yb, int hh, int d, int rg, const float* lbraw, float (&lg)[16], float (&kk)[16], float (&qq)[16]) {
    if (hh < 4) {
        const float a = lbraw[hh * 128 + d], b2 = lbraw[512 + hh * 128 + d];
        const float mx = fmaxf(a, b2), ea = __expf(a - mx), eb = __expf(b2 - mx), lbv = ea / (ea + eb);
        const bf16* pf = Yb + (size_t)(16 * rg) * EIN + 512 + hh * 128 + d;
        const bf16* pq = Yb + (size_t)(16 * rg) * EIN + hh * 128 + d;
#pragma unroll
        for (int e = 0; e < 16; ++e) { const float x = bf2f(pf[(size_t)e * EIN]); const float f = lbv + (1.f - lbv) * sigmoidf_(x); lg[e] = __logf(f); kk[e] = 1.f - f;
            if (WANT_Q) qq[e] = siluf_(bf2f(pq[(size_t)e * EIN])); }
    } else {
        const int r = hh - 4; const float lgam = __logf(1.f - exp2f(-5.f - (float)r));
        const bf16* pk = Yb + (size_t)(16 * rg) * EIN + 2560 + r * 128 + d;
        const bf16* pq = Yb + (size_t)(16 * rg) * EIN + 2048 + r * 128 + d;
#pragma unroll
        for (int e = 0; e < 16; ++e) { lg[e] = lgam; kk[e] = bf2f(pk[(size_t)e * EIN]) * 0.08838834764831845f; if (WANT_Q) qq[e] = bf2f(pq[(size_t)e * EIN]); }
    }
    float run = 0.f;
#pragma unroll
    for (int e = 0; e < 16; ++e) { run += lg[e]; lg[e] = run; }
}
DI void la_stage_vt(const bf16* Yb, int hh, int d, int rg, LAS bf16* VT) {
    const bf16* pv = Yb + (size_t)(16 * rg) * EIN + (hh < 4 ? 1024 + hh * 128 : 3072 + (hh - 4) * 128) + d;
    unsigned w[8];
#pragma unroll
    for (int e = 0; e < 8; ++e) w[e] = (unsigned)pv[(size_t)(2 * e) * EIN] | ((unsigned)pv[(size_t)(2 * e + 1) * EIN] << 16);
    LAS u32x4* dst = (LAS u32x4*)(VT + d * KT_LD + 16 * rg);
    dst[0] = (u32x4){w[0], w[1], w[2], w[3]}; dst[1] = (u32x4){w[4], w[5], w[6], w[7]};
}
DI void la_state_phase(const bf16* Y0, const float* lbraw, bf16* ST, float* DEC, LAS unsigned char* lds) {
    LAS bf16* KT = (LAS bf16*)lds; LAS bf16* VT = KT + 128 * KT_LD; LAS float* tot = (LAS float*)(VT + 128 * KT_LD);
    const int tid = threadIdx.x, lane = tid & 63, w = tid >> 6, l15 = lane & 15, q = lane >> 4, d = tid & 127, rg = tid >> 7;
    for (int unit = blockIdx.x; unit < LA_UNITS; unit += gridDim.x) {
        const int b = unit >> 10, hh = (unit >> 7) & 7, n = unit & 127;
        const bf16* Yb = Y0 + (size_t)(b * T + n * 64) * EIN;
        float lg[16], kk[16], qq[16];
        la_load_col<false>(Yb, hh, d, rg, lbraw, lg, kk, qq);
        tot[rg * 128 + d] = lg[15];
        la_stage_vt(Yb, hh, d, rg, VT);
        __syncthreads();
        float pre = 0.f, last = 0.f;
#pragma unroll
        for (int g2 = 0; g2 < 4; ++g2) { const float tv = tot[g2 * 128 + d]; if (g2 < rg) pre += tv; last += tv; }
        unsigned wv[8];
#pragma unroll
        for (int e = 0; e < 8; ++e) { const float c0 = pre + lg[2 * e], c1 = pre + lg[2 * e + 1]; wv[e] = pk2(kk[2 * e] * __expf(last - c0), kk[2 * e + 1] * __expf(last - c1)); }
        LAS u32x4* dst = (LAS u32x4*)(KT + d * KT_LD + 16 * rg);
        dst[0] = (u32x4){wv[0], wv[1], wv[2], wv[3]}; dst[1] = (u32x4){wv[4], wv[5], wv[6], wv[7]};
        if (rg == 0) DEC[(size_t)unit * 128 + d] = __expf(last);
        __syncthreads();
        f32x4 acc[8];
#pragma unroll
        for (int dt = 0; dt < 8; ++dt) acc[dt] = (f32x4){0.f, 0.f, 0.f, 0.f};
#pragma unroll
        for (int ks = 0; ks < 2; ++ks) { const bf16x8 bv = *(const LAS bf16x8*)(VT + (16 * w + l15) * KT_LD + 32 * ks + 8 * q);
#pragma unroll
            for (int dt = 0; dt < 8; ++dt) { const bf16x8 ak = *(const LAS bf16x8*)(KT + (16 * dt + l15) * KT_LD + 32 * ks + 8 * q); acc[dt] = MFMA16(ak, bv, acc[dt]); } }
        bf16* so = ST + (size_t)unit * 16384 + (16 * w + l15) * 128 + 4 * q;
#pragma unroll
        for (int dt = 0; dt < 8; ++dt) { u32x2 o; o.x = pk2(acc[dt][0], acc[dt][1]); o.y = pk2(acc[dt][2], acc[dt][3]); *(u32x2*)(so + 16 * dt) = o; }
        __syncthreads();
    }
}
DI void la_scan_phase(bf16* ST, const float* DEC) {
    const int gid = blockIdx.x * 512 + threadIdx.x, nth = gridDim.x * 512;
    for (int wk = gid; wk < 32 * 4096; wk += nth) {
        const int bh = wk >> 12, e4 = (wk & 4095) * 4, d = e4 & 127;
        f32x4 s = {0.f, 0.f, 0.f, 0.f};
        bf16* sp = ST + (size_t)bh * 128 * 16384 + e4; const float* dp = DEC + (size_t)bh * 128 * 128 + d;
        for (int n0 = 0; n0 < 128; n0 += 8) {
            u32x2 uv[8]; f32x4 dv[8];
#pragma unroll
            for (int i = 0; i < 8; ++i) { uv[i] = *(const u32x2*)(sp + (size_t)(n0 + i) * 16384); dv[i] = *(const f32x4*)(dp + (size_t)(n0 + i) * 128); }
#pragma unroll
            for (int i = 0; i < 8; ++i) { u32x2 o; o.x = pk2(s.x, s.y); o.y = pk2(s.z, s.w); *(u32x2*)(sp + (size_t)(n0 + i) * 16384) = o;
                s.x = dv[i].x * s.x + bflo(uv[i].x); s.y = dv[i].y * s.y + bfhi(uv[i].x); s.z = dv[i].z * s.z + bflo(uv[i].y); s.w = dv[i].w * s.w + bfhi(uv[i].y); }
        }
    }
}
DI void la_out_phase(const bf16* Y0, const float* lbraw, const bf16* ST, const float* gh, const float* gr, bf16* MIX, LAS unsigned char* lds) {
    LAS bf16* QT = (LAS bf16*)lds; LAS bf16* K2 = QT + 64 * QT_LD; LAS bf16* QS = K2 + 64 * QT_LD; LAS bf16* VT = QS + 64 * QT_LD;
    LAS float* tot = (LAS float*)(VT + 128 * KT_LD); LAS float* ssq = tot + 512;
    const int tid = threadIdx.x, lane = tid & 63, w = tid >> 6, l15 = lane & 15, q = lane >> 4, d = tid & 127, rg = tid >> 7;
    const int it = w & 3, vh = w >> 2;
    for (int unit = blockIdx.x; unit < LA_UNITS; unit += gridDim.x) {
        const int b = unit >> 10, hh = (unit >> 7) & 7, n = unit & 127;
        const int row0 = b * T + n * 64;
        const bf16* Yb = Y0 + (size_t)row0 * EIN;
        float lg[16], kk[16], qq[16];
        la_load_col<true>(Yb, hh, d, rg, lbraw, lg, kk, qq);
        tot[rg * 128 + d] = lg[15];
        la_stage_vt(Yb, hh, d, rg, VT);
        __syncthreads();
        float pre = 0.f;
#pragma unroll
        for (int g2 = 0; g2 < 4; ++g2) { const float tv = tot[g2 * 128 + d]; if (g2 < rg) pre += tv; }
        const float ref = tot[d] + tot[128 + d];
#pragma unroll
        for (int e = 0; e < 16; ++e) { const float c = pre + lg[e]; const int j = 16 * rg + e;
            QT[j * QT_LD + d] = f2bf(qq[e] * __expf(c - ref)); K2[j * QT_LD + d] = f2bf(kk[e] * __expf(ref - c)); QS[j * QT_LD + d] = f2bf(qq[e] * __expf(c)); }
        __syncthreads();
        f32x4 at[4];
#pragma unroll
        for (int jt = 0; jt < 4; ++jt) at[jt] = (f32x4){0.f, 0.f, 0.f, 0.f};
#pragma unroll
        for (int ks = 0; ks < 4; ++ks) { const bf16x8 bq = *(const LAS bf16x8*)(QT + (16 * it + l15) * QT_LD + 32 * ks + 8 * q);
#pragma unroll
            for (int jt = 0; jt < 4; ++jt) { const bf16x8 ak = *(const LAS bf16x8*)(K2 + (16 * jt + l15) * QT_LD + 32 * ks + 8 * q); at[jt] = MFMA16(ak, bq, at[jt]); } }
        const int irow = 16 * it + l15;
#pragma unroll
        for (int jt = 0; jt < 4; ++jt)
#pragma unroll
            for (int r = 0; r < 4; ++r) { const int j = 16 * jt + 4 * q + r; if (j > irow) at[jt][r] = 0.f; }
        f32x4 o[4];
#pragma unroll
        for (int vt = 0; vt < 4; ++vt) o[vt] = (f32x4){0.f, 0.f, 0.f, 0.f};
#pragma unroll
        for (int k2 = 0; k2 < 2; ++k2) {
            u32x4 pw; pw.x = pk2(at[2 * k2][0], at[2 * k2][1]); pw.y = pk2(at[2 * k2][2], at[2 * k2][3]); pw.z = pk2(at[2 * k2 + 1][0], at[2 * k2 + 1][1]); pw.w = pk2(at[2 * k2 + 1][2], at[2 * k2 + 1][3]);
            const bf16x8 pf = __builtin_bit_cast(bf16x8, pw);
#pragma unroll
            for (int vt = 0; vt < 4; ++vt) { const LAS bf16* vp = VT + (64 * vh + 16 * vt + l15) * KT_LD + 32 * k2 + 4 * q;
                const u32x2 lo = *(const LAS u32x2*)vp, hi = *(const LAS u32x2*)(vp + 16);
                const bf16x8 av = __builtin_bit_cast(bf16x8, ((u32x4){lo.x, lo.y, hi.x, hi.y})); o[vt] = MFMA16(av, pf, o[vt]); }
        }
        const bf16* sb = ST + (size_t)unit * 16384;
#pragma unroll
        for (int ks = 0; ks < 4; ++ks) { const bf16x8 bq = *(const LAS bf16x8*)(QS + (16 * it + l15) * QT_LD + 32 * ks + 8 * q);
#pragma unroll
            for (int vt = 0; vt < 4; ++vt) { const bf16x8 as = *(const bf16x8*)(sb + (64 * vh + 16 * vt + l15) * 128 + 32 * ks + 8 * q); o[vt] = MFMA16(as, bq, o[vt]); } }
        float ss = 0.f;
#pragma unroll
        for (int vt = 0; vt < 4; ++vt) ss += (o[vt][0] * o[vt][0] + o[vt][1] * o[vt][1]) + (o[vt][2] * o[vt][2] + o[vt][3] * o[vt][3]);
        ss += __shfl_xor(ss, 16); ss += __shfl_xor(ss, 32);
        if (q == 0) ssq[vh * 64 + irow] = ss;
        __syncthreads();
        const float rs = rsqrtf((ssq[irow] + ssq[64 + irow]) * (1.f / 128.f) + RMS_EPS);
        const float* gn = (hh < 4) ? gh : gr;
        const bf16* gp = Yb + (size_t)irow * EIN + (hh < 4 ? 1536 + hh * 128 : 3584 + (hh - 4) * 128);
        bf16* op = MIX + (size_t)(row0 + irow) * D + hh * 128;
#pragma unroll
        for (int vt = 0; vt < 4; ++vt) { const int v0 = 64 * vh + 16 * vt + 4 * q; const f32x4 gv = *(const f32x4*)(gn + v0); const u32x2 gw = *(const u32x2*)(gp + v0);
            u32x2 ow; ow.x = pk2(o[vt][0] * rs * gv.x * siluf_(bflo(gw.x)), o[vt][1] * rs * gv.y * siluf_(bfhi(gw.x)));
            ow.y = pk2(o[vt][2] * rs * gv.z * siluf_(bflo(gw.y)), o[vt][3] * rs * gv.w * siluf_(bfhi(gw.y))); *(u32x2*)(op + v0) = ow; }
        __syncthreads();
    }
}
constexpr int NC = 511, NCP = 512;
DI void nsa_compress_phase(const bf16* Y1, const float* posk, const float* posv, const bf16* w1kT, const bf16* w1vT, const bf16* w2kT, const bf16* w2vT,
                           bf16* KCMP, bf16* VCMPT, int gw, int ngw, int lane) {
    const int l15 = lane & 15, q = lane >> 4;
    for (int task = gw; task < 512; task += ngw) {
        const int kv = task & 1, rt = task >> 1;
        int r = rt * 16 + l15; const bool rvalid = r < NB * NC * 2; if (!rvalid) r = NB * NC * 2 - 1;
        const int b = r / (NC * 2), rem = r % (NC * 2), i = rem >> 1, g = rem & 1;
        const bf16* src = Y1 + (size_t)(b * T + 16 * i) * OINP + (kv ? 1152 : 1024) + g * 64;
        const float* pos = kv ? posv : posk; const bf16* w1 = kv ? w1vT : w1kT; const bf16* w2 = kv ? w2vT : w2kT;
        f32x4 acc[4];
#pragma unroll
        for (int nt = 0; nt < 4; ++nt) acc[nt] = (f32x4){0.f, 0.f, 0.f, 0.f};
        for (int ks = 0; ks < 64; ++ks) {
            const int p = ks >> 1, d0 = (ks & 1) * 32 + 8 * q;
            const u32x4 xv = *(const u32x4*)(src + (size_t)p * OINP + d0);
            const f32x4 p0 = *(const f32x4*)(pos + p * 64 + d0), p1 = *(const f32x4*)(pos + p * 64 + d0 + 4);
            u32x4 bw; bw.x = pk2(bflo(xv.x) + p0.x, bfhi(xv.x) + p0.y); bw.y = pk2(bflo(xv.y) + p0.z, bfhi(xv.y) + p0.w);
            bw.z = pk2(bflo(xv.z) + p1.x, bfhi(xv.z) + p1.y); bw.w = pk2(bflo(xv.w) + p1.z, bfhi(xv.w) + p1.w);
            const bf16x8 bf = __builtin_bit_cast(bf16x8, bw);
#pragma unroll
            for (int nt = 0; nt < 4; ++nt) { const bf16x8 af = *(const bf16x8*)(w1 + (size_t)(16 * nt + l15) * 2048 + 32 * ks + 8 * q); acc[nt] = MFMA16(af, bf, acc[nt]); }
        }
        f32x4 o2[4];
#pragma unroll
        for (int t2 = 0; t2 < 4; ++t2) o2[t2] = (f32x4){0.f, 0.f, 0.f, 0.f};
#pragma unroll
        for (int k2 = 0; k2 < 2; ++k2) {
            u32x4 pw; pw.x = pk2(siluf_(acc[2 * k2][0]), siluf_(acc[2 * k2][1])); pw.y = pk2(siluf_(acc[2 * k2][2]), siluf_(acc[2 * k2][3]));
            pw.z = pk2(siluf_(acc[2 * k2 + 1][0]), siluf_(acc[2 * k2 + 1][1])); pw.w = pk2(siluf_(acc[2 * k2 + 1][2]), siluf_(acc[2 * k2 + 1][3]));
            const bf16x8 pf = __builtin_bit_cast(bf16x8, pw);
#pragma unroll
            for (int t2 = 0; t2 < 4; ++t2) { const bf16* wp = w2 + (16 * t2 + l15) * 64 + 32 * k2 + 4 * q;
                const u32x2 lo = *(const u32x2*)wp, hi = *(const u32x2*)(wp + 16);
                const bf16x8 av = __builtin_bit_cast(bf16x8, ((u32x4){lo.x, lo.y, hi.x, hi.y})); o2[t2] = MFMA16(av, pf, o2[t2]); }
        }
        if (rvalid) {
            if (kv == 0) { bf16* op = KCMP + ((size_t)(b * 2 + g) * NCP + i) * 64 + 4 * q;
#pragma unroll
                for (int t2 = 0; t2 < 4; ++t2) { u32x2 ow; ow.x = pk2(o2[t2][0], o2[t2][1]); ow.y = pk2(o2[t2][2], o2[t2][3]); *(u32x2*)(op + 16 * t2) = ow; }
            } else { bf16* op = VCMPT + (size_t)(b * 2 + g) * 64 * NCP + i;
#pragma unroll
                for (int t2 = 0; t2 < 4; ++t2)
#pragma unroll
                    for (int r2 = 0; r2 < 4; ++r2) op[(size_t)(16 * t2 + 4 * q + r2) * NCP] = f2bf(o2[t2][r2]); }
        }
    }
    for (int z = gw * 64 + lane; z < NB * 2 * 64; z += ngw * 64) { const int bg = z >> 6, dd = z & 63; KCMP[((size_t)bg * NCP + NC) * 64 + dd] = 0; VCMPT[((size_t)bg * 64 + dd) * NCP + NC] = 0; }
}
DI void nsa_vt_phase(const bf16* Y1, bf16* VST, bf16* VWT, int gw, int ngw, int lane) {
    for (int task = gw; task < 2 * NB * 2 * 128; task += ngw) {
        const int which = task & 1, g = (task >> 1) & 1, b = (task >> 2) & 3, blk = task >> 4;
        const int t = blk * 64 + lane;
        const bf16* src = Y1 + (size_t)(b * T + t) * OINP + (which ? 1664 : 1408) + g * 64;
        bf16* dst = (which ? VWT : VST) + (size_t)(b * 2 + g) * 64 * T + t;
        u32x4 v[8];
#pragma unroll
        for (int c = 0; c < 8; ++c) v[c] = *(const u32x4*)(src + 8 * c);
#pragma unroll
        for (int c = 0; c < 8; ++c) {
            dst[(size_t)(8 * c + 0) * T] = (bf16)(v[c].x & 0xffff); dst[(size_t)(8 * c + 1) * T] = (bf16)(v[c].x >> 16);
            dst[(size_t)(8 * c + 2) * T] = (bf16)(v[c].y & 0xffff); dst[(size_t)(8 * c + 3) * T] = (bf16)(v[c].y >> 16);
            dst[(size_t)(8 * c + 4) * T] = (bf16)(v[c].z & 0xffff); dst[(size_t)(8 * c + 5) * T] = (bf16)(v[c].z >> 16);
            dst[(size_t)(8 * c + 6) * T] = (bf16)(v[c].w & 0xffff); dst[(size_t)(8 * c + 7) * T] = (bf16)(v[c].w >> 16);
        }
    }
}
DI void qk_scores(const bf16* kp, int ldk, const bf16x8 (&qf)[2], int l15, int q, f32x4& sa, f32x4& sb) {
    sa = (f32x4){0.f, 0.f, 0.f, 0.f}; sb = sa;
#pragma unroll
    for (int ks = 0; ks < 2; ++ks) { const bf16x8 a0 = *(const bf16x8*)(kp + (size_t)l15 * ldk + 32 * ks + 8 * q), a1 = *(const bf16x8*)(kp + (size_t)(16 + l15) * ldk + 32 * ks + 8 * q);
        sa = MFMA16(a0, qf[ks], sa); sb = MFMA16(a1, qf[ks], sb); }
}
DI void pv_acc(const bf16* vtp, int ldv, bf16x8 pf, f32x4 (&acc)[4], int l15, int q) {
#pragma unroll
    for (int dt = 0; dt < 4; ++dt) { const bf16* r = vtp + (size_t)(16 * dt + l15) * ldv + 4 * q;
        const u32x2 lo = *(const u32x2*)r, hi = *(const u32x2*)(r + 16);
        const bf16x8 av = __builtin_bit_cast(bf16x8, ((u32x4){lo.x, lo.y, hi.x, hi.y})); acc[dt] = MFMA16(av, pf, acc[dt]); }
}
DI void attn_step(const bf16* kp, int ldk, const bf16* vtp, int ldv, const bf16x8 (&qf)[2], f32x4 (&acc)[4], float& m, float& lp,
                  int t, int kpos0, float slope2, int lim, bool extra, int l15, int q) {
    f32x4 sa, sb; qk_scores(kp, ldk, qf, l15, q, sa, sb);
    float s[8]; float mx = -INFINITY;
#pragma unroll
    for (int e = 0; e < 8; ++e) { const int kl = (e >> 2) * 16 + 4 * q + (e & 3); const int dist = t - (kpos0 + kl); const bool valid = extra && dist >= 0 && dist < lim;
        const float sc = (e < 4 ? sa[e & 3] : sb[e & 3]) * (0.125f * LOG2E) - slope2 * (float)dist; s[e] = valid ? sc : -INFINITY; mx = fmaxf(mx, s[e]); }
    mx = fmaxf(mx, __shfl_xor(mx, 16)); mx = fmaxf(mx, __shfl_xor(mx, 32));
    const float mn = fmaxf(m, mx), alpha = exp2f(m - mn); m = mn;
    float ps = 0.f; float p[8];
#pragma unroll
    for (int e = 0; e < 8; ++e) { p[e] = exp2f(s[e] - mn); ps += p[e]; }
    lp = lp * alpha + ps;
#pragma unroll
    for (int dt = 0; dt < 4; ++dt) { acc[dt][0] *= alpha; acc[dt][1] *= alpha; acc[dt][2] *= alpha; acc[dt][3] *= alpha; }
    u32x4 pw; pw.x = pk2(p[0], p[1]); pw.y = pk2(p[2], p[3]); pw.z = pk2(p[4], p[5]); pw.w = pk2(p[6], p[7]);
    pv_acc(vtp, ldv, __builtin_bit_cast(bf16x8, pw), acc, l15, q);
}
constexpr int SLAB_LD = 132;
DI void nsa_attn_phase(const bf16* Y1, const bf16* KCMP, const bf16* VCMPT, const bf16* VST, const bf16* VWT, bf16* MIX, LAS unsigned char* lds) {
    LAS float* slab = (LAS float*)lds;
    LAS float* pslc = slab + 8 * 16 * SLAB_LD;
    LAS unsigned* selm = (LAS unsigned*)(pslc + 16 * 128);
    LAS unsigned* uni = selm + 64;
    const int tid = threadIdx.x, lane = tid & 63, w = tid >> 6, l15 = lane & 15, q = lane >> 4;
    LAS float* myslab = slab + w * 16 * SLAB_LD;
    for (int u = blockIdx.x; u < NB * 2 * (T / 16); u += gridDim.x) {
        const int b = u & 3, g = (u >> 2) & 1, tile = u >> 3, t0 = tile * 16, qblk = t0 >> 6;
        const int h = g * 8 + w; const float slope = exp2f(-0.5f * (float)(h + 1)), slope2 = slope * LOG2E;
        const int t = t0 + l15; const size_t row = (size_t)b * T + t;
        bf16x8 qf[2];
        qf[0] = *(const bf16x8*)(Y1 + row * OINP + h * 64 + 8 * q); qf[1] = *(const bf16x8*)(Y1 + row * OINP + h * 64 + 32 + 8 * q);
        const bf16* gl = Y1 + row * OINP + 1792 + h * 3;
        const float g0 = sigmoidf_(bf2f(gl[0])), g1 = sigmoidf_(bf2f(gl[1])), g2 = sigmoidf_(bf2f(gl[2]));
        for (int i = lane; i < 16 * SLAB_LD; i += 64) myslab[i] = 0.f;
        if (tid < 64) selm[tid] = 0u; if (tid < 4) uni[tid] = 0u;
        f32x4 ot[4];
        {
            const bf16* kc = KCMP + (size_t)(b * 2 + g) * NCP * 64; const bf16* vct = VCMPT + (size_t)(b * 2 + g) * 64 * NCP;
            const int nsteps = tile >= 1 ? ((tile - 1) >> 5) + 1 : 0;
            float m = -1e30f, lp = 0.f;
            for (int s = 0; s < nsteps; ++s) {
                f32x4 sa, sb; qk_scores(kc + (size_t)(32 * s) * 64, 64, qf, l15, q, sa, sb);
                float sv[8]; float mx = -INFINITY;
#pragma unroll
                for (int e = 0; e < 8; ++e) { const int c = 32 * s + (e >> 2) * 16 + 4 * q + (e & 3); const int dist = t - (16 * c + 31);
                    const float sc = (e < 4 ? sa[e & 3] : sb[e & 3]) * (0.125f * LOG2E) - slope2 * (float)dist; sv[e] = dist >= 0 ? sc : -INFINITY; mx = fmaxf(mx, sv[e]); }
                mx = fmaxf(mx, __shfl_xor(mx, 16)); mx = fmaxf(mx, __shfl_xor(mx, 32));
                const float mn = fmaxf(m, mx); float ps = 0.f;
#pragma unroll
                for (int e = 0; e < 8; ++e) ps += exp2f(sv[e] - mn);
                lp = lp * exp2f(m - mn) + ps; m = mn;
            }
            float l = lp; l += __shfl_xor(l, 16); l += __shfl_xor(l, 32);
            const float inv = l > 0.f ? 1.0f / l : 0.f;
            f32x4 acc[4];
#pragma unroll
            for (int dt = 0; dt < 4; ++dt) acc[dt] = (f32x4){0.f, 0.f, 0.f, 0.f};
            for (int s = 0; s < nsteps; ++s) {
                f32x4 sa, sb; qk_scores(kc + (size_t)(32 * s) * 64, 64, qf, l15, q, sa, sb);
                float p[8];
#pragma unroll
                for (int e = 0; e < 8; ++e) { const int c = 32 * s + (e >> 2) * 16 + 4 * q + (e & 3); const int dist = t - (16 * c + 31);
                    const float sc = (e < 4 ? sa[e & 3] : sb[e & 3]) * (0.125f * LOG2E) - slope2 * (float)dist; p[e] = dist >= 0 ? exp2f(sc - m) * inv : 0.f; }
#pragma unroll
                for (int x = 0; x < 2; ++x) { const int j = 8 * s + 4 * x + q;
                    __hip_atomic_fetch_add(&myslab[l15 * SLAB_LD + j], (p[4 * x] + p[4 * x + 1]) + (p[4 * x + 2] + 0.5f * p[4 * x + 3]), __ATOMIC_RELAXED, __HIP_MEMORY_SCOPE_WORKGROUP);
                    __hip_atomic_fetch_add(&myslab[l15 * SLAB_LD + j + 1], 0.5f * p[4 * x + 3], __ATOMIC_RELAXED, __HIP_MEMORY_SCOPE_WORKGROUP); }
                u32x4 pw; pw.x = pk2(p[0], p[1]); pw.y = pk2(p[2], p[3]); pw.z = pk2(p[4], p[5]); pw.w = pk2(p[6], p[7]);
                pv_acc(vct + 32 * s, NCP, __builtin_bit_cast(bf16x8, pw), acc, l15, q);
            }
#pragma unroll
            for (int dt = 0; dt < 4; ++dt) { ot[dt][0] = g0 * acc[dt][0]; ot[dt][1] = g0 * acc[dt][1]; ot[dt][2] = g0 * acc[dt][2]; ot[dt][3] = g0 * acc[dt][3]; }
        }
        __syncthreads();
#pragma unroll
        for (int k = 0; k < 4; ++k) { const int idx = tid + 512 * k, tok = idx >> 7, j = idx & 127; float s = 0.f;
#pragma unroll
            for (int ww = 0; ww < 8; ++ww) s += slab[(ww * 16 + tok) * SLAB_LD + j];
            const bool forced = (j == 0) || (j == qblk) || (j == qblk - 1);
            pslc[tok * 128 + j] = forced ? 1e9f : (j <= qblk ? s : -1e30f); }
        __syncthreads();
#pragma unroll
        for (int k = 0; k < 4; ++k) { const int idx = tid + 512 * k, tok = idx >> 7, j = idx & 127;
            if (j <= qblk) { const float my = pslc[tok * 128 + j]; int rank = 0;
                for (int jj = 0; jj <= qblk; ++jj) { const float o = pslc[tok * 128 + jj]; rank += (o > my || (o == my && jj < j)) ? 1 : 0; }
                if (rank < 16) { __hip_atomic_fetch_or(&selm[tok * 4 + (j >> 5)], 1u << (j & 31), __ATOMIC_RELAXED, __HIP_MEMORY_SCOPE_WORKGROUP); __hip_atomic_fetch_or(&uni[j >> 5], 1u << (j & 31), __ATOMIC_RELAXED, __HIP_MEMORY_SCOPE_WORKGROUP); } } }
        __syncthreads();
        {
            const bf16* kb = Y1 + (size_t)b * T * OINP + 1280 + g * 64; const bf16* vt = VST + (size_t)(b * 2 + g) * 64 * T;
            float m = -1e30f, lp = 0.f; f32x4 acc[4];
#pragma unroll
            for (int dt = 0; dt < 4; ++dt) acc[dt] = (f32x4){0.f, 0.f, 0.f, 0.f};
            for (int j = 0; j <= qblk; ++j) {
                const unsigned uw = (unsigned)__builtin_amdgcn_readfirstlane((int)uni[j >> 5]);
                if (!((uw >> (j & 31)) & 1u)) continue;
                const bool selb = (selm[l15 * 4 + (j >> 5)] >> (j & 31)) & 1u;
#pragma unroll
                for (int hf = 0; hf < 2; ++hf) { const int key0 = 64 * j + 32 * hf;
                    attn_step(kb + (size_t)key0 * OINP, OINP, vt + key0, T, qf, acc, m, lp, t, key0, slope2, 0x7fffffff, selb, l15, q); }
            }
            float l = lp; l += __shfl_xor(l, 16); l += __shfl_xor(l, 32);
            const float sc = l > 0.f ? g1 / l : 0.f;
#pragma unroll
            for (int dt = 0; dt < 4; ++dt) { ot[dt][0] += sc * acc[dt][0]; ot[dt][1] += sc * acc[dt][1]; ot[dt][2] += sc * acc[dt][2]; ot[dt][3] += sc * acc[dt][3]; }
        }
        {
            const bf16* kb = Y1 + (size_t)b * T * OINP + 1536 + g * 64; const bf16* vt = VWT + (size_t)(b * 2 + g) * 64 * T;
            float m = -1e30f, lp = 0.f; f32x4 acc[4];
#pragma unroll
            for (int dt = 0; dt < 4; ++dt) acc[dt] = (f32x4){0.f, 0.f, 0.f, 0.f};
            int kstart = t0 - 511; kstart = kstart < 0 ? 0 : (kstart & ~31);
            for (int key0 = kstart; key0 <= t0 + 15; key0 += 32)
                attn_step(kb + (size_t)key0 * OINP, OINP, vt + key0, T, qf, acc, m, lp, t, key0, slope2, 512, true, l15, q);
            float l = lp; l += __shfl_xor(l, 16); l += __shfl_xor(l, 32);
            const float sc = l > 0.f ? g2 / l : 0.f;
#pragma unroll
            for (int dt = 0; dt < 4; ++dt) { ot[dt][0] += sc * acc[dt][0]; ot[dt][1] += sc * acc[dt][1]; ot[dt][2] += sc * acc[dt][2]; ot[dt][3] += sc * acc[dt][3]; }
        }
        bf16* op = MIX + row * D + h * 64 + 4 * q;
#pragma unroll
        for (int dt = 0; dt < 4; ++dt) { u32x2 ow; ow.x = pk2(ot[dt][0], ot[dt][1]); ow.y = pk2(ot[dt][2], ot[dt][3]); *(u32x2*)(op + 16 * dt) = ow; }
        __syncthreads();
    }
}
struct Args { const float* in[19]; float* out; unsigned char* ws; int ph_lo, ph_hi; };
constexpr int N_PHASES = 18;
template <class Epi>
DI void run_gemm(LAS unsigned char* lds, const bf16* A, const bf16* Bt, int N, int K, const Epi& E) {
    pg8::Gemm g{A, Bt, M, N, K}; pg8::StaticOrder S; S.init(M, N, (int)gridDim.x, (int)blockIdx.x);
    pg8::gemm_phase<Epi, pg8::StaticOrder, true, true>(lds, g, S, E);
}
__global__ void __launch_bounds__(512, 2) mega(Args a) {
    extern __shared__ __attribute__((aligned(16))) unsigned char lds_raw[];
    LAS unsigned char* lds = (LAS unsigned char*)lds_raw;
    cg::grid_group grid = cg::this_grid();
    const int tid = threadIdx.x, lane = tid & 63, wave = __builtin_amdgcn_readfirstlane(tid >> 6);
    const int gw = blockIdx.x * 8 + wave, ngw = gridDim.x * 8;
    unsigned char* ws = a.ws;
    bf16* W_EIN = (bf16*)(ws + WS_EIN); bf16* W_EOUT = (bf16*)(ws + WS_EOUT); bf16* W_OIN = (bf16*)(ws + WS_OIN); bf16* W_OOUT = (bf16*)(ws + WS_OOUT);
    bf16* W_GU = (bf16*)(ws + WS_GU); bf16* W_DN = (bf16*)(ws + WS_DN);
    bf16* W1K = (bf16*)(ws + WS_W1K); bf16* W1V = (bf16*)(ws + WS_W1V); bf16* W2K = (bf16*)(ws + WS_W2K); bf16* W2V = (bf16*)(ws + WS_W2V);
    float* DEC = (float*)(ws + WS_DEC); bf16* KCMP = (bf16*)(ws + WS_KCMP); bf16* VCMPT = (bf16*)(ws + WS_VCMPT);
    bf16* Y = (bf16*)(ws + WS_Y); bf16* VST = (bf16*)(ws + WS_VST); bf16* VWT = (bf16*)(ws + WS_VWT); bf16* HN = (bf16*)(ws + WS_HN);
    bf16* ST = (bf16*)a.out;
    const int lo = a.ph_lo, hi = a.ph_hi;
#define PH(k) if (lo <= (k) && (k) < hi)
#define SEAM(k) if (lo <= (k) && (k) + 1 < hi) grid.sync()
    PH(0) {
        LAS float* scr = (LAS float*)(lds + wave * 8448);
        constexpr int I0 = 2048, I1 = 512, I2 = 1024, I3 = 512, I4 = 2816, I5 = 1408, I6 = 64, I7 = 2;
        constexpr int NIT = I0 + I1 + I2 + I3 + 2 * I4 + 2 * I5 + 2 * I6 + 2 * I7;
        for (int it = gw; it < NIT; it += ngw) {
            int r = it;
            if (r < I0) { transpose_item(a.in[4], 1024, EIN, EIN, W_EIN, 0, scr, r, lane); continue; } r -= I0;
            if (r < I1) { transpose_item(a.in[8], 1024, 1024, 1024, W_EOUT, 0, scr, r, lane); continue; } r -= I1;
            if (r < I2) { transpose_item(a.in[9], 1024, OIN, OINP, W_OIN, 0, scr, r, lane); continue; } r -= I2;
            if (r < I3) { transpose_item(a.in[16], 1024, 1024, 1024, W_OOUT, 0, scr, r, lane); continue; } r -= I3;
            if (r < 2 * I4) { const int l = r / I4; transpose_item(a.in[17] + (size_t)l * D * 2 * FF, 1024, 2 * FF, 2 * FF, W_GU + (size_t)l * GU_STRIDE, 1, scr, r % I4, lane); continue; } r -= 2 * I4;
            if (r < 2 * I5) { const int l = r / I5; transpose_item(a.in[18] + (size_t)l * FF * D, FF, 1024, 1024, W_DN + (size_t)l * DN_STRIDE, 0, scr, r % I5, lane); continue; } r -= 2 * I5;
            if (r < I6) { transpose_item(a.in[12], 2048, 64, 64, W1K, 0, scr, r, lane); continue; } r -= I6;
            if (r < I6) { transpose_item(a.in[14], 2048, 64, 64, W1V, 0, scr, r, lane); continue; } r -= I6;
            if (r < I7) { transpose_item(a.in[13], 64, 64, 64, W2K, 0, scr, r, lane); continue; } r -= I7;
            transpose_item(a.in[15], 64, 64, 64, W2V, 0, scr, r, lane);
        }
        norm_rows_bf16(a.in[0], a.in[1], HN, gw, ngw, lane);
    }
    SEAM(0);
    PH(1) { EpiStore E{Y, EIN}; run_gemm(lds, HN, W_EIN, EIN, 1024, E); }
    SEAM(1);
    PH(2) { la_state_phase(Y, a.in[5], ST, DEC, lds); }
    SEAM(2);
    PH(3) { la_scan_phase(ST, DEC); }
    SEAM(3);
    PH(4) { la_out_phase(Y, a.in[5], ST, a.in[6], a.in[7], HN, lds); }
    SEAM(4);
    PH(5) { EpiResid E{a.in[0], a.out}; run_gemm(lds, HN, W_EOUT, 1024, 1024, E); }
    SEAM(5);
    PH(6) { norm_rows_bf16(a.out, a.in[2], HN, gw, ngw, lane); }
    SEAM(6);
    PH(7) { EpiSwiglu E{Y}; run_gemm(lds, HN, W_GU, 2 * FF, 1024, E); }
    SEAM(7);
    PH(8) { EpiResid E{a.out, a.out}; run_gemm(lds, Y, W_DN, 1024, FF, E); }
    SEAM(8);
    PH(9) { norm_rows_bf16(a.out, a.in[1] + D, HN, gw, ngw, lane); }
    SEAM(9);
    PH(10) { EpiStore E{Y, OINP}; run_gemm(lds, HN, W_OIN, OINP, 1024, E); }
    SEAM(10);
    PH(11) { nsa_compress_phase(Y, a.in[10], a.in[11], W1K, W1V, W2K, W2V, KCMP, VCMPT, gw, ngw, lane); nsa_vt_phase(Y, VST, VWT, gw, ngw, lane); }
    SEAM(11);
    PH(12) { nsa_attn_phase(Y, KCMP, VCMPT, VST, VWT, HN, lds); }
    SEAM(12);
    PH(13) { EpiResid E{a.out, a.out}; run_gemm(lds, HN, W_OOUT, 1024, 1024, E); }
    SEAM(13);
    PH(14) { norm_rows_bf16(a.out, a.in[2] + D, HN, gw, ngw, lane); }
    SEAM(14);
    PH(15) { EpiSwiglu E{Y}; run_gemm(lds, HN, W_GU + GU_STRIDE, 2 * FF, 1024, E); }
    SEAM(15);
    PH(16) { EpiResid E{a.out, a.out}; run_gemm(lds, Y, W_DN + DN_STRIDE, 1024, FF, E); }
    SEAM(16);
    PH(17) { norm_rows_f32_inplace(a.out, a.in[3], gw, ngw, lane); }
#undef PH
#undef SEAM
}

extern "C" void kernel_launch(void* const* d_in, const int* in_sizes, int n_in, void* d_out, int out_size, void* d_ws, size_t ws_size, hipStream_t stream) {
    static int grid = 0;
    if (grid == 0) {
        if (n_in != 19 || in_sizes[0] != M * D || out_size != M * D || ws_size < WS_END) { fprintf(stderr, "kernel_launch: unexpected shapes (n_in %d, in0 %d, out %d, ws %zu)\n", n_in, n_in > 0 ? in_sizes[0] : -1, out_size, ws_size); grid = -1; return; }
        int dev = 0, cus = 0, per_cu = 0;
        (void)hipGetDevice(&dev); (void)hipDeviceGetAttribute(&cus, hipDeviceAttributeMultiprocessorCount, dev);
        if (hipFuncSetAttribute((const void*)mega, hipFuncAttributeMaxDynamicSharedMemorySize, LDS_BYTES) != hipSuccess) { fprintf(stderr, "kernel_launch: hipFuncSetAttribute failed\n"); grid = -1; return; }
        if (hipOccupancyMaxActiveBlocksPerMultiprocessor(&per_cu, (const void*)mega, 512, LDS_BYTES) != hipSuccess || per_cu < 1) { fprintf(stderr, "kernel_launch: occupancy query says %d\n", per_cu); per_cu = 1; }
        (void)hipGetLastError();
        grid = cus * 1;
    }
    if (grid < 0) return;
    Args a{};
    for (int i = 0; i < 19; ++i) a.in[i] = (const float*)d_in[i];
    a.out = (float*)d_out; a.ws = (unsigned char*)d_ws; a.ph_lo = 0; a.ph_hi = N_PHASES;
    void* args[] = {&a};
    hipError_t e = hipLaunchCooperativeKernel((const void*)mega, dim3(grid), dim3(512), args, LDS_BYTES, stream);
    if (e != hipSuccess) fprintf(stderr, "kernel_launch: cooperative launch failed: %s (grid %d)\n", hipGetErrorString(e), grid);
}
```

```cpp
#include <hip/hip_runtime.h>
#include <hip/hip_cooperative_groups.h>
#include <cstdio>
#include <cstdint>
namespace cg = cooperative_groups;
namespace pg8 {
#define PG8_LAS __attribute__((address_space(3)))
typedef unsigned short bf16_t;
typedef short bf16x8 __attribute__((ext_vector_type(8)));
typedef float f32x4 __attribute__((ext_vector_type(4)));
typedef unsigned u32x4 __attribute__((ext_vector_type(4)));
constexpr int BM = 256, BK = 64, HALF = 128, HTB = HALF * BK * 2  , STAGE_BYTES = 8 * HTB, NXCD = 8, WGM = 8;

__host__ __device__ __forceinline__ int lds_byte(int r, int c) { const int st = (r >> 4) * 2 + (c >> 5), rr = r & 15, cc = c & 31, ob = rr * 64 + cc * 2; return st * 1024 + (ob ^ (((ob >> 9) & 1) << 5)); }
__host__ __device__ __forceinline__ void stage_rc(int b, int& R, int& C) { const int st = b / 1024, sb = b % 1024, swz = sb ^ (((sb >> 9) & 1) << 5); R = (st >> 1) * 16 + swz / 64; C = (st & 1) * 32 + (swz % 64) / 2; }
__host__ __device__ __forceinline__ int perm32(int rho) { const int n = rho >> 4, i = rho & 15; return 8 * (i >> 2) + 4 * n + (i & 3); }

struct Unit { int pm, pn; };
struct Gemm { const bf16_t* A; const bf16_t* Bt; int M, N, K; };

struct StaticOrder {
    int nM, nN, nwg, G, c;
    __host__ __device__ void init(int M, int N, int G_, int c_) { nM = M / BM; nN = N / BM; nwg = nM * nN; G = G_; c = c_; }
    __host__ __device__ bool next(int i, Unit& u) const {
        const long L = (long)i * G + c; if (L >= nwg) return false;
        int wgid = (int)L; { const int q = nwg / NXCD, r = nwg % NXCD, xcd = wgid % NXCD, off = wgid / NXCD; wgid = (xcd < r ? xcd * (q + 1) : r * (q + 1) + (xcd - r) * q) + off; }
        const int nig = WGM * nN, gid = wgid / nig, fm = gid * WGM, gsz = (nM - fm) < WGM ? (nM - fm) : WGM;
        u.pm = fm + ((wgid % nig) % gsz); u.pn = (wgid % nig) / gsz; return true;
    }
    __device__ __forceinline__ void a_ready(const Unit&) const {}
    __device__ __forceinline__ void done(const Unit&) const {}
};

__device__ __forceinline__ unsigned cvt_pk_bf16(float lo, float hi) { unsigned r; asm volatile("v_cvt_pk_bf16_f32 %0, %1, %2" : "=v"(r) : "v"(lo), "v"(hi)); return r; }
template <class Epi, class Sched, bool ALIGN_EPI = false, bool SP2 = false>
__device__ __forceinline__ void gemm_phase(PG8_LAS unsigned char* lds, const Gemm g, const Sched& S, const Epi& E) {
    const int tid = threadIdx.x, wid = __builtin_amdgcn_readfirstlane(tid >> 6), lane = tid & 63, wr = wid >> 2, wc = wid & 3, fr = lane & 15, fq = lane >> 4;
    const int K = g.K, nt = K / BK;
    unsigned voffA[2], voffB[2];
#pragma unroll
    for (int i = 0; i < 2; ++i) { int R, C; stage_rc(tid * 16 + i * 8192, R, C); const int Rb = Epi::PERM ? ((R & ~31) + perm32(R & 31)) : R;
        voffA[i] = (unsigned)(R * K + C) * 2u; voffB[i] = (unsigned)(Rb * K + C) * 2u; }
    const size_t kstep = (size_t)(BK * 2);
    const size_t hstep = (size_t)HALF * K * 2;
    const size_t tstep = 2 * hstep;
    const unsigned ldsw = (unsigned)wid * 1024u;
    const int aoff = lds_byte(wr * 64 + fr, fq * 8), boff = lds_byte(wc * 32 + fr, fq * 8);
#define PG8_SA(b, h) (((b) * 2 + (h)) * HTB)
#define PG8_SB(b, h) ((4 + (b) * 2 + (h)) * HTB)
#define PG8_STAGE(bufoff, gbase, voff) do { _Pragma("unroll") for (int _i = 0; _i < 2; ++_i) \
        __builtin_amdgcn_global_load_lds((const unsigned*)((const char*)(gbase) + (voff)[_i]), (PG8_LAS unsigned*)(lds + (bufoff) + ldsw + _i * 8192), 16, 0, 0); } while (0)
#define PG8_LDA(dst, b, h) do { _Pragma("unroll") for (int m = 0; m < 4; ++m) _Pragma("unroll") for (int k = 0; k < 2; ++k) dst[m][k] = *(const PG8_LAS bf16x8*)(lds + PG8_SA(b, h) + aoff + m * 2048 + k * 1024); } while (0)
#define PG8_LDB(dst, b, h) do { _Pragma("unroll") for (int n = 0; n < 2; ++n) _Pragma("unroll") for (int k = 0; k < 2; ++k) dst[n][k] = *(const PG8_LAS bf16x8*)(lds + PG8_SB(b, h) + boff + n * 2048 + k * 1024); } while (0)
#define PG8_MMA(ai, bj, At, Bt) do { __builtin_amdgcn_s_setprio(1); _Pragma("unroll") for (int m = 0; m < 4; ++m) _Pragma("unroll") for (int n = 0; n < 2; ++n) _Pragma("unroll") for (int k = 0; k < 2; ++k) \
        acc[ai][bj][m][n] = __builtin_amdgcn_mfma_f32_16x16x32_bf16(Bt[n][k], At[m][k], acc[ai][bj][m][n], 0, 0, 0); __builtin_amdgcn_s_setprio(0); } while (0)
#define PG8_WAIT_V(n) asm volatile("s_waitcnt vmcnt(" #n ")" ::: "memory")
#define PG8_WAIT_L(n) asm volatile("s_waitcnt lgkmcnt(" #n ")" ::: "memory")
#define PG8_BAR __builtin_amdgcn_s_barrier()
#define PG8_SCHED __builtin_amdgcn_sched_barrier(0)
    Unit cur, nxt; int ui = 0;
    if (!S.next(0, cur)) return;
    f32x4 acc[2][2][4][2];
#pragma unroll
    for (int a = 0; a < 2; ++a)
#pragma unroll
        for (int b = 0; b < 2; ++b)
#pragma unroll
            for (int m = 0; m < 4; ++m)
#pragma unroll
                for (int n = 0; n < 2; ++n) acc[a][b][m][n] = (f32x4){0.f, 0.f, 0.f, 0.f};
    bf16x8 At[4][2], B0[2][2], B1[2][2];
    const char* cA = (const char*)g.A + (size_t)cur.pm * tstep; const char* cB = (const char*)g.Bt + (size_t)cur.pn * tstep;
    S.a_ready(cur);
    if constexpr (SP2) {
        PG8_STAGE(PG8_SB(0, 0), cB, voffB); PG8_STAGE(PG8_SB(0, 1), cB + hstep, voffB); PG8_STAGE(PG8_SA(0, 0), cA, voffA); PG8_STAGE(PG8_SA(0, 1), cA + hstep, voffA);
        if (wr == 1) PG8_BAR;
        PG8_WAIT_V(2); PG8_BAR;
        PG8_STAGE(PG8_SB(1, 0), cB + kstep, voffB); PG8_STAGE(PG8_SA(1, 0), cA + kstep, voffA); PG8_STAGE(PG8_SB(1, 1), cB + hstep + kstep, voffB);
        PG8_WAIT_V(6); PG8_BAR;
    } else {
        PG8_STAGE(PG8_SB(0, 0), cB, voffB); PG8_STAGE(PG8_SA(0, 0), cA, voffA); PG8_STAGE(PG8_SB(0, 1), cB + hstep, voffB); PG8_STAGE(PG8_SA(0, 1), cA + hstep, voffA);
        if (wr == 1) PG8_BAR;
        PG8_WAIT_V(4); PG8_BAR;
        PG8_STAGE(PG8_SB(1, 0), cB + kstep, voffB); PG8_STAGE(PG8_SA(1, 0), cA + kstep, voffA); PG8_STAGE(PG8_SB(1, 1), cB + hstep + kstep, voffB);
        PG8_WAIT_V(6); PG8_BAR;
    }
    for (;;) {
        const bool has_next = S.next(ui + 1, nxt);
        const char* nA = has_next ? (const char*)g.A + (size_t)nxt.pm * tstep : cA; const char* nB = has_next ? (const char*)g.Bt + (size_t)nxt.pn * tstep : cB;
        for (int t = 0; t < nt; t += 2) {
            const bool last = (t == nt - 2);
            const char* a1 = cA + (size_t)(t + 1) * kstep;
            const char* a2 = last ? nA : cA + (size_t)(t + 2) * kstep; const char* b2 = last ? nB : cB + (size_t)(t + 2) * kstep;
            const char* a3 = a2 + kstep; const char* b3 = b2 + kstep;
            if (last && has_next) S.a_ready(nxt);
            if constexpr (SP2) {
            PG8_LDB(B0, 0, 0); PG8_LDB(B1, 0, 1); PG8_SCHED; PG8_LDA(At, 0, 0); PG8_STAGE(PG8_SA(1, 1), a1 + hstep, voffA);
            PG8_WAIT_V(8); PG8_WAIT_L(0); PG8_BAR; PG8_MMA(0, 0, At, B0); PG8_MMA(0, 1, At, B1); PG8_BAR; PG8_SCHED;
            PG8_LDA(At, 0, 1); PG8_STAGE(PG8_SB(0, 0), b2, voffB); PG8_STAGE(PG8_SB(0, 1), b2 + hstep, voffB); PG8_STAGE(PG8_SA(0, 0), a2, voffA);
            PG8_WAIT_V(8); PG8_WAIT_L(0); PG8_BAR; PG8_MMA(1, 0, At, B0); PG8_MMA(1, 1, At, B1); PG8_BAR; PG8_SCHED;
            PG8_LDB(B0, 1, 0); PG8_LDB(B1, 1, 1); PG8_SCHED; PG8_LDA(At, 1, 0); PG8_STAGE(PG8_SA(0, 1), a2 + hstep, voffA);
            PG8_WAIT_V(8); PG8_WAIT_L(0); PG8_BAR; PG8_MMA(0, 0, At, B0); PG8_MMA(0, 1, At, B1); PG8_BAR; PG8_SCHED;
            PG8_LDA(At, 1, 1); PG8_STAGE(PG8_SB(1, 0), b3, voffB); PG8_STAGE(PG8_SB(1, 1), b3 + hstep, voffB); PG8_STAGE(PG8_SA(1, 0), a3, voffA);
            PG8_WAIT_V(8); PG8_WAIT_L(0); PG8_BAR; PG8_MMA(1, 0, At, B0); PG8_MMA(1, 1, At, B1); PG8_BAR; PG8_SCHED;
            } else {
            PG8_LDB(B0, 0, 0); PG8_SCHED; PG8_LDA(At, 0, 0); PG8_STAGE(PG8_SA(1, 1), a1 + hstep, voffA);
            PG8_WAIT_L(8); PG8_BAR; PG8_WAIT_L(0); PG8_MMA(0, 0, At, B0); PG8_BAR; PG8_SCHED;
            PG8_LDB(B1, 0, 1); PG8_STAGE(PG8_SB(0, 0), b2, voffB);
            PG8_BAR; PG8_WAIT_L(0); PG8_MMA(0, 1, At, B1); PG8_BAR;
            PG8_LDA(At, 0, 1); PG8_STAGE(PG8_SA(0, 0), a2, voffA);
            PG8_BAR; PG8_WAIT_L(0); PG8_MMA(1, 0, At, B0); PG8_BAR; PG8_SCHED;
            PG8_STAGE(PG8_SB(0, 1), b2 + hstep, voffB);
            PG8_WAIT_V(6); PG8_BAR; PG8_MMA(1, 1, At, B1); PG8_BAR;
            PG8_LDB(B0, 1, 0); PG8_SCHED; PG8_LDA(At, 1, 0); PG8_STAGE(PG8_SA(0, 1), a2 + hstep, voffA);
            PG8_WAIT_L(8); PG8_BAR; PG8_WAIT_L(0); PG8_MMA(0, 0, At, B0); PG8_BAR; PG8_SCHED;
            PG8_LDB(B1, 1, 1); PG8_STAGE(PG8_SB(1, 0), b3, voffB);
            PG8_BAR; PG8_WAIT_L(0); PG8_MMA(0, 1, At, B1); PG8_BAR;
            PG8_LDA(At, 1, 1); PG8_STAGE(PG8_SA(1, 0), a3, voffA);
            PG8_BAR; PG8_WAIT_L(0); PG8_MMA(1, 0, At, B0); PG8_BAR; PG8_SCHED;
            PG8_STAGE(PG8_SB(1, 1), b3 + hstep, voffB);
            PG8_WAIT_V(6); PG8_BAR; PG8_MMA(1, 1, At, B1); PG8_BAR;
            }
        }
        if constexpr (ALIGN_EPI) { if (wr == 0) PG8_BAR; }
        if constexpr (!Epi::AFTER_DRAIN) { E(acc, cur, wr, wc, fr, fq); S.done(cur); }
        if (!has_next) break;
#pragma unroll
        for (int a = 0; a < 2; ++a)
#pragma unroll
            for (int b = 0; b < 2; ++b)
#pragma unroll
                for (int m = 0; m < 4; ++m)
#pragma unroll
                    for (int n = 0; n < 2; ++n) acc[a][b][m][n] = (f32x4){0.f, 0.f, 0.f, 0.f};
        cur = nxt; cA = nA; cB = nB; ++ui;
        if constexpr (ALIGN_EPI) { if (wr == 1) PG8_BAR; }
    }
    PG8_WAIT_V(0);
    if constexpr (!ALIGN_EPI) { if (wr == 0) PG8_BAR; }
    PG8_BAR;
    if constexpr (Epi::AFTER_DRAIN) { E.fused(acc, cur, wr, wc, fr, fq, lds, wid, lane); S.done(cur); }
#undef PG8_SA
#undef PG8_SB
#undef PG8_STAGE
#undef PG8_LDA
#undef PG8_LDB
#undef PG8_MMA
#undef PG8_WAIT_V
#undef PG8_WAIT_L
#undef PG8_BAR
#undef PG8_SCHED
}
}
#define GAS __attribute__((address_space(1)))
#define LAS __attribute__((address_space(3)))
#define DI __device__ __forceinline__
typedef unsigned short bf16;
typedef short bf16x8 __attribute__((ext_vector_type(8)));
typedef short s16x4 __attribute__((ext_vector_type(4)));
typedef float f32x4 __attribute__((ext_vector_type(4)));
typedef float f32x2 __attribute__((ext_vector_type(2)));
typedef unsigned u32x4 __attribute__((ext_vector_type(4)));
typedef unsigned u32x2 __attribute__((ext_vector_type(2)));
typedef __bf16 bf16x2_t __attribute__((ext_vector_type(2)));
#define MFMA16(a, b, c) __builtin_amdgcn_mfma_f32_16x16x32_bf16((a), (b), (c), 0, 0, 0)

constexpr int NB = 4, T = 8192, D = 1024, M = NB * T, FF = 2816;
constexpr int EIN = 4096, OIN = 1840, OINP = 2048;
constexpr float RMS_EPS = 1e-6f, LOG2E = 1.4426950408889634f;
constexpr size_t MiB = 1u << 20;
constexpr size_t WS_EIN = 0, WS_EOUT = 8 * MiB, WS_OIN = 10 * MiB, WS_OOUT = 14 * MiB, WS_GU = 16 * MiB, WS_DN = 38 * MiB;
constexpr size_t WS_W1K = 49 * MiB, WS_W1V = WS_W1K + 256 * 1024, WS_W2K = WS_W1V + 256 * 1024, WS_W2V = WS_W2K + 8192;
constexpr size_t WS_DEC = 52 * MiB, WS_KCMP = 54 * MiB, WS_VCMPT = WS_KCMP + 512 * 1024;
constexpr size_t WS_Y = 64 * MiB;
constexpr size_t WS_VST = 192 * MiB, WS_VWT = 200 * MiB;
constexpr size_t WS_HN = 320 * MiB, WS_END = 384 * MiB;
constexpr size_t GU_STRIDE = (size_t)2 * FF * D, DN_STRIDE = (size_t)D * FF;
constexpr int LDS_BYTES = 147456;

DI unsigned pk2(float lo, float hi) { f32x2 v = {lo, hi}; return __builtin_bit_cast(unsigned, __builtin_convertvector(v, bf16x2_t)); }
DI bf16 f2bf(float f) { return (bf16)(pk2(f, 0.f) & 0xffffu); }
DI float bf2f(bf16 x) { return __uint_as_float(((unsigned)x) << 16); }
DI float bflo(unsigned w) { return __uint_as_float(w << 16); }
DI float bfhi(unsigned w) { return __uint_as_float(w & 0xffff0000u); }
DI float wave_sum(float v) {
#pragma unroll
    for (int o = 1; o < 64; o <<= 1) v += __shfl_xor(v, o);
    return v;
}
DI float sigmoidf_(float x) { return 1.0f / (1.0f + __expf(-x)); }
DI float siluf_(float x) { return x / (1.0f + __expf(-x)); }

struct EpiStore {
    static constexpr bool PERM = true, AFTER_DRAIN = false;
    bf16* O; int ldc;
    DI void operator()(const pg8::f32x4 (&acc)[2][2][4][2], const pg8::Unit& u, int wr, int wc, int fr, int fq) const {
        const int row0 = u.pm * 256 + wr * 64 + fr, col0 = u.pn * 256 + wc * 32 + 8 * fq;
#pragma unroll
        for (int ai = 0; ai < 2; ++ai)
#pragma unroll
            for (int m = 0; m < 4; ++m) { bf16* rowp = O + (size_t)(row0 + ai * 128 + m * 16) * ldc + col0;
#pragma unroll
                for (int bj = 0; bj < 2; ++bj) { const pg8::f32x4 v0 = acc[ai][bj][m][0], v1 = acc[ai][bj][m][1];
                    u32x4 w; w.x = pk2(v0[0], v0[1]); w.y = pk2(v0[2], v0[3]); w.z = pk2(v1[0], v1[1]); w.w = pk2(v1[2], v1[3]);
                    *(u32x4*)(rowp + bj * 128) = w; } }
    }
};
struct EpiSwiglu {
    static constexpr bool PERM = true, AFTER_DRAIN = false;
    bf16* O;
    DI void operator()(const pg8::f32x4 (&acc)[2][2][4][2], const pg8::Unit& u, int wr, int wc, int fr, int fq) const {
        const int row0 = u.pm * 256 + wr * 64 + fr, col0 = u.pn * 128 + wc * 32 + 8 * fq;
#pragma unroll
        for (int ai = 0; ai < 2; ++ai)
#pragma unroll
            for (int m = 0; m < 4; ++m) { bf16* rowp = O + (size_t)(row0 + ai * 128 + m * 16) * FF + col0;
                float r[8];
#pragma unroll
                for (int n = 0; n < 2; ++n)
#pragma unroll
                    for (int e = 0; e < 4; ++e) { const float g = acc[ai][0][m][n][e], up = acc[ai][1][m][n][e]; r[n * 4 + e] = g * __builtin_amdgcn_rcpf(1.0f + __expf(-g)) * up; }
                u32x4 w; w.x = pk2(r[0], r[1]); w.y = pk2(r[2], r[3]); w.z = pk2(r[4], r[5]); w.w = pk2(r[6], r[7]);
                *(u32x4*)rowp = w; }
    }
};
struct EpiResid {
    static constexpr bool PERM = false, AFTER_DRAIN = false;
    const float* base; float* out;
    DI void operator()(const pg8::f32x4 (&acc)[2][2][4][2], const pg8::Unit& u, int wr, int wc, int fr, int fq) const {
        const int row0 = u.pm * 256 + wr * 64 + fr, col0 = u.pn * 256 + wc * 32 + 4 * fq;
#pragma unroll
        for (int ai = 0; ai < 2; ++ai)
#pragma unroll
            for (int m = 0; m < 4; ++m) { const size_t off = (size_t)(row0 + ai * 128 + m * 16) * D + col0;
#pragma unroll
                for (int bj = 0; bj < 2; ++bj)
#pragma unroll
                    for (int n = 0; n < 2; ++n) { const f32x4 bs = *(const f32x4*)(base + off + bj * 128 + n * 16); const pg8::f32x4 a = acc[ai][bj][m][n];
                        f32x4 o; o.x = bs.x + a[0]; o.y = bs.y + a[1]; o.z = bs.z + a[2]; o.w = bs.w + a[3]; *(f32x4*)(out + off + bj * 128 + n * 16) = o; } }
    }
};

DI void transpose_item(const float* W, int K, int N, int Npad, bf16* WT, int mode, LAS float* scr, int item, int lane) {
    const int nblk = Npad / 32, kb = item / nblk, nb = item % nblk, k0 = 64 * kb, n0 = 32 * nb;
    const int nl = n0 + (lane & 31);
#pragma unroll 8
    for (int i = 0; i < 32; ++i) { const int kk = 2 * i + (lane >> 5); scr[kk * 33 + (lane & 31)] = (nl < N) ? W[(size_t)(k0 + kk) * N + nl] : 0.f; }
    asm volatile("s_waitcnt lgkmcnt(0)" ::: "memory");
    const int c = lane & 7;
    int drow0 = n0;
    if (mode == 1) { drow0 = (n0 < FF) ? (256 * (n0 >> 7) + (n0 & 127)) : (256 * ((n0 - FF) >> 7) + 128 + ((n0 - FF) & 127)); }
#pragma unroll
    for (int j = 0; j < 4; ++j) { const int n = (lane >> 3) + 8 * j; const LAS float* s = scr + (8 * c) * 33 + n;
        u32x4 o; o.x = pk2(s[0 * 33], s[1 * 33]); o.y = pk2(s[2 * 33], s[3 * 33]); o.z = pk2(s[4 * 33], s[5 * 33]); o.w = pk2(s[6 * 33], s[7 * 33]);
        *(u32x4*)(WT + (size_t)(drow0 + n) * K + k0 + 8 * c) = o; }
    asm volatile("s_waitcnt lgkmcnt(0)" ::: "memory");
}
DI void norm_rows_bf16(const float* h, const float* g, bf16* out, int gw, int ngw, int lane) {
    f32x4 gv[4];
#pragma unroll
    for (int j = 0; j < 4; ++j) gv[j] = *((const f32x4*)g + lane + 64 * j);
    for (int m = gw; m < M; m += ngw) {
        const f32x4* xr = (const f32x4*)(h + (size_t)m * D) + lane; f32x4 v[4]; float s = 0.f;
#pragma unroll
        for (int j = 0; j < 4; ++j) { v[j] = xr[64 * j]; s += (v[j].x * v[j].x + v[j].y * v[j].y) + (v[j].z * v[j].z + v[j].w * v[j].w); }
        const float r = rsqrtf(wave_sum(s) * (1.f / D) + RMS_EPS);
        u32x2* o8 = (u32x2*)(out + (size_t)m * D) + lane;
#pragma unroll
        for (int j = 0; j < 4; ++j) { u32x2 w; w.x = pk2(v[j].x * r * gv[j].x, v[j].y * r * gv[j].y); w.y = pk2(v[j].z * r * gv[j].z, v[j].w * r * gv[j].w); o8[64 * j] = w; }
    }
}
DI void norm_rows_f32_inplace(float* h, const float* g, int gw, int ngw, int lane) {
    f32x4 gv[4];
#pragma unroll
    for (int j = 0; j < 4; ++j) gv[j] = *((const f32x4*)g + lane + 64 * j);
    for (int m = gw; m < M; m += ngw) {
        f32x4* xr = (f32x4*)(h + (size_t)m * D) + lane; f32x4 v[4]; float s = 0.f;
#pragma unroll
        for (int j = 0; j < 4; ++j) { v[j] = xr[64 * j]; s += (v[j].x * v[j].x + v[j].y * v[j].y) + (v[j].z * v[j].z + v[j].w * v[j].w); }
        const float r = rsqrtf(wave_sum(s) * (1.f / D) + RMS_EPS);
#pragma unroll
        for (int j = 0; j < 4; ++j) { f32x4 o; o.x = v[j].x * r * gv[j].x; o.y = v[j].y * r * gv[j].y; o.z = v[j].z * r * gv[j].z; o.w = v[j].w * r * gv[j].w; xr[64 * j] = o; }
    }
}
constexpr int LA_UNITS = NB * 8 * 128;
constexpr int KT_LD = 72, QT_LD = 136;
template <bool WANT_Q>
DI void la_load_col(const bf16* Yb, int hh, int d, int rg, const float* lbraw, float (&lg)[16], float (&kk)[16], float (&qq)[16]) {
    if (hh < 4) {
        const float a = lbraw[hh * 128 + d], b2 = lbraw[512 + hh * 128 + d];
        const float mx = fmaxf(a, b2), ea = __expf(a - mx), eb = __expf(b2 - mx), lbv = ea / (ea + eb);
        const bf16* pf = Yb + (size_t)(16 * rg) * EIN + 512 + hh * 128 + d;
        const bf16* pq = Yb + (size_t)(16 * rg) * EIN + hh * 128 + d;
#pragma unroll
        for (int e = 0; e < 16; ++e) { const float x = bf2f(pf[(size_t)e * EIN]); const float f = lbv + (1.f - lbv) * sigmoidf_(x); lg[e] = __logf(f); kk[e] = 1.f - f;
            if (WANT_Q) qq[e] = siluf_(bf2f(pq[(size_t)e * EIN])); }
    } else {
        const int r = hh - 4; const float lgam = __logf(1.f - exp2f(-5.f - (float)r));
        const bf16* pk = Yb + (size_t)(16 * rg) * EIN + 2560 + r * 128 + d;
        const bf16* pq = Yb + (size_t)(16 * rg) * EIN + 2048 + r * 128 + d;
#pragma unroll
        for (int e = 0; e < 16; ++e) { lg[e] = lgam; kk[e] = bf2f(pk[(size_t)e * EIN]) * 0.08838834764831845f; if (WANT_Q) qq[e] = bf2f(pq[(size_t)e * EIN]); }
    }
    float run = 0.f;
#pragma unroll
    for (int e = 0; e < 16; ++e) { run += lg[e]; lg[e] = run; }
}
DI void la_stage_vt(const bf16* Yb, int hh, int d, int rg, LAS bf16* VT) {
    const bf16* pv = Yb + (size_t)(16 * rg) * EIN + (hh < 4 ? 1024 + hh * 128 : 3072 + (hh - 4) * 128) + d;
    unsigned w[8];
#pragma unroll
    for (int e = 0; e < 8; ++e) w[e] = (unsigned)pv[(size_t)(2 * e) * EIN] | ((unsigned)pv[(size_t)(2 * e + 1) * EIN] << 16);
    LAS u32x4* dst = (LAS u32x4*)(VT + d * KT_LD + 16 * rg);
    dst[0] = (u32x4){w[0], w[1], w[2], w[3]}; dst[1] = (u32x4){w[4], w[5], w[6], w[7]};
}
DI void la_state_phase(const bf16* Y0, const float* lbraw, bf16* ST, float* DEC, LAS unsigned char* lds) {
    LAS bf16* KT = (LAS bf16*)lds; LAS bf16* VT = KT + 128 * KT_LD; LAS float* tot = (LAS float*)(VT + 128 * KT_LD);
    const int tid = threadIdx.x, lane = tid & 63, w = tid >> 6, l15 = lane & 15, q = lane >> 4, d = tid & 127, rg = tid >> 7;
    for (int unit = blockIdx.x; unit < LA_UNITS; unit += gridDim.x) {
        const int b = unit >> 10, hh = (unit >> 7) & 7, n = unit & 127;
        const bf16* Yb = Y0 + (size_t)(b * T + n * 64) * EIN;
        float lg[16], kk[16], qq[16];
        la_load_col<false>(Yb, hh, d, rg, lbraw, lg, kk, qq);
        tot[rg * 128 + d] = lg[15];
        la_stage_vt(Yb, hh, d, rg, VT);
        __syncthreads();
        float pre = 0.f, last = 0.f;
#pragma unroll
        for (int g2 = 0; g2 < 4; ++g2) { const float tv = tot[g2 * 128 + d]; if (g2 < rg) pre += tv; last += tv; }
        unsigned wv[8];
#pragma unroll
        for (int e = 0; e < 8; ++e) { const float c0 = pre + lg[2 * e], c1 = pre + lg[2 * e + 1]; wv[e] = pk2(kk[2 * e] * __expf(last - c0), kk[2 * e + 1] * __expf(last - c1)); }
        LAS u32x4* dst = (LAS u32x4*)(KT + d * KT_LD + 16 * rg);
        dst[0] = (u32x4){wv[0], wv[1], wv[2], wv[3]}; dst[1] = (u32x4){wv[4], wv[5], wv[6], wv[7]};
        if (rg == 0) DEC[(size_t)unit * 128 + d] = __expf(last);
        __syncthreads();
        f32x4 acc[8];
#pragma unroll
        for (int dt = 0; dt < 8; ++dt) acc[dt] = (f32x4){0.f, 0.f, 0.f, 0.f};
#pragma unroll
        for (int ks = 0; ks < 2; ++ks) { const bf16x8 bv = *(const LAS bf16x8*)(VT + (16 * w + l15) * KT_LD + 32 * ks + 8 * q);
#pragma unroll
            for (int dt = 0; dt < 8; ++dt) { const bf16x8 ak = *(const LAS bf16x8*)(KT + (16 * dt + l15) * KT_LD + 32 * ks + 8 * q); acc[dt] = MFMA16(ak, bv, acc[dt]); } }
        bf16* so = ST + (size_t)unit * 16384 + (16 * w + l15) * 128 + 4 * q;
#pragma unroll
        for (int dt = 0; dt < 8; ++dt) { u32x2 o; o.x = pk2(acc[dt][0], acc[dt][1]); o.y = pk2(acc[dt][2], acc[dt][3]); *(u32x2*)(so + 16 * dt) = o; }
        __syncthreads();
    }
}
DI void la_scan_phase(bf16* ST, const float* DEC) {
    const int gid = blockIdx.x * 512 + threadIdx.x, nth = gridDim.x * 512;
    for (int wk = gid; wk < 32 * 4096; wk += nth) {
        const int bh = wk >> 12, e4 = (wk & 4095) * 4, d = e4 & 127;
        f32x4 s = {0.f, 0.f, 0.f, 0.f};
        bf16* sp = ST + (size_t)bh * 128 * 16384 + e4; const float* dp = DEC + (size_t)bh * 128 * 128 + d;
        for (int n0 = 0; n0 < 128; n0 += 8) {
            u32x2 uv[8]; f32x4 dv[8];
#pragma unroll
            for (int i = 0; i < 8; ++i) { uv[i] = *(const u32x2*)(sp + (size_t)(n0 + i) * 16384); dv[i] = *(const f32x4*)(dp + (size_t)(n0 + i) * 128); }
#pragma unroll
            for (int i = 0; i < 8; ++i) { u32x2 o; o.x = pk2(s.x, s.y); o.y = pk2(s.z, s.w); *(u32x2*)(sp + (size_t)(n0 + i) * 16384) = o;
                s.x = dv[i].x * s.x + bflo(uv[i].x); s.y = dv[i].y * s.y + bfhi(uv[i].x); s.z = dv[i].z * s.z + bflo(uv[i].y); s.w = dv[i].w * s.w + bfhi(uv[i].y); }
        }
    }
}
DI void la_out_phase(const bf16* Y0, const float* lbraw, const bf16* ST, const float* gh, const float* gr, bf16* MIX, LAS unsigned char* lds) {
    LAS bf16* QT = (LAS bf16*)lds; LAS bf16* K2 = QT + 64 * QT_LD; LAS bf16* QS = K2 + 64 * QT_LD; LAS bf16* VT = QS + 64 * QT_LD;
    LAS float* tot = (LAS float*)(VT + 128 * KT_LD); LAS float* ssq = tot + 512;
    const int tid = threadIdx.x, lane = tid & 63, w = tid >> 6, l15 = lane & 15, q = lane >> 4, d = tid & 127, rg = tid >> 7;
    const int it = w & 3, vh = w >> 2;
    for (int unit = blockIdx.x; unit < LA_UNITS; unit += gridDim.x) {
        const int b = unit >> 10, hh = (unit >> 7) & 7, n = unit & 127;
        const int row0 = b * T + n * 64;
        const bf16* Yb = Y0 + (size_t)row0 * EIN;
        float lg[16], kk[16], qq[16];
        la_load_col<true>(Yb, hh, d, rg, lbraw, lg, kk, qq);
        tot[rg * 128 + d] = lg[15];
        la_stage_vt(Yb, hh, d, rg, VT);
        __syncthreads();
        float pre = 0.f;
#pragma unroll
        for (int g2 = 0; g2 < 4; ++g2) { const float tv = tot[g2 * 128 + d]; if (g2 < rg) pre += tv; }
        const float ref = tot[d] + tot[128 + d];
#pragma unroll
        for (int e = 0; e < 16; ++e) { const float c = pre + lg[e]; const int j = 16 * rg + e;
            QT[j * QT_LD + d] = f2bf(qq[e] * __expf(c - ref)); K2[j * QT_LD + d] = f2bf(kk[e] * __expf(ref - c)); QS[j * QT_LD + d] = f2bf(qq[e] * __expf(c)); }
        __syncthreads();
        f32x4 at[4];
#pragma unroll
        for (int jt = 0; jt < 4; ++jt) at[jt] = (f32x4){0.f, 0.f, 0.f, 0.f};
#pragma unroll
        for (int ks = 0; ks < 4; ++ks) { const bf16x8 bq = *(const LAS bf16x8*)(QT + (16 * it + l15) * QT_LD + 32 * ks + 8 * q);
#pragma unroll
            for (int jt = 0; jt < 4; ++jt) { const bf16x8 ak = *(const LAS bf16x8*)(K2 + (16 * jt + l15) * QT_LD + 32 * ks + 8 * q); at[jt] = MFMA16(ak, bq, at[jt]); } }
        const int irow = 16 * it + l15;
#pragma unroll
        for (int jt = 0; jt < 4; ++jt)
#pragma unroll
            for (int r = 0; r < 4; ++r) { const int j = 16 * jt + 4 * q + r; if (j > irow) at[jt][r] = 0.f; }
        f32x4 o[4];
#pragma unroll
        for (int vt = 0; vt < 4; ++vt) o[vt] = (f32x4){0.f, 0.f, 0.f, 0.f};
#pragma unroll
        for (int k2 = 0; k2 < 2; ++k2) {
            u32x4 pw; pw.x = pk2(at[2 * k2][0], at[2 * k2][1]); pw.y = pk2(at[2 * k2][2], at[2 * k2][3]); pw.z = pk2(at[2 * k2 + 1][0], at[2 * k2 + 1][1]); pw.w = pk2(at[2 * k2 + 1][2], at[2 * k2 + 1][3]);
            const bf16x8 pf = __builtin_bit_cast(bf16x8, pw);
#pragma unroll
            for (int vt = 0; vt < 4; ++vt) { const LAS bf16* vp = VT + (64 * vh + 16 * vt + l15) * KT_LD + 32 * k2 + 4 * q;
                const u32x2 lo = *(const LAS u32x2*)vp, hi = *(const LAS u32x2*)(vp + 16);
                const bf16x8 av = __builtin_bit_cast(bf16x8, ((u32x4){lo.x, lo.y, hi.x, hi.y})); o[vt] = MFMA16(av, pf, o[vt]); }
        }
        const bf16* sb = ST + (size_t)unit * 16384;
#pragma unroll
        for (int ks = 0; ks < 4; ++ks) { const bf16x8 bq = *(const LAS bf16x8*)(QS + (16 * it + l15) * QT_LD + 32 * ks + 8 * q);
#pragma unroll
            for (int vt = 0; vt < 4; ++vt) { const bf16x8 as = *(const bf16x8*)(sb + (64 * vh + 16 * vt + l15) * 128 + 32 * ks + 8 * q); o[vt] = MFMA16(as, bq, o[vt]); } }
        float ss = 0.f;
#pragma unroll
        for (int vt = 0; vt < 4; ++vt) ss += (o[vt][0] * o[vt][0] + o[vt][1] * o[vt][1]) + (o[vt][2] * o[vt][2] + o[vt][3] * o[vt][3]);
        ss += __shfl_xor(ss, 16); ss += __shfl_xor(ss, 32);
        if (q == 0) ssq[vh * 64 + irow] = ss;
        __syncthreads();
        const float rs = rsqrtf((ssq[irow] + ssq[64 + irow]) * (1.f / 128.f) + RMS_EPS);
        const float* gn = (hh < 4) ? gh : gr;
        const bf16* gp = Yb + (size_t)irow * EIN + (hh < 4 ? 1536 + hh * 128 : 3584 + (hh - 4) * 128);
        bf16* op = MIX + (size_t)(row0 + irow) * D + hh * 128;
#pragma unroll
        for (int vt = 0; vt < 4; ++vt) { const int v0 = 64 * vh + 16 * vt + 4 * q; const f32x4 gv = *(const f32x4*)(gn + v0); const u32x2 gw = *(const u32x2*)(gp + v0);
            u32x2 ow; ow.x = pk2(o[vt][0] * rs * gv.x * siluf_(bflo(gw.x)), o[vt][1] * rs * gv.y * siluf_(bfhi(gw.x)));
            ow.y = pk2(o[vt][2] * rs * gv.z * siluf_(bflo(gw.y)), o[vt][3] * rs * gv.w * siluf_(bfhi(gw.y))); *(u32x2*)(op + v0) = ow; }
        __syncthreads();
    }
}
constexpr int NC = 511, NCP = 512;
DI void nsa_compress_phase(const bf16* Y1, const float* posk, const float* posv, const bf16* w1kT, const bf16* w1vT, const bf16* w2kT, const bf16* w2vT,
                           bf16* KCMP, bf16* VCMPT, int gw, int ngw, int lane) {
    const int l15 = lane & 15, q = lane >> 4;
    for (int task = gw; task < 512; task += ngw) {
        const int kv = task & 1, rt = task >> 1;
        int r = rt * 16 + l15; const bool rvalid = r < NB * NC * 2; if (!rvalid) r = NB * NC * 2 - 1;
        const int b = r / (NC * 2), rem = r % (NC * 2), i = rem >> 1, g = rem & 1;
        const bf16* src = Y1 + (size_t)(b * T + 16 * i) * OINP + (kv ? 1152 : 1024) + g * 64;
        const float* pos = kv ? posv : posk; const bf16* w1 = kv ? w1vT : w1kT; const bf16* w2 = kv ? w2vT : w2kT;
        f32x4 acc[4];
#pragma unroll
        for (int nt = 0; nt < 4; ++nt) acc[nt] = (f32x4){0.f, 0.f, 0.f, 0.f};
        for (int ks = 0; ks < 64; ++ks) {
            const int p = ks >> 1, d0 = (ks & 1) * 32 + 8 * q;
            const u32x4 xv = *(const u32x4*)(src + (size_t)p * OINP + d0);
            const f32x4 p0 = *(const f32x4*)(pos + p * 64 + d0), p1 = *(const f32x4*)(pos + p * 64 + d0 + 4);
            u32x4 bw; bw.x = pk2(bflo(xv.x) + p0.x, bfhi(xv.x) + p0.y); bw.y = pk2(bflo(xv.y) + p0.z, bfhi(xv.y) + p0.w);
            bw.z = pk2(bflo(xv.z) + p1.x, bfhi(xv.z) + p1.y); bw.w = pk2(bflo(xv.w) + p1.z, bfhi(xv.w) + p1.w);
            const bf16x8 bf = __builtin_bit_cast(bf16x8, bw);
#pragma unroll
            for (int nt = 0; nt < 4; ++nt) { const bf16x8 af = *(const bf16x8*)(w1 + (size_t)(16 * nt + l15) * 2048 + 32 * ks + 8 * q); acc[nt] = MFMA16(af, bf, acc[nt]); }
        }
        f32x4 o2[4];
#pragma unroll
        for (int t2 = 0; t2 < 4; ++t2) o2[t2] = (f32x4){0.f, 0.f, 0.f, 0.f};
#pragma unroll
        for (int k2 = 0; k2 < 2; ++k2) {
            u32x4 pw; pw.x = pk2(siluf_(acc[2 * k2][0]), siluf_(acc[2 * k2][1])); pw.y = pk2(siluf_(acc[2 * k2][2]), siluf_(acc[2 * k2][3]));
            pw.z = pk2(siluf_(acc[2 * k2 + 1][0]), siluf_(acc[2 * k2 + 1][1])); pw.w = pk2(siluf_(acc[2 * k2 + 1][2]), siluf_(acc[2 * k2 + 1][3]));
            const bf16x8 pf = __builtin_bit_cast(bf16x8, pw);
#pragma unroll
            for (int t2 = 0; t2 < 4; ++t2) { const bf16* wp = w2 + (16 * t2 + l15) * 64 + 32 * k2 + 4 * q;
                const u32x2 lo = *(const u32x2*)wp, hi = *(const u32x2*)(wp + 16);
                const bf16x8 av = __builtin_bit_cast(bf16x8, ((u32x4){lo.x, lo.y, hi.x, hi.y})); o2[t2] = MFMA16(av, pf, o2[t2]); }
        }
        if (rvalid) {
            if (kv == 0) { bf16* op = KCMP + ((size_t)(b * 2 + g) * NCP + i) * 64 + 4 * q;
#pragma unroll
                for (int t2 = 0; t2 < 4; ++t2) { u32x2 ow; ow.x = pk2(o2[t2][0], o2[t2][1]); ow.y = pk2(o2[t2][2], o2[t2][3]); *(u32x2*)(op + 16 * t2) = ow; }
            } else { bf16* op = VCMPT + (size_t)(b * 2 + g) * 64 * NCP + i;
#pragma unroll
                for (int t2 = 0; t2 < 4; ++t2)
#pragma unroll
                    for (int r2 = 0; r2 < 4; ++r2) op[(size_t)(16 * t2 + 4 * q + r2) * NCP] = f2bf(o2[t2][r2]); }
        }
    }
    for (int z = gw * 64 + lane; z < NB * 2 * 64; z += ngw * 64) { const int bg = z >> 6, dd = z & 63; KCMP[((size_t)bg * NCP + NC) * 64 + dd] = 0; VCMPT[((size_t)bg * 64 + dd) * NCP + NC] = 0; }
}
DI void nsa_vt_phase(const bf16* Y1, bf16* VST, bf16* VWT, int gw, int ngw, int lane) {
    for (int task = gw; task < 2 * NB * 2 * 128; task += ngw) {
        const int which = task & 1, g = (task >> 1) & 1, b = (task >> 2) & 3, blk = task >> 4;
        const int t = blk * 64 + lane;
        const bf16* src = Y1 + (size_t)(b * T + t) * OINP + (which ? 1664 : 1408) + g * 64;
        bf16* dst = (which ? VWT : VST) + (size_t)(b * 2 + g) * 64 * T + t;
        u32x4 v[8];
#pragma unroll
        for (int c = 0; c < 8; ++c) v[c] = *(const u32x4*)(src + 8 * c);
#pragma unroll
        for (int c = 0; c < 8; ++c) {
            dst[(size_t)(8 * c + 0) * T] = (bf16)(v[c].x & 0xffff); dst[(size_t)(8 * c + 1) * T] = (bf16)(v[c].x >> 16);
            dst[(size_t)(8 * c + 2) * T] = (bf16)(v[c].y & 0xffff); dst[(size_t)(8 * c + 3) * T] = (bf16)(v[c].y >> 16);
            dst[(size_t)(8 * c + 4) * T] = (bf16)(v[c].z & 0xffff); dst[(size_t)(8 * c + 5) * T] = (bf16)(v[c].z >> 16);
            dst[(size_t)(8 * c + 6) * T] = (bf16)(v[c].w & 0xffff); dst[(size_t)(8 * c + 7) * T] = (bf16)(v[c].w >> 16);
        }
    }
}
constexpr int TL = 72;
constexpr int SLAB_LD = 132;
constexpr float C1 = 0.125f * LOG2E;
DI void tile_fetch(const bf16* kg, int ldk, const bf16* vg, int ldv, int tid, u32x4& kr, u32x4& vr) {
    const int r = tid >> 3, c = (tid & 7) * 8;
    kr = *(const u32x4*)(kg + (size_t)r * ldk + c); vr = *(const u32x4*)(vg + (size_t)r * ldv + c);
}
DI void tile_store(LAS bf16* Kb, LAS bf16* Vb, int tid, u32x4 kr, u32x4 vr) {
    const int r = tid >> 3, c = (tid & 7) * 8;
    *(LAS u32x4*)(Kb + r * TL + c) = kr; *(LAS u32x4*)(Vb + r * TL + c) = vr;
}
DI void tile_scores(const LAS bf16* Kb, const bf16x8 (&qf)[2], int l15, int q, f32x4 (&sc)[4]) {
#pragma unroll
    for (int x = 0; x < 4; ++x) { sc[x] = (f32x4){0.f, 0.f, 0.f, 0.f};
#pragma unroll
        for (int ks = 0; ks < 2; ++ks) { const bf16x8 a = *(const LAS bf16x8*)(Kb + (16 * x + l15) * TL + 32 * ks + 8 * q); sc[x] = MFMA16(a, qf[ks], sc[x]); } }
}
DI void tile_pv(const LAS bf16* Vb, const float (&p)[16], f32x4 (&acc)[4], int l15, int q) {
#pragma unroll
    for (int k2 = 0; k2 < 2; ++k2) {
        u32x4 pw; pw.x = pk2(p[8 * k2], p[8 * k2 + 1]); pw.y = pk2(p[8 * k2 + 2], p[8 * k2 + 3]); pw.z = pk2(p[8 * k2 + 4], p[8 * k2 + 5]); pw.w = pk2(p[8 * k2 + 6], p[8 * k2 + 7]);
        const bf16x8 pf = __builtin_bit_cast(bf16x8, pw);
#pragma unroll
        for (int dt = 0; dt < 4; ++dt) { const LAS bf16* r = Vb + (16 * dt + l15) * TL + 32 * k2 + 4 * q;
            const u32x2 lo = *(const LAS u32x2*)r, hi = *(const LAS u32x2*)(r + 16);
            const bf16x8 av = __builtin_bit_cast(bf16x8, ((u32x4){lo.x, lo.y, hi.x, hi.y})); acc[dt] = MFMA16(av, pf, acc[dt]); }
    }
}
template <bool MASKED, int KS>
DI float tile_logits(const f32x4 (&sc)[4], float (&s)[16], int d0, float slope2, unsigned lim, bool extra) {
    const float A = -slope2 * (float)d0; float mx = -INFINITY;
#pragma unroll
    for (int e = 0; e < 16; ++e) { const int ke = KS * (16 * (e >> 2) + (e & 3)); float v = sc[e >> 2][e & 3] * C1 + (A + slope2 * (float)ke);
        if (MASKED) { const bool valid = extra && ((unsigned)(d0 - ke) < lim); v = valid ? v : -INFINITY; }
        s[e] = v; mx = fmaxf(mx, v); }
    mx = fmaxf(mx, __shfl_xor(mx, 16)); mx = fmaxf(mx, __shfl_xor(mx, 32));
    return mx;
}
template <bool MASKED>
DI void tile_step(const LAS bf16* Kb, const LAS bf16* Vb, const bf16x8 (&qf)[2], f32x4 (&acc)[4], float& m, float& lp, int d0, float slope2, unsigned lim, bool extra, int l15, int q) {
    f32x4 sc[4]; tile_scores(Kb, qf, l15, q, sc);
    float s[16]; const float mx = tile_logits<MASKED, 1>(sc, s, d0, slope2, lim, extra);
    const float mn = fmaxf(m, mx), alpha = exp2f(m - mn); m = mn;
    float ps = 0.f;
#pragma unroll
    for (int e = 0; e < 16; ++e) { s[e] = exp2f(s[e] - mn); ps += s[e]; }
    lp = lp * alpha + ps;
#pragma unroll
    for (int dt = 0; dt < 4; ++dt) { acc[dt][0] *= alpha; acc[dt][1] *= alpha; acc[dt][2] *= alpha; acc[dt][3] *= alpha; }
    tile_pv(Vb, s, acc, l15, q);
}
DI void nsa_attn_phase(const bf16* Y1, const bf16* KCMP, const bf16* VCMPT, const bf16* VST, const bf16* VWT, bf16* MIX, LAS unsigned char* lds) {
    LAS bf16* KB0 = (LAS bf16*)lds;
    LAS bf16* VB0 = KB0 + 2 * 64 * TL;
    LAS float* slab = (LAS float*)(lds + 36864);
    LAS float* pslc = slab + 8 * 16 * SLAB_LD;
    LAS unsigned* selm = (LAS unsigned*)(pslc + 16 * 128);
    LAS unsigned* uni = selm + 64;
    LAS unsigned* blist = uni + 4;
    const int tid = threadIdx.x, lane = tid & 63, w = tid >> 6, l15 = lane & 15, q = lane >> 4;
    LAS float* myslab = slab + w * 16 * SLAB_LD;
#define KBUF(i) (KB0 + ((i) & 1) * 64 * TL)
#define VBUF(i) (VB0 + ((i) & 1) * 64 * TL)
    for (int u = blockIdx.x; u < NB * 2 * (T / 16); u += gridDim.x) {
        const int b = u & 3, g = (u >> 2) & 1, tile = u >> 3, t0 = tile * 16, qblk = t0 >> 6;
        const int h = g * 8 + w; const float slope = exp2f(-0.5f * (float)(h + 1)), slope2 = slope * LOG2E;
        const int t = t0 + l15; const size_t row = (size_t)b * T + t;
        bf16x8 qf[2];
        qf[0] = *(const bf16x8*)(Y1 + row * OINP + h * 64 + 8 * q); qf[1] = *(const bf16x8*)(Y1 + row * OINP + h * 64 + 32 + 8 * q);
        const bf16* gl = Y1 + row * OINP + 1792 + h * 3;
        const float g0 = sigmoidf_(bf2f(gl[0])), g1 = sigmoidf_(bf2f(gl[1])), g2 = sigmoidf_(bf2f(gl[2]));
        for (int i = lane; i < 16 * SLAB_LD; i += 64) myslab[i] = 0.f;
        if (tid < 64) selm[tid] = 0u; if (tid < 4) uni[tid] = 0u;
        f32x4 ot[4];
        u32x4 kr, vr;
        {
            const bf16* kc = KCMP + (size_t)(b * 2 + g) * NCP * 64; const bf16* vct = VCMPT + (size_t)(b * 2 + g) * 64 * NCP;
            const int nst = tile >= 1 ? ((tile - 1) >> 6) + 1 : 0;
            const int dc = t - 31 - 64 * q;
            float m = -1e30f, lp = 0.f;
            f32x4 acc[4];
#pragma unroll
            for (int dt = 0; dt < 4; ++dt) acc[dt] = (f32x4){0.f, 0.f, 0.f, 0.f};
            float inv = 0.f;
            for (int pass = 0; pass < 2; ++pass) {
                if (nst > 0) { tile_fetch(kc, 64, vct, NCP, tid, kr, vr); tile_store(KBUF(0), VBUF(0), tid, kr, vr); }
                __syncthreads();
                for (int s = 0; s < nst; ++s) {
                    const bool more = s + 1 < nst;
                    if (more) tile_fetch(kc + (size_t)(64 * (s + 1)) * 64, 64, vct + 64 * (s + 1), NCP, tid, kr, vr);
                    f32x4 sc[4]; tile_scores(KBUF(s), qf, l15, q, sc);
                    float sv[16]; float mx;
                    const int d0 = dc - 1024 * s;
                    if (64 * s + 63 <= tile - 2) mx = tile_logits<false, 16>(sc, sv, d0, slope2, 0x7fffffffu, true);
                    else mx = tile_logits<true, 16>(sc, sv, d0, slope2, 0x7fffffffu, true);
                    if (pass == 0) {
                        const float mn = fmaxf(m, mx); float ps = 0.f;
#pragma unroll
                        for (int e = 0; e < 16; ++e) ps += exp2f(sv[e] - mn);
                        lp = lp * exp2f(m - mn) + ps; m = mn;
                    } else {
#pragma unroll
                        for (int e = 0; e < 16; ++e) sv[e] = exp2f(sv[e] - m) * inv;
#pragma unroll
                        for (int x = 0; x < 4; ++x) { const int j = 16 * s + 4 * x + q;
                            __hip_atomic_fetch_add(&myslab[l15 * SLAB_LD + j], (sv[4 * x] + sv[4 * x + 1]) + (sv[4 * x + 2] + 0.5f * sv[4 * x + 3]), __ATOMIC_RELAXED, __HIP_MEMORY_SCOPE_WORKGROUP);
                            __hip_atomic_fetch_add(&myslab[l15 * SLAB_LD + j + 1], 0.5f * sv[4 * x + 3], __ATOMIC_RELAXED, __HIP_MEMORY_SCOPE_WORKGROUP); }
                        tile_pv(VBUF(s), sv, acc, l15, q);
                    }
                    if (more) tile_store(KBUF(s + 1), VBUF(s + 1), tid, kr, vr);
                    __syncthreads();
                }
                if (pass == 0) { float l = lp; l += __shfl_xor(l, 16); l += __shfl_xor(l, 32); inv = l > 0.f ? 1.0f / l : 0.f; }
            }
#pragma unroll
            for (int dt = 0; dt < 4; ++dt) { ot[dt][0] = g0 * acc[dt][0]; ot[dt][1] = g0 * acc[dt][1]; ot[dt][2] = g0 * acc[dt][2]; ot[dt][3] = g0 * acc[dt][3]; }
        }
        __syncthreads();
#pragma unroll 1
        for (int k = 0; k < 4; ++k) { const int idx = tid + 512 * k, tok = idx >> 7, j = idx & 127; float s = 0.f;
#pragma unroll
            for (int ww = 0; ww < 8; ++ww) s += slab[(ww * 16 + tok) * SLAB_LD + j];
            const bool forced = (j == 0) || (j == qblk) || (j == qblk - 1);
            pslc[tok * 128 + j] = forced ? 1e9f : (j <= qblk ? s : -1e30f); }
        __syncthreads();
#pragma unroll 1
        for (int k = 0; k < 4; ++k) { const int idx = tid + 512 * k, tok = idx >> 7, j = idx & 127;
            if (j <= qblk) { const float my = pslc[tok * 128 + j]; int rank = 0;
                for (int jj = 0; jj <= qblk; ++jj) { const float o = pslc[tok * 128 + jj]; rank += (o > my || (o == my && jj < j)) ? 1 : 0; }
                if (rank < 16) { __hip_atomic_fetch_or(&selm[tok * 4 + (j >> 5)], 1u << (j & 31), __ATOMIC_RELAXED, __HIP_MEMORY_SCOPE_WORKGROUP); __hip_atomic_fetch_or(&uni[j >> 5], 1u << (j & 31), __ATOMIC_RELAXED, __HIP_MEMORY_SCOPE_WORKGROUP); } } }
        __syncthreads();
        if (tid < 128) { const unsigned u0 = uni[0], u1 = uni[1], u2 = uni[2], u3 = uni[3]; const int wd = tid >> 5, bt = tid & 31;
            const unsigned uw = wd == 0 ? u0 : wd == 1 ? u1 : wd == 2 ? u2 : u3;
            if ((uw >> bt) & 1u) { const int pos = (wd > 0 ? __popc(u0) : 0) + (wd > 1 ? __popc(u1) : 0) + (wd > 2 ? __popc(u2) : 0) + __popc(uw & ((1u << bt) - 1u)); blist[pos] = (unsigned)tid; }
            if (tid == 0) blist[128] = (unsigned)(__popc(u0) + __popc(u1) + __popc(u2) + __popc(u3)); }
        __syncthreads();
        {
            const bf16* kb = Y1 + (size_t)b * T * OINP + 1280 + g * 64; const bf16* vt = VST + (size_t)(b * 2 + g) * 64 * T;
            float m = -1e30f, lp = 0.f; f32x4 acc[4];
#pragma unroll
            for (int dt = 0; dt < 4; ++dt) acc[dt] = (f32x4){0.f, 0.f, 0.f, 0.f};
            unsigned am = selm[lane];
            am &= __shfl_xor(am, 4); am &= __shfl_xor(am, 8); am &= __shfl_xor(am, 16); am &= __shfl_xor(am, 32);
            const unsigned am0 = __builtin_amdgcn_readlane(am, 0), am1 = __builtin_amdgcn_readlane(am, 1), am2 = __builtin_amdgcn_readlane(am, 2), am3 = __builtin_amdgcn_readlane(am, 3);
            const int nsel = (int)__builtin_amdgcn_readfirstlane((int)blist[128]);
            int j = (int)__builtin_amdgcn_readfirstlane((int)blist[0]);
            tile_fetch(kb + (size_t)(64 * j) * OINP, OINP, vt + 64 * j, T, tid, kr, vr); tile_store(KBUF(0), VBUF(0), tid, kr, vr);
            __syncthreads();
            for (int i = 0; i < nsel; ++i) {
                const bool more = i + 1 < nsel;
                int jn = 0;
                if (more) { jn = (int)__builtin_amdgcn_readfirstlane((int)blist[i + 1]); tile_fetch(kb + (size_t)(64 * jn) * OINP, OINP, vt + 64 * jn, T, tid, kr, vr); }
                const int wd = j >> 5; const unsigned aw = wd == 0 ? am0 : wd == 1 ? am1 : wd == 2 ? am2 : am3;
                const int d0 = t - 64 * j - 4 * q;
                if (((aw >> (j & 31)) & 1u) && j < qblk) tile_step<false>(KBUF(i), VBUF(i), qf, acc, m, lp, d0, slope2, 0x7fffffffu, true, l15, q);
                else { const bool selb = (selm[l15 * 4 + wd] >> (j & 31)) & 1u; tile_step<true>(KBUF(i), VBUF(i), qf, acc, m, lp, d0, slope2, 0x7fffffffu, selb, l15, q); }
                if (more) tile_store(KBUF(i + 1), VBUF(i + 1), tid, kr, vr);
                j = jn;
                __syncthreads();
            }
            float l = lp; l += __shfl_xor(l, 16); l += __shfl_xor(l, 32);
            const float sc = l > 0.f ? g1 / l : 0.f;
#pragma unroll
            for (int dt = 0; dt < 4; ++dt) { ot[dt][0] += sc * acc[dt][0]; ot[dt][1] += sc * acc[dt][1]; ot[dt][2] += sc * acc[dt][2]; ot[dt][3] += sc * acc[dt][3]; }
        }
        {
            const bf16* kb = Y1 + (size_t)b * T * OINP + 1536 + g * 64; const bf16* vt = VWT + (size_t)(b * 2 + g) * 64 * T;
            float m = -1e30f, lp = 0.f; f32x4 acc[4];
#pragma unroll
            for (int dt = 0; dt < 4; ++dt) acc[dt] = (f32x4){0.f, 0.f, 0.f, 0.f};
            int kstart = t0 - 511; kstart = kstart < 0 ? 0 : (kstart & ~63);
            const int nw = ((t0 + 15 - kstart) >> 6) + 1;
            tile_fetch(kb + (size_t)kstart * OINP, OINP, vt + kstart, T, tid, kr, vr); tile_store(KBUF(0), VBUF(0), tid, kr, vr);
            __syncthreads();
            for (int i = 0; i < nw; ++i) {
                const bool more = i + 1 < nw; const int key0 = kstart + 64 * i;
                if (more) tile_fetch(kb + (size_t)(key0 + 64) * OINP, OINP, vt + key0 + 64, T, tid, kr, vr);
                const int d0 = t - key0 - 4 * q;
                if (key0 + 63 <= t0 && key0 >= t0 - 496) tile_step<false>(KBUF(i), VBUF(i), qf, acc, m, lp, d0, slope2, 512u, true, l15, q);
                else tile_step<true>(KBUF(i), VBUF(i), qf, acc, m, lp, d0, slope2, 512u, true, l15, q);
                if (more) tile_store(KBUF(i + 1), VBUF(i + 1), tid, kr, vr);
                __syncthreads();
            }
            float l = lp; l += __shfl_xor(l, 16); l += __shfl_xor(l, 32);
            const float sc = l > 0.f ? g2 / l : 0.f;
#pragma unroll
            for (int dt = 0; dt < 4; ++dt) { ot[dt][0] += sc * acc[dt][0]; ot[dt][1] += sc * acc[dt][1]; ot[dt][2] += sc * acc[dt][2]; ot[dt][3] += sc * acc[dt][3]; }
        }
        bf16* op = MIX + row * D + h * 64 + 4 * q;
#pragma unroll
        for (int dt = 0; dt < 4; ++dt) { u32x2 ow; ow.x = pk2(ot[dt][0], ot[dt][1]); ow.y = pk2(ot[dt][2], ot[dt][3]); *(u32x2*)(op + 16 * dt) = ow; }
    }
#undef KBUF
#undef VBUF
}
struct Args { const float* in[19]; float* out; unsigned char* ws; int ph_lo, ph_hi; };
constexpr int N_PHASES = 18;
template <class Epi>
DI void run_gemm(LAS unsigned char* lds, const bf16* A, const bf16* Bt, int N, int K, const Epi& E) {
    pg8::Gemm g{A, Bt, M, N, K}; pg8::StaticOrder S; S.init(M, N, (int)gridDim.x, (int)blockIdx.x);
    pg8::gemm_phase<Epi, pg8::StaticOrder, true, true>(lds, g, S, E);
}
__global__ void __launch_bounds__(512, 2) mega(Args a) {
    extern __shared__ __attribute__((aligned(16))) unsigned char lds_raw[];
    LAS unsigned char* lds = (LAS unsigned char*)lds_raw;
    cg::grid_group grid = cg::this_grid();
    const int tid = threadIdx.x, lane = tid & 63, wave = __builtin_amdgcn_readfirstlane(tid >> 6);
    const int gw = blockIdx.x * 8 + wave, ngw = gridDim.x * 8;
#define WSP(off) ((bf16*)(a.ws + (off)))
#define W_EIN WSP(WS_EIN)
#define W_EOUT WSP(WS_EOUT)
#define W_OIN WSP(WS_OIN)
#define W_OOUT WSP(WS_OOUT)
#define W_GU WSP(WS_GU)
#define W_DN WSP(WS_DN)
#define W1K WSP(WS_W1K)
#define W1V WSP(WS_W1V)
#define W2K WSP(WS_W2K)
#define W2V WSP(WS_W2V)
#define DEC ((float*)(a.ws + WS_DEC))
#define KCMP WSP(WS_KCMP)
#define VCMPT WSP(WS_VCMPT)
#define Y WSP(WS_Y)
#define VST WSP(WS_VST)
#define VWT WSP(WS_VWT)
#define HN WSP(WS_HN)
#define ST ((bf16*)a.out)
    const int lo = a.ph_lo, hi = a.ph_hi;
#define PH(k) if (lo <= (k) && (k) < hi)
#define SEAM(k) if (lo <= (k) && (k) + 1 < hi) grid.sync()
    PH(0) {
        LAS float* scr = (LAS float*)(lds + wave * 8448);
        constexpr int I0 = 2048, I1 = 512, I2 = 1024, I3 = 512, I4 = 2816, I5 = 1408, I6 = 64, I7 = 2;
        constexpr int NIT = I0 + I1 + I2 + I3 + 2 * I4 + 2 * I5 + 2 * I6 + 2 * I7;
        for (int it = gw; it < NIT; it += ngw) {
            int r = it;
            if (r < I0) { transpose_item(a.in[4], 1024, EIN, EIN, W_EIN, 0, scr, r, lane); continue; } r -= I0;
            if (r < I1) { transpose_item(a.in[8], 1024, 1024, 1024, W_EOUT, 0, scr, r, lane); continue; } r -= I1;
            if (r < I2) { transpose_item(a.in[9], 1024, OIN, OINP, W_OIN, 0, scr, r, lane); continue; } r -= I2;
            if (r < I3) { transpose_item(a.in[16], 1024, 1024, 1024, W_OOUT, 0, scr, r, lane); continue; } r -= I3;
            if (r < 2 * I4) { const int l = r / I4; transpose_item(a.in[17] + (size_t)l * D * 2 * FF, 1024, 2 * FF, 2 * FF, W_GU + (size_t)l * GU_STRIDE, 1, scr, r % I4, lane); continue; } r -= 2 * I4;
            if (r < 2 * I5) { const int l = r / I5; transpose_item(a.in[18] + (size_t)l * FF * D, FF, 1024, 1024, W_DN + (size_t)l * DN_STRIDE, 0, scr, r % I5, lane); continue; } r -= 2 * I5;
            if (r < I6) { transpose_item(a.in[12], 2048, 64, 64, W1K, 0, scr, r, lane); continue; } r -= I6;
            if (r < I6) { transpose_item(a.in[14], 2048, 64, 64, W1V, 0, scr, r, lane); continue; } r -= I6;
            if (r < I7) { transpose_item(a.in[13], 64, 64, 64, W2K, 0, scr, r, lane); continue; } r -= I7;
            transpose_item(a.in[15], 64, 64, 64, W2V, 0, scr, r, lane);
        }
        norm_rows_bf16(a.in[0], a.in[1], HN, gw, ngw, lane);
    }
    SEAM(0);
    PH(1) { EpiStore E{Y, EIN}; run_gemm(lds, HN, W_EIN, EIN, 1024, E); }
    SEAM(1);
    PH(2) { la_state_phase(Y, a.in[5], ST, DEC, lds); }
    SEAM(2);
    PH(3) { la_scan_phase(ST, DEC); }
    SEAM(3);
    PH(4) { la_out_phase(Y, a.in[5], ST, a.in[6], a.in[7], HN, lds); }
    SEAM(4);
    PH(5) { EpiResid E{a.in[0], a.out}; run_gemm(lds, HN, W_EOUT, 1024, 1024, E); }
    SEAM(5);
    PH(6) { norm_rows_bf16(a.out, a.in[2], HN, gw, ngw, lane); }
    SEAM(6);
    PH(7) { EpiSwiglu E{Y}; run_gemm(lds, HN, W_GU, 2 * FF, 1024, E); }
    SEAM(7);
    PH(8) { EpiResid E{a.out, a.out}; run_gemm(lds, Y, W_DN, 1024, FF, E); }
    SEAM(8);
    PH(9) { norm_rows_bf16(a.out, a.in[1] + D, HN, gw, ngw, lane); }
    SEAM(9);
    PH(10) { EpiStore E{Y, OINP}; run_gemm(lds, HN, W_OIN, OINP, 1024, E); }
    SEAM(10);
    PH(11) { nsa_compress_phase(Y, a.in[10], a.in[11], W1K, W1V, W2K, W2V, KCMP, VCMPT, gw, ngw, lane); nsa_vt_phase(Y, VST, VWT, gw, ngw, lane); }
    SEAM(11);
    PH(12) { nsa_attn_phase(Y, KCMP, VCMPT, VST, VWT, HN, lds); }
    SEAM(12);
    PH(13) { EpiResid E{a.out, a.out}; run_gemm(lds, HN, W_OOUT, 1024, 1024, E); }
    SEAM(13);
    PH(14) { norm_rows_bf16(a.out, a.in[2] + D, HN, gw, ngw, lane); }
    SEAM(14);
    PH(15) { EpiSwiglu E{Y}; run_gemm(lds, HN, W_GU + GU_STRIDE, 2 * FF, 1024, E); }
    SEAM(15);
    PH(16) { EpiResid E{a.out, a.out}; run_gemm(lds, Y, W_DN + DN_STRIDE, 1024, FF, E); }
    SEAM(16);
    PH(17) { norm_rows_f32_inplace(a.out, a.in[3], gw, ngw, lane); }
#undef PH
#undef SEAM
}

extern "C" void kernel_launch(void* const* d_in, const int* in_sizes, int n_in, void* d_out, int out_size, void* d_ws, size_t ws_size, hipStream_t stream) {
    static int grid = 0;
    if (grid == 0) {
        if (n_in != 19 || in_sizes[0] != M * D || out_size != M * D || ws_size < WS_END) { fprintf(stderr, "kernel_launch: unexpected shapes (n_in %d, in0 %d, out %d, ws %zu)\n", n_in, n_in > 0 ? in_sizes[0] : -1, out_size, ws_size); grid = -1; return; }
        int dev = 0, cus = 0, per_cu = 0;
        (void)hipGetDevice(&dev); (void)hipDeviceGetAttribute(&cus, hipDeviceAttributeMultiprocessorCount, dev);
        if (hipFuncSetAttribute((const void*)mega, hipFuncAttributeMaxDynamicSharedMemorySize, LDS_BYTES) != hipSuccess) { fprintf(stderr, "kernel_launch: hipFuncSetAttribute failed\n"); grid = -1; return; }
        if (hipOccupancyMaxActiveBlocksPerMultiprocessor(&per_cu, (const void*)mega, 512, LDS_BYTES) != hipSuccess || per_cu < 1) { fprintf(stderr, "kernel_launch: occupancy query says %d\n", per_cu); per_cu = 1; }
        (void)hipGetLastError();
        grid = cus * 1;
    }
    if (grid < 0) return;
    Args a{};
    for (int i = 0; i < 19; ++i) a.in[i] = (const float*)d_in[i];
    a.out = (float*)d_out; a.ws = (unsigned char*)d_ws; a.ph_lo = 0; a.ph_hi = N_PHASES;
    void* args[] = {&a};
    hipError_t e = hipLaunchCooperativeKernel((const void*)mega, dim3(grid), dim3(512), args, LDS_BYTES, stream);
    if (e != hipSuccess) fprintf(stderr, "kernel_launch: cooperative launch failed: %s (grid %d)\n", hipGetErrorString(e), grid);
#ifdef PROBE_PHASES
    { const int pp[] = {PROBE_PHASES};
      for (unsigned i = 0; i < sizeof(pp) / sizeof(pp[0]); ++i) { a.ph_lo = pp[i]; a.ph_hi = pp[i] + 1; (void)hipLaunchCooperativeKernel((const void*)mega, dim3(grid), dim3(512), args, LDS_BYTES, stream); } }
#endif
}
```

```cpp
#include <hip/hip_runtime.h>
#include <hip/hip_cooperative_groups.h>
#include <cstdio>
#include <cstdint>
namespace cg = cooperative_groups;
namespace pg8 {
#define PG8_LAS __attribute__((address_space(3)))
typedef unsigned short bf16_t;
typedef short bf16x8 __attribute__((ext_vector_type(8)));
typedef float f32x4 __attribute__((ext_vector_type(4)));
typedef unsigned u32x4 __attribute__((ext_vector_type(4)));
constexpr int BM = 256, BK = 64, HALF = 128, HTB = HALF * BK * 2  , STAGE_BYTES = 8 * HTB, NXCD = 8, WGM = 8;

__host__ __device__ __forceinline__ int lds_byte(int r, int c) { const int st = (r >> 4) * 2 + (c >> 5), rr = r & 15, cc = c & 31, ob = rr * 64 + cc * 2; return st * 1024 + (ob ^ (((ob >> 9) & 1) << 5)); }
__host__ __device__ __forceinline__ void stage_rc(int b, int& R, int& C) { const int st = b / 1024, sb = b % 1024, swz = sb ^ (((sb >> 9) & 1) << 5); R = (st >> 1) * 16 + swz / 64; C = (st & 1) * 32 + (swz % 64) / 2; }
__host__ __device__ __forceinline__ int perm32(int rho) { const int n = rho >> 4, i = rho & 15; return 8 * (i >> 2) + 4 * n + (i & 3); }

struct Unit { int pm, pn; };
struct Gemm { const bf16_t* A; const bf16_t* Bt; int M, N, K; };

struct StaticOrder {
    int nM, nN, nwg, G, c;
    __host__ __device__ void init(int M, int N, int G_, int c_) { nM = M / BM; nN = N / BM; nwg = nM * nN; G = G_; c = c_; }
    __host__ __device__ bool next(int i, Unit& u) const {
        const long L = (long)i * G + c; if (L >= nwg) return false;
        int wgid = (int)L; { const int q = nwg / NXCD, r = nwg % NXCD, xcd = wgid % NXCD, off = wgid / NXCD; wgid = (xcd < r ? xcd * (q + 1) : r * (q + 1) + (xcd - r) * q) + off; }
        const int nig = WGM * nN, gid = wgid / nig, fm = gid * WGM, gsz = (nM - fm) < WGM ? (nM - fm) : WGM;
        u.pm = fm + ((wgid % nig) % gsz); u.pn = (wgid % nig) / gsz; return true;
    }
    __device__ __forceinline__ void a_ready(const Unit&) const {}
    __device__ __forceinline__ void done(const Unit&) const {}
};

__device__ __forceinline__ unsigned cvt_pk_bf16(float lo, float hi) { unsigned r; asm volatile("v_cvt_pk_bf16_f32 %0, %1, %2" : "=v"(r) : "v"(lo), "v"(hi)); return r; }
template <class Epi, class Sched, bool ALIGN_EPI = false, bool SP2 = false>
__device__ __forceinline__ void gemm_phase(PG8_LAS unsigned char* lds, const Gemm g, const Sched& S, const Epi& E) {
    const int tid = threadIdx.x, wid = __builtin_amdgcn_readfirstlane(tid >> 6), lane = tid & 63, wr = wid >> 2, wc = wid & 3, fr = lane & 15, fq = lane >> 4;
    const int K = g.K, nt = K / BK;
    unsigned voffA[2], voffB[2];
#pragma unroll
    for (int i = 0; i < 2; ++i) { int R, C; stage_rc(tid * 16 + i * 8192, R, C); const int Rb = Epi::PERM ? ((R & ~31) + perm32(R & 31)) : R;
        voffA[i] = (unsigned)(R * K + C) * 2u; voffB[i] = (unsigned)(Rb * K + C) * 2u; }
    const size_t kstep = (size_t)(BK * 2);
    const size_t hstep = (size_t)HALF * K * 2;
    const size_t tstep = 2 * hstep;
    const unsigned ldsw = (unsigned)wid * 1024u;
    const int aoff = lds_byte(wr * 64 + fr, fq * 8), boff = lds_byte(wc * 32 + fr, fq * 8);
#define PG8_SA(b, h) (((b) * 2 + (h)) * HTB)
#define PG8_SB(b, h) ((4 + (b) * 2 + (h)) * HTB)
#define PG8_STAGE(bufoff, gbase, voff) do { _Pragma("unroll") for (int _i = 0; _i < 2; ++_i) \
        __builtin_amdgcn_global_load_lds((const unsigned*)((const char*)(gbase) + (voff)[_i]), (PG8_LAS unsigned*)(lds + (bufoff) + ldsw + _i * 8192), 16, 0, 0); } while (0)
#define PG8_LDA(dst, b, h) do { _Pragma("unroll") for (int m = 0; m < 4; ++m) _Pragma("unroll") for (int k = 0; k < 2; ++k) dst[m][k] = *(const PG8_LAS bf16x8*)(lds + PG8_SA(b, h) + aoff + m * 2048 + k * 1024); } while (0)
#define PG8_LDB(dst, b, h) do { _Pragma("unroll") for (int n = 0; n < 2; ++n) _Pragma("unroll") for (int k = 0; k < 2; ++k) dst[n][k] = *(const PG8_LAS bf16x8*)(lds + PG8_SB(b, h) + boff + n * 2048 + k * 1024); } while (0)
#define PG8_MMA(ai, bj, At, Bt) do { __builtin_amdgcn_s_setprio(1); _Pragma("unroll") for (int m = 0; m < 4; ++m) _Pragma("unroll") for (int n = 0; n < 2; ++n) _Pragma("unroll") for (int k = 0; k < 2; ++k) \
        acc[ai][bj][m][n] = __builtin_amdgcn_mfma_f32_16x16x32_bf16(Bt[n][k], At[m][k], acc[ai][bj][m][n], 0, 0, 0); __builtin_amdgcn_s_setprio(0); } while (0)
#define PG8_WAIT_V(n) asm volatile("s_waitcnt vmcnt(" #n ")" ::: "memory")
#define PG8_WAIT_L(n) asm volatile("s_waitcnt lgkmcnt(" #n ")" ::: "memory")
#define PG8_BAR __builtin_amdgcn_s_barrier()
#define PG8_SCHED __builtin_amdgcn_sched_barrier(0)
    Unit cur, nxt; int ui = 0;
    if (!S.next(0, cur)) return;
    f32x4 acc[2][2][4][2];
#pragma unroll
    for (int a = 0; a < 2; ++a)
#pragma unroll
        for (int b = 0; b < 2; ++b)
#pragma unroll
            for (int m = 0; m < 4; ++m)
#pragma unroll
                for (int n = 0; n < 2; ++n) acc[a][b][m][n] = (f32x4){0.f, 0.f, 0.f, 0.f};
    bf16x8 At[4][2], B0[2][2], B1[2][2];
    const char* cA = (const char*)g.A + (size_t)cur.pm * tstep; const char* cB = (const char*)g.Bt + (size_t)cur.pn * tstep;
    S.a_ready(cur);
    if constexpr (SP2) {
        PG8_STAGE(PG8_SB(0, 0), cB, voffB); PG8_STAGE(PG8_SB(0, 1), cB + hstep, voffB); PG8_STAGE(PG8_SA(0, 0), cA, voffA); PG8_STAGE(PG8_SA(0, 1), cA + hstep, voffA);
        if (wr == 1) PG8_BAR;
        PG8_WAIT_V(2); PG8_BAR;
        PG8_STAGE(PG8_SB(1, 0), cB + kstep, voffB); PG8_STAGE(PG8_SA(1, 0), cA + kstep, voffA); PG8_STAGE(PG8_SB(1, 1), cB + hstep + kstep, voffB);
        PG8_WAIT_V(6); PG8_BAR;
    } else {
        PG8_STAGE(PG8_SB(0, 0), cB, voffB); PG8_STAGE(PG8_SA(0, 0), cA, voffA); PG8_STAGE(PG8_SB(0, 1), cB + hstep, voffB); PG8_STAGE(PG8_SA(0, 1), cA + hstep, voffA);
        if (wr == 1) PG8_BAR;
        PG8_WAIT_V(4); PG8_BAR;
        PG8_STAGE(PG8_SB(1, 0), cB + kstep, voffB); PG8_STAGE(PG8_SA(1, 0), cA + kstep, voffA); PG8_STAGE(PG8_SB(1, 1), cB + hstep + kstep, voffB);
        PG8_WAIT_V(6); PG8_BAR;
    }
    for (;;) {
        const bool has_next = S.next(ui + 1, nxt);
        const char* nA = has_next ? (const char*)g.A + (size_t)nxt.pm * tstep : cA; const char* nB = has_next ? (const char*)g.Bt + (size_t)nxt.pn * tstep : cB;
        for (int t = 0; t < nt; t += 2) {
            const bool last = (t == nt - 2);
            const char* a1 = cA + (size_t)(t + 1) * kstep;
            const char* a2 = last ? nA : cA + (size_t)(t + 2) * kstep; const char* b2 = last ? nB : cB + (size_t)(t + 2) * kstep;
            const char* a3 = a2 + kstep; const char* b3 = b2 + kstep;
            if (last && has_next) S.a_ready(nxt);
            if constexpr (SP2) {
            PG8_LDB(B0, 0, 0); PG8_LDB(B1, 0, 1); PG8_SCHED; PG8_LDA(At, 0, 0); PG8_STAGE(PG8_SA(1, 1), a1 + hstep, voffA);
            PG8_WAIT_V(8); PG8_WAIT_L(0); PG8_BAR; PG8_MMA(0, 0, At, B0); PG8_MMA(0, 1, At, B1); PG8_BAR; PG8_SCHED;
            PG8_LDA(At, 0, 1); PG8_STAGE(PG8_SB(0, 0), b2, voffB); PG8_STAGE(PG8_SB(0, 1), b2 + hstep, voffB); PG8_STAGE(PG8_SA(0, 0), a2, voffA);
            PG8_WAIT_V(8); PG8_WAIT_L(0); PG8_BAR; PG8_MMA(1, 0, At, B0); PG8_MMA(1, 1, At, B1); PG8_BAR; PG8_SCHED;
            PG8_LDB(B0, 1, 0); PG8_LDB(B1, 1, 1); PG8_SCHED; PG8_LDA(At, 1, 0); PG8_STAGE(PG8_SA(0, 1), a2 + hstep, voffA);
            PG8_WAIT_V(8); PG8_WAIT_L(0); PG8_BAR; PG8_MMA(0, 0, At, B0); PG8_MMA(0, 1, At, B1); PG8_BAR; PG8_SCHED;
            PG8_LDA(At, 1, 1); PG8_STAGE(PG8_SB(1, 0), b3, voffB); PG8_STAGE(PG8_SB(1, 1), b3 + hstep, voffB); PG8_STAGE(PG8_SA(1, 0), a3, voffA);
            PG8_WAIT_V(8); PG8_WAIT_L(0); PG8_BAR; PG8_MMA(1, 0, At, B0); PG8_MMA(1, 1, At, B1); PG8_BAR; PG8_SCHED;
            } else {
            PG8_LDB(B0, 0, 0); PG8_SCHED; PG8_LDA(At, 0, 0); PG8_STAGE(PG8_SA(1, 1), a1 + hstep, voffA);
            PG8_WAIT_L(8); PG8_BAR; PG8_WAIT_L(0); PG8_MMA(0, 0, At, B0); PG8_BAR; PG8_SCHED;
            PG8_LDB(B1, 0, 1); PG8_STAGE(PG8_SB(0, 0), b2, voffB);
            PG8_BAR; PG8_WAIT_L(0); PG8_MMA(0, 1, At, B1); PG8_BAR;
            PG8_LDA(At, 0, 1); PG8_STAGE(PG8_SA(0, 0), a2, voffA);
            PG8_BAR; PG8_WAIT_L(0); PG8_MMA(1, 0, At, B0); PG8_BAR; PG8_SCHED;
            PG8_STAGE(PG8_SB(0, 1), b2 + hstep, voffB);
            PG8_WAIT_V(6); PG8_BAR; PG8_MMA(1, 1, At, B1); PG8_BAR;
            PG8_LDB(B0, 1, 0); PG8_SCHED; PG8_LDA(At, 1, 0); PG8_STAGE(PG8_SA(0, 1), a2 + hstep, voffA);
            PG8_WAIT_L(8); PG8_BAR; PG8_WAIT_L(0); PG8_MMA(0, 0, At, B0); PG8_BAR; PG8_SCHED;
            PG8_LDB(B1, 1, 1); PG8_STAGE(PG8_SB(1, 0), b3, voffB);
            PG8_BAR; PG8_WAIT_L(0); PG8_MMA(0, 1, At, B1); PG8_BAR;
            PG8_LDA(At, 1, 1); PG8_STAGE(PG8_SA(1, 0), a3, voffA);
            PG8_BAR; PG8_WAIT_L(0); PG8_MMA(1, 0, At, B0); PG8_BAR; PG8_SCHED;
            PG8_STAGE(PG8_SB(1, 1), b3 + hstep, voffB);
            PG8_WAIT_V(6); PG8_BAR; PG8_MMA(1, 1, At, B1); PG8_BAR;
            }
        }
        if constexpr (ALIGN_EPI) { if (wr == 0) PG8_BAR; }
        if constexpr (!Epi::AFTER_DRAIN) { E(acc, cur, wr, wc, fr, fq); S.done(cur); }
        if (!has_next) break;
#pragma unroll
        for (int a = 0; a < 2; ++a)
#pragma unroll
            for (int b = 0; b < 2; ++b)
#pragma unroll
                for (int m = 0; m < 4; ++m)
#pragma unroll
                    for (int n = 0; n < 2; ++n) acc[a][b][m][n] = (f32x4){0.f, 0.f, 0.f, 0.f};
        cur = nxt; cA = nA; cB = nB; ++ui;
        if constexpr (ALIGN_EPI) { if (wr == 1) PG8_BAR; }
    }
    PG8_WAIT_V(0);
    if constexpr (!ALIGN_EPI) { if (wr == 0) PG8_BAR; }
    PG8_BAR;
    if constexpr (Epi::AFTER_DRAIN) { E.fused(acc, cur, wr, wc, fr, fq, lds, wid, lane); S.done(cur); }
#undef PG8_SA
#undef PG8_SB
#undef PG8_STAGE
#undef PG8_LDA
#undef PG8_LDB
#undef PG8_MMA
#undef PG8_WAIT_V
#undef PG8_WAIT_L
#undef PG8_BAR
#undef PG8_SCHED
}
}
#define GAS __attribute__((address_space(1)))
#define LAS __attribute__((address_space(3)))
#define DI __device__ __forceinline__
typedef unsigned short bf16;
typedef short bf16x8 __attribute__((ext_vector_type(8)));
typedef short s16x4 __attribute__((ext_vector_type(4)));
typedef float f32x4 __attribute__((ext_vector_type(4)));
typedef float f32x2 __attribute__((ext_vector_type(2)));
typedef unsigned u32x4 __attribute__((ext_vector_type(4)));
typedef unsigned u32x2 __attribute__((ext_vector_type(2)));
typedef __bf16 bf16x2_t __attribute__((ext_vector_type(2)));
#define MFMA16(a, b, c) __builtin_amdgcn_mfma_f32_16x16x32_bf16((a), (b), (c), 0, 0, 0)

constexpr int NB = 4, T = 8192, D = 1024, M = NB * T, FF = 2816;
constexpr int EIN = 4096, OIN = 1840, OINP = 2048;
constexpr float RMS_EPS = 1e-6f, LOG2E = 1.4426950408889634f;
constexpr size_t MiB = 1u << 20;
constexpr size_t WS_EIN = 0, WS_EOUT = 8 * MiB, WS_OIN = 10 * MiB, WS_OOUT = 14 * MiB, WS_GU = 16 * MiB, WS_DN = 38 * MiB;
constexpr size_t WS_W1K = 49 * MiB, WS_W1V = WS_W1K + 256 * 1024, WS_W2K = WS_W1V + 256 * 1024, WS_W2V = WS_W2K + 8192;
constexpr size_t WS_CTL = 56 * MiB, CTL_BYTES = 16384;
constexpr size_t WS_DEC = 52 * MiB, WS_KCMP = 54 * MiB, WS_VCMPT = WS_KCMP + 512 * 1024;
constexpr size_t WS_Y = 64 * MiB;
constexpr size_t WS_VST = 192 * MiB, WS_VWT = 200 * MiB;
constexpr size_t WS_HN = 320 * MiB, WS_ST = 384 * MiB, WS_END = 512 * MiB;
constexpr size_t GU_STRIDE = (size_t)2 * FF * D, DN_STRIDE = (size_t)D * FF;
constexpr int LDS_BYTES = 147456;

DI unsigned pk2(float lo, float hi) { f32x2 v = {lo, hi}; return __builtin_bit_cast(unsigned, __builtin_convertvector(v, bf16x2_t)); }
DI bf16 f2bf(float f) { return (bf16)(pk2(f, 0.f) & 0xffffu); }
DI float bf2f(bf16 x) { return __uint_as_float(((unsigned)x) << 16); }
DI float bflo(unsigned w) { return __uint_as_float(w << 16); }
DI float bfhi(unsigned w) { return __uint_as_float(w & 0xffff0000u); }
DI float wave_sum(float v) {
#pragma unroll
    for (int o = 1; o < 64; o <<= 1) v += __shfl_xor(v, o);
    return v;
}
DI float ex2(float x) { return __builtin_amdgcn_exp2f(x); }
DI float sigmoidf_(float x) { return 1.0f / (1.0f + __expf(-x)); }
DI float siluf_(float x) { return x / (1.0f + __expf(-x)); }

struct EpiStore {
    static constexpr bool PERM = true, AFTER_DRAIN = false;
    bf16* O; int ldc;
    DI void operator()(const pg8::f32x4 (&acc)[2][2][4][2], const pg8::Unit& u, int wr, int wc, int fr, int fq) const {
        const int row0 = u.pm * 256 + wr * 64 + fr, col0 = u.pn * 256 + wc * 32 + 8 * fq;
#pragma unroll
        for (int ai = 0; ai < 2; ++ai)
#pragma unroll
            for (int m = 0; m < 4; ++m) { bf16* rowp = O + (size_t)(row0 + ai * 128 + m * 16) * ldc + col0;
#pragma unroll
                for (int bj = 0; bj < 2; ++bj) { const pg8::f32x4 v0 = acc[ai][bj][m][0], v1 = acc[ai][bj][m][1];
                    u32x4 w; w.x = pk2(v0[0], v0[1]); w.y = pk2(v0[2], v0[3]); w.z = pk2(v1[0], v1[1]); w.w = pk2(v1[2], v1[3]);
                    *(u32x4*)(rowp + bj * 128) = w; } }
    }
};
struct EpiSwiglu {
    static constexpr bool PERM = true, AFTER_DRAIN = false;
    bf16* O;
    DI void operator()(const pg8::f32x4 (&acc)[2][2][4][2], const pg8::Unit& u, int wr, int wc, int fr, int fq) const {
        const int row0 = u.pm * 256 + wr * 64 + fr, col0 = u.pn * 128 + wc * 32 + 8 * fq;
#pragma unroll
        for (int ai = 0; ai < 2; ++ai)
#pragma unroll
            for (int m = 0; m < 4; ++m) { bf16* rowp = O + (size_t)(row0 + ai * 128 + m * 16) * FF + col0;
                float r[8];
#pragma unroll
                for (int n = 0; n < 2; ++n)
#pragma unroll
                    for (int e = 0; e < 4; ++e) { const float g = acc[ai][0][m][n][e], up = acc[ai][1][m][n][e]; r[n * 4 + e] = g * __builtin_amdgcn_rcpf(1.0f + __expf(-g)) * up; }
                u32x4 w; w.x = pk2(r[0], r[1]); w.y = pk2(r[2], r[3]); w.z = pk2(r[4], r[5]); w.w = pk2(r[6], r[7]);
                *(u32x4*)rowp = w; }
    }
};
struct EpiResid {
    static constexpr bool PERM = false, AFTER_DRAIN = false;
    const float* base; float* out;
    DI void operator()(const pg8::f32x4 (&acc)[2][2][4][2], const pg8::Unit& u, int wr, int wc, int fr, int fq) const {
        const int row0 = u.pm * 256 + wr * 64 + fr, col0 = u.pn * 256 + wc * 32 + 4 * fq;
#pragma unroll
        for (int ai = 0; ai < 2; ++ai)
#pragma unroll
            for (int m = 0; m < 4; ++m) { const size_t off = (size_t)(row0 + ai * 128 + m * 16) * D + col0;
#pragma unroll
                for (int bj = 0; bj < 2; ++bj)
#pragma unroll
                    for (int n = 0; n < 2; ++n) { const f32x4 bs = *(const f32x4*)(base + off + bj * 128 + n * 16); const pg8::f32x4 a = acc[ai][bj][m][n];
                        f32x4 o; o.x = bs.x + a[0]; o.y = bs.y + a[1]; o.z = bs.z + a[2]; o.w = bs.w + a[3]; *(f32x4*)(out + off + bj * 128 + n * 16) = o; } }
    }
};

DI void transpose_item(const float* W, int K, int N, int Npad, bf16* WT, int mode, LAS float* scr, int item, int lane) {
    const int nblk = Npad / 32, kb = item / nblk, nb = item % nblk, k0 = 64 * kb, n0 = 32 * nb;
    const int nl = n0 + (lane & 31);
#pragma unroll 8
    for (int i = 0; i < 32; ++i) { const int kk = 2 * i + (lane >> 5); scr[kk * 33 + (lane & 31)] = (nl < N) ? W[(size_t)(k0 + kk) * N + nl] : 0.f; }
    asm volatile("s_waitcnt lgkmcnt(0)" ::: "memory");
    const int c = lane & 7;
    int drow0 = n0;
    if (mode == 1) { drow0 = (n0 < FF) ? (256 * (n0 >> 7) + (n0 & 127)) : (256 * ((n0 - FF) >> 7) + 128 + ((n0 - FF) & 127)); }
#pragma unroll
    for (int j = 0; j < 4; ++j) { const int n = (lane >> 3) + 8 * j; const LAS float* s = scr + (8 * c) * 33 + n;
        u32x4 o; o.x = pk2(s[0 * 33], s[1 * 33]); o.y = pk2(s[2 * 33], s[3 * 33]); o.z = pk2(s[4 * 33], s[5 * 33]); o.w = pk2(s[6 * 33], s[7 * 33]);
        *(u32x4*)(WT + (size_t)(drow0 + n) * K + k0 + 8 * c) = o; }
    asm volatile("s_waitcnt lgkmcnt(0)" ::: "memory");
}
DI void norm_rows_bf16(const float* h, const float* g, bf16* out, int gw, int ngw, int lane) {
    f32x4 gv[4];
#pragma unroll
    for (int j = 0; j < 4; ++j) gv[j] = *((const f32x4*)g + lane + 64 * j);
    for (int m = gw; m < M; m += ngw) {
        const f32x4* xr = (const f32x4*)(h + (size_t)m * D) + lane; f32x4 v[4]; float s = 0.f;
#pragma unroll
        for (int j = 0; j < 4; ++j) { v[j] = xr[64 * j]; s += (v[j].x * v[j].x + v[j].y * v[j].y) + (v[j].z * v[j].z + v[j].w * v[j].w); }
        const float r = rsqrtf(wave_sum(s) * (1.f / D) + RMS_EPS);
        u32x2* o8 = (u32x2*)(out + (size_t)m * D) + lane;
#pragma unroll
        for (int j = 0; j < 4; ++j) { u32x2 w; w.x = pk2(v[j].x * r * gv[j].x, v[j].y * r * gv[j].y); w.y = pk2(v[j].z * r * gv[j].z, v[j].w * r * gv[j].w); o8[64 * j] = w; }
    }
}
DI void norm_rows_f32_inplace(float* h, const float* g, int gw, int ngw, int lane) {
    f32x4 gv[4];
#pragma unroll
    for (int j = 0; j < 4; ++j) gv[j] = *((const f32x4*)g + lane + 64 * j);
    for (int m = gw; m < M; m += ngw) {
        f32x4* xr = (f32x4*)(h + (size_t)m * D) + lane; f32x4 v[4]; float s = 0.f;
#pragma unroll
        for (int j = 0; j < 4; ++j) { v[j] = xr[64 * j]; s += (v[j].x * v[j].x + v[j].y * v[j].y) + (v[j].z * v[j].z + v[j].w * v[j].w); }
        const float r = rsqrtf(wave_sum(s) * (1.f / D) + RMS_EPS);
#pragma unroll
        for (int j = 0; j < 4; ++j) { f32x4 o; o.x = v[j].x * r * gv[j].x; o.y = v[j].y * r * gv[j].y; o.z = v[j].z * r * gv[j].z; o.w = v[j].w * r * gv[j].w; xr[64 * j] = o; }
    }
}
typedef GAS unsigned gu32;
#define XB_TMO      128
#define XB_XCNT(j)  (256  + 64 * (j))
#define XB_XSUB(j)  (1280 + 64 * (j))
#define XB_XGEN(j)  (2304 + 64 * (j))
#define XB_TOP      3328
#define XB_TOPGEN   3392
#define XCD_BAR_WORDS 3456
#define XB_SPIN_CAP (1u << 18)

__device__ __forceinline__ unsigned xb_ld(unsigned* p)              { return __hip_atomic_load(p, __ATOMIC_RELAXED, __HIP_MEMORY_SCOPE_AGENT); }
__device__ __forceinline__ unsigned xb_add(unsigned* p, unsigned v) { return __hip_atomic_fetch_add(p, v, __ATOMIC_RELAXED, __HIP_MEMORY_SCOPE_AGENT); }
__device__ __forceinline__ unsigned xb_xcc_id() { return (unsigned)__builtin_amdgcn_s_getreg((3 << 11) | 20) & 0xFu; }
#define XB_SPIN(cond, bar) do { unsigned _sp = 0; while (cond) { __builtin_amdgcn_s_sleep(1); \
    if ((++_sp & 255u) == 0u) { if (xb_ld(&(bar)[XB_TMO])) break; if (_sp > XB_SPIN_CAP) { atomicAdd(&(bar)[XB_TMO], 1u); break; } } } } while (0)

struct XcdBarrier {
    unsigned* bar; unsigned x;
    volatile LAS unsigned* st;
};

__device__ __forceinline__ XcdBarrier xcd_barrier_post(unsigned* bar, volatile LAS unsigned* st) {
    XcdBarrier b; b.bar = bar; b.x = xb_xcc_id(); b.st = st;
    if (threadIdx.x == 0) (void)xb_add(&bar[XB_XCNT(b.x)], 1u);
    return b;
}
__device__ __forceinline__ void xcd_barrier_complete(unsigned* bar, unsigned x, unsigned& nloc, unsigned& nx) {
    const unsigned G = gridDim.x * gridDim.y * gridDim.z;
    unsigned sum, cnt, mine, sp = 0u;
    for (;;) {
        sum = 0u; cnt = 0u; mine = 0u;
#pragma unroll
        for (unsigned j = 0; j < 16; ++j) { const unsigned c = xb_ld(&bar[XB_XCNT(j)]); sum += c; cnt += (c > 0u) ? 1u : 0u; mine = (j == x) ? c : mine; }
        if (sum == G) break;
        __builtin_amdgcn_s_sleep(1);
        if ((++sp & 255u) == 0u) { if (xb_ld(&bar[XB_TMO])) break; if (sp > XB_SPIN_CAP) { atomicAdd(&bar[XB_TMO], 1u); break; } }
    }
    nloc = mine > 0u ? mine : 1u; nx = cnt > 0u ? cnt : 1u;
}

__device__ __forceinline__ void xcd_barrier(const XcdBarrier& b) {
    asm volatile("s_waitcnt vmcnt(0)" ::: "memory");
    __syncthreads();
    if (threadIdx.x == 0) {
        unsigned* bar = b.bar;
        __builtin_amdgcn_s_waitcnt(0);
        unsigned nloc = b.st[0], nx = b.st[1];
        if (nloc == 0u) { xcd_barrier_complete(bar, b.x, nloc, nx); b.st[0] = nloc; b.st[1] = nx; }
        const unsigned old = xb_add(&bar[XB_XSUB(b.x)], 1u);
        const unsigned gen = old / nloc;
        if (old + 1u == (gen + 1u) * nloc) {
            __builtin_amdgcn_fence(__ATOMIC_RELEASE, "agent");
            asm volatile("s_waitcnt vmcnt(0)" ::: "memory");
            const unsigned og = xb_add(&bar[XB_TOP], 1u);
            const unsigned tg = og / nx;
            if (og + 1u == (tg + 1u) * nx) xb_add(&bar[XB_TOPGEN], 1u);
            else XB_SPIN(xb_ld(&bar[XB_TOPGEN]) == tg, bar);
            __builtin_amdgcn_fence(__ATOMIC_ACQUIRE, "agent");
            xb_add(&bar[XB_XGEN(b.x)], 1u);
            asm volatile("s_waitcnt vmcnt(0)" ::: "memory");
        } else {
            XB_SPIN(xb_ld(&bar[XB_XGEN(b.x)]) == gen, bar);
            __builtin_amdgcn_fence(__ATOMIC_ACQUIRE, "agent");
            asm volatile("s_waitcnt vmcnt(0)" ::: "memory");
        }
    }
    __syncthreads();
}
constexpr int LA_UNITS = NB * 8 * 128;
constexpr int KT_LD = 72, QT_LD = 136;
template <bool WANT_Q>
DI void la_load_col(const bf16* Yb, int hh, int d, int rg, const float* lbraw, float (&lg)[16], float (&kk)[16], float (&qq)[16]) {
    if (hh < 4) {
        const float a = lbraw[hh * 128 + d], b2 = lbraw[512 + hh * 128 + d];
        const float mx = fmaxf(a, b2), ea = __expf(a - mx), eb = __expf(b2 - mx), lbv = ea / (ea + eb);
        const bf16* pf = Yb + (size_t)(16 * rg) * EIN + 512 + hh * 128 + d;
        const bf16* pq = Yb + (size_t)(16 * rg) * EIN + hh * 128 + d;
#pragma unroll
        for (int e = 0; e < 16; ++e) { const float x = bf2f(pf[(size_t)e * EIN]); const float f = lbv + (1.f - lbv) * sigmoidf_(x); lg[e] = __logf(f); kk[e] = 1.f - f;
            if (WANT_Q) qq[e] = siluf_(bf2f(pq[(size_t)e * EIN])); }
    } else {
        const int r = hh - 4; const float lgam = __logf(1.f - exp2f(-5.f - (float)r));
        const bf16* pk = Yb + (size_t)(16 * rg) * EIN + 2560 + r * 128 + d;
        const bf16* pq = Yb + (size_t)(16 * rg) * EIN + 2048 + r * 128 + d;
#pragma unroll
        for (int e = 0; e < 16; ++e) { lg[e] = lgam; kk[e] = bf2f(pk[(size_t)e * EIN]) * 0.08838834764831845f; if (WANT_Q) qq[e] = bf2f(pq[(size_t)e * EIN]); }
    }
    float run = 0.f;
#pragma unroll
    for (int e = 0; e < 16; ++e) { run += lg[e]; lg[e] = run; }
}
DI void la_stage_vt(const bf16* Yb, int hh, int d, int rg, LAS bf16* VT) {
    const bf16* pv = Yb + (size_t)(16 * rg) * EIN + (hh < 4 ? 1024 + hh * 128 : 3072 + (hh - 4) * 128) + d;
    unsigned w[8];
#pragma unroll
    for (int e = 0; e < 8; ++e) w[e] = (unsigned)pv[(size_t)(2 * e) * EIN] | ((unsigned)pv[(size_t)(2 * e + 1) * EIN] << 16);
    LAS u32x4* dst = (LAS u32x4*)(VT + d * KT_LD + 16 * rg);
    dst[0] = (u32x4){w[0], w[1], w[2], w[3]}; dst[1] = (u32x4){w[4], w[5], w[6], w[7]};
}
DI void la_state_phase(const bf16* Y0, const float* lbraw, bf16* ST, float* DEC, LAS unsigned char* lds) {
    LAS bf16* KT = (LAS bf16*)lds; LAS bf16* VT = KT + 128 * KT_LD; LAS float* tot = (LAS float*)(VT + 128 * KT_LD);
    const int tid = threadIdx.x, lane = tid & 63, w = tid >> 6, l15 = lane & 15, q = lane >> 4, d = tid & 127, rg = tid >> 7;
    for (int unit = blockIdx.x; unit < LA_UNITS; unit += gridDim.x) {
        const int b = unit >> 10, hh = (unit >> 7) & 7, n = unit & 127;
        const bf16* Yb = Y0 + (size_t)(b * T + n * 64) * EIN;
        float lg[16], kk[16], qq[16];
        la_load_col<false>(Yb, hh, d, rg, lbraw, lg, kk, qq);
        tot[rg * 128 + d] = lg[15];
        la_stage_vt(Yb, hh, d, rg, VT);
        __syncthreads();
        float pre = 0.f, last = 0.f;
#pragma unroll
        for (int g2 = 0; g2 < 4; ++g2) { const float tv = tot[g2 * 128 + d]; if (g2 < rg) pre += tv; last += tv; }
        unsigned wv[8];
#pragma unroll
        for (int e = 0; e < 8; ++e) { const float c0 = pre + lg[2 * e], c1 = pre + lg[2 * e + 1]; wv[e] = pk2(kk[2 * e] * __expf(last - c0), kk[2 * e + 1] * __expf(last - c1)); }
        LAS u32x4* dst = (LAS u32x4*)(KT + d * KT_LD + 16 * rg);
        dst[0] = (u32x4){wv[0], wv[1], wv[2], wv[3]}; dst[1] = (u32x4){wv[4], wv[5], wv[6], wv[7]};
        if (rg == 0) DEC[(size_t)unit * 128 + d] = __expf(last);
        __syncthreads();
        f32x4 acc[8];
#pragma unroll
        for (int dt = 0; dt < 8; ++dt) acc[dt] = (f32x4){0.f, 0.f, 0.f, 0.f};
#pragma unroll
        for (int ks = 0; ks < 2; ++ks) { const bf16x8 bv = *(const LAS bf16x8*)(VT + (16 * w + l15) * KT_LD + 32 * ks + 8 * q);
#pragma unroll
            for (int dt = 0; dt < 8; ++dt) { const bf16x8 ak = *(const LAS bf16x8*)(KT + (16 * dt + l15) * KT_LD + 32 * ks + 8 * q); acc[dt] = MFMA16(ak, bv, acc[dt]); } }
        bf16* so = ST + (size_t)unit * 16384 + (16 * w + l15) * 128 + 4 * q;
#pragma unroll
        for (int dt = 0; dt < 8; ++dt) { u32x2 o; o.x = pk2(acc[dt][0], acc[dt][1]); o.y = pk2(acc[dt][2], acc[dt][3]); *(u32x2*)(so + 16 * dt) = o; }
        __syncthreads();
    }
}
DI void la_scan_phase(bf16* ST, const float* DEC) {
    const int gid = blockIdx.x * 512 + threadIdx.x, nth = gridDim.x * 512;
    for (int wk = gid; wk < 32 * 4096; wk += nth) {
        const int bh = wk >> 12, e4 = (wk & 4095) * 4, d = e4 & 127;
        f32x4 s = {0.f, 0.f, 0.f, 0.f};
        bf16* sp = ST + (size_t)bh * 128 * 16384 + e4; const float* dp = DEC + (size_t)bh * 128 * 128 + d;
        for (int n0 = 0; n0 < 128; n0 += 8) {
            u32x2 uv[8]; f32x4 dv[8];
#pragma unroll
            for (int i = 0; i < 8; ++i) { uv[i] = *(const u32x2*)(sp + (size_t)(n0 + i) * 16384); dv[i] = *(const f32x4*)(dp + (size_t)(n0 + i) * 128); }
#pragma unroll
            for (int i = 0; i < 8; ++i) { u32x2 o; o.x = pk2(s.x, s.y); o.y = pk2(s.z, s.w); *(u32x2*)(sp + (size_t)(n0 + i) * 16384) = o;
                s.x = dv[i].x * s.x + bflo(uv[i].x); s.y = dv[i].y * s.y + bfhi(uv[i].x); s.z = dv[i].z * s.z + bflo(uv[i].y); s.w = dv[i].w * s.w + bfhi(uv[i].y); }
        }
    }
}
DI void la_out_phase(const bf16* Y0, const float* lbraw, const bf16* ST, const float* gh, const float* gr, bf16* MIX, LAS unsigned char* lds) {
    LAS bf16* QT = (LAS bf16*)lds; LAS bf16* K2 = QT + 64 * QT_LD; LAS bf16* QS = K2 + 64 * QT_LD; LAS bf16* VT = QS + 64 * QT_LD;
    LAS float* tot = (LAS float*)(VT + 128 * KT_LD); LAS float* ssq = tot + 512;
    const int tid = threadIdx.x, lane = tid & 63, w = tid >> 6, l15 = lane & 15, q = lane >> 4, d = tid & 127, rg = tid >> 7;
    const int it = w & 3, vh = w >> 2;
    for (int unit = blockIdx.x; unit < LA_UNITS; unit += gridDim.x) {
        const int b = unit >> 10, hh = (unit >> 7) & 7, n = unit & 127;
        const int row0 = b * T + n * 64;
        const bf16* Yb = Y0 + (size_t)row0 * EIN;
        float lg[16], kk[16], qq[16];
        la_load_col<true>(Yb, hh, d, rg, lbraw, lg, kk, qq);
        tot[rg * 128 + d] = lg[15];
        la_stage_vt(Yb, hh, d, rg, VT);
        __syncthreads();
        float pre = 0.f;
#pragma unroll
        for (int g2 = 0; g2 < 4; ++g2) { const float tv = tot[g2 * 128 + d]; if (g2 < rg) pre += tv; }
        const float ref = tot[d] + tot[128 + d];
#pragma unroll
        for (int e = 0; e < 16; ++e) { const float c = pre + lg[e]; const int j = 16 * rg + e;
            QT[j * QT_LD + d] = f2bf(qq[e] * __expf(c - ref)); K2[j * QT_LD + d] = f2bf(kk[e] * __expf(ref - c)); QS[j * QT_LD + d] = f2bf(qq[e] * __expf(c)); }
        __syncthreads();
        f32x4 at[4];
#pragma unroll
        for (int jt = 0; jt < 4; ++jt) at[jt] = (f32x4){0.f, 0.f, 0.f, 0.f};
#pragma unroll
        for (int ks = 0; ks < 4; ++ks) { const bf16x8 bq = *(const LAS bf16x8*)(QT + (16 * it + l15) * QT_LD + 32 * ks + 8 * q);
#pragma unroll
            for (int jt = 0; jt < 4; ++jt) { const bf16x8 ak = *(const LAS bf16x8*)(K2 + (16 * jt + l15) * QT_LD + 32 * ks + 8 * q); at[jt] = MFMA16(ak, bq, at[jt]); } }
        const int irow = 16 * it + l15;
#pragma unroll
        for (int jt = 0; jt < 4; ++jt)
#pragma unroll
            for (int r = 0; r < 4; ++r) { const int j = 16 * jt + 4 * q + r; if (j > irow) at[jt][r] = 0.f; }
        f32x4 o[4];
#pragma unroll
        for (int vt = 0; vt < 4; ++vt) o[vt] = (f32x4){0.f, 0.f, 0.f, 0.f};
#pragma unroll
        for (int k2 = 0; k2 < 2; ++k2) {
            u32x4 pw; pw.x = pk2(at[2 * k2][0], at[2 * k2][1]); pw.y = pk2(at[2 * k2][2], at[2 * k2][3]); pw.z = pk2(at[2 * k2 + 1][0], at[2 * k2 + 1][1]); pw.w = pk2(at[2 * k2 + 1][2], at[2 * k2 + 1][3]);
            const bf16x8 pf = __builtin_bit_cast(bf16x8, pw);
#pragma unroll
            for (int vt = 0; vt < 4; ++vt) { const LAS bf16* vp = VT + (64 * vh + 16 * vt + l15) * KT_LD + 32 * k2 + 4 * q;
                const u32x2 lo = *(const LAS u32x2*)vp, hi = *(const LAS u32x2*)(vp + 16);
                const bf16x8 av = __builtin_bit_cast(bf16x8, ((u32x4){lo.x, lo.y, hi.x, hi.y})); o[vt] = MFMA16(av, pf, o[vt]); }
        }
        const bf16* sb = ST + (size_t)unit * 16384;
#pragma unroll
        for (int ks = 0; ks < 4; ++ks) { const bf16x8 bq = *(const LAS bf16x8*)(QS + (16 * it + l15) * QT_LD + 32 * ks + 8 * q);
#pragma unroll
            for (int vt = 0; vt < 4; ++vt) { const bf16x8 as = *(const bf16x8*)(sb + (64 * vh + 16 * vt + l15) * 128 + 32 * ks + 8 * q); o[vt] = MFMA16(as, bq, o[vt]); } }
        float ss = 0.f;
#pragma unroll
        for (int vt = 0; vt < 4; ++vt) ss += (o[vt][0] * o[vt][0] + o[vt][1] * o[vt][1]) + (o[vt][2] * o[vt][2] + o[vt][3] * o[vt][3]);
        ss += __shfl_xor(ss, 16); ss += __shfl_xor(ss, 32);
        if (q == 0) ssq[vh * 64 + irow] = ss;
        __syncthreads();
        const float rs = rsqrtf((ssq[irow] + ssq[64 + irow]) * (1.f / 128.f) + RMS_EPS);
        const float* gn = (hh < 4) ? gh : gr;
        const bf16* gp = Yb + (size_t)irow * EIN + (hh < 4 ? 1536 + hh * 128 : 3584 + (hh - 4) * 128);
        bf16* op = MIX + (size_t)(row0 + irow) * D + hh * 128;
#pragma unroll
        for (int vt = 0; vt < 4; ++vt) { const int v0 = 64 * vh + 16 * vt + 4 * q; const f32x4 gv = *(const f32x4*)(gn + v0); const u32x2 gw = *(const u32x2*)(gp + v0);
            u32x2 ow; ow.x = pk2(o[vt][0] * rs * gv.x * siluf_(bflo(gw.x)), o[vt][1] * rs * gv.y * siluf_(bfhi(gw.x)));
            ow.y = pk2(o[vt][2] * rs * gv.z * siluf_(bflo(gw.y)), o[vt][3] * rs * gv.w * siluf_(bfhi(gw.y))); *(u32x2*)(op + v0) = ow; }
        __syncthreads();
    }
}
constexpr int NC = 511, NCP = 512;
DI void nsa_compress_phase(const bf16* Y1, const float* posk, const float* posv, const bf16* w1kT, const bf16* w1vT, const bf16* w2kT, const bf16* w2vT,
                           bf16* KCMP, bf16* VCMPT, int gw, int ngw, int lane) {
    const int l15 = lane & 15, q = lane >> 4;
    for (int task = gw; task < 512; task += ngw) {
        const int kv = task & 1, rt = task >> 1;
        int r = rt * 16 + l15; const bool rvalid = r < NB * NC * 2; if (!rvalid) r = NB * NC * 2 - 1;
        const int b = r / (NC * 2), rem = r % (NC * 2), i = rem >> 1, g = rem & 1;
        const bf16* src = Y1 + (size_t)(b * T + 16 * i) * OINP + (kv ? 1152 : 1024) + g * 64;
        const float* pos = kv ? posv : posk; const bf16* w1 = kv ? w1vT : w1kT; const bf16* w2 = kv ? w2vT : w2kT;
        f32x4 acc[4];
#pragma unroll
        for (int nt = 0; nt < 4; ++nt) acc[nt] = (f32x4){0.f, 0.f, 0.f, 0.f};
        for (int ks = 0; ks < 64; ++ks) {
            const int p = ks >> 1, d0 = (ks & 1) * 32 + 8 * q;
            const u32x4 xv = *(const u32x4*)(src + (size_t)p * OINP + d0);
            const f32x4 p0 = *(const f32x4*)(pos + p * 64 + d0), p1 = *(const f32x4*)(pos + p * 64 + d0 + 4);
            u32x4 bw; bw.x = pk2(bflo(xv.x) + p0.x, bfhi(xv.x) + p0.y); bw.y = pk2(bflo(xv.y) + p0.z, bfhi(xv.y) + p0.w);
            bw.z = pk2(bflo(xv.z) + p1.x, bfhi(xv.z) + p1.y); bw.w = pk2(bflo(xv.w) + p1.z, bfhi(xv.w) + p1.w);
            const bf16x8 bf = __builtin_bit_cast(bf16x8, bw);
#pragma unroll
            for (int nt = 0; nt < 4; ++nt) { const bf16x8 af = *(const bf16x8*)(w1 + (size_t)(16 * nt + l15) * 2048 + 32 * ks + 8 * q); acc[nt] = MFMA16(af, bf, acc[nt]); }
        }
        f32x4 o2[4];
#pragma unroll
        for (int t2 = 0; t2 < 4; ++t2) o2[t2] = (f32x4){0.f, 0.f, 0.f, 0.f};
#pragma unroll
        for (int k2 = 0; k2 < 2; ++k2) {
            u32x4 pw; pw.x = pk2(siluf_(acc[2 * k2][0]), siluf_(acc[2 * k2][1])); pw.y = pk2(siluf_(acc[2 * k2][2]), siluf_(acc[2 * k2][3]));
            pw.z = pk2(siluf_(acc[2 * k2 + 1][0]), siluf_(acc[2 * k2 + 1][1])); pw.w = pk2(siluf_(acc[2 * k2 + 1][2]), siluf_(acc[2 * k2 + 1][3]));
            const bf16x8 pf = __builtin_bit_cast(bf16x8, pw);
#pragma unroll
            for (int t2 = 0; t2 < 4; ++t2) { const bf16* wp = w2 + (16 * t2 + l15) * 64 + 32 * k2 + 4 * q;
                const u32x2 lo = *(const u32x2*)wp, hi = *(const u32x2*)(wp + 16);
                const bf16x8 av = __builtin_bit_cast(bf16x8, ((u32x4){lo.x, lo.y, hi.x, hi.y})); o2[t2] = MFMA16(av, pf, o2[t2]); }
        }
        if (rvalid) {
            if (kv == 0) { bf16* op = KCMP + ((size_t)(b * 2 + g) * NCP + i) * 64 + 4 * q;
#pragma unroll
                for (int t2 = 0; t2 < 4; ++t2) { u32x2 ow; ow.x = pk2(o2[t2][0], o2[t2][1]); ow.y = pk2(o2[t2][2], o2[t2][3]); *(u32x2*)(op + 16 * t2) = ow; }
            } else { bf16* op = VCMPT + (size_t)(b * 2 + g) * 64 * NCP + i;
#pragma unroll
                for (int t2 = 0; t2 < 4; ++t2)
#pragma unroll
                    for (int r2 = 0; r2 < 4; ++r2) op[(size_t)(16 * t2 + 4 * q + r2) * NCP] = f2bf(o2[t2][r2]); }
        }
    }
    for (int z = gw * 64 + lane; z < NB * 2 * 64; z += ngw * 64) { const int bg = z >> 6, dd = z & 63; KCMP[((size_t)bg * NCP + NC) * 64 + dd] = 0; VCMPT[((size_t)bg * 64 + dd) * NCP + NC] = 0; }
}
DI void nsa_vt_phase(const bf16* Y1, bf16* VST, bf16* VWT, int gw, int ngw, int lane) {
    for (int task = gw; task < 2 * NB * 2 * 128; task += ngw) {
        const int which = task & 1, g = (task >> 1) & 1, b = (task >> 2) & 3, blk = task >> 4;
        const int t = blk * 64 + lane;
        const bf16* src = Y1 + (size_t)(b * T + t) * OINP + (which ? 1664 : 1408) + g * 64;
        bf16* dst = (which ? VWT : VST) + (size_t)(b * 2 + g) * 64 * T + t;
        u32x4 v[8];
#pragma unroll
        for (int c = 0; c < 8; ++c) v[c] = *(const u32x4*)(src + 8 * c);
#pragma unroll
        for (int c = 0; c < 8; ++c) {
            dst[(size_t)(8 * c + 0) * T] = (bf16)(v[c].x & 0xffff); dst[(size_t)(8 * c + 1) * T] = (bf16)(v[c].x >> 16);
            dst[(size_t)(8 * c + 2) * T] = (bf16)(v[c].y & 0xffff); dst[(size_t)(8 * c + 3) * T] = (bf16)(v[c].y >> 16);
            dst[(size_t)(8 * c + 4) * T] = (bf16)(v[c].z & 0xffff); dst[(size_t)(8 * c + 5) * T] = (bf16)(v[c].z >> 16);
            dst[(size_t)(8 * c + 6) * T] = (bf16)(v[c].w & 0xffff); dst[(size_t)(8 * c + 7) * T] = (bf16)(v[c].w >> 16);
        }
    }
}
constexpr int TL = 72;
constexpr int SLAB_LD = 132;
constexpr float C1 = 0.125f * LOG2E;
DI void tile_fetch(const bf16* kg, int ldk, const bf16* vg, int ldv, int tid, u32x4& kr, u32x4& vr) {
    const int r = tid >> 3, c = (tid & 7) * 8;
    kr = *(const u32x4*)(kg + (size_t)r * ldk + c); vr = *(const u32x4*)(vg + (size_t)r * ldv + c);
}
DI void tile_store(LAS bf16* Kb, LAS bf16* Vb, int tid, u32x4 kr, u32x4 vr) {
    const int r = tid >> 3, c = (tid & 7) * 8;
    *(LAS u32x4*)(Kb + r * TL + c) = kr; *(LAS u32x4*)(Vb + r * TL + c) = vr;
}
DI void tile_scores(const LAS bf16* Kb, const bf16x8 (&qf)[2], int l15, int q, f32x4 (&sc)[4]) {
#pragma unroll
    for (int x = 0; x < 4; ++x) { sc[x] = (f32x4){0.f, 0.f, 0.f, 0.f};
#pragma unroll
        for (int ks = 0; ks < 2; ++ks) { const bf16x8 a = *(const LAS bf16x8*)(Kb + (16 * x + l15) * TL + 32 * ks + 8 * q); sc[x] = MFMA16(a, qf[ks], sc[x]); } }
}
DI void tile_pv(const LAS bf16* Vb, const float (&p)[16], f32x4 (&acc)[4], int l15, int q) {
#pragma unroll
    for (int k2 = 0; k2 < 2; ++k2) {
        u32x4 pw; pw.x = pk2(p[8 * k2], p[8 * k2 + 1]); pw.y = pk2(p[8 * k2 + 2], p[8 * k2 + 3]); pw.z = pk2(p[8 * k2 + 4], p[8 * k2 + 5]); pw.w = pk2(p[8 * k2 + 6], p[8 * k2 + 7]);
        const bf16x8 pf = __builtin_bit_cast(bf16x8, pw);
#pragma unroll
        for (int dt = 0; dt < 4; ++dt) { const LAS bf16* r = Vb + (16 * dt + l15) * TL + 32 * k2 + 4 * q;
            const u32x2 lo = *(const LAS u32x2*)r, hi = *(const LAS u32x2*)(r + 16);
            const bf16x8 av = __builtin_bit_cast(bf16x8, ((u32x4){lo.x, lo.y, hi.x, hi.y})); acc[dt] = MFMA16(av, pf, acc[dt]); }
    }
}
template <bool MASKED, int KS>
DI float tile_logits(const f32x4 (&sc)[4], float (&s)[16], int d0, float slope2, unsigned lim, bool extra) {
    const float A = -slope2 * (float)d0; float mx = -INFINITY;
#pragma unroll
    for (int e = 0; e < 16; ++e) { const int ke = KS * (16 * (e >> 2) + (e & 3)); float v = sc[e >> 2][e & 3] * C1 + (A + slope2 * (float)ke);
        if (MASKED) { const bool valid = extra && ((unsigned)(d0 - ke) < lim); v = valid ? v : -INFINITY; }
        s[e] = v; mx = fmaxf(mx, v); }
    mx = fmaxf(mx, __shfl_xor(mx, 16)); mx = fmaxf(mx, __shfl_xor(mx, 32));
    return mx;
}
template <bool MASKED>
DI void tile_step(const LAS bf16* Kb, const LAS bf16* Vb, const bf16x8 (&qf)[2], f32x4 (&acc)[4], float& m, float& lp, int d0, float slope2, unsigned lim, bool extra, int l15, int q) {
    f32x4 sc[4]; tile_scores(Kb, qf, l15, q, sc);
    float s[16]; const float mx = tile_logits<MASKED, 1>(sc, s, d0, slope2, lim, extra);
    const float mn = fmaxf(m, mx), alpha = ex2(m - mn); m = mn;
    float ps = 0.f;
#pragma unroll
    for (int e = 0; e < 16; ++e) { s[e] = ex2(s[e] - mn); ps += s[e]; }
    lp = lp * alpha + ps;
#pragma unroll
    for (int dt = 0; dt < 4; ++dt) { acc[dt][0] *= alpha; acc[dt][1] *= alpha; acc[dt][2] *= alpha; acc[dt][3] *= alpha; }
    tile_pv(Vb, s, acc, l15, q);
}
DI void nsa_attn_phase(const bf16* Y1, const bf16* KCMP, const bf16* VCMPT, const bf16* VST, const bf16* VWT, bf16* MIX, LAS unsigned char* lds) {
    LAS bf16* KB0 = (LAS bf16*)lds;
    LAS bf16* VB0 = KB0 + 2 * 64 * TL;
    LAS float* slab = (LAS float*)(lds + 36864);
    LAS float* pslc = slab + 8 * 16 * SLAB_LD;
    LAS unsigned* selm = (LAS unsigned*)(pslc + 16 * 128);
    LAS unsigned* uni = selm + 64;
    LAS unsigned* blist = uni + 4;
    const int tid = threadIdx.x, lane = tid & 63, w = tid >> 6, l15 = lane & 15, q = lane >> 4;
    LAS float* myslab = slab + w * 16 * SLAB_LD;
#define KBUF(i) (KB0 + ((i) & 1) * 64 * TL)
#define VBUF(i) (VB0 + ((i) & 1) * 64 * TL)
    for (int u = blockIdx.x; u < NB * 2 * (T / 16); u += gridDim.x) {
        const int b = u & 3, g = (u >> 2) & 1, tile = u >> 3, t0 = tile * 16, qblk = t0 >> 6;
        const int h = g * 8 + w; const float slope = exp2f(-0.5f * (float)(h + 1)), slope2 = slope * LOG2E;
        const int t = t0 + l15; const size_t row = (size_t)b * T + t;
        bf16x8 qf[2];
        qf[0] = *(const bf16x8*)(Y1 + row * OINP + h * 64 + 8 * q); qf[1] = *(const bf16x8*)(Y1 + row * OINP + h * 64 + 32 + 8 * q);
        const bf16* gl = Y1 + row * OINP + 1792 + h * 3;
        const float g0 = sigmoidf_(bf2f(gl[0])), g1 = sigmoidf_(bf2f(gl[1])), g2 = sigmoidf_(bf2f(gl[2]));
        for (int i = lane; i < 16 * SLAB_LD; i += 64) myslab[i] = 0.f;
        if (tid < 64) selm[tid] = 0u; if (tid < 4) uni[tid] = 0u;
        f32x4 ot[4];
        u32x4 kr, vr;
        {
            const bf16* kc = KCMP + (size_t)(b * 2 + g) * NCP * 64; const bf16* vct = VCMPT + (size_t)(b * 2 + g) * 64 * NCP;
            const int nst = tile >= 1 ? ((tile - 1) >> 6) + 1 : 0;
            const int dc = t - 31 - 64 * q;
            float m = -1e30f, lp = 0.f;
            f32x4 acc[4];
#pragma unroll
            for (int dt = 0; dt < 4; ++dt) acc[dt] = (f32x4){0.f, 0.f, 0.f, 0.f};
            float inv = 0.f;
            for (int pass = 0; pass < 2; ++pass) {
                if (nst > 0) { tile_fetch(kc, 64, vct, NCP, tid, kr, vr); tile_store(KBUF(0), VBUF(0), tid, kr, vr); }
                __syncthreads();
                for (int s = 0; s < nst; ++s) {
                    const bool more = s + 1 < nst;
                    if (more) tile_fetch(kc + (size_t)(64 * (s + 1)) * 64, 64, vct + 64 * (s + 1), NCP, tid, kr, vr);
                    f32x4 sc[4]; tile_scores(KBUF(s), qf, l15, q, sc);
                    float sv[16]; float mx;
                    const int d0 = dc - 1024 * s;
                    if (64 * s + 63 <= tile - 2) mx = tile_logits<false, 16>(sc, sv, d0, slope2, 0x7fffffffu, true);
                    else mx = tile_logits<true, 16>(sc, sv, d0, slope2, 0x7fffffffu, true);
                    if (pass == 0) {
                        const float mn = fmaxf(m, mx); float ps = 0.f;
#pragma unroll
                        for (int e = 0; e < 16; ++e) ps += ex2(sv[e] - mn);
                        lp = lp * ex2(m - mn) + ps; m = mn;
                    } else {
#pragma unroll
                        for (int e = 0; e < 16; ++e) sv[e] = ex2(sv[e] - m) * inv;
#pragma unroll
                        for (int x = 0; x < 4; ++x) { const int j = 16 * s + 4 * x + q;
                            __hip_atomic_fetch_add(&myslab[l15 * SLAB_LD + j], (sv[4 * x] + sv[4 * x + 1]) + (sv[4 * x + 2] + 0.5f * sv[4 * x + 3]), __ATOMIC_RELAXED, __HIP_MEMORY_SCOPE_WORKGROUP);
                            __hip_atomic_fetch_add(&myslab[l15 * SLAB_LD + j + 1], 0.5f * sv[4 * x + 3], __ATOMIC_RELAXED, __HIP_MEMORY_SCOPE_WORKGROUP); }
                        tile_pv(VBUF(s), sv, acc, l15, q);
                    }
                    if (more) tile_store(KBUF(s + 1), VBUF(s + 1), tid, kr, vr);
                    __syncthreads();
                }
                if (pass == 0) { float l = lp; l += __shfl_xor(l, 16); l += __shfl_xor(l, 32); inv = l > 0.f ? 1.0f / l : 0.f; }
            }
#pragma unroll
            for (int dt = 0; dt < 4; ++dt) { ot[dt][0] = g0 * acc[dt][0]; ot[dt][1] = g0 * acc[dt][1]; ot[dt][2] = g0 * acc[dt][2]; ot[dt][3] = g0 * acc[dt][3]; }
        }
        __syncthreads();
#pragma unroll 1
        for (int k = 0; k < 4; ++k) { const int idx = tid + 512 * k, tok = idx >> 7, j = idx & 127; float s = 0.f;
#pragma unroll
            for (int ww = 0; ww < 8; ++ww) s += slab[(ww * 16 + tok) * SLAB_LD + j];
            const bool forced = (j == 0) || (j == qblk) || (j == qblk - 1);
            pslc[tok * 128 + j] = forced ? 1e9f : (j <= qblk ? s : -1e30f); }
        __syncthreads();
#pragma unroll 1
        for (int k = 0; k < 4; ++k) { const int idx = tid + 512 * k, tok = idx >> 7, j = idx & 127;
            if (j <= qblk) { const float my = pslc[tok * 128 + j]; int rank = 0;
                for (int jj = 0; jj <= qblk; ++jj) { const float o = pslc[tok * 128 + jj]; rank += (o > my || (o == my && jj < j)) ? 1 : 0; }
                if (rank < 16) { __hip_atomic_fetch_or(&selm[tok * 4 + (j >> 5)], 1u << (j & 31), __ATOMIC_RELAXED, __HIP_MEMORY_SCOPE_WORKGROUP); __hip_atomic_fetch_or(&uni[j >> 5], 1u << (j & 31), __ATOMIC_RELAXED, __HIP_MEMORY_SCOPE_WORKGROUP); } } }
        __syncthreads();
        if (tid < 128) { const unsigned u0 = uni[0], u1 = uni[1], u2 = uni[2], u3 = uni[3]; const int wd = tid >> 5, bt = tid & 31;
            const unsigned uw = wd == 0 ? u0 : wd == 1 ? u1 : wd == 2 ? u2 : u3;
            if ((uw >> bt) & 1u) { const int pos = (wd > 0 ? __popc(u0) : 0) + (wd > 1 ? __popc(u1) : 0) + (wd > 2 ? __popc(u2) : 0) + __popc(uw & ((1u << bt) - 1u)); blist[pos] = (unsigned)tid; }
            if (tid == 0) blist[128] = (unsigned)(__popc(u0) + __popc(u1) + __popc(u2) + __popc(u3)); }
        __syncthreads();
        {
            const bf16* kb = Y1 + (size_t)b * T * OINP + 1280 + g * 64; const bf16* vt = VST + (size_t)(b * 2 + g) * 64 * T;
            float m = -1e30f, lp = 0.f; f32x4 acc[4];
#pragma unroll
            for (int dt = 0; dt < 4; ++dt) acc[dt] = (f32x4){0.f, 0.f, 0.f, 0.f};
            unsigned am = selm[lane];
            am &= __shfl_xor(am, 4); am &= __shfl_xor(am, 8); am &= __shfl_xor(am, 16); am &= __shfl_xor(am, 32);
            const unsigned am0 = __builtin_amdgcn_readlane(am, 0), am1 = __builtin_amdgcn_readlane(am, 1), am2 = __builtin_amdgcn_readlane(am, 2), am3 = __builtin_amdgcn_readlane(am, 3);
            const int nsel = (int)__builtin_amdgcn_readfirstlane((int)blist[128]);
            int j = (int)__builtin_amdgcn_readfirstlane((int)blist[0]);
            tile_fetch(kb + (size_t)(64 * j) * OINP, OINP, vt + 64 * j, T, tid, kr, vr); tile_store(KBUF(0), VBUF(0), tid, kr, vr);
            __syncthreads();
            for (int i = 0; i < nsel; ++i) {
                const bool more = i + 1 < nsel;
                int jn = 0;
                if (more) { jn = (int)__builtin_amdgcn_readfirstlane((int)blist[i + 1]); tile_fetch(kb + (size_t)(64 * jn) * OINP, OINP, vt + 64 * jn, T, tid, kr, vr); }
                const int wd = j >> 5; const unsigned aw = wd == 0 ? am0 : wd == 1 ? am1 : wd == 2 ? am2 : am3;
                const int d0 = t - 64 * j - 4 * q;
                if (((aw >> (j & 31)) & 1u) && j < qblk) tile_step<false>(KBUF(i), VBUF(i), qf, acc, m, lp, d0, slope2, 0x7fffffffu, true, l15, q);
                else { const bool selb = (selm[l15 * 4 + wd] >> (j & 31)) & 1u; tile_step<true>(KBUF(i), VBUF(i), qf, acc, m, lp, d0, slope2, 0x7fffffffu, selb, l15, q); }
                if (more) tile_store(KBUF(i + 1), VBUF(i + 1), tid, kr, vr);
                j = jn;
                __syncthreads();
            }
            float l = lp; l += __shfl_xor(l, 16); l += __shfl_xor(l, 32);
            const float sc = l > 0.f ? g1 / l : 0.f;
#pragma unroll
            for (int dt = 0; dt < 4; ++dt) { ot[dt][0] += sc * acc[dt][0]; ot[dt][1] += sc * acc[dt][1]; ot[dt][2] += sc * acc[dt][2]; ot[dt][3] += sc * acc[dt][3]; }
        }
        {
            const bf16* kb = Y1 + (size_t)b * T * OINP + 1536 + g * 64; const bf16* vt = VWT + (size_t)(b * 2 + g) * 64 * T;
            float m = -1e30f, lp = 0.f; f32x4 acc[4];
#pragma unroll
            for (int dt = 0; dt < 4; ++dt) acc[dt] = (f32x4){0.f, 0.f, 0.f, 0.f};
            int kstart = t0 - 511; kstart = kstart < 0 ? 0 : (kstart & ~63);
            const int nw = ((t0 + 15 - kstart) >> 6) + 1;
            tile_fetch(kb + (size_t)kstart * OINP, OINP, vt + kstart, T, tid, kr, vr); tile_store(KBUF(0), VBUF(0), tid, kr, vr);
            __syncthreads();
            for (int i = 0; i < nw; ++i) {
                const bool more = i + 1 < nw; const int key0 = kstart + 64 * i;
                if (more) tile_fetch(kb + (size_t)(key0 + 64) * OINP, OINP, vt + key0 + 64, T, tid, kr, vr);
                const int d0 = t - key0 - 4 * q;
                if (key0 + 63 <= t0 && key0 >= t0 - 496) tile_step<false>(KBUF(i), VBUF(i), qf, acc, m, lp, d0, slope2, 512u, true, l15, q);
                else tile_step<true>(KBUF(i), VBUF(i), qf, acc, m, lp, d0, slope2, 512u, true, l15, q);
                if (more) tile_store(KBUF(i + 1), VBUF(i + 1), tid, kr, vr);
                __syncthreads();
            }
            float l = lp; l += __shfl_xor(l, 16); l += __shfl_xor(l, 32);
            const float sc = l > 0.f ? g2 / l : 0.f;
#pragma unroll
            for (int dt = 0; dt < 4; ++dt) { ot[dt][0] += sc * acc[dt][0]; ot[dt][1] += sc * acc[dt][1]; ot[dt][2] += sc * acc[dt][2]; ot[dt][3] += sc * acc[dt][3]; }
        }
        bf16* op = MIX + row * D + h * 64 + 4 * q;
#pragma unroll
        for (int dt = 0; dt < 4; ++dt) { u32x2 ow; ow.x = pk2(ot[dt][0], ot[dt][1]); ow.y = pk2(ot[dt][2], ot[dt][3]); *(u32x2*)(op + 16 * dt) = ow; }
    }
#undef KBUF
#undef VBUF
}
struct Args { const float* in[19]; float* out; unsigned char* ws; int ph_lo, ph_hi; };
constexpr int N_PHASES = 18;
template <class Epi>
DI void run_gemm(LAS unsigned char* lds, const bf16* A, const bf16* Bt, int N, int K, const Epi& E) {
    pg8::Gemm g{A, Bt, M, N, K}; pg8::StaticOrder S; S.init(M, N, (int)gridDim.x, (int)blockIdx.x);
    pg8::gemm_phase<Epi, pg8::StaticOrder, true, true>(lds, g, S, E);
}
__global__ void __launch_bounds__(512, 2) mega(Args a) {
    extern __shared__ __attribute__((aligned(16))) unsigned char lds_raw[];
    LAS unsigned char* lds = (LAS unsigned char*)lds_raw;
    cg::grid_group grid = cg::this_grid();
    volatile LAS unsigned* bst = (volatile LAS unsigned*)(lds + 147456 - 64);
    if (threadIdx.x < 2) bst[threadIdx.x] = 0u;
    __syncthreads();
    XcdBarrier xbar = xcd_barrier_post((unsigned*)(a.ws + WS_CTL), bst);
    const int tid = threadIdx.x, lane = tid & 63, wave = __builtin_amdgcn_readfirstlane(tid >> 6);
    const int gw = blockIdx.x * 8 + wave, ngw = gridDim.x * 8;
#define WSP(off) ((bf16*)(a.ws + (off)))
#define W_EIN WSP(WS_EIN)
#define W_EOUT WSP(WS_EOUT)
#define W_OIN WSP(WS_OIN)
#define W_OOUT WSP(WS_OOUT)
#define W_GU WSP(WS_GU)
#define W_DN WSP(WS_DN)
#define W1K WSP(WS_W1K)
#define W1V WSP(WS_W1V)
#define W2K WSP(WS_W2K)
#define W2V WSP(WS_W2V)
#define DEC ((float*)(a.ws + WS_DEC))
#define KCMP WSP(WS_KCMP)
#define VCMPT WSP(WS_VCMPT)
#define Y WSP(WS_Y)
#define VST WSP(WS_VST)
#define VWT WSP(WS_VWT)
#define HN WSP(WS_HN)
#define ST WSP(WS_ST)
    const int lo = a.ph_lo, hi = a.ph_hi;
#define PH(k) if (lo <= (k) && (k) < hi)
#define SEAM(k) if (lo <= (k) && (k) + 1 < hi) { if ((k) == 0) grid.sync(); else xcd_barrier(xbar); }
    PH(0) {
        LAS float* scr = (LAS float*)(lds + wave * 8448);
        constexpr int I0 = 2048, I1 = 512, I2 = 1024, I3 = 512, I4 = 2816, I5 = 1408, I6 = 64, I7 = 2;
        constexpr int NIT = I0 + I1 + I2 + I3 + 2 * I4 + 2 * I5 + 2 * I6 + 2 * I7;
        for (int it = gw; it < NIT; it += ngw) {
            int r = it;
            if (r < I0) { transpose_item(a.in[4], 1024, EIN, EIN, W_EIN, 0, scr, r, lane); continue; } r -= I0;
            if (r < I1) { transpose_item(a.in[8], 1024, 1024, 1024, W_EOUT, 0, scr, r, lane); continue; } r -= I1;
            if (r < I2) { transpose_item(a.in[9], 1024, OIN, OINP, W_OIN, 0, scr, r, lane); continue; } r -= I2;
            if (r < I3) { transpose_item(a.in[16], 1024, 1024, 1024, W_OOUT, 0, scr, r, lane); continue; } r -= I3;
            if (r < 2 * I4) { const int l = r / I4; transpose_item(a.in[17] + (size_t)l * D * 2 * FF, 1024, 2 * FF, 2 * FF, W_GU + (size_t)l * GU_STRIDE, 1, scr, r % I4, lane); continue; } r -= 2 * I4;
            if (r < 2 * I5) { const int l = r / I5; transpose_item(a.in[18] + (size_t)l * FF * D, FF, 1024, 1024, W_DN + (size_t)l * DN_STRIDE, 0, scr, r % I5, lane); continue; } r -= 2 * I5;
            if (r < I6) { transpose_item(a.in[12], 2048, 64, 64, W1K, 0, scr, r, lane); continue; } r -= I6;
            if (r < I6) { transpose_item(a.in[14], 2048, 64, 64, W1V, 0, scr, r, lane); continue; } r -= I6;
            if (r < I7) { transpose_item(a.in[13], 64, 64, 64, W2K, 0, scr, r, lane); continue; } r -= I7;
            transpose_item(a.in[15], 64, 64, 64, W2V, 0, scr, r, lane);
        }
        norm_rows_bf16(a.in[0], a.in[1], HN, gw, ngw, lane);
    }
    SEAM(0);
    PH(1) { EpiStore E{Y, EIN}; run_gemm(lds, HN, W_EIN, EIN, 1024, E); }
    SEAM(1);
    PH(2) { la_state_phase(Y, a.in[5], ST, DEC, lds); }
    SEAM(2);
    PH(3) { la_scan_phase(ST, DEC); }
    SEAM(3);
    PH(4) { la_out_phase(Y, a.in[5], ST, a.in[6], a.in[7], HN, lds); }
    SEAM(4);
    PH(5) { EpiResid E{a.in[0], a.out}; run_gemm(lds, HN, W_EOUT, 1024, 1024, E); }
    SEAM(5);
    PH(6) { norm_rows_bf16(a.out, a.in[2], HN, gw, ngw, lane); }
    SEAM(6);
    PH(7) { EpiSwiglu E{Y}; run_gemm(lds, HN, W_GU, 2 * FF, 1024, E); }
    SEAM(7);
    PH(8) { EpiResid E{a.out, a.out}; run_gemm(lds, Y, W_DN, 1024, FF, E); }
    SEAM(8);
    PH(9) { norm_rows_bf16(a.out, a.in[1] + D, HN, gw, ngw, lane); }
    SEAM(9);
    PH(10) { EpiStore E{Y, OINP}; run_gemm(lds, HN, W_OIN, OINP, 1024, E); }
    SEAM(10);
    PH(11) { nsa_compress_phase(Y, a.in[10], a.in[11], W1K, W1V, W2K, W2V, KCMP, VCMPT, gw, ngw, lane); nsa_vt_phase(Y, VST, VWT, gw, ngw, lane); }
    SEAM(11);
    PH(12) { nsa_attn_phase(Y, KCMP, VCMPT, VST, VWT, HN, lds); }
    SEAM(12);
    PH(13) { EpiResid E{a.out, a.out}; run_gemm(lds, HN, W_OOUT, 1024, 1024, E); }
    SEAM(13);
    PH(14) { norm_rows_bf16(a.out, a.in[2] + D, HN, gw, ngw, lane); }
    SEAM(14);
    PH(15) { EpiSwiglu E{Y}; run_gemm(lds, HN, W_GU + GU_STRIDE, 2 * FF, 1024, E); }
    SEAM(15);
    PH(16) { EpiResid E{a.out, a.out}; run_gemm(lds, Y, W_DN + DN_STRIDE, 1024, FF, E); }
    SEAM(16);
    PH(17) { norm_rows_f32_inplace(a.out, a.in[3], gw, ngw, lane); }
#undef PH
#undef SEAM
}

extern "C" void kernel_launch(void* const* d_in, const int* in_sizes, int n_in, void* d_out, int out_size, void* d_ws, size_t ws_size, hipStream_t stream) {
    static int grid = 0;
    if (grid == 0) {
        if (n_in != 19 || in_sizes[0] != M * D || out_size != M * D || ws_size < WS_END) { fprintf(stderr, "kernel_launch: unexpected shapes (n_in %d, in0 %d, out %d, ws %zu)\n", n_in, n_in > 0 ? in_sizes[0] : -1, out_size, ws_size); grid = -1; return; }
        int dev = 0, cus = 0, per_cu = 0;
        (void)hipGetDevice(&dev); (void)hipDeviceGetAttribute(&cus, hipDeviceAttributeMultiprocessorCount, dev);
        if (hipFuncSetAttribute((const void*)mega, hipFuncAttributeMaxDynamicSharedMemorySize, LDS_BYTES) != hipSuccess) { fprintf(stderr, "kernel_launch: hipFuncSetAttribute failed\n"); grid = -1; return; }
        if (hipOccupancyMaxActiveBlocksPerMultiprocessor(&per_cu, (const void*)mega, 512, LDS_BYTES) != hipSuccess || per_cu < 1) { fprintf(stderr, "kernel_launch: occupancy query says %d\n", per_cu); per_cu = 1; }
        (void)hipGetLastError();
        grid = cus * 1;
    }
    if (grid < 0) return;
    if (hipMemsetAsync((char*)d_ws + WS_CTL, 0, CTL_BYTES, stream) != hipSuccess) { fprintf(stderr, "kernel_launch: memset failed\n"); return; }
    Args a{};
    for (int i = 0; i < 19; ++i) a.in[i] = (const float*)d_in[i];
    a.out = (float*)d_out; a.ws = (unsigned char*)d_ws; a.ph_lo = 0; a.ph_hi = N_PHASES;
    void* args[] = {&a};
    hipError_t e = hipLaunchCooperativeKernel((const void*)mega, dim3(grid), dim3(512), args, LDS_BYTES, stream);
    if (e != hipSuccess) fprintf(stderr, "kernel_launch: cooperative launch failed: %s (grid %d)\n", hipGetErrorString(e), grid);
#ifdef PROBE_PHASES
    { const int pp[] = {PROBE_PHASES};
      for (unsigned i = 0; i < sizeof(pp) / sizeof(pp[0]); ++i) { a.ph_lo = pp[i]; a.ph_hi = pp[i] + 1; (void)hipLaunchCooperativeKernel((const void*)mega, dim3(grid), dim3(512), args, LDS_BYTES, stream); } }
#endif
}
```

```cpp
#include <hip/hip_runtime.h>
#include <hip/hip_cooperative_groups.h>
#include <cstdio>
#include <cstdint>
namespace cg = cooperative_groups;
namespace pg8 {
#define PG8_LAS __attribute__((address_space(3)))
typedef unsigned short bf16_t;
typedef short bf16x8 __attribute__((ext_vector_type(8)));
typedef float f32x4 __attribute__((ext_vector_type(4)));
typedef unsigned u32x4 __attribute__((ext_vector_type(4)));
constexpr int BM = 256, BK = 64, HALF = 128, HTB = HALF * BK * 2  , STAGE_BYTES = 8 * HTB, NXCD = 8, WGM = 8;

__host__ __device__ __forceinline__ int lds_byte(int r, int c) { const int st = (r >> 4) * 2 + (c >> 5), rr = r & 15, cc = c & 31, ob = rr * 64 + cc * 2; return st * 1024 + (ob ^ (((ob >> 9) & 1) << 5)); }
__host__ __device__ __forceinline__ void stage_rc(int b, int& R, int& C) { const int st = b / 1024, sb = b % 1024, swz = sb ^ (((sb >> 9) & 1) << 5); R = (st >> 1) * 16 + swz / 64; C = (st & 1) * 32 + (swz % 64) / 2; }
__host__ __device__ __forceinline__ int perm32(int rho) { const int n = rho >> 4, i = rho & 15; return 8 * (i >> 2) + 4 * n + (i & 3); }

struct Unit { int pm, pn; };
struct Gemm { const bf16_t* A; const bf16_t* Bt; int M, N, K; };

struct StaticOrder {
    int nM, nN, nwg, G, c;
    __host__ __device__ void init(int M, int N, int G_, int c_) { nM = M / BM; nN = N / BM; nwg = nM * nN; G = G_; c = c_; }
    __host__ __device__ bool next(int i, Unit& u) const {
        const long L = (long)i * G + c; if (L >= nwg) return false;
        int wgid = (int)L; { const int q = nwg / NXCD, r = nwg % NXCD, xcd = wgid % NXCD, off = wgid / NXCD; wgid = (xcd < r ? xcd * (q + 1) : r * (q + 1) + (xcd - r) * q) + off; }
        const int nig = WGM * nN, gid = wgid / nig, fm = gid * WGM, gsz = (nM - fm) < WGM ? (nM - fm) : WGM;
        u.pm = fm + ((wgid % nig) % gsz); u.pn = (wgid % nig) / gsz; return true;
    }
    __device__ __forceinline__ void a_ready(const Unit&) const {}
    __device__ __forceinline__ void done(const Unit&) const {}
};

__device__ __forceinline__ unsigned cvt_pk_bf16(float lo, float hi) { unsigned r; asm volatile("v_cvt_pk_bf16_f32 %0, %1, %2" : "=v"(r) : "v"(lo), "v"(hi)); return r; }
template <class Epi, class Sched, bool ALIGN_EPI = false, bool SP2 = false>
__device__ __forceinline__ void gemm_phase(PG8_LAS unsigned char* lds, const Gemm g, const Sched& S, const Epi& E) {
    const int tid = threadIdx.x, wid = __builtin_amdgcn_readfirstlane(tid >> 6), lane = tid & 63, wr = wid >> 2, wc = wid & 3, fr = lane & 15, fq = lane >> 4;
    const int K = g.K, nt = K / BK;
    unsigned voffA[2], voffB[2];
#pragma unroll
    for (int i = 0; i < 2; ++i) { int R, C; stage_rc(tid * 16 + i * 8192, R, C); const int Rb = Epi::PERM ? ((R & ~31) + perm32(R & 31)) : R;
        voffA[i] = (unsigned)(R * K + C) * 2u; voffB[i] = (unsigned)(Rb * K + C) * 2u; }
    const size_t kstep = (size_t)(BK * 2);
    const size_t hstep = (size_t)HALF * K * 2;
    const size_t tstep = 2 * hstep;
    const unsigned ldsw = (unsigned)wid * 1024u;
    const int aoff = lds_byte(wr * 64 + fr, fq * 8), boff = lds_byte(wc * 32 + fr, fq * 8);
#define PG8_SA(b, h) (((b) * 2 + (h)) * HTB)
#define PG8_SB(b, h) ((4 + (b) * 2 + (h)) * HTB)
#define PG8_STAGE(bufoff, gbase, voff) do { _Pragma("unroll") for (int _i = 0; _i < 2; ++_i) \
        __builtin_amdgcn_global_load_lds((const unsigned*)((const char*)(gbase) + (voff)[_i]), (PG8_LAS unsigned*)(lds + (bufoff) + ldsw + _i * 8192), 16, 0, 0); } while (0)
#define PG8_LDA(dst, b, h) do { _Pragma("unroll") for (int m = 0; m < 4; ++m) _Pragma("unroll") for (int k = 0; k < 2; ++k) dst[m][k] = *(const PG8_LAS bf16x8*)(lds + PG8_SA(b, h) + aoff + m * 2048 + k * 1024); } while (0)
#define PG8_LDB(dst, b, h) do { _Pragma("unroll") for (int n = 0; n < 2; ++n) _Pragma("unroll") for (int k = 0; k < 2; ++k) dst[n][k] = *(const PG8_LAS bf16x8*)(lds + PG8_SB(b, h) + boff + n * 2048 + k * 1024); } while (0)
#define PG8_MMA(ai, bj, At, Bt) do { __builtin_amdgcn_s_setprio(1); _Pragma("unroll") for (int m = 0; m < 4; ++m) _Pragma("unroll") for (int n = 0; n < 2; ++n) _Pragma("unroll") for (int k = 0; k < 2; ++k) \
        acc[ai][bj][m][n] = __builtin_amdgcn_mfma_f32_16x16x32_bf16(Bt[n][k], At[m][k], acc[ai][bj][m][n], 0, 0, 0); __builtin_amdgcn_s_setprio(0); } while (0)
#define PG8_WAIT_V(n) asm volatile("s_waitcnt vmcnt(" #n ")" ::: "memory")
#define PG8_WAIT_L(n) asm volatile("s_waitcnt lgkmcnt(" #n ")" ::: "memory")
#define PG8_BAR __builtin_amdgcn_s_barrier()
#define PG8_SCHED __builtin_amdgcn_sched_barrier(0)
    Unit cur, nxt; int ui = 0;
    if (!S.next(0, cur)) return;
    f32x4 acc[2][2][4][2];
#pragma unroll
    for (int a = 0; a < 2; ++a)
#pragma unroll
        for (int b = 0; b < 2; ++b)
#pragma unroll
            for (int m = 0; m < 4; ++m)
#pragma unroll
                for (int n = 0; n < 2; ++n) acc[a][b][m][n] = (f32x4){0.f, 0.f, 0.f, 0.f};
    bf16x8 At[4][2], B0[2][2], B1[2][2];
    const char* cA = (const char*)g.A + (size_t)cur.pm * tstep; const char* cB = (const char*)g.Bt + (size_t)cur.pn * tstep;
    S.a_ready(cur);
    if constexpr (SP2) {
        PG8_STAGE(PG8_SB(0, 0), cB, voffB); PG8_STAGE(PG8_SB(0, 1), cB + hstep, voffB); PG8_STAGE(PG8_SA(0, 0), cA, voffA); PG8_STAGE(PG8_SA(0, 1), cA + hstep, voffA);
        if (wr == 1) PG8_BAR;
        PG8_WAIT_V(2); PG8_BAR;
        PG8_STAGE(PG8_SB(1, 0), cB + kstep, voffB); PG8_STAGE(PG8_SA(1, 0), cA + kstep, voffA); PG8_STAGE(PG8_SB(1, 1), cB + hstep + kstep, voffB);
        PG8_WAIT_V(6); PG8_BAR;
    } else {
        PG8_STAGE(PG8_SB(0, 0), cB, voffB); PG8_STAGE(PG8_SA(0, 0), cA, voffA); PG8_STAGE(PG8_SB(0, 1), cB + hstep, voffB); PG8_STAGE(PG8_SA(0, 1), cA + hstep, voffA);
        if (wr == 1) PG8_BAR;
        PG8_WAIT_V(4); PG8_BAR;
        PG8_STAGE(PG8_SB(1, 0), cB + kstep, voffB); PG8_STAGE(PG8_SA(1, 0), cA + kstep, voffA); PG8_STAGE(PG8_SB(1, 1), cB + hstep + kstep, voffB);
        PG8_WAIT_V(6); PG8_BAR;
    }
    for (;;) {
        const bool has_next = S.next(ui + 1, nxt);
        const char* nA = has_next ? (const char*)g.A + (size_t)nxt.pm * tstep : cA; const char* nB = has_next ? (const char*)g.Bt + (size_t)nxt.pn * tstep : cB;
        for (int t = 0; t < nt; t += 2) {
            const bool last = (t == nt - 2);
            const char* a1 = cA + (size_t)(t + 1) * kstep;
            const char* a2 = last ? nA : cA + (size_t)(t + 2) * kstep; const char* b2 = last ? nB : cB + (size_t)(t + 2) * kstep;
            const char* a3 = a2 + kstep; const char* b3 = b2 + kstep;
            if (last && has_next) S.a_ready(nxt);
            if constexpr (SP2) {
            PG8_LDB(B0, 0, 0); PG8_LDB(B1, 0, 1); PG8_SCHED; PG8_LDA(At, 0, 0); PG8_STAGE(PG8_SA(1, 1), a1 + hstep, voffA);
            PG8_WAIT_V(8); PG8_WAIT_L(0); PG8_BAR; PG8_MMA(0, 0, At, B0); PG8_MMA(0, 1, At, B1); PG8_BAR; PG8_SCHED;
            PG8_LDA(At, 0, 1); PG8_STAGE(PG8_SB(0, 0), b2, voffB); PG8_STAGE(PG8_SB(0, 1), b2 + hstep, voffB); PG8_STAGE(PG8_SA(0, 0), a2, voffA);
            PG8_WAIT_V(8); PG8_WAIT_L(0); PG8_BAR; PG8_MMA(1, 0, At, B0); PG8_MMA(1, 1, At, B1); PG8_BAR; PG8_SCHED;
            PG8_LDB(B0, 1, 0); PG8_LDB(B1, 1, 1); PG8_SCHED; PG8_LDA(At, 1, 0); PG8_STAGE(PG8_SA(0, 1), a2 + hstep, voffA);
            PG8_WAIT_V(8); PG8_WAIT_L(0); PG8_BAR; PG8_MMA(0, 0, At, B0); PG8_MMA(0, 1, At, B1); PG8_BAR; PG8_SCHED;
            PG8_LDA(At, 1, 1); PG8_STAGE(PG8_SB(1, 0), b3, voffB); PG8_STAGE(PG8_SB(1, 1), b3 + hstep, voffB); PG8_STAGE(PG8_SA(1, 0), a3, voffA);
            PG8_WAIT_V(8); PG8_WAIT_L(0); PG8_BAR; PG8_MMA(1, 0, At, B0); PG8_MMA(1, 1, At, B1); PG8_BAR; PG8_SCHED;
            } else {
            PG8_LDB(B0, 0, 0); PG8_SCHED; PG8_LDA(At, 0, 0); PG8_STAGE(PG8_SA(1, 1), a1 + hstep, voffA);
            PG8_WAIT_L(8); PG8_BAR; PG8_WAIT_L(0); PG8_MMA(0, 0, At, B0); PG8_BAR; PG8_SCHED;
            PG8_LDB(B1, 0, 1); PG8_STAGE(PG8_SB(0, 0), b2, voffB);
            PG8_BAR; PG8_WAIT_L(0); PG8_MMA(0, 1, At, B1); PG8_BAR;
            PG8_LDA(At, 0, 1); PG8_STAGE(PG8_SA(0, 0), a2, voffA);
            PG8_BAR; PG8_WAIT_L(0); PG8_MMA(1, 0, At, B0); PG8_BAR; PG8_SCHED;
            PG8_STAGE(PG8_SB(0, 1), b2 + hstep, voffB);
            PG8_WAIT_V(6); PG8_BAR; PG8_MMA(1, 1, At, B1); PG8_BAR;
            PG8_LDB(B0, 1, 0); PG8_SCHED; PG8_LDA(At, 1, 0); PG8_STAGE(PG8_SA(0, 1), a2 + hstep, voffA);
            PG8_WAIT_L(8); PG8_BAR; PG8_WAIT_L(0); PG8_MMA(0, 0, At, B0); PG8_BAR; PG8_SCHED;
            PG8_LDB(B1, 1, 1); PG8_STAGE(PG8_SB(1, 0), b3, voffB);
            PG8_BAR; PG8_WAIT_L(0); PG8_MMA(0, 1, At, B1); PG8_BAR;
            PG8_LDA(At, 1, 1); PG8_STAGE(PG8_SA(1, 0), a3, voffA);
            PG8_BAR; PG8_WAIT_L(0); PG8_MMA(1, 0, At, B0); PG8_BAR; PG8_SCHED;
            PG8_STAGE(PG8_SB(1, 1), b3 + hstep, voffB);
            PG8_WAIT_V(6); PG8_BAR; PG8_MMA(1, 1, At, B1); PG8_BAR;
            }
        }
        if constexpr (ALIGN_EPI) { if (wr == 0) PG8_BAR; }
        if constexpr (!Epi::AFTER_DRAIN) { E(acc, cur, wr, wc, fr, fq); S.done(cur); }
        if (!has_next) break;
#pragma unroll
        for (int a = 0; a < 2; ++a)
#pragma unroll
            for (int b = 0; b < 2; ++b)
#pragma unroll
                for (int m = 0; m < 4; ++m)
#pragma unroll
                    for (int n = 0; n < 2; ++n) acc[a][b][m][n] = (f32x4){0.f, 0.f, 0.f, 0.f};
        cur = nxt; cA = nA; cB = nB; ++ui;
        if constexpr (ALIGN_EPI) { if (wr == 1) PG8_BAR; }
    }
    PG8_WAIT_V(0);
    if constexpr (!ALIGN_EPI) { if (wr == 0) PG8_BAR; }
    PG8_BAR;
    if constexpr (Epi::AFTER_DRAIN) { E.fused(acc, cur, wr, wc, fr, fq, lds, wid, lane); S.done(cur); }
#undef PG8_SA
#undef PG8_SB
#undef PG8_STAGE
#undef PG8_LDA
#undef PG8_LDB
#undef PG8_MMA
#undef PG8_WAIT_V
#undef PG8_WAIT_L
#undef PG8_BAR
#undef PG8_SCHED
}
}
#define GAS __attribute__((address_space(1)))
#define LAS __attribute__((address_space(3)))
#define DI __device__ __forceinline__
typedef unsigned short bf16;
typedef short bf16x8 __attribute__((ext_vector_type(8)));
typedef short s16x4 __attribute__((ext_vector_type(4)));
typedef float f32x4 __attribute__((ext_vector_type(4)));
typedef float f32x2 __attribute__((ext_vector_type(2)));
typedef unsigned u32x4 __attribute__((ext_vector_type(4)));
typedef unsigned u32x2 __attribute__((ext_vector_type(2)));
typedef __bf16 bf16x2_t __attribute__((ext_vector_type(2)));
#define MFMA16(a, b, c) __builtin_amdgcn_mfma_f32_16x16x32_bf16((a), (b), (c), 0, 0, 0)

constexpr int NB = 4, T = 8192, D = 1024, M = NB * T, FF = 2816;
constexpr int EIN = 4096, OIN = 1840, OINP = 2048;
constexpr float RMS_EPS = 1e-6f, LOG2E = 1.4426950408889634f;
constexpr size_t MiB = 1u << 20;
constexpr size_t WS_EIN = 0, WS_EOUT = 8 * MiB, WS_OIN = 10 * MiB, WS_OOUT = 14 * MiB, WS_GU = 16 * MiB, WS_DN = 38 * MiB;
constexpr size_t WS_W1K = 49 * MiB, WS_W1V = WS_W1K + 256 * 1024, WS_W2K = WS_W1V + 256 * 1024, WS_W2V = WS_W2K + 8192;
constexpr size_t WS_CTL = 56 * MiB, CTL_BYTES = 16384, WS_RS = 57 * MiB;
constexpr size_t WS_DEC = 52 * MiB, WS_KCMP = 54 * MiB, WS_VCMPT = WS_KCMP + 512 * 1024;
constexpr size_t WS_Y = 64 * MiB;
constexpr size_t WS_VST = 192 * MiB, WS_VWT = 200 * MiB, WS_HB = 240 * MiB;
constexpr size_t WS_HN = 320 * MiB, WS_ST = 384 * MiB, WS_END = 512 * MiB;
constexpr size_t GU_STRIDE = (size_t)2 * FF * D, DN_STRIDE = (size_t)D * FF;
constexpr int LDS_BYTES = 147456;

DI unsigned pk2(float lo, float hi) { f32x2 v = {lo, hi}; return __builtin_bit_cast(unsigned, __builtin_convertvector(v, bf16x2_t)); }
DI bf16 f2bf(float f) { return (bf16)(pk2(f, 0.f) & 0xffffu); }
DI float bf2f(bf16 x) { return __uint_as_float(((unsigned)x) << 16); }
DI float bflo(unsigned w) { return __uint_as_float(w << 16); }
DI float bfhi(unsigned w) { return __uint_as_float(w & 0xffff0000u); }
DI float wave_sum(float v) {
#pragma unroll
    for (int o = 1; o < 64; o <<= 1) v += __shfl_xor(v, o);
    return v;
}
DI float ex2(float x) { return __builtin_amdgcn_exp2f(x); }
DI float sigmoidf_(float x) { return 1.0f / (1.0f + __expf(-x)); }
DI float siluf_(float x) { return x / (1.0f + __expf(-x)); }

DI float rowscale(const float* rs, int row, int fq) {
    const f32x4 p = *(const f32x4*)(rs + (size_t)row * 16 + 4 * fq);
    float s = (p.x + p.y) + (p.z + p.w); s += __shfl_xor(s, 16); s += __shfl_xor(s, 32);
    return rsqrtf(s * (1.f / D) + RMS_EPS);
}
struct EpiStore {
    static constexpr bool PERM = true, AFTER_DRAIN = false;
    bf16* O; int ldc; const float* rs;
    DI void operator()(const pg8::f32x4 (&acc)[2][2][4][2], const pg8::Unit& u, int wr, int wc, int fr, int fq) const {
        const int row0 = u.pm * 256 + wr * 64 + fr, col0 = u.pn * 256 + wc * 32 + 8 * fq;
#pragma unroll
        for (int ai = 0; ai < 2; ++ai)
#pragma unroll
            for (int m = 0; m < 4; ++m) { const int row = row0 + ai * 128 + m * 16; bf16* rowp = O + (size_t)row * ldc + col0;
                const float r = rs ? rowscale(rs, row, fq) : 1.f;
#pragma unroll
                for (int bj = 0; bj < 2; ++bj) { const pg8::f32x4 v0 = acc[ai][bj][m][0] * r, v1 = acc[ai][bj][m][1] * r;
                    u32x4 w; w.x = pk2(v0[0], v0[1]); w.y = pk2(v0[2], v0[3]); w.z = pk2(v1[0], v1[1]); w.w = pk2(v1[2], v1[3]);
                    *(u32x4*)(rowp + bj * 128) = w; } }
    }
};
struct EpiSwiglu {
    static constexpr bool PERM = true, AFTER_DRAIN = false;
    bf16* O; const float* rs;
    DI void operator()(const pg8::f32x4 (&acc)[2][2][4][2], const pg8::Unit& u, int wr, int wc, int fr, int fq) const {
        const int row0 = u.pm * 256 + wr * 64 + fr, col0 = u.pn * 128 + wc * 32 + 8 * fq;
#pragma unroll
        for (int ai = 0; ai < 2; ++ai)
#pragma unroll
            for (int m = 0; m < 4; ++m) { const int row = row0 + ai * 128 + m * 16; bf16* rowp = O + (size_t)row * FF + col0;
                const float rsc = rowscale(rs, row, fq);
                float r[8];
#pragma unroll
                for (int n = 0; n < 2; ++n)
#pragma unroll
                    for (int e = 0; e < 4; ++e) { const float g = acc[ai][0][m][n][e] * rsc, up = acc[ai][1][m][n][e] * rsc; r[n * 4 + e] = g * __builtin_amdgcn_rcpf(1.0f + __expf(-g)) * up; }
                u32x4 w; w.x = pk2(r[0], r[1]); w.y = pk2(r[2], r[3]); w.z = pk2(r[4], r[5]); w.w = pk2(r[6], r[7]);
                *(u32x4*)rowp = w; }
    }
};
struct EpiResid {
    static constexpr bool PERM = false, AFTER_DRAIN = false;
    const float* base; float* out; bf16* hb; float* rs;
    DI void operator()(const pg8::f32x4 (&acc)[2][2][4][2], const pg8::Unit& u, int wr, int wc, int fr, int fq) const {
        const int row0 = u.pm * 256 + wr * 64 + fr, col0 = u.pn * 256 + wc * 32 + 4 * fq;
#pragma unroll
        for (int ai = 0; ai < 2; ++ai)
#pragma unroll
            for (int m = 0; m < 4; ++m) { const int row = row0 + ai * 128 + m * 16; const size_t off = (size_t)row * D + col0; float ss = 0.f;
#pragma unroll
                for (int bj = 0; bj < 2; ++bj)
#pragma unroll
                    for (int n = 0; n < 2; ++n) { const f32x4 bs = *(const f32x4*)(base + off + bj * 128 + n * 16); const pg8::f32x4 a = acc[ai][bj][m][n];
                        f32x4 o; o.x = bs.x + a[0]; o.y = bs.y + a[1]; o.z = bs.z + a[2]; o.w = bs.w + a[3]; *(f32x4*)(out + off + bj * 128 + n * 16) = o;
                        if (hb) { u32x2 hw; hw.x = pk2(o.x, o.y); hw.y = pk2(o.z, o.w); *(u32x2*)(hb + off + bj * 128 + n * 16) = hw; ss += (o.x * o.x + o.y * o.y) + (o.z * o.z + o.w * o.w); } }
                if (hb) { ss += __shfl_xor(ss, 16); ss += __shfl_xor(ss, 32); if (fq == 0) rs[(size_t)row * 16 + u.pn * 4 + wc] = ss; } }
    }
};

DI void transpose_item(const float* W, int K, int N, int Npad, bf16* WT, int mode, LAS float* scr, int item, int lane, const float* gk = nullptr) {
    const int nblk = Npad / 32, kb = item / nblk, nb = item % nblk, k0 = 64 * kb, n0 = 32 * nb;
    const int nl = n0 + (lane & 31);
#pragma unroll 8
    for (int i = 0; i < 32; ++i) { const int kk = 2 * i + (lane >> 5); const float gv = gk ? gk[k0 + kk] : 1.f; scr[kk * 33 + (lane & 31)] = (nl < N) ? W[(size_t)(k0 + kk) * N + nl] * gv : 0.f; }
    asm volatile("s_waitcnt lgkmcnt(0)" ::: "memory");
    const int c = lane & 7;
    int drow0 = n0;
    if (mode == 1) { drow0 = (n0 < FF) ? (256 * (n0 >> 7) + (n0 & 127)) : (256 * ((n0 - FF) >> 7) + 128 + ((n0 - FF) & 127)); }
#pragma unroll
    for (int j = 0; j < 4; ++j) { const int n = (lane >> 3) + 8 * j; const LAS float* s = scr + (8 * c) * 33 + n;
        u32x4 o; o.x = pk2(s[0 * 33], s[1 * 33]); o.y = pk2(s[2 * 33], s[3 * 33]); o.z = pk2(s[4 * 33], s[5 * 33]); o.w = pk2(s[6 * 33], s[7 * 33]);
        *(u32x4*)(WT + (size_t)(drow0 + n) * K + k0 + 8 * c) = o; }
    asm volatile("s_waitcnt lgkmcnt(0)" ::: "memory");
}
DI void norm_rows_bf16(const float* h, const float* g, bf16* out, int gw, int ngw, int lane) {
    f32x4 gv[4];
#pragma unroll
    for (int j = 0; j < 4; ++j) gv[j] = *((const f32x4*)g + lane + 64 * j);
    for (int m = gw; m < M; m += ngw) {
        const f32x4* xr = (const f32x4*)(h + (size_t)m * D) + lane; f32x4 v[4]; float s = 0.f;
#pragma unroll
        for (int j = 0; j < 4; ++j) { v[j] = xr[64 * j]; s += (v[j].x * v[j].x + v[j].y * v[j].y) + (v[j].z * v[j].z + v[j].w * v[j].w); }
        const float r = rsqrtf(wave_sum(s) * (1.f / D) + RMS_EPS);
        u32x2* o8 = (u32x2*)(out + (size_t)m * D) + lane;
#pragma unroll
        for (int j = 0; j < 4; ++j) { u32x2 w; w.x = pk2(v[j].x * r * gv[j].x, v[j].y * r * gv[j].y); w.y = pk2(v[j].z * r * gv[j].z, v[j].w * r * gv[j].w); o8[64 * j] = w; }
    }
}
DI void norm_rows_f32_inplace(float* h, const float* g, int gw, int ngw, int lane) {
    f32x4 gv[4];
#pragma unroll
    for (int j = 0; j < 4; ++j) gv[j] = *((const f32x4*)g + lane + 64 * j);
    for (int m = gw; m < M; m += ngw) {
        f32x4* xr = (f32x4*)(h + (size_t)m * D) + lane; f32x4 v[4]; float s = 0.f;
#pragma unroll
        for (int j = 0; j < 4; ++j) { v[j] = xr[64 * j]; s += (v[j].x * v[j].x + v[j].y * v[j].y) + (v[j].z * v[j].z + v[j].w * v[j].w); }
        const float r = rsqrtf(wave_sum(s) * (1.f / D) + RMS_EPS);
#pragma unroll
        for (int j = 0; j < 4; ++j) { f32x4 o; o.x = v[j].x * r * gv[j].x; o.y = v[j].y * r * gv[j].y; o.z = v[j].z * r * gv[j].z; o.w = v[j].w * r * gv[j].w; xr[64 * j] = o; }
    }
}
typedef GAS unsigned gu32;
#define XB_TMO      128
#define XB_XCNT(j)  (256  + 64 * (j))
#define XB_XSUB(j)  (1280 + 64 * (j))
#define XB_XGEN(j)  (2304 + 64 * (j))
#define XB_TOP      3328
#define XB_TOPGEN   3392
#define XCD_BAR_WORDS 3456
#define XB_SPIN_CAP (1u << 18)

__device__ __forceinline__ unsigned xb_ld(unsigned* p)              { return __hip_atomic_load(p, __ATOMIC_RELAXED, __HIP_MEMORY_SCOPE_AGENT); }
__device__ __forceinline__ unsigned xb_add(unsigned* p, unsigned v) { return __hip_atomic_fetch_add(p, v, __ATOMIC_RELAXED, __HIP_MEMORY_SCOPE_AGENT); }
__device__ __forceinline__ unsigned xb_xcc_id() { return (unsigned)__builtin_amdgcn_s_getreg((3 << 11) | 20) & 0xFu; }
#define XB_SPIN(cond, bar) do { unsigned _sp = 0; while (cond) { __builtin_amdgcn_s_sleep(1); \
    if ((++_sp & 255u) == 0u) { if (xb_ld(&(bar)[XB_TMO])) break; if (_sp > XB_SPIN_CAP) { atomicAdd(&(bar)[XB_TMO], 1u); break; } } } } while (0)

struct XcdBarrier {
    unsigned* bar; unsigned x;
    volatile LAS unsigned* st;
};

__device__ __forceinline__ XcdBarrier xcd_barrier_post(unsigned* bar, volatile LAS unsigned* st) {
    XcdBarrier b; b.bar = bar; b.x = xb_xcc_id(); b.st = st;
    if (threadIdx.x == 0) (void)xb_add(&bar[XB_XCNT(b.x)], 1u);
    return b;
}
__device__ __forceinline__ void xcd_barrier_complete(unsigned* bar, unsigned x, unsigned& nloc, unsigned& nx) {
    const unsigned G = gridDim.x * gridDim.y * gridDim.z;
    unsigned sum, cnt, mine, sp = 0u;
    for (;;) {
        sum = 0u; cnt = 0u; mine = 0u;
#pragma unroll
        for (unsigned j = 0; j < 16; ++j) { const unsigned c = xb_ld(&bar[XB_XCNT(j)]); sum += c; cnt += (c > 0u) ? 1u : 0u; mine = (j == x) ? c : mine; }
        if (sum == G) break;
        __builtin_amdgcn_s_sleep(1);
        if ((++sp & 255u) == 0u) { if (xb_ld(&bar[XB_TMO])) break; if (sp > XB_SPIN_CAP) { atomicAdd(&bar[XB_TMO], 1u); break; } }
    }
    nloc = mine > 0u ? mine : 1u; nx = cnt > 0u ? cnt : 1u;
}

__device__ __forceinline__ void xcd_barrier(const XcdBarrier& b) {
    asm volatile("s_waitcnt vmcnt(0)" ::: "memory");
    __syncthreads();
    if (threadIdx.x == 0) {
        unsigned* bar = b.bar;
        __builtin_amdgcn_s_waitcnt(0);
        unsigned nloc = b.st[0], nx = b.st[1];
        if (nloc == 0u) { xcd_barrier_complete(bar, b.x, nloc, nx); b.st[0] = nloc; b.st[1] = nx; }
        const unsigned old = xb_add(&bar[XB_XSUB(b.x)], 1u);
        const unsigned gen = old / nloc;
        if (old + 1u == (gen + 1u) * nloc) {
            __builtin_amdgcn_fence(__ATOMIC_RELEASE, "agent");
            asm volatile("s_waitcnt vmcnt(0)" ::: "memory");
            const unsigned og = xb_add(&bar[XB_TOP], 1u);
            const unsigned tg = og / nx;
            if (og + 1u == (tg + 1u) * nx) xb_add(&bar[XB_TOPGEN], 1u);
            else XB_SPIN(xb_ld(&bar[XB_TOPGEN]) == tg, bar);
            __builtin_amdgcn_fence(__ATOMIC_ACQUIRE, "agent");
            xb_add(&bar[XB_XGEN(b.x)], 1u);
            asm volatile("s_waitcnt vmcnt(0)" ::: "memory");
        } else {
            XB_SPIN(xb_ld(&bar[XB_XGEN(b.x)]) == gen, bar);
            __builtin_amdgcn_fence(__ATOMIC_ACQUIRE, "agent");
            asm volatile("s_waitcnt vmcnt(0)" ::: "memory");
        }
    }
    __syncthreads();
}
constexpr int LA_UNITS = NB * 8 * 128;
constexpr int KT_LD = 72, QT_LD = 136;
template <bool WANT_Q>
DI void la_load_col(const bf16* Yb, int hh, int d, int rg, const float* lbraw, float (&lg)[16], float (&kk)[16], float (&qq)[16]) {
    if (hh < 4) {
        const float a = lbraw[hh * 128 + d], b2 = lbraw[512 + hh * 128 + d];
        const float mx = fmaxf(a, b2), ea = __expf(a - mx), eb = __expf(b2 - mx), lbv = ea / (ea + eb);
        const bf16* pf = Yb + (size_t)(16 * rg) * EIN + 512 + hh * 128 + d;
        const bf16* pq = Yb + (size_t)(16 * rg) * EIN + hh * 128 + d;
#pragma unroll
        for (int e = 0; e < 16; ++e) { const float x = bf2f(pf[(size_t)e * EIN]); const float f = lbv + (1.f - lbv) * sigmoidf_(x); lg[e] = __logf(f); kk[e] = 1.f - f;
            if (WANT_Q) qq[e] = siluf_(bf2f(pq[(size_t)e * EIN])); }
    } else {
        const int r = hh - 4; const float lgam = __logf(1.f - exp2f(-5.f - (float)r));
        const bf16* pk = Yb + (size_t)(16 * rg) * EIN + 2560 + r * 128 + d;
        const bf16* pq = Yb + (size_t)(16 * rg) * EIN + 2048 + r * 128 + d;
#pragma unroll
        for (int e = 0; e < 16; ++e) { lg[e] = lgam; kk[e] = bf2f(pk[(size_t)e * EIN]) * 0.08838834764831845f; if (WANT_Q) qq[e] = bf2f(pq[(size_t)e * EIN]); }
    }
    float run = 0.f;
#pragma unroll
    for (int e = 0; e < 16; ++e) { run += lg[e]; lg[e] = run; }
}
DI void la_stage_vt(const bf16* Yb, int hh, int d, int rg, LAS bf16* VT) {
    const bf16* pv = Yb + (size_t)(16 * rg) * EIN + (hh < 4 ? 1024 + hh * 128 : 3072 + (hh - 4) * 128) + d;
    unsigned w[8];
#pragma unroll
    for (int e = 0; e < 8; ++e) w[e] = (unsigned)pv[(size_t)(2 * e) * EIN] | ((unsigned)pv[(size_t)(2 * e + 1) * EIN] << 16);
    LAS u32x4* dst = (LAS u32x4*)(VT + d * KT_LD + 16 * rg);
    dst[0] = (u32x4){w[0], w[1], w[2], w[3]}; dst[1] = (u32x4){w[4], w[5], w[6], w[7]};
}
DI void la_state_phase(const bf16* Y0, const float* lbraw, bf16* ST, float* DEC, LAS unsigned char* lds) {
    LAS bf16* KT = (LAS bf16*)lds; LAS bf16* VT = KT + 128 * KT_LD; LAS float* tot = (LAS float*)(VT + 128 * KT_LD);
    const int tid = threadIdx.x, lane = tid & 63, w = tid >> 6, l15 = lane & 15, q = lane >> 4, d = tid & 127, rg = tid >> 7;
    for (int unit = blockIdx.x; unit < LA_UNITS; unit += gridDim.x) {
        const int b = unit >> 10, hh = (unit >> 7) & 7, n = unit & 127;
        const bf16* Yb = Y0 + (size_t)(b * T + n * 64) * EIN;
        float lg[16], kk[16], qq[16];
        la_load_col<false>(Yb, hh, d, rg, lbraw, lg, kk, qq);
        tot[rg * 128 + d] = lg[15];
        la_stage_vt(Yb, hh, d, rg, VT);
        __syncthreads();
        float pre = 0.f, last = 0.f;
#pragma unroll
        for (int g2 = 0; g2 < 4; ++g2) { const float tv = tot[g2 * 128 + d]; if (g2 < rg) pre += tv; last += tv; }
        unsigned wv[8];
#pragma unroll
        for (int e = 0; e < 8; ++e) { const float c0 = pre + lg[2 * e], c1 = pre + lg[2 * e + 1]; wv[e] = pk2(kk[2 * e] * __expf(last - c0), kk[2 * e + 1] * __expf(last - c1)); }
        LAS u32x4* dst = (LAS u32x4*)(KT + d * KT_LD + 16 * rg);
        dst[0] = (u32x4){wv[0], wv[1], wv[2], wv[3]}; dst[1] = (u32x4){wv[4], wv[5], wv[6], wv[7]};
        if (rg == 0) DEC[(size_t)unit * 128 + d] = __expf(last);
        __syncthreads();
        f32x4 acc[8];
#pragma unroll
        for (int dt = 0; dt < 8; ++dt) acc[dt] = (f32x4){0.f, 0.f, 0.f, 0.f};
#pragma unroll
        for (int ks = 0; ks < 2; ++ks) { const bf16x8 bv = *(const LAS bf16x8*)(VT + (16 * w + l15) * KT_LD + 32 * ks + 8 * q);
#pragma unroll
            for (int dt = 0; dt < 8; ++dt) { const bf16x8 ak = *(const LAS bf16x8*)(KT + (16 * dt + l15) * KT_LD + 32 * ks + 8 * q); acc[dt] = MFMA16(ak, bv, acc[dt]); } }
        bf16* so = ST + (size_t)unit * 16384 + (16 * w + l15) * 128 + 4 * q;
#pragma unroll
        for (int dt = 0; dt < 8; ++dt) { u32x2 o; o.x = pk2(acc[dt][0], acc[dt][1]); o.y = pk2(acc[dt][2], acc[dt][3]); *(u32x2*)(so + 16 * dt) = o; }
        __syncthreads();
    }
}
DI void la_scan_phase(bf16* ST, const float* DEC) {
    const int gid = blockIdx.x * 512 + threadIdx.x, nth = gridDim.x * 512;
    for (int wk = gid; wk < 32 * 4096; wk += nth) {
        const int bh = wk >> 12, e4 = (wk & 4095) * 4, d = e4 & 127;
        f32x4 s = {0.f, 0.f, 0.f, 0.f};
        bf16* sp = ST + (size_t)bh * 128 * 16384 + e4; const float* dp = DEC + (size_t)bh * 128 * 128 + d;
        for (int n0 = 0; n0 < 128; n0 += 8) {
            u32x2 uv[8]; f32x4 dv[8];
#pragma unroll
            for (int i = 0; i < 8; ++i) { uv[i] = *(const u32x2*)(sp + (size_t)(n0 + i) * 16384); dv[i] = *(const f32x4*)(dp + (size_t)(n0 + i) * 128); }
#pragma unroll
            for (int i = 0; i < 8; ++i) { u32x2 o; o.x = pk2(s.x, s.y); o.y = pk2(s.z, s.w); *(u32x2*)(sp + (size_t)(n0 + i) * 16384) = o;
                s.x = dv[i].x * s.x + bflo(uv[i].x); s.y = dv[i].y * s.y + bfhi(uv[i].x); s.z = dv[i].z * s.z + bflo(uv[i].y); s.w = dv[i].w * s.w + bfhi(uv[i].y); }
        }
    }
}
DI void la_out_phase(const bf16* Y0, const float* lbraw, const bf16* ST, const float* gh, const float* gr, bf16* MIX, LAS unsigned char* lds) {
    LAS bf16* QT = (LAS bf16*)lds; LAS bf16* K2 = QT + 64 * QT_LD; LAS bf16* QS = K2 + 64 * QT_LD; LAS bf16* VT = QS + 64 * QT_LD;
    LAS float* tot = (LAS float*)(VT + 128 * KT_LD); LAS float* ssq = tot + 512;
    const int tid = threadIdx.x, lane = tid & 63, w = tid >> 6, l15 = lane & 15, q = lane >> 4, d = tid & 127, rg = tid >> 7;
    const int it = w & 3, vh = w >> 2;
    for (int unit = blockIdx.x; unit < LA_UNITS; unit += gridDim.x) {
        const int b = unit >> 10, hh = (unit >> 7) & 7, n = unit & 127;
        const int row0 = b * T + n * 64;
        const bf16* Yb = Y0 + (size_t)row0 * EIN;
        float lg[16], kk[16], qq[16];
        la_load_col<true>(Yb, hh, d, rg, lbraw, lg, kk, qq);
        tot[rg * 128 + d] = lg[15];
        la_stage_vt(Yb, hh, d, rg, VT);
        __syncthreads();
        float pre = 0.f;
#pragma unroll
        for (int g2 = 0; g2 < 4; ++g2) { const float tv = tot[g2 * 128 + d]; if (g2 < rg) pre += tv; }
        const float ref = tot[d] + tot[128 + d];
#pragma unroll
        for (int e = 0; e < 16; ++e) { const float c = pre + lg[e]; const int j = 16 * rg + e;
            QT[j * QT_LD + d] = f2bf(qq[e] * __expf(c - ref)); K2[j * QT_LD + d] = f2bf(kk[e] * __expf(ref - c)); QS[j * QT_LD + d] = f2bf(qq[e] * __expf(c)); }
        __syncthreads();
        f32x4 at[4];
#pragma unroll
        for (int jt = 0; jt < 4; ++jt) at[jt] = (f32x4){0.f, 0.f, 0.f, 0.f};
#pragma unroll
        for (int ks = 0; ks < 4; ++ks) { const bf16x8 bq = *(const LAS bf16x8*)(QT + (16 * it + l15) * QT_LD + 32 * ks + 8 * q);
#pragma unroll
            for (int jt = 0; jt < 4; ++jt) { const bf16x8 ak = *(const LAS bf16x8*)(K2 + (16 * jt + l15) * QT_LD + 32 * ks + 8 * q); at[jt] = MFMA16(ak, bq, at[jt]); } }
        const int irow = 16 * it + l15;
#pragma unroll
        for (int jt = 0; jt < 4; ++jt)
#pragma unroll
            for (int r = 0; r < 4; ++r) { const int j = 16 * jt + 4 * q + r; if (j > irow) at[jt][r] = 0.f; }
        f32x4 o[4];
#pragma unroll
        for (int vt = 0; vt < 4; ++vt) o[vt] = (f32x4){0.f, 0.f, 0.f, 0.f};
#pragma unroll
        for (int k2 = 0; k2 < 2; ++k2) {
            u32x4 pw; pw.x = pk2(at[2 * k2][0], at[2 * k2][1]); pw.y = pk2(at[2 * k2][2], at[2 * k2][3]); pw.z = pk2(at[2 * k2 + 1][0], at[2 * k2 + 1][1]); pw.w = pk2(at[2 * k2 + 1][2], at[2 * k2 + 1][3]);
            const bf16x8 pf = __builtin_bit_cast(bf16x8, pw);
#pragma unroll
            for (int vt = 0; vt < 4; ++vt) { const LAS bf16* vp = VT + (64 * vh + 16 * vt + l15) * KT_LD + 32 * k2 + 4 * q;
                const u32x2 lo = *(const LAS u32x2*)vp, hi = *(const LAS u32x2*)(vp + 16);
                const bf16x8 av = __builtin_bit_cast(bf16x8, ((u32x4){lo.x, lo.y, hi.x, hi.y})); o[vt] = MFMA16(av, pf, o[vt]); }
        }
        const bf16* sb = ST + (size_t)unit * 16384;
#pragma unroll
        for (int ks = 0; ks < 4; ++ks) { const bf16x8 bq = *(const LAS bf16x8*)(QS + (16 * it + l15) * QT_LD + 32 * ks + 8 * q);
#pragma unroll
            for (int vt = 0; vt < 4; ++vt) { const bf16x8 as = *(const bf16x8*)(sb + (64 * vh + 16 * vt + l15) * 128 + 32 * ks + 8 * q); o[vt] = MFMA16(as, bq, o[vt]); } }
        float ss = 0.f;
#pragma unroll
        for (int vt = 0; vt < 4; ++vt) ss += (o[vt][0] * o[vt][0] + o[vt][1] * o[vt][1]) + (o[vt][2] * o[vt][2] + o[vt][3] * o[vt][3]);
        ss += __shfl_xor(ss, 16); ss += __shfl_xor(ss, 32);
        if (q == 0) ssq[vh * 64 + irow] = ss;
        __syncthreads();
        const float rs = rsqrtf((ssq[irow] + ssq[64 + irow]) * (1.f / 128.f) + RMS_EPS);
        const float* gn = (hh < 4) ? gh : gr;
        const bf16* gp = Yb + (size_t)irow * EIN + (hh < 4 ? 1536 + hh * 128 : 3584 + (hh - 4) * 128);
        bf16* op = MIX + (size_t)(row0 + irow) * D + hh * 128;
#pragma unroll
        for (int vt = 0; vt < 4; ++vt) { const int v0 = 64 * vh + 16 * vt + 4 * q; const f32x4 gv = *(const f32x4*)(gn + v0); const u32x2 gw = *(const u32x2*)(gp + v0);
            u32x2 ow; ow.x = pk2(o[vt][0] * rs * gv.x * siluf_(bflo(gw.x)), o[vt][1] * rs * gv.y * siluf_(bfhi(gw.x)));
            ow.y = pk2(o[vt][2] * rs * gv.z * siluf_(bflo(gw.y)), o[vt][3] * rs * gv.w * siluf_(bfhi(gw.y))); *(u32x2*)(op + v0) = ow; }
        __syncthreads();
    }
}
constexpr int NC = 511, NCP = 512;
DI void nsa_compress_phase(const bf16* Y1, const float* posk, const float* posv, const bf16* w1kT, const bf16* w1vT, const bf16* w2kT, const bf16* w2vT,
                           bf16* KCMP, bf16* VCMPT, int gw, int ngw, int lane) {
    const int l15 = lane & 15, q = lane >> 4;
    for (int task = gw; task < 512; task += ngw) {
        const int kv = task & 1, rt = task >> 1;
        int r = rt * 16 + l15; const bool rvalid = r < NB * NC * 2; if (!rvalid) r = NB * NC * 2 - 1;
        const int b = r / (NC * 2), rem = r % (NC * 2), i = rem >> 1, g = rem & 1;
        const bf16* src = Y1 + (size_t)(b * T + 16 * i) * OINP + (kv ? 1152 : 1024) + g * 64;
        const float* pos = kv ? posv : posk; const bf16* w1 = kv ? w1vT : w1kT; const bf16* w2 = kv ? w2vT : w2kT;
        f32x4 acc[4];
#pragma unroll
        for (int nt = 0; nt < 4; ++nt) acc[nt] = (f32x4){0.f, 0.f, 0.f, 0.f};
        for (int ks = 0; ks < 64; ++ks) {
            const int p = ks >> 1, d0 = (ks & 1) * 32 + 8 * q;
            const u32x4 xv = *(const u32x4*)(src + (size_t)p * OINP + d0);
            const f32x4 p0 = *(const f32x4*)(pos + p * 64 + d0), p1 = *(const f32x4*)(pos + p * 64 + d0 + 4);
            u32x4 bw; bw.x = pk2(bflo(xv.x) + p0.x, bfhi(xv.x) + p0.y); bw.y = pk2(bflo(xv.y) + p0.z, bfhi(xv.y) + p0.w);
            bw.z = pk2(bflo(xv.z) + p1.x, bfhi(xv.z) + p1.y); bw.w = pk2(bflo(xv.w) + p1.z, bfhi(xv.w) + p1.w);
            const bf16x8 bf = __builtin_bit_cast(bf16x8, bw);
#pragma unroll
            for (int nt = 0; nt < 4; ++nt) { const bf16x8 af = *(const bf16x8*)(w1 + (size_t)(16 * nt + l15) * 2048 + 32 * ks + 8 * q); acc[nt] = MFMA16(af, bf, acc[nt]); }
        }
        f32x4 o2[4];
#pragma unroll
        for (int t2 = 0; t2 < 4; ++t2) o2[t2] = (f32x4){0.f, 0.f, 0.f, 0.f};
#pragma unroll
        for (int k2 = 0; k2 < 2; ++k2) {
            u32x4 pw; pw.x = pk2(siluf_(acc[2 * k2][0]), siluf_(acc[2 * k2][1])); pw.y = pk2(siluf_(acc[2 * k2][2]), siluf_(acc[2 * k2][3]));
            pw.z = pk2(siluf_(acc[2 * k2 + 1][0]), siluf_(acc[2 * k2 + 1][1])); pw.w = pk2(siluf_(acc[2 * k2 + 1][2]), siluf_(acc[2 * k2 + 1][3]));
            const bf16x8 pf = __builtin_bit_cast(bf16x8, pw);
#pragma unroll
            for (int t2 = 0; t2 < 4; ++t2) { const bf16* wp = w2 + (16 * t2 + l15) * 64 + 32 * k2 + 4 * q;
                const u32x2 lo = *(const u32x2*)wp, hi = *(const u32x2*)(wp + 16);
                const bf16x8 av = __builtin_bit_cast(bf16x8, ((u32x4){lo.x, lo.y, hi.x, hi.y})); o2[t2] = MFMA16(av, pf, o2[t2]); }
        }
        if (rvalid) {
            if (kv == 0) { bf16* op = KCMP + ((size_t)(b * 2 + g) * NCP + i) * 64 + 4 * q;
#pragma unroll
                for (int t2 = 0; t2 < 4; ++t2) { u32x2 ow; ow.x = pk2(o2[t2][0], o2[t2][1]); ow.y = pk2(o2[t2][2], o2[t2][3]); *(u32x2*)(op + 16 * t2) = ow; }
            } else { bf16* op = VCMPT + (size_t)(b * 2 + g) * 64 * NCP + i;
#pragma unroll
                for (int t2 = 0; t2 < 4; ++t2)
#pragma unroll
                    for (int r2 = 0; r2 < 4; ++r2) op[(size_t)(16 * t2 + 4 * q + r2) * NCP] = f2bf(o2[t2][r2]); }
        }
    }
    for (int z = gw * 64 + lane; z < NB * 2 * 64; z += ngw * 64) { const int bg = z >> 6, dd = z & 63; KCMP[((size_t)bg * NCP + NC) * 64 + dd] = 0; VCMPT[((size_t)bg * 64 + dd) * NCP + NC] = 0; }
}
DI void nsa_vt_phase(const bf16* Y1, bf16* VST, bf16* VWT, int gw, int ngw, int lane) {
    for (int task = gw; task < 2 * NB * 2 * 128; task += ngw) {
        const int which = task & 1, g = (task >> 1) & 1, b = (task >> 2) & 3, blk = task >> 4;
        const int t = blk * 64 + lane;
        const bf16* src = Y1 + (size_t)(b * T + t) * OINP + (which ? 1664 : 1408) + g * 64;
        bf16* dst = (which ? VWT : VST) + (size_t)(b * 2 + g) * 64 * T + t;
        u32x4 v[8];
#pragma unroll
        for (int c = 0; c < 8; ++c) v[c] = *(const u32x4*)(src + 8 * c);
#pragma unroll
        for (int c = 0; c < 8; ++c) {
            dst[(size_t)(8 * c + 0) * T] = (bf16)(v[c].x & 0xffff); dst[(size_t)(8 * c + 1) * T] = (bf16)(v[c].x >> 16);
            dst[(size_t)(8 * c + 2) * T] = (bf16)(v[c].y & 0xffff); dst[(size_t)(8 * c + 3) * T] = (bf16)(v[c].y >> 16);
            dst[(size_t)(8 * c + 4) * T] = (bf16)(v[c].z & 0xffff); dst[(size_t)(8 * c + 5) * T] = (bf16)(v[c].z >> 16);
            dst[(size_t)(8 * c + 6) * T] = (bf16)(v[c].w & 0xffff); dst[(size_t)(8 * c + 7) * T] = (bf16)(v[c].w >> 16);
        }
    }
}
#define LDS_BAR() do { asm volatile("s_waitcnt lgkmcnt(0)" ::: "memory"); __builtin_amdgcn_s_barrier(); asm volatile("" ::: "memory"); } while (0)
constexpr int TL = 80;
constexpr int SLAB_LD = 132;
constexpr float C1 = 0.125f * LOG2E;
DI void tile_fetch(const bf16* kg, int ldk, const bf16* vg, int ldv, int tid, u32x4& kr, u32x4& vr) {
    const int r = tid >> 3, c = (tid & 7) * 8;
    kr = *(const u32x4*)(kg + (size_t)r * ldk + c); vr = *(const u32x4*)(vg + (size_t)r * ldv + c);
    asm volatile("" ::: "memory");
}
DI void tile_store(LAS bf16* Kb, LAS bf16* Vb, int tid, u32x4 kr, u32x4 vr) {
    const int r = tid >> 3, c = (tid & 7) * 8;
    *(LAS u32x4*)(Kb + r * TL + c) = kr;
    const int g32 = c & 32, k0 = c & 31, k1 = k0 + 4;
    const int p0 = 8 * ((k0 & 15) >> 2) + 4 * (k0 >> 4), p1 = 8 * ((k1 & 15) >> 2) + 4 * (k1 >> 4);
    *(LAS u32x2*)(Vb + r * TL + g32 + p0) = (u32x2){vr.x, vr.y}; *(LAS u32x2*)(Vb + r * TL + g32 + p1) = (u32x2){vr.z, vr.w};
}
DI void tile_scores(const LAS bf16* Kb, const bf16x8 (&qf)[2], int l15, int q, f32x4 (&sc)[4]) {
#pragma unroll
    for (int x = 0; x < 4; ++x) { sc[x] = (f32x4){0.f, 0.f, 0.f, 0.f};
#pragma unroll
        for (int ks = 0; ks < 2; ++ks) { const bf16x8 a = *(const LAS bf16x8*)(Kb + (16 * x + l15) * TL + 32 * ks + 8 * q); sc[x] = MFMA16(a, qf[ks], sc[x]); } }
}
DI void tile_pv(const LAS bf16* Vb, const float (&p)[16], f32x4 (&acc)[4], int l15, int q) {
#pragma unroll
    for (int k2 = 0; k2 < 2; ++k2) {
        u32x4 pw; pw.x = pk2(p[8 * k2], p[8 * k2 + 1]); pw.y = pk2(p[8 * k2 + 2], p[8 * k2 + 3]); pw.z = pk2(p[8 * k2 + 4], p[8 * k2 + 5]); pw.w = pk2(p[8 * k2 + 6], p[8 * k2 + 7]);
        const bf16x8 pf = __builtin_bit_cast(bf16x8, pw);
#pragma unroll
        for (int dt = 0; dt < 4; ++dt) { const bf16x8 av = *(const LAS bf16x8*)(Vb + (16 * dt + l15) * TL + 32 * k2 + 8 * q); acc[dt] = MFMA16(av, pf, acc[dt]); }
    }
}
template <bool MASKED, int KS>
DI float tile_logits(const f32x4 (&sc)[4], float (&s)[16], int d0, float slope2, unsigned lim, bool extra) {
    const float A = -slope2 * (float)d0; float mx = -INFINITY;
#pragma unroll
    for (int e = 0; e < 16; ++e) { const int ke = KS * (16 * (e >> 2) + (e & 3)); float v = sc[e >> 2][e & 3] * C1 + (A + slope2 * (float)ke);
        if (MASKED) { const bool valid = extra && ((unsigned)(d0 - ke) < lim); v = valid ? v : -INFINITY; }
        s[e] = v; mx = fmaxf(mx, v); }
    mx = fmaxf(mx, __shfl_xor(mx, 16)); mx = fmaxf(mx, __shfl_xor(mx, 32));
    return mx;
}
template <bool MASKED>
DI void tile_step(const LAS bf16* Kb, const LAS bf16* Vb, const bf16x8 (&qf)[2], f32x4 (&acc)[4], float& m, float& lp, int d0, float slope2, unsigned lim, bool extra, int l15, int q) {
    f32x4 sc[4]; tile_scores(Kb, qf, l15, q, sc);
    float s[16]; const float mx = tile_logits<MASKED, 1>(sc, s, d0, slope2, lim, extra);
    const float mn = fmaxf(m, mx), alpha = ex2(m - mn); m = mn;
    float ps = 0.f;
#pragma unroll
    for (int e = 0; e < 16; ++e) { s[e] = ex2(s[e] - mn); ps += s[e]; }
    lp = lp * alpha + ps;
#pragma unroll
    for (int dt = 0; dt < 4; ++dt) { acc[dt][0] *= alpha; acc[dt][1] *= alpha; acc[dt][2] *= alpha; acc[dt][3] *= alpha; }
    tile_pv(Vb, s, acc, l15, q);
}
DI void nsa_attn_phase(const bf16* Y1, const bf16* KCMP, const bf16* VCMPT, const bf16* VST, const bf16* VWT, bf16* MIX, LAS unsigned char* lds) {
    LAS bf16* KB0 = (LAS bf16*)lds;
    LAS bf16* VB0 = KB0 + 2 * 64 * TL;
    LAS float* slab = (LAS float*)(lds + 4 * 64 * TL * 2);
    LAS float* pslc = slab + 8 * 16 * SLAB_LD;
    LAS unsigned* selm = (LAS unsigned*)(pslc + 16 * 128);
    LAS unsigned* uni = selm + 64;
    LAS unsigned* blist = uni + 4;
    const int tid = threadIdx.x, lane = tid & 63, w = tid >> 6, l15 = lane & 15, q = lane >> 4;
    LAS float* myslab = slab + w * 16 * SLAB_LD;
#define KBUF(i) (KB0 + ((i) & 1) * 64 * TL)
#define VBUF(i) (VB0 + ((i) & 1) * 64 * TL)
    for (int u = blockIdx.x; u < NB * 2 * (T / 16); u += gridDim.x) {
        const int b = u & 3, g = (u >> 2) & 1, tile = u >> 3, t0 = tile * 16, qblk = t0 >> 6;
        const int h = g * 8 + w; const float slope = exp2f(-0.5f * (float)(h + 1)), slope2 = slope * LOG2E;
        const int t = t0 + l15; const size_t row = (size_t)b * T + t;
        bf16x8 qf[2];
        qf[0] = *(const bf16x8*)(Y1 + row * OINP + h * 64 + 8 * q); qf[1] = *(const bf16x8*)(Y1 + row * OINP + h * 64 + 32 + 8 * q);
        const bf16* gl = Y1 + row * OINP + 1792 + h * 3;
        const float g0 = sigmoidf_(bf2f(gl[0])), g1 = sigmoidf_(bf2f(gl[1])), g2 = sigmoidf_(bf2f(gl[2]));
        for (int i = lane; i < 16 * SLAB_LD / 4; i += 64) ((LAS f32x4*)myslab)[i] = (f32x4){0.f, 0.f, 0.f, 0.f};
        f32x4 ot[4];
        u32x4 kr, vr, kr2, vr2;
        {
            const bf16* kc = KCMP + (size_t)(b * 2 + g) * NCP * 64; const bf16* vct = VCMPT + (size_t)(b * 2 + g) * 64 * NCP;
            const int nst = tile >= 1 ? ((tile - 1) >> 6) + 1 : 0;
            const int dc = t - 31 - 64 * q;
            float m = -1e30f, lp = 0.f;
            f32x4 acc[4];
#pragma unroll
            for (int dt = 0; dt < 4; ++dt) acc[dt] = (f32x4){0.f, 0.f, 0.f, 0.f};
            float inv = 0.f;
            for (int pass = 0; pass < 2; ++pass) {
#define CMP_FETCH(idx, KR, VR) { const int i_ = (idx) < nst ? (idx) : nst - 1; tile_fetch(kc + (size_t)(64 * i_) * 64, 64, vct + 64 * i_, NCP, tid, KR, VR); }
#define CMP_COMPUTE(s, KB, VB) { \
                    f32x4 sc[4]; tile_scores(KB, qf, l15, q, sc); \
                    float sv[16]; float mx; \
                    const int d0 = dc - 1024 * (s); \
                    if (64 * (s) + 63 <= tile - 2) mx = tile_logits<false, 16>(sc, sv, d0, slope2, 0x7fffffffu, true); \
                    else mx = tile_logits<true, 16>(sc, sv, d0, slope2, 0x7fffffffu, true); \
                    if (pass == 0) { \
                        const float mn = fmaxf(m, mx); float ps = 0.f; \
                        _Pragma("unroll") for (int e = 0; e < 16; ++e) ps += ex2(sv[e] - mn); \
                        lp = lp * ex2(m - mn) + ps; m = mn; \
                    } else { \
                        _Pragma("unroll") for (int e = 0; e < 16; ++e) sv[e] = ex2(sv[e] - m) * inv; \
                        _Pragma("unroll") for (int x = 0; x < 4; ++x) { const int j = 16 * (s) + 4 * x + q; \
                            __hip_atomic_fetch_add(&myslab[l15 * SLAB_LD + j], (sv[4 * x] + sv[4 * x + 1]) + (sv[4 * x + 2] + 0.5f * sv[4 * x + 3]), __ATOMIC_RELAXED, __HIP_MEMORY_SCOPE_WORKGROUP); \
                            __hip_atomic_fetch_add(&myslab[l15 * SLAB_LD + j + 1], 0.5f * sv[4 * x + 3], __ATOMIC_RELAXED, __HIP_MEMORY_SCOPE_WORKGROUP); } \
                        tile_pv(VB, sv, acc, l15, q); \
                    } }
                if (nst > 0) {
                    CMP_FETCH(0, kr, vr) tile_store(KBUF(0), VBUF(0), tid, kr, vr); CMP_FETCH(1, kr, vr)
                    LDS_BAR();
                    int s = 0;
                    for (; s + 1 < nst; s += 2) {
                        CMP_FETCH(s + 2, kr2, vr2) CMP_COMPUTE(s, KBUF(0), VBUF(0)) tile_store(KBUF(1), VBUF(1), tid, kr, vr); LDS_BAR();
                        CMP_FETCH(s + 3, kr, vr) CMP_COMPUTE(s + 1, KBUF(1), VBUF(1)) tile_store(KBUF(0), VBUF(0), tid, kr2, vr2); LDS_BAR();
                    }
                    if (s < nst) { CMP_COMPUTE(s, KBUF(0), VBUF(0)) LDS_BAR(); }
                }
#undef CMP_FETCH
#undef CMP_COMPUTE
                if (pass == 0) { float l = lp; l += __shfl_xor(l, 16); l += __shfl_xor(l, 32); inv = l > 0.f ? 1.0f / l : 0.f; }
            }
#pragma unroll
            for (int dt = 0; dt < 4; ++dt) { ot[dt][0] = g0 * acc[dt][0]; ot[dt][1] = g0 * acc[dt][1]; ot[dt][2] = g0 * acc[dt][2]; ot[dt][3] = g0 * acc[dt][3]; }
        }
        LDS_BAR();
#pragma unroll 1
        for (int tt = 0; tt < 2; ++tt) {
            const int tok = 2 * w + tt;
            float s0 = 0.f, s1 = 0.f;
#pragma unroll
            for (int ww = 0; ww < 8; ++ww) { s0 += slab[(ww * 16 + tok) * SLAB_LD + lane]; s1 += slab[(ww * 16 + tok) * SLAB_LD + lane + 64]; }
            const int j0 = lane, j1 = lane + 64;
            const bool v0 = j0 <= qblk, v1 = j1 <= qblk;
            const bool f0 = (j0 == 0) || (j0 == qblk) || (j0 == qblk - 1), f1 = (j1 == qblk) || (j1 == qblk - 1);
            const unsigned k0 = f0 ? 0x7f000000u : __float_as_uint(s0), k1 = f1 ? 0x7f000000u : __float_as_uint(s1);
            unsigned Tk = 0u;
#pragma unroll 1
            for (int bit = 30; bit >= 0; --bit) { const unsigned trial = Tk | (1u << bit);
                const int c = __popcll(__ballot(v0 && k0 >= trial)) + __popcll(__ballot(v1 && k1 >= trial)); if (c >= 16) Tk = trial; }
            const bool gt0 = v0 && k0 > Tk, gt1 = v1 && k1 > Tk, eq0 = v0 && k0 == Tk, eq1 = v1 && k1 == Tk;
            const unsigned long long mq0 = __ballot(eq0), mq1 = __ballot(eq1);
            const int need = 16 - (__popcll(__ballot(gt0)) + __popcll(__ballot(gt1)));
            const unsigned long long lt = (1ull << lane) - 1ull;
            const int r0 = __popcll(mq0 & lt), r1 = __popcll(mq0) + __popcll(mq1 & lt);
            const unsigned long long m0 = __ballot(gt0 || (eq0 && r0 < need)), m1 = __ballot(gt1 || (eq1 && r1 < need));
            if (lane == 0) { selm[tok * 4 + 0] = (unsigned)m0; selm[tok * 4 + 1] = (unsigned)(m0 >> 32); selm[tok * 4 + 2] = (unsigned)m1; selm[tok * 4 + 3] = (unsigned)(m1 >> 32); }
        }
        LDS_BAR();
        unsigned om = selm[lane], am = om;
        om |= __shfl_xor(om, 4); om |= __shfl_xor(om, 8); om |= __shfl_xor(om, 16); om |= __shfl_xor(om, 32);
        am &= __shfl_xor(am, 4); am &= __shfl_xor(am, 8); am &= __shfl_xor(am, 16); am &= __shfl_xor(am, 32);
        const unsigned u0 = __builtin_amdgcn_readlane(om, 0), u1 = __builtin_amdgcn_readlane(om, 1), u2 = __builtin_amdgcn_readlane(om, 2), u3 = __builtin_amdgcn_readlane(om, 3);
        const unsigned am0 = __builtin_amdgcn_readlane(am, 0), am1 = __builtin_amdgcn_readlane(am, 1), am2 = __builtin_amdgcn_readlane(am, 2), am3 = __builtin_amdgcn_readlane(am, 3);
        if (tid < 128) { const int wd = tid >> 5, bt = tid & 31;
            const unsigned uw = wd == 0 ? u0 : wd == 1 ? u1 : wd == 2 ? u2 : u3;
            if ((uw >> bt) & 1u) { const int pos = (wd > 0 ? __popc(u0) : 0) + (wd > 1 ? __popc(u1) : 0) + (wd > 2 ? __popc(u2) : 0) + __popc(uw & ((1u << bt) - 1u)); blist[pos] = (unsigned)tid; } }
        const int nsel = __popc(u0) + __popc(u1) + __popc(u2) + __popc(u3);
        LDS_BAR();
        {
            const bf16* kb = Y1 + (size_t)b * T * OINP + 1280 + g * 64; const bf16* vt = VST + (size_t)(b * 2 + g) * 64 * T;
            float m = -1e30f, lp = 0.f; f32x4 acc[4];
#pragma unroll
            for (int dt = 0; dt < 4; ++dt) acc[dt] = (f32x4){0.f, 0.f, 0.f, 0.f};
#define SEL_FETCH(idx, KR, VR) { const int i_ = (idx) < nsel ? (idx) : nsel - 1; const int j_ = (int)__builtin_amdgcn_readfirstlane((int)blist[i_]); tile_fetch(kb + (size_t)(64 * j_) * OINP, OINP, vt + 64 * j_, T, tid, KR, VR); }
#define SEL_COMPUTE(i, KB, VB) { \
                const int j = (int)__builtin_amdgcn_readfirstlane((int)blist[i]); \
                const int wd = j >> 5; const unsigned aw = wd == 0 ? am0 : wd == 1 ? am1 : wd == 2 ? am2 : am3; \
                const int d0 = t - 64 * j - 4 * q; \
                if (((aw >> (j & 31)) & 1u) && j < qblk) tile_step<false>(KB, VB, qf, acc, m, lp, d0, slope2, 0x7fffffffu, true, l15, q); \
                else { const bool selb = (selm[l15 * 4 + wd] >> (j & 31)) & 1u; tile_step<true>(KB, VB, qf, acc, m, lp, d0, slope2, 0x7fffffffu, selb, l15, q); } }
            {
                SEL_FETCH(0, kr, vr) tile_store(KBUF(0), VBUF(0), tid, kr, vr); SEL_FETCH(1, kr, vr)
                LDS_BAR();
                int i = 0;
                for (; i + 1 < nsel; i += 2) {
                    SEL_FETCH(i + 2, kr2, vr2) SEL_COMPUTE(i, KBUF(0), VBUF(0)) tile_store(KBUF(1), VBUF(1), tid, kr, vr); LDS_BAR();
                    SEL_FETCH(i + 3, kr, vr) SEL_COMPUTE(i + 1, KBUF(1), VBUF(1)) tile_store(KBUF(0), VBUF(0), tid, kr2, vr2); LDS_BAR();
                }
                if (i < nsel) { SEL_COMPUTE(i, KBUF(0), VBUF(0)) LDS_BAR(); }
            }
#undef SEL_FETCH
#undef SEL_COMPUTE
            float l = lp; l += __shfl_xor(l, 16); l += __shfl_xor(l, 32);
            const float sc = l > 0.f ? g1 / l : 0.f;
#pragma unroll
            for (int dt = 0; dt < 4; ++dt) { ot[dt][0] += sc * acc[dt][0]; ot[dt][1] += sc * acc[dt][1]; ot[dt][2] += sc * acc[dt][2]; ot[dt][3] += sc * acc[dt][3]; }
        }
        {
            const bf16* kb = Y1 + (size_t)b * T * OINP + 1536 + g * 64; const bf16* vt = VWT + (size_t)(b * 2 + g) * 64 * T;
            float m = -1e30f, lp = 0.f; f32x4 acc[4];
#pragma unroll
            for (int dt = 0; dt < 4; ++dt) acc[dt] = (f32x4){0.f, 0.f, 0.f, 0.f};
            int kstart = t0 - 511; kstart = kstart < 0 ? 0 : (kstart & ~63);
            const int nw = ((t0 + 15 - kstart) >> 6) + 1;
#define WIN_FETCH(idx, KR, VR) { const int i_ = (idx) < nw ? (idx) : nw - 1; const int k_ = kstart + 64 * i_; tile_fetch(kb + (size_t)k_ * OINP, OINP, vt + k_, T, tid, KR, VR); }
#define WIN_COMPUTE(i, KB, VB) { \
                const int key0 = kstart + 64 * (i); \
                const int d0 = t - key0 - 4 * q; \
                if (key0 + 63 <= t0 && key0 >= t0 - 496) tile_step<false>(KB, VB, qf, acc, m, lp, d0, slope2, 512u, true, l15, q); \
                else tile_step<true>(KB, VB, qf, acc, m, lp, d0, slope2, 512u, true, l15, q); }
            {
                WIN_FETCH(0, kr, vr) tile_store(KBUF(0), VBUF(0), tid, kr, vr); WIN_FETCH(1, kr, vr)
                LDS_BAR();
                int i = 0;
                for (; i + 1 < nw; i += 2) {
                    WIN_FETCH(i + 2, kr2, vr2) WIN_COMPUTE(i, KBUF(0), VBUF(0)) tile_store(KBUF(1), VBUF(1), tid, kr, vr); LDS_BAR();
                    WIN_FETCH(i + 3, kr, vr) WIN_COMPUTE(i + 1, KBUF(1), VBUF(1)) tile_store(KBUF(0), VBUF(0), tid, kr2, vr2); LDS_BAR();
                }
                if (i < nw) { WIN_COMPUTE(i, KBUF(0), VBUF(0)) LDS_BAR(); }
            }
#undef WIN_FETCH
#undef WIN_COMPUTE
            float l = lp; l += __shfl_xor(l, 16); l += __shfl_xor(l, 32);
            const float sc = l > 0.f ? g2 / l : 0.f;
#pragma unroll
            for (int dt = 0; dt < 4; ++dt) { ot[dt][0] += sc * acc[dt][0]; ot[dt][1] += sc * acc[dt][1]; ot[dt][2] += sc * acc[dt][2]; ot[dt][3] += sc * acc[dt][3]; }
        }
        bf16* op = MIX + row * D + h * 64 + 4 * q;
#pragma unroll
        for (int dt = 0; dt < 4; ++dt) { u32x2 ow; ow.x = pk2(ot[dt][0], ot[dt][1]); ow.y = pk2(ot[dt][2], ot[dt][3]); *(u32x2*)(op + 16 * dt) = ow; }
    }
#undef KBUF
#undef VBUF
}
struct Args { const float* in[19]; float* out; unsigned char* ws; int ph_lo, ph_hi; };
constexpr int N_PHASES = 18;
template <class Epi>
DI void run_gemm(LAS unsigned char* lds, const bf16* A, const bf16* Bt, int N, int K, const Epi& E) {
    pg8::Gemm g{A, Bt, M, N, K}; pg8::StaticOrder S; S.init(M, N, (int)gridDim.x, (int)blockIdx.x);
    pg8::gemm_phase<Epi, pg8::StaticOrder, true, true>(lds, g, S, E);
}
__global__ void __launch_bounds__(512, 2) mega(Args a) {
    extern __shared__ __attribute__((aligned(16))) unsigned char lds_raw[];
    LAS unsigned char* lds = (LAS unsigned char*)lds_raw;
    cg::grid_group grid = cg::this_grid();
    volatile LAS unsigned* bst = (volatile LAS unsigned*)(lds + 147456 - 64);
    if (threadIdx.x < 2) bst[threadIdx.x] = 0u;
    __syncthreads();
    XcdBarrier xbar = xcd_barrier_post((unsigned*)(a.ws + WS_CTL), bst);
    const int tid = threadIdx.x, lane = tid & 63, wave = __builtin_amdgcn_readfirstlane(tid >> 6);
    const int gw = blockIdx.x * 8 + wave, ngw = gridDim.x * 8;
#define WSP(off) ((bf16*)(a.ws + (off)))
#define W_EIN WSP(WS_EIN)
#define W_EOUT WSP(WS_EOUT)
#define W_OIN WSP(WS_OIN)
#define W_OOUT WSP(WS_OOUT)
#define W_GU WSP(WS_GU)
#define W_DN WSP(WS_DN)
#define W1K WSP(WS_W1K)
#define W1V WSP(WS_W1V)
#define W2K WSP(WS_W2K)
#define W2V WSP(WS_W2V)
#define DEC ((float*)(a.ws + WS_DEC))
#define KCMP WSP(WS_KCMP)
#define VCMPT WSP(WS_VCMPT)
#define Y WSP(WS_Y)
#define VST WSP(WS_VST)
#define VWT WSP(WS_VWT)
#define HN WSP(WS_HN)
#define ST WSP(WS_ST)
#define RS ((float*)(a.ws + WS_RS))
#define HB WSP(WS_HB)
    const int lo = a.ph_lo, hi = a.ph_hi;
#define PH(k) if (lo <= (k) && (k) < hi)
#define SEAM(k) if (lo <= (k) && (k) + 1 < hi && hi > 0) { if ((k) == 0) grid.sync(); else xcd_barrier(xbar); }
    PH(0) {
        LAS float* scr = (LAS float*)(lds + wave * 8448);
        constexpr int I0 = 2048, I1 = 512, I2 = 1024, I3 = 512, I4 = 2816, I5 = 1408, I6 = 64, I7 = 2;
        constexpr int NIT = I0 + I1 + I2 + I3 + 2 * I4 + 2 * I5 + 2 * I6 + 2 * I7;
        for (int it = gw; it < NIT; it += ngw) {
            int r = it;
            if (r < I0) { transpose_item(a.in[4], 1024, EIN, EIN, W_EIN, 0, scr, r, lane); continue; } r -= I0;
            if (r < I1) { transpose_item(a.in[8], 1024, 1024, 1024, W_EOUT, 0, scr, r, lane); continue; } r -= I1;
            if (r < I2) { transpose_item(a.in[9], 1024, OIN, OINP, W_OIN, 0, scr, r, lane, a.in[1] + D); continue; } r -= I2;
            if (r < I3) { transpose_item(a.in[16], 1024, 1024, 1024, W_OOUT, 0, scr, r, lane); continue; } r -= I3;
            if (r < 2 * I4) { const int l = r / I4; transpose_item(a.in[17] + (size_t)l * D * 2 * FF, 1024, 2 * FF, 2 * FF, W_GU + (size_t)l * GU_STRIDE, 1, scr, r % I4, lane, a.in[2] + l * D); continue; } r -= 2 * I4;
            if (r < 2 * I5) { const int l = r / I5; transpose_item(a.in[18] + (size_t)l * FF * D, FF, 1024, 1024, W_DN + (size_t)l * DN_STRIDE, 0, scr, r % I5, lane); continue; } r -= 2 * I5;
            if (r < I6) { transpose_item(a.in[12], 2048, 64, 64, W1K, 0, scr, r, lane); continue; } r -= I6;
            if (r < I6) { transpose_item(a.in[14], 2048, 64, 64, W1V, 0, scr, r, lane); continue; } r -= I6;
            if (r < I7) { transpose_item(a.in[13], 64, 64, 64, W2K, 0, scr, r, lane); continue; } r -= I7;
            transpose_item(a.in[15], 64, 64, 64, W2V, 0, scr, r, lane);
        }
        norm_rows_bf16(a.in[0], a.in[1], HN, gw, ngw, lane);
    }
    SEAM(0);
    PH(1) { EpiStore E{Y, EIN, nullptr}; run_gemm(lds, HN, W_EIN, EIN, 1024, E); }
    SEAM(1);
    PH(2) { la_state_phase(Y, a.in[5], ST, DEC, lds); }
    SEAM(2);
    PH(3) { la_scan_phase(ST, DEC); }
    SEAM(3);
    PH(4) { la_out_phase(Y, a.in[5], ST, a.in[6], a.in[7], HN, lds); }
    SEAM(4);
    PH(5) { EpiResid E{a.in[0], a.out, HB, RS}; run_gemm(lds, HN, W_EOUT, 1024, 1024, E); }
    SEAM(5);
    PH(7) { EpiSwiglu E{Y, RS}; run_gemm(lds, HB, W_GU, 2 * FF, 1024, E); }
    SEAM(7);
    PH(8) { EpiResid E{a.out, a.out, HB, RS + 16 * M}; run_gemm(lds, Y, W_DN, 1024, FF, E); }
    SEAM(8);
    PH(10) { EpiStore E{Y, OINP, RS + 16 * M}; run_gemm(lds, HB, W_OIN, OINP, 1024, E); }
    SEAM(10);
    PH(11) { nsa_compress_phase(Y, a.in[10], a.in[11], W1K, W1V, W2K, W2V, KCMP, VCMPT, gw, ngw, lane); nsa_vt_phase(Y, VST, VWT, gw, ngw, lane); }
    SEAM(11);
    PH(12) { nsa_attn_phase(Y, KCMP, VCMPT, VST, VWT, HN, lds); }
    SEAM(12);
    PH(13) { EpiResid E{a.out, a.out, HB, RS + 32 * M}; run_gemm(lds, HN, W_OOUT, 1024, 1024, E); }
    SEAM(13);
    PH(15) { EpiSwiglu E{Y, RS + 32 * M}; run_gemm(lds, HB, W_GU + GU_STRIDE, 2 * FF, 1024, E); }
    SEAM(15);
    PH(16) { EpiResid E{a.out, a.out, nullptr, nullptr}; run_gemm(lds, Y, W_DN + DN_STRIDE, 1024, FF, E); }
    SEAM(16);
    PH(17) { norm_rows_f32_inplace(a.out, a.in[3], gw, ngw, lane); }
#undef PH
#undef SEAM
}

extern "C" void kernel_launch(void* const* d_in, const int* in_sizes, int n_in, void* d_out, int out_size, void* d_ws, size_t ws_size, hipStream_t stream) {
    static int grid = 0;
    if (grid == 0) {
        if (n_in != 19 || in_sizes[0] != M * D || out_size != M * D || ws_size < WS_END) { fprintf(stderr, "kernel_launch: unexpected shapes (n_in %d, in0 %d, out %d, ws %zu)\n", n_in, n_in > 0 ? in_sizes[0] : -1, out_size, ws_size); grid = -1; return; }
        int dev = 0, cus = 0, per_cu = 0;
        (void)hipGetDevice(&dev); (void)hipDeviceGetAttribute(&cus, hipDeviceAttributeMultiprocessorCount, dev);
        if (hipFuncSetAttribute((const void*)mega, hipFuncAttributeMaxDynamicSharedMemorySize, LDS_BYTES) != hipSuccess) { fprintf(stderr, "kernel_launch: hipFuncSetAttribute failed\n"); grid = -1; return; }
        if (hipOccupancyMaxActiveBlocksPerMultiprocessor(&per_cu, (const void*)mega, 512, LDS_BYTES) != hipSuccess || per_cu < 1) { fprintf(stderr, "kernel_launch: occupancy query says %d\n", per_cu); per_cu = 1; }
        (void)hipGetLastError();
        grid = cus * 1;
    }
    if (grid < 0) return;
    if (hipMemsetAsync((char*)d_ws + WS_CTL, 0, CTL_BYTES, stream) != hipSuccess) { fprintf(stderr, "kernel_launch: memset failed\n"); return; }
    Args a{};
    for (int i = 0; i < 19; ++i) a.in[i] = (const float*)d_in[i];
    a.out = (float*)d_out; a.ws = (unsigned char*)d_ws; a.ph_lo = 0; a.ph_hi = N_PHASES;
    void* args[] = {&a};
    hipError_t e = hipLaunchCooperativeKernel((const void*)mega, dim3(grid), dim3(512), args, LDS_BYTES, stream);
    if (e != hipSuccess) fprintf(stderr, "kernel_launch: cooperative launch failed: %s (grid %d)\n", hipGetErrorString(e), grid);
#ifdef PROBE_PHASES
    { const int pp[] = {PROBE_PHASES};
      for (unsigned i = 0; i < sizeof(pp) / sizeof(pp[0]); ++i) { a.ph_lo = pp[i]; a.ph_hi = pp[i] + 1; (void)hipLaunchCooperativeKernel((const void*)mega, dim3(grid), dim3(512), args, LDS_BYTES, stream); } }
#endif
}
```

```cpp
#include <hip/hip_runtime.h>
#include <hip/hip_cooperative_groups.h>
#include <cstdio>
#include <cstdint>
namespace cg = cooperative_groups;
namespace pg8 {
#define PG8_LAS __attribute__((address_space(3)))
typedef unsigned short bf16_t;
typedef short bf16x8 __attribute__((ext_vector_type(8)));
typedef float f32x4 __attribute__((ext_vector_type(4)));
typedef unsigned u32x4 __attribute__((ext_vector_type(4)));
constexpr int BM = 256, BK = 64, HALF = 128, HTB = HALF * BK * 2  , STAGE_BYTES = 8 * HTB, NXCD = 8, WGM = 8;

__host__ __device__ __forceinline__ int lds_byte(int r, int c) { const int st = (r >> 4) * 2 + (c >> 5), rr = r & 15, cc = c & 31, ob = rr * 64 + cc * 2; return st * 1024 + (ob ^ (((ob >> 9) & 1) << 5)); }
__host__ __device__ __forceinline__ void stage_rc(int b, int& R, int& C) { const int st = b / 1024, sb = b % 1024, swz = sb ^ (((sb >> 9) & 1) << 5); R = (st >> 1) * 16 + swz / 64; C = (st & 1) * 32 + (swz % 64) / 2; }
__host__ __device__ __forceinline__ int perm32(int rho) { const int n = rho >> 4, i = rho & 15; return 8 * (i >> 2) + 4 * n + (i & 3); }

struct Unit { int pm, pn; };
struct Gemm { const bf16_t* A; const bf16_t* Bt; int M, N, K; };

struct StaticOrder {
    int nM, nN, nwg, G, c;
    __host__ __device__ void init(int M, int N, int G_, int c_) { nM = M / BM; nN = N / BM; nwg = nM * nN; G = G_; c = c_; }
    __host__ __device__ bool next(int i, Unit& u) const {
        const long L = (long)i * G + c; if (L >= nwg) return false;
        int wgid = (int)L; { const int q = nwg / NXCD, r = nwg % NXCD, xcd = wgid % NXCD, off = wgid / NXCD; wgid = (xcd < r ? xcd * (q + 1) : r * (q + 1) + (xcd - r) * q) + off; }
        const int nig = WGM * nN, gid = wgid / nig, fm = gid * WGM, gsz = (nM - fm) < WGM ? (nM - fm) : WGM;
        u.pm = fm + ((wgid % nig) % gsz); u.pn = (wgid % nig) / gsz; return true;
    }
    __device__ __forceinline__ void a_ready(const Unit&) const {}
    __device__ __forceinline__ void done(const Unit&) const {}
};

__device__ __forceinline__ unsigned cvt_pk_bf16(float lo, float hi) { unsigned r; asm volatile("v_cvt_pk_bf16_f32 %0, %1, %2" : "=v"(r) : "v"(lo), "v"(hi)); return r; }
template <class Epi, class Sched, bool ALIGN_EPI = false, bool SP2 = false>
__device__ __forceinline__ void gemm_phase(PG8_LAS unsigned char* lds, const Gemm g, const Sched& S, const Epi& E) {
    const int tid = threadIdx.x, wid = __builtin_amdgcn_readfirstlane(tid >> 6), lane = tid & 63, wr = wid >> 2, wc = wid & 3, fr = lane & 15, fq = lane >> 4;
    const int K = g.K, nt = K / BK;
    unsigned voffA[2], voffB[2];
#pragma unroll
    for (int i = 0; i < 2; ++i) { int R, C; stage_rc(tid * 16 + i * 8192, R, C); const int Rb = Epi::PERM ? ((R & ~31) + perm32(R & 31)) : R;
        voffA[i] = (unsigned)(R * K + C) * 2u; voffB[i] = (unsigned)(Rb * K + C) * 2u; }
    const size_t kstep = (size_t)(BK * 2);
    const size_t hstep = (size_t)HALF * K * 2;
    const size_t tstep = 2 * hstep;
    const unsigned ldsw = (unsigned)wid * 1024u;
    const int aoff = lds_byte(wr * 64 + fr, fq * 8), boff = lds_byte(wc * 32 + fr, fq * 8);
#define PG8_SA(b, h) (((b) * 2 + (h)) * HTB)
#define PG8_SB(b, h) ((4 + (b) * 2 + (h)) * HTB)
#define PG8_STAGE(bufoff, gbase, voff) do { _Pragma("unroll") for (int _i = 0; _i < 2; ++_i) \
        __builtin_amdgcn_global_load_lds((const unsigned*)((const char*)(gbase) + (voff)[_i]), (PG8_LAS unsigned*)(lds + (bufoff) + ldsw + _i * 8192), 16, 0, 0); } while (0)
#define PG8_LDA(dst, b, h) do { _Pragma("unroll") for (int m = 0; m < 4; ++m) _Pragma("unroll") for (int k = 0; k < 2; ++k) dst[m][k] = *(const PG8_LAS bf16x8*)(lds + PG8_SA(b, h) + aoff + m * 2048 + k * 1024); } while (0)
#define PG8_LDB(dst, b, h) do { _Pragma("unroll") for (int n = 0; n < 2; ++n) _Pragma("unroll") for (int k = 0; k < 2; ++k) dst[n][k] = *(const PG8_LAS bf16x8*)(lds + PG8_SB(b, h) + boff + n * 2048 + k * 1024); } while (0)
#define PG8_MMA(ai, bj, At, Bt) do { __builtin_amdgcn_s_setprio(1); _Pragma("unroll") for (int m = 0; m < 4; ++m) _Pragma("unroll") for (int n = 0; n < 2; ++n) _Pragma("unroll") for (int k = 0; k < 2; ++k) \
        acc[ai][bj][m][n] = __builtin_amdgcn_mfma_f32_16x16x32_bf16(Bt[n][k], At[m][k], acc[ai][bj][m][n], 0, 0, 0); __builtin_amdgcn_s_setprio(0); } while (0)
#define PG8_WAIT_V(n) asm volatile("s_waitcnt vmcnt(" #n ")" ::: "memory")
#define PG8_WAIT_L(n) asm volatile("s_waitcnt lgkmcnt(" #n ")" ::: "memory")
#define PG8_BAR __builtin_amdgcn_s_barrier()
#define PG8_SCHED __builtin_amdgcn_sched_barrier(0)
    Unit cur, nxt; int ui = 0;
    if (!S.next(0, cur)) return;
    f32x4 acc[2][2][4][2];
#pragma unroll
    for (int a = 0; a < 2; ++a)
#pragma unroll
        for (int b = 0; b < 2; ++b)
#pragma unroll
            for (int m = 0; m < 4; ++m)
#pragma unroll
                for (int n = 0; n < 2; ++n) acc[a][b][m][n] = (f32x4){0.f, 0.f, 0.f, 0.f};
    bf16x8 At[4][2], B0[2][2], B1[2][2];
    const char* cA = (const char*)g.A + (size_t)cur.pm * tstep; const char* cB = (const char*)g.Bt + (size_t)cur.pn * tstep;
    S.a_ready(cur);
    if constexpr (SP2) {
        PG8_STAGE(PG8_SB(0, 0), cB, voffB); PG8_STAGE(PG8_SB(0, 1), cB + hstep, voffB); PG8_STAGE(PG8_SA(0, 0), cA, voffA); PG8_STAGE(PG8_SA(0, 1), cA + hstep, voffA);
        if (wr == 1) PG8_BAR;
        PG8_WAIT_V(2); PG8_BAR;
        PG8_STAGE(PG8_SB(1, 0), cB + kstep, voffB); PG8_STAGE(PG8_SA(1, 0), cA + kstep, voffA); PG8_STAGE(PG8_SB(1, 1), cB + hstep + kstep, voffB);
        PG8_WAIT_V(6); PG8_BAR;
    } else {
        PG8_STAGE(PG8_SB(0, 0), cB, voffB); PG8_STAGE(PG8_SA(0, 0), cA, voffA); PG8_STAGE(PG8_SB(0, 1), cB + hstep, voffB); PG8_STAGE(PG8_SA(0, 1), cA + hstep, voffA);
        if (wr == 1) PG8_BAR;
        PG8_WAIT_V(4); PG8_BAR;
        PG8_STAGE(PG8_SB(1, 0), cB + kstep, voffB); PG8_STAGE(PG8_SA(1, 0), cA + kstep, voffA); PG8_STAGE(PG8_SB(1, 1), cB + hstep + kstep, voffB);
        PG8_WAIT_V(6); PG8_BAR;
    }
    for (;;) {
        const bool has_next = S.next(ui + 1, nxt);
        const char* nA = has_next ? (const char*)g.A + (size_t)nxt.pm * tstep : cA; const char* nB = has_next ? (const char*)g.Bt + (size_t)nxt.pn * tstep : cB;
        for (int t = 0; t < nt; t += 2) {
            const bool last = (t == nt - 2);
            const char* a1 = cA + (size_t)(t + 1) * kstep;
            const char* a2 = last ? nA : cA + (size_t)(t + 2) * kstep; const char* b2 = last ? nB : cB + (size_t)(t + 2) * kstep;
            const char* a3 = a2 + kstep; const char* b3 = b2 + kstep;
            if (last && has_next) S.a_ready(nxt);
            if constexpr (SP2) {
            PG8_LDB(B0, 0, 0); PG8_LDB(B1, 0, 1); PG8_SCHED; PG8_LDA(At, 0, 0); PG8_STAGE(PG8_SA(1, 1), a1 + hstep, voffA);
            PG8_WAIT_V(8); PG8_WAIT_L(0); PG8_BAR; PG8_MMA(0, 0, At, B0); PG8_MMA(0, 1, At, B1); PG8_BAR; PG8_SCHED;
            PG8_LDA(At, 0, 1); PG8_STAGE(PG8_SB(0, 0), b2, voffB); PG8_STAGE(PG8_SB(0, 1), b2 + hstep, voffB); PG8_STAGE(PG8_SA(0, 0), a2, voffA);
            PG8_WAIT_V(8); PG8_WAIT_L(0); PG8_BAR; PG8_MMA(1, 0, At, B0); PG8_MMA(1, 1, At, B1); PG8_BAR; PG8_SCHED;
            PG8_LDB(B0, 1, 0); PG8_LDB(B1, 1, 1); PG8_SCHED; PG8_LDA(At, 1, 0); PG8_STAGE(PG8_SA(0, 1), a2 + hstep, voffA);
            PG8_WAIT_V(8); PG8_WAIT_L(0); PG8_BAR; PG8_MMA(0, 0, At, B0); PG8_MMA(0, 1, At, B1); PG8_BAR; PG8_SCHED;
            PG8_LDA(At, 1, 1); PG8_STAGE(PG8_SB(1, 0), b3, voffB); PG8_STAGE(PG8_SB(1, 1), b3 + hstep, voffB); PG8_STAGE(PG8_SA(1, 0), a3, voffA);
            PG8_WAIT_V(8); PG8_WAIT_L(0); PG8_BAR; PG8_MMA(1, 0, At, B0); PG8_MMA(1, 1, At, B1); PG8_BAR; PG8_SCHED;
            } else {
            PG8_LDB(B0, 0, 0); PG8_SCHED; PG8_LDA(At, 0, 0); PG8_STAGE(PG8_SA(1, 1), a1 + hstep, voffA);
            PG8_WAIT_L(8); PG8_BAR; PG8_WAIT_L(0); PG8_MMA(0, 0, At, B0); PG8_BAR; PG8_SCHED;
            PG8_LDB(B1, 0, 1); PG8_STAGE(PG8_SB(0, 0), b2, voffB);
            PG8_BAR; PG8_WAIT_L(0); PG8_MMA(0, 1, At, B1); PG8_BAR;
            PG8_LDA(At, 0, 1); PG8_STAGE(PG8_SA(0, 0), a2, voffA);
            PG8_BAR; PG8_WAIT_L(0); PG8_MMA(1, 0, At, B0); PG8_BAR; PG8_SCHED;
            PG8_STAGE(PG8_SB(0, 1), b2 + hstep, voffB);
            PG8_WAIT_V(6); PG8_BAR; PG8_MMA(1, 1, At, B1); PG8_BAR;
            PG8_LDB(B0, 1, 0); PG8_SCHED; PG8_LDA(At, 1, 0); PG8_STAGE(PG8_SA(0, 1), a2 + hstep, voffA);
            PG8_WAIT_L(8); PG8_BAR; PG8_WAIT_L(0); PG8_MMA(0, 0, At, B0); PG8_BAR; PG8_SCHED;
            PG8_LDB(B1, 1, 1); PG8_STAGE(PG8_SB(1, 0), b3, voffB);
            PG8_BAR; PG8_WAIT_L(0); PG8_MMA(0, 1, At, B1); PG8_BAR;
            PG8_LDA(At, 1, 1); PG8_STAGE(PG8_SA(1, 0), a3, voffA);
            PG8_BAR; PG8_WAIT_L(0); PG8_MMA(1, 0, At, B0); PG8_BAR; PG8_SCHED;
            PG8_STAGE(PG8_SB(1, 1), b3 + hstep, voffB);
            PG8_WAIT_V(6); PG8_BAR; PG8_MMA(1, 1, At, B1); PG8_BAR;
            }
        }
        if constexpr (ALIGN_EPI) { if (wr == 0) PG8_BAR; }
        if constexpr (!Epi::AFTER_DRAIN) { E(acc, cur, wr, wc, fr, fq); S.done(cur); }
        if (!has_next) break;
#pragma unroll
        for (int a = 0; a < 2; ++a)
#pragma unroll
            for (int b = 0; b < 2; ++b)
#pragma unroll
                for (int m = 0; m < 4; ++m)
#pragma unroll
                    for (int n = 0; n < 2; ++n) acc[a][b][m][n] = (f32x4){0.f, 0.f, 0.f, 0.f};
        cur = nxt; cA = nA; cB = nB; ++ui;
        if constexpr (ALIGN_EPI) { if (wr == 1) PG8_BAR; }
    }
    PG8_WAIT_V(0);
    if constexpr (!ALIGN_EPI) { if (wr == 0) PG8_BAR; }
    PG8_BAR;
    if constexpr (Epi::AFTER_DRAIN) { E.fused(acc, cur, wr, wc, fr, fq, lds, wid, lane); S.done(cur); }
#undef PG8_SA
#undef PG8_SB
#undef PG8_STAGE
#undef PG8_LDA
#undef PG8_LDB
#undef PG8_MMA
#undef PG8_WAIT_V
#undef PG8_WAIT_L
#undef PG8_BAR
#undef PG8_SCHED
}
}
#define GAS __attribute__((address_space(1)))
#define LAS __attribute__((address_space(3)))
#define DI __device__ __forceinline__
typedef unsigned short bf16;
typedef short bf16x8 __attribute__((ext_vector_type(8)));
typedef short s16x4 __attribute__((ext_vector_type(4)));
typedef float f32x4 __attribute__((ext_vector_type(4)));
typedef float f32x2 __attribute__((ext_vector_type(2)));
typedef unsigned u32x4 __attribute__((ext_vector_type(4)));
typedef unsigned u32x2 __attribute__((ext_vector_type(2)));
typedef __bf16 bf16x2_t __attribute__((ext_vector_type(2)));
#define MFMA16(a, b, c) __builtin_amdgcn_mfma_f32_16x16x32_bf16((a), (b), (c), 0, 0, 0)

constexpr int NB = 4, T = 8192, D = 1024, M = NB * T, FF = 2816;
constexpr int EIN = 4096, OIN = 1840, OINP = 2048;
constexpr float RMS_EPS = 1e-6f, LOG2E = 1.4426950408889634f;
constexpr size_t MiB = 1u << 20;
constexpr size_t WS_EIN = 0, WS_EOUT = 8 * MiB, WS_OIN = 10 * MiB, WS_OOUT = 14 * MiB, WS_GU = 16 * MiB, WS_DN = 38 * MiB;
constexpr size_t WS_W1K = 49 * MiB, WS_W1V = WS_W1K + 256 * 1024, WS_W2K = WS_W1V + 256 * 1024, WS_W2V = WS_W2K + 8192;
constexpr size_t WS_CTL = 56 * MiB, CTL_BYTES = 16384, WS_RS = 57 * MiB;
constexpr size_t WS_DEC = 52 * MiB, WS_KCMP = 54 * MiB, WS_VCMPT = WS_KCMP + 512 * 1024;
constexpr size_t WS_Y = 64 * MiB;
constexpr size_t WS_VST = 192 * MiB, WS_VWT = 200 * MiB, WS_HB = 240 * MiB;
constexpr size_t WS_HN = 320 * MiB, WS_ST = 384 * MiB, WS_END = 512 * MiB;
constexpr size_t GU_STRIDE = (size_t)2 * FF * D, DN_STRIDE = (size_t)D * FF;
constexpr int LDS_BYTES = 147456;

DI unsigned pk2(float lo, float hi) { f32x2 v = {lo, hi}; return __builtin_bit_cast(unsigned, __builtin_convertvector(v, bf16x2_t)); }
DI bf16 f2bf(float f) { return (bf16)(pk2(f, 0.f) & 0xffffu); }
DI float bf2f(bf16 x) { return __uint_as_float(((unsigned)x) << 16); }
DI float bflo(unsigned w) { return __uint_as_float(w << 16); }
DI float bfhi(unsigned w) { return __uint_as_float(w & 0xffff0000u); }
DI float wave_sum(float v) {
#pragma unroll
    for (int o = 1; o < 64; o <<= 1) v += __shfl_xor(v, o);
    return v;
}
DI float ex2(float x) { return __builtin_amdgcn_exp2f(x); }
DI float sigmoidf_(float x) { return __builtin_amdgcn_rcpf(1.0f + __expf(-x)); }
DI float siluf_(float x) { return x * __builtin_amdgcn_rcpf(1.0f + __expf(-x)); }

DI float rowscale(const float* rs, int row, int fq) {
    const f32x4 p = *(const f32x4*)(rs + (size_t)row * 16 + 4 * fq);
    float s = (p.x + p.y) + (p.z + p.w); s += __shfl_xor(s, 16); s += __shfl_xor(s, 32);
    return rsqrtf(s * (1.f / D) + RMS_EPS);
}
struct EpiStore {
    static constexpr bool PERM = true, AFTER_DRAIN = false;
    bf16* O; int ldc; const float* rs;
    DI void operator()(const pg8::f32x4 (&acc)[2][2][4][2], const pg8::Unit& u, int wr, int wc, int fr, int fq) const {
        const int row0 = u.pm * 256 + wr * 64 + fr, col0 = u.pn * 256 + wc * 32 + 8 * fq;
#pragma unroll
        for (int ai = 0; ai < 2; ++ai)
#pragma unroll
            for (int m = 0; m < 4; ++m) { const int row = row0 + ai * 128 + m * 16; bf16* rowp = O + (size_t)row * ldc + col0;
                const float r = rs ? rowscale(rs, row, fq) : 1.f;
#pragma unroll
                for (int bj = 0; bj < 2; ++bj) { const pg8::f32x4 v0 = acc[ai][bj][m][0] * r, v1 = acc[ai][bj][m][1] * r;
                    u32x4 w; w.x = pk2(v0[0], v0[1]); w.y = pk2(v0[2], v0[3]); w.z = pk2(v1[0], v1[1]); w.w = pk2(v1[2], v1[3]);
                    *(u32x4*)(rowp + bj * 128) = w; } }
    }
};
struct EpiSwiglu {
    static constexpr bool PERM = true, AFTER_DRAIN = false;
    bf16* O; const float* rs;
    DI void operator()(const pg8::f32x4 (&acc)[2][2][4][2], const pg8::Unit& u, int wr, int wc, int fr, int fq) const {
        const int row0 = u.pm * 256 + wr * 64 + fr, col0 = u.pn * 128 + wc * 32 + 8 * fq;
#pragma unroll
        for (int ai = 0; ai < 2; ++ai)
#pragma unroll
            for (int m = 0; m < 4; ++m) { const int row = row0 + ai * 128 + m * 16; bf16* rowp = O + (size_t)row * FF + col0;
                const float rsc = rowscale(rs, row, fq);
                float r[8];
#pragma unroll
                for (int n = 0; n < 2; ++n)
#pragma unroll
                    for (int e = 0; e < 4; ++e) { const float g = acc[ai][0][m][n][e] * rsc, up = acc[ai][1][m][n][e] * rsc; r[n * 4 + e] = g * __builtin_amdgcn_rcpf(1.0f + __expf(-g)) * up; }
                u32x4 w; w.x = pk2(r[0], r[1]); w.y = pk2(r[2], r[3]); w.z = pk2(r[4], r[5]); w.w = pk2(r[6], r[7]);
                *(u32x4*)rowp = w; }
    }
};
struct EpiResid {
    static constexpr bool PERM = false, AFTER_DRAIN = false;
    const float* base; float* out; bf16* hb; float* rs;
    DI void operator()(const pg8::f32x4 (&acc)[2][2][4][2], const pg8::Unit& u, int wr, int wc, int fr, int fq) const {
        const int row0 = u.pm * 256 + wr * 64 + fr, col0 = u.pn * 256 + wc * 32 + 4 * fq;
#pragma unroll
        for (int ai = 0; ai < 2; ++ai)
#pragma unroll
            for (int m = 0; m < 4; ++m) { const int row = row0 + ai * 128 + m * 16; const size_t off = (size_t)row * D + col0; float ss = 0.f;
#pragma unroll
                for (int bj = 0; bj < 2; ++bj)
#pragma unroll
                    for (int n = 0; n < 2; ++n) { const f32x4 bs = *(const f32x4*)(base + off + bj * 128 + n * 16); const pg8::f32x4 a = acc[ai][bj][m][n];
                        f32x4 o; o.x = bs.x + a[0]; o.y = bs.y + a[1]; o.z = bs.z + a[2]; o.w = bs.w + a[3]; *(f32x4*)(out + off + bj * 128 + n * 16) = o;
                        if (hb) { u32x2 hw; hw.x = pk2(o.x, o.y); hw.y = pk2(o.z, o.w); *(u32x2*)(hb + off + bj * 128 + n * 16) = hw; ss += (o.x * o.x + o.y * o.y) + (o.z * o.z + o.w * o.w); } }
                if (hb) { ss += __shfl_xor(ss, 16); ss += __shfl_xor(ss, 32); if (fq == 0) rs[(size_t)row * 16 + u.pn * 4 + wc] = ss; } }
    }
};

DI void transpose_item(const float* W, int K, int N, int Npad, bf16* WT, int mode, LAS float* scr, int item, int lane, const float* gk = nullptr) {
    const int nblk = Npad / 32, kb = item / nblk, nb = item % nblk, k0 = 64 * kb, n0 = 32 * nb;
    const int nl = n0 + (lane & 31);
#pragma unroll 8
    for (int i = 0; i < 32; ++i) { const int kk = 2 * i + (lane >> 5); const float gv = gk ? gk[k0 + kk] : 1.f; scr[kk * 33 + (lane & 31)] = (nl < N) ? W[(size_t)(k0 + kk) * N + nl] * gv : 0.f; }
    asm volatile("s_waitcnt lgkmcnt(0)" ::: "memory");
    const int c = lane & 7;
    int drow0 = n0;
    if (mode == 1) { drow0 = (n0 < FF) ? (256 * (n0 >> 7) + (n0 & 127)) : (256 * ((n0 - FF) >> 7) + 128 + ((n0 - FF) & 127)); }
#pragma unroll
    for (int j = 0; j < 4; ++j) { const int n = (lane >> 3) + 8 * j; const LAS float* s = scr + (8 * c) * 33 + n;
        u32x4 o; o.x = pk2(s[0 * 33], s[1 * 33]); o.y = pk2(s[2 * 33], s[3 * 33]); o.z = pk2(s[4 * 33], s[5 * 33]); o.w = pk2(s[6 * 33], s[7 * 33]);
        *(u32x4*)(WT + (size_t)(drow0 + n) * K + k0 + 8 * c) = o; }
    asm volatile("s_waitcnt lgkmcnt(0)" ::: "memory");
}
DI void norm_rows_bf16(const float* h, const float* g, bf16* out, int gw, int ngw, int lane) {
    f32x4 gv[4];
#pragma unroll
    for (int j = 0; j < 4; ++j) gv[j] = *((const f32x4*)g + lane + 64 * j);
    for (int m = gw; m < M; m += ngw) {
        const f32x4* xr = (const f32x4*)(h + (size_t)m * D) + lane; f32x4 v[4]; float s = 0.f;
#pragma unroll
        for (int j = 0; j < 4; ++j) { v[j] = xr[64 * j]; s += (v[j].x * v[j].x + v[j].y * v[j].y) + (v[j].z * v[j].z + v[j].w * v[j].w); }
        const float r = rsqrtf(wave_sum(s) * (1.f / D) + RMS_EPS);
        u32x2* o8 = (u32x2*)(out + (size_t)m * D) + lane;
#pragma unroll
        for (int j = 0; j < 4; ++j) { u32x2 w; w.x = pk2(v[j].x * r * gv[j].x, v[j].y * r * gv[j].y); w.y = pk2(v[j].z * r * gv[j].z, v[j].w * r * gv[j].w); o8[64 * j] = w; }
    }
}
DI void norm_rows_f32_inplace(float* h, const float* g, int gw, int ngw, int lane) {
    f32x4 gv[4];
#pragma unroll
    for (int j = 0; j < 4; ++j) gv[j] = *((const f32x4*)g + lane + 64 * j);
    for (int m = gw; m < M; m += ngw) {
        f32x4* xr = (f32x4*)(h + (size_t)m * D) + lane; f32x4 v[4]; float s = 0.f;
#pragma unroll
        for (int j = 0; j < 4; ++j) { v[j] = xr[64 * j]; s += (v[j].x * v[j].x + v[j].y * v[j].y) + (v[j].z * v[j].z + v[j].w * v[j].w); }
        const float r = rsqrtf(wave_sum(s) * (1.f / D) + RMS_EPS);
#pragma unroll
        for (int j = 0; j < 4; ++j) { f32x4 o; o.x = v[j].x * r * gv[j].x; o.y = v[j].y * r * gv[j].y; o.z = v[j].z * r * gv[j].z; o.w = v[j].w * r * gv[j].w; xr[64 * j] = o; }
    }
}
typedef GAS unsigned gu32;
#define XB_TMO      128
#define XB_XCNT(j)  (256  + 64 * (j))
#define XB_XSUB(j)  (1280 + 64 * (j))
#define XB_XGEN(j)  (2304 + 64 * (j))
#define XB_TOP      3328
#define XB_TOPGEN   3392
#define XCD_BAR_WORDS 3456
#define XB_SPIN_CAP (1u << 18)

__device__ __forceinline__ unsigned xb_ld(unsigned* p)              { return __hip_atomic_load(p, __ATOMIC_RELAXED, __HIP_MEMORY_SCOPE_AGENT); }
__device__ __forceinline__ unsigned xb_add(unsigned* p, unsigned v) { return __hip_atomic_fetch_add(p, v, __ATOMIC_RELAXED, __HIP_MEMORY_SCOPE_AGENT); }
__device__ __forceinline__ unsigned xb_xcc_id() { return (unsigned)__builtin_amdgcn_s_getreg((3 << 11) | 20) & 0xFu; }
#define XB_SPIN(cond, bar) do { unsigned _sp = 0; while (cond) { __builtin_amdgcn_s_sleep(1); \
    if ((++_sp & 255u) == 0u) { if (xb_ld(&(bar)[XB_TMO])) break; if (_sp > XB_SPIN_CAP) { atomicAdd(&(bar)[XB_TMO], 1u); break; } } } } while (0)

struct XcdBarrier {
    unsigned* bar; unsigned x;
    volatile LAS unsigned* st;
};

__device__ __forceinline__ XcdBarrier xcd_barrier_post(unsigned* bar, volatile LAS unsigned* st) {
    XcdBarrier b; b.bar = bar; b.x = xb_xcc_id(); b.st = st;
    if (threadIdx.x == 0) (void)xb_add(&bar[XB_XCNT(b.x)], 1u);
    return b;
}
__device__ __forceinline__ void xcd_barrier_complete(unsigned* bar, unsigned x, unsigned& nloc, unsigned& nx) {
    const unsigned G = gridDim.x * gridDim.y * gridDim.z;
    unsigned sum, cnt, mine, sp = 0u;
    for (;;) {
        sum = 0u; cnt = 0u; mine = 0u;
#pragma unroll
        for (unsigned j = 0; j < 16; ++j) { const unsigned c = xb_ld(&bar[XB_XCNT(j)]); sum += c; cnt += (c > 0u) ? 1u : 0u; mine = (j == x) ? c : mine; }
        if (sum == G) break;
        __builtin_amdgcn_s_sleep(1);
        if ((++sp & 255u) == 0u) { if (xb_ld(&bar[XB_TMO])) break; if (sp > XB_SPIN_CAP) { atomicAdd(&bar[XB_TMO], 1u); break; } }
    }
    nloc = mine > 0u ? mine : 1u; nx = cnt > 0u ? cnt : 1u;
}

__device__ __forceinline__ void xcd_barrier(const XcdBarrier& b) {
    asm volatile("s_waitcnt vmcnt(0)" ::: "memory");
    __syncthreads();
    if (threadIdx.x == 0) {
        unsigned* bar = b.bar;
        __builtin_amdgcn_s_waitcnt(0);
        unsigned nloc = b.st[0], nx = b.st[1];
        if (nloc == 0u) { xcd_barrier_complete(bar, b.x, nloc, nx); b.st[0] = nloc; b.st[1] = nx; }
        const unsigned old = xb_add(&bar[XB_XSUB(b.x)], 1u);
        const unsigned gen = old / nloc;
        if (old + 1u == (gen + 1u) * nloc) {
            __builtin_amdgcn_fence(__ATOMIC_RELEASE, "agent");
            asm volatile("s_waitcnt vmcnt(0)" ::: "memory");
            const unsigned og = xb_add(&bar[XB_TOP], 1u);
            const unsigned tg = og / nx;
            if (og + 1u == (tg + 1u) * nx) xb_add(&bar[XB_TOPGEN], 1u);
            else XB_SPIN(xb_ld(&bar[XB_TOPGEN]) == tg, bar);
            __builtin_amdgcn_fence(__ATOMIC_ACQUIRE, "agent");
            xb_add(&bar[XB_XGEN(b.x)], 1u);
            asm volatile("s_waitcnt vmcnt(0)" ::: "memory");
        } else {
            XB_SPIN(xb_ld(&bar[XB_XGEN(b.x)]) == gen, bar);
            __builtin_amdgcn_fence(__ATOMIC_ACQUIRE, "agent");
            asm volatile("s_waitcnt vmcnt(0)" ::: "memory");
        }
    }
    __syncthreads();
}
constexpr int LA_UNITS = NB * 8 * 128;
constexpr int KT_LD = 72, QT_LD = 136;
#define LA_BAR() do { asm volatile("s_waitcnt lgkmcnt(0)" ::: "memory"); __builtin_amdgcn_s_barrier(); asm volatile("" ::: "memory"); } while (0)
struct LaRaw { unsigned f[16], qv[16], v[16]; float lba, lbb; };
template <bool WANT_Q>
DI void la_issue(const bf16* Y0, const float* lbraw, int unit, int d, int rg, LaRaw& R) {
    const int b = unit >> 10, hh = (unit >> 7) & 7, n = unit & 127;
    const bf16* Yb = Y0 + (size_t)(b * T + n * 64 + 16 * rg) * EIN + d;
    const int cf = hh < 4 ? 512 + hh * 128 : 2560 + (hh - 4) * 128;
    const int cq = hh < 4 ? hh * 128 : 2048 + (hh - 4) * 128;
    const int cv = hh < 4 ? 1024 + hh * 128 : 3072 + (hh - 4) * 128;
#pragma unroll
    for (int e = 0; e < 16; ++e) { R.f[e] = Yb[(size_t)e * EIN + cf]; if (WANT_Q) R.qv[e] = Yb[(size_t)e * EIN + cq]; R.v[e] = Yb[(size_t)e * EIN + cv]; }
    const int li = (hh & 3) * 128 + d; R.lba = lbraw[li]; R.lbb = lbraw[512 + li];
    asm volatile("" ::: "memory");
}
template <bool WANT_Q>
DI void la_math(const LaRaw& R, int hh, float (&lg)[16], float (&kk)[16], float (&qq)[16]) {
    if (hh < 4) {
        const float mx = fmaxf(R.lba, R.lbb), ea = __expf(R.lba - mx), eb = __expf(R.lbb - mx), lbv = ea / (ea + eb);
#pragma unroll
        for (int e = 0; e < 16; ++e) { const float x = bf2f((bf16)R.f[e]); const float f = lbv + (1.f - lbv) * sigmoidf_(x); lg[e] = __logf(f); kk[e] = 1.f - f;
            if (WANT_Q) qq[e] = siluf_(bf2f((bf16)R.qv[e])); }
    } else {
        const int r = hh - 4; const float lgam = __logf(1.f - exp2f(-5.f - (float)r));
#pragma unroll
        for (int e = 0; e < 16; ++e) { lg[e] = lgam; kk[e] = bf2f((bf16)R.f[e]) * 0.08838834764831845f; if (WANT_Q) qq[e] = bf2f((bf16)R.qv[e]); }
    }
    float run = 0.f;
#pragma unroll
    for (int e = 0; e < 16; ++e) { run += lg[e]; lg[e] = run; }
}
DI void la_store_vt(const LaRaw& R, int d, int rg, LAS bf16* VT) {
    LAS u32x4* dst = (LAS u32x4*)(VT + d * KT_LD + 16 * rg);
    dst[0] = (u32x4){R.v[0] | (R.v[1] << 16), R.v[2] | (R.v[3] << 16), R.v[4] | (R.v[5] << 16), R.v[6] | (R.v[7] << 16)};
    dst[1] = (u32x4){R.v[8] | (R.v[9] << 16), R.v[10] | (R.v[11] << 16), R.v[12] | (R.v[13] << 16), R.v[14] | (R.v[15] << 16)};
}
DI void la_state_phase(const bf16* Y0, const float* lbraw, bf16* ST, float* DEC, LAS unsigned char* lds) {
    LAS bf16* KT = (LAS bf16*)lds; LAS bf16* VT = KT + 128 * KT_LD; LAS float* tot = (LAS float*)(VT + 128 * KT_LD);
    const int tid = threadIdx.x, lane = tid & 63, w = tid >> 6, l15 = lane & 15, q = lane >> 4, d = tid & 127, rg = tid >> 7;
    LaRaw R;
    if ((int)blockIdx.x < LA_UNITS) la_issue<false>(Y0, lbraw, blockIdx.x, d, rg, R);
    for (int unit = blockIdx.x; unit < LA_UNITS; unit += gridDim.x) {
        const int hh = (unit >> 7) & 7;
        float lg[16], kk[16], qq[16];
        la_math<false>(R, hh, lg, kk, qq);
        tot[rg * 128 + d] = lg[15];
        la_store_vt(R, d, rg, VT);
        { const int nx = unit + (int)gridDim.x; la_issue<false>(Y0, lbraw, nx < LA_UNITS ? nx : unit, d, rg, R); }
        LA_BAR();
        float pre = 0.f, last = 0.f;
#pragma unroll
        for (int g2 = 0; g2 < 4; ++g2) { const float tv = tot[g2 * 128 + d]; if (g2 < rg) pre += tv; last += tv; }
        unsigned wv[8];
#pragma unroll
        for (int e = 0; e < 8; ++e) { const float c0 = pre + lg[2 * e], c1 = pre + lg[2 * e + 1]; wv[e] = pk2(kk[2 * e] * __expf(last - c0), kk[2 * e + 1] * __expf(last - c1)); }
        LAS u32x4* dst = (LAS u32x4*)(KT + d * KT_LD + 16 * rg);
        dst[0] = (u32x4){wv[0], wv[1], wv[2], wv[3]}; dst[1] = (u32x4){wv[4], wv[5], wv[6], wv[7]};
        if (rg == 0) DEC[(size_t)unit * 128 + d] = __expf(last);
        LA_BAR();
        f32x4 acc[8];
#pragma unroll
        for (int dt = 0; dt < 8; ++dt) acc[dt] = (f32x4){0.f, 0.f, 0.f, 0.f};
#pragma unroll
        for (int ks = 0; ks < 2; ++ks) { const bf16x8 bv = *(const LAS bf16x8*)(VT + (16 * w + l15) * KT_LD + 32 * ks + 8 * q);
#pragma unroll
            for (int dt = 0; dt < 8; ++dt) { const bf16x8 ak = *(const LAS bf16x8*)(KT + (16 * dt + l15) * KT_LD + 32 * ks + 8 * q); acc[dt] = MFMA16(ak, bv, acc[dt]); } }
        bf16* so = ST + (size_t)unit * 16384 + (16 * w + l15) * 128 + 4 * q;
#pragma unroll
        for (int dt = 0; dt < 8; ++dt) { u32x2 o; o.x = pk2(acc[dt][0], acc[dt][1]); o.y = pk2(acc[dt][2], acc[dt][3]); *(u32x2*)(so + 16 * dt) = o; }
        LA_BAR();
    }
}
DI void la_scan_phase(bf16* ST, const float* DEC) {
    const int gid = blockIdx.x * 512 + threadIdx.x, nth = gridDim.x * 512;
    for (int wk = gid; wk < 32 * 4096; wk += nth) {
        const int bh = wk >> 12, e4 = (wk & 4095) * 4, d = e4 & 127;
        f32x4 s = {0.f, 0.f, 0.f, 0.f};
        bf16* sp = ST + (size_t)bh * 128 * 16384 + e4; const float* dp = DEC + (size_t)bh * 128 * 128 + d;
        for (int n0 = 0; n0 < 128; n0 += 8) {
            u32x2 uv[8]; f32x4 dv[8];
#pragma unroll
            for (int i = 0; i < 8; ++i) { uv[i] = *(const u32x2*)(sp + (size_t)(n0 + i) * 16384); dv[i] = *(const f32x4*)(dp + (size_t)(n0 + i) * 128); }
#pragma unroll
            for (int i = 0; i < 8; ++i) { u32x2 o; o.x = pk2(s.x, s.y); o.y = pk2(s.z, s.w); *(u32x2*)(sp + (size_t)(n0 + i) * 16384) = o;
                s.x = dv[i].x * s.x + bflo(uv[i].x); s.y = dv[i].y * s.y + bfhi(uv[i].x); s.z = dv[i].z * s.z + bflo(uv[i].y); s.w = dv[i].w * s.w + bfhi(uv[i].y); }
        }
    }
}
DI void la_out_phase(const bf16* Y0, const float* lbraw, const bf16* ST, const float* gh, const float* gr, bf16* MIX, LAS unsigned char* lds) {
    LAS bf16* QT = (LAS bf16*)lds; LAS bf16* K2 = QT + 64 * QT_LD; LAS bf16* QS = K2 + 64 * QT_LD; LAS bf16* VT = QS + 64 * QT_LD;
    LAS float* tot = (LAS float*)(VT + 128 * KT_LD); LAS float* ssq = tot + 512; LAS float* gnl = ssq + 128;
    const int tid = threadIdx.x, lane = tid & 63, w = tid >> 6, l15 = lane & 15, q = lane >> 4, d = tid & 127, rg = tid >> 7;
    const int it = w & 3, vh = w >> 2;
    if (tid < 256) gnl[tid] = tid < 128 ? gh[tid] : gr[tid - 128];
    __syncthreads();
    const int irow = 16 * it + l15;
    LaRaw R;
    if ((int)blockIdx.x < LA_UNITS) la_issue<true>(Y0, lbraw, blockIdx.x, d, rg, R);
    for (int unit = blockIdx.x; unit < LA_UNITS; unit += gridDim.x) {
        const int b = unit >> 10, hh = (unit >> 7) & 7, n = unit & 127;
        const int row0 = b * T + n * 64;
        const bf16* gp = Y0 + (size_t)(row0 + irow) * EIN + (hh < 4 ? 1536 + hh * 128 : 3584 + (hh - 4) * 128) + 64 * vh + 4 * q;
        u32x2 gw[4];
#pragma unroll
        for (int vt = 0; vt < 4; ++vt) gw[vt] = *(const u32x2*)(gp + 16 * vt);
        const bf16* sb = ST + (size_t)unit * 16384;
        bf16x8 sfr[4][4];
#pragma unroll
        for (int ks = 0; ks < 4; ++ks)
#pragma unroll
            for (int vt = 0; vt < 4; ++vt) sfr[ks][vt] = *(const bf16x8*)(sb + (64 * vh + 16 * vt + l15) * 128 + 32 * ks + 8 * q);
        asm volatile("" ::: "memory");
        float lg[16], kk[16], qq[16];
        la_math<true>(R, hh, lg, kk, qq);
        tot[rg * 128 + d] = lg[15];
        la_store_vt(R, d, rg, VT);
        { const int nx = unit + (int)gridDim.x; la_issue<true>(Y0, lbraw, nx < LA_UNITS ? nx : unit, d, rg, R); }
        LA_BAR();
        float pre = 0.f;
#pragma unroll
        for (int g2 = 0; g2 < 4; ++g2) { const float tv = tot[g2 * 128 + d]; if (g2 < rg) pre += tv; }
        const float ref = tot[d] + tot[128 + d];
#pragma unroll
        for (int e = 0; e < 16; ++e) { const float c = pre + lg[e]; const int j = 16 * rg + e;
            QT[j * QT_LD + d] = f2bf(qq[e] * __expf(c - ref)); K2[j * QT_LD + d] = f2bf(kk[e] * __expf(ref - c)); QS[j * QT_LD + d] = f2bf(qq[e] * __expf(c)); }
        LA_BAR();
        f32x4 at[4];
#pragma unroll
        for (int jt = 0; jt < 4; ++jt) at[jt] = (f32x4){0.f, 0.f, 0.f, 0.f};
#pragma unroll
        for (int ks = 0; ks < 4; ++ks) { const bf16x8 bq = *(const LAS bf16x8*)(QT + (16 * it + l15) * QT_LD + 32 * ks + 8 * q);
#pragma unroll
            for (int jt = 0; jt < 4; ++jt) { const bf16x8 ak = *(const LAS bf16x8*)(K2 + (16 * jt + l15) * QT_LD + 32 * ks + 8 * q); at[jt] = MFMA16(ak, bq, at[jt]); } }
#pragma unroll
        for (int jt = 0; jt < 4; ++jt)
#pragma unroll
            for (int r = 0; r < 4; ++r) { const int j = 16 * jt + 4 * q + r; if (j > irow) at[jt][r] = 0.f; }
        f32x4 o[4];
#pragma unroll
        for (int vt = 0; vt < 4; ++vt) o[vt] = (f32x4){0.f, 0.f, 0.f, 0.f};
#pragma unroll
        for (int k2 = 0; k2 < 2; ++k2) {
            u32x4 pw; pw.x = pk2(at[2 * k2][0], at[2 * k2][1]); pw.y = pk2(at[2 * k2][2], at[2 * k2][3]); pw.z = pk2(at[2 * k2 + 1][0], at[2 * k2 + 1][1]); pw.w = pk2(at[2 * k2 + 1][2], at[2 * k2 + 1][3]);
            const bf16x8 pf = __builtin_bit_cast(bf16x8, pw);
#pragma unroll
            for (int vt = 0; vt < 4; ++vt) { const LAS bf16* vp = VT + (64 * vh + 16 * vt + l15) * KT_LD + 32 * k2 + 4 * q;
                const u32x2 lo = *(const LAS u32x2*)vp, hi = *(const LAS u32x2*)(vp + 16);
                const bf16x8 av = __builtin_bit_cast(bf16x8, ((u32x4){lo.x, lo.y, hi.x, hi.y})); o[vt] = MFMA16(av, pf, o[vt]); }
        }
#pragma unroll
        for (int ks = 0; ks < 4; ++ks) { const bf16x8 bq = *(const LAS bf16x8*)(QS + (16 * it + l15) * QT_LD + 32 * ks + 8 * q);
#pragma unroll
            for (int vt = 0; vt < 4; ++vt) o[vt] = MFMA16(sfr[ks][vt], bq, o[vt]); }
        float ss = 0.f;
#pragma unroll
        for (int vt = 0; vt < 4; ++vt) ss += (o[vt][0] * o[vt][0] + o[vt][1] * o[vt][1]) + (o[vt][2] * o[vt][2] + o[vt][3] * o[vt][3]);
        ss += __shfl_xor(ss, 16); ss += __shfl_xor(ss, 32);
        if (q == 0) ssq[vh * 64 + irow] = ss;
        LA_BAR();
        const float rs = rsqrtf((ssq[irow] + ssq[64 + irow]) * (1.f / 128.f) + RMS_EPS);
        const LAS float* gn = gnl + (hh < 4 ? 0 : 128);
        bf16* op = MIX + (size_t)(row0 + irow) * D + hh * 128;
#pragma unroll
        for (int vt = 0; vt < 4; ++vt) { const int v0 = 64 * vh + 16 * vt + 4 * q; const f32x4 gv = *(const LAS f32x4*)(gn + v0);
            u32x2 ow; ow.x = pk2(o[vt][0] * rs * gv.x * siluf_(bflo(gw[vt].x)), o[vt][1] * rs * gv.y * siluf_(bfhi(gw[vt].x)));
            ow.y = pk2(o[vt][2] * rs * gv.z * siluf_(bflo(gw[vt].y)), o[vt][3] * rs * gv.w * siluf_(bfhi(gw[vt].y))); *(u32x2*)(op + v0) = ow; }
        LA_BAR();
    }
}
constexpr int NC = 511, NCP = 512;
DI void nsa_compress_phase(const bf16* Y1, const float* posk, const float* posv, const bf16* w1kT, const bf16* w1vT, const bf16* w2kT, const bf16* w2vT,
                           bf16* KCMP, bf16* VCMPT, int gw, int ngw, int lane) {
    const int l15 = lane & 15, q = lane >> 4;
    for (int task = gw; task < 512; task += ngw) {
        const int kv = task & 1, rt = task >> 1;
        int r = rt * 16 + l15; const bool rvalid = r < NB * NC * 2; if (!rvalid) r = NB * NC * 2 - 1;
        const int b = r / (NC * 2), rem = r % (NC * 2), i = rem >> 1, g = rem & 1;
        const bf16* src = Y1 + (size_t)(b * T + 16 * i) * OINP + (kv ? 1152 : 1024) + g * 64;
        const float* pos = kv ? posv : posk; const bf16* w1 = kv ? w1vT : w1kT; const bf16* w2 = kv ? w2vT : w2kT;
        f32x4 acc[4];
#pragma unroll
        for (int nt = 0; nt < 4; ++nt) acc[nt] = (f32x4){0.f, 0.f, 0.f, 0.f};
#pragma unroll 4
        for (int ks = 0; ks < 64; ++ks) {
            const int p = ks >> 1, d0 = (ks & 1) * 32 + 8 * q;
            const u32x4 xv = *(const u32x4*)(src + (size_t)p * OINP + d0);
            const f32x4 p0 = *(const f32x4*)(pos + p * 64 + d0), p1 = *(const f32x4*)(pos + p * 64 + d0 + 4);
            u32x4 bw; bw.x = pk2(bflo(xv.x) + p0.x, bfhi(xv.x) + p0.y); bw.y = pk2(bflo(xv.y) + p0.z, bfhi(xv.y) + p0.w);
            bw.z = pk2(bflo(xv.z) + p1.x, bfhi(xv.z) + p1.y); bw.w = pk2(bflo(xv.w) + p1.z, bfhi(xv.w) + p1.w);
            const bf16x8 bf = __builtin_bit_cast(bf16x8, bw);
#pragma unroll
            for (int nt = 0; nt < 4; ++nt) { const bf16x8 af = *(const bf16x8*)(w1 + (size_t)(16 * nt + l15) * 2048 + 32 * ks + 8 * q); acc[nt] = MFMA16(af, bf, acc[nt]); }
        }
        f32x4 o2[4];
#pragma unroll
        for (int t2 = 0; t2 < 4; ++t2) o2[t2] = (f32x4){0.f, 0.f, 0.f, 0.f};
#pragma unroll
        for (int k2 = 0; k2 < 2; ++k2) {
            u32x4 pw; pw.x = pk2(siluf_(acc[2 * k2][0]), siluf_(acc[2 * k2][1])); pw.y = pk2(siluf_(acc[2 * k2][2]), siluf_(acc[2 * k2][3]));
            pw.z = pk2(siluf_(acc[2 * k2 + 1][0]), siluf_(acc[2 * k2 + 1][1])); pw.w = pk2(siluf_(acc[2 * k2 + 1][2]), siluf_(acc[2 * k2 + 1][3]));
            const bf16x8 pf = __builtin_bit_cast(bf16x8, pw);
#pragma unroll
            for (int t2 = 0; t2 < 4; ++t2) { const bf16* wp = w2 + (16 * t2 + l15) * 64 + 32 * k2 + 4 * q;
                const u32x2 lo = *(const u32x2*)wp, hi = *(const u32x2*)(wp + 16);
                const bf16x8 av = __builtin_bit_cast(bf16x8, ((u32x4){lo.x, lo.y, hi.x, hi.y})); o2[t2] = MFMA16(av, pf, o2[t2]); }
        }
        if (rvalid) {
            if (kv == 0) { bf16* op = KCMP + ((size_t)(b * 2 + g) * NCP + i) * 64 + 4 * q;
#pragma unroll
                for (int t2 = 0; t2 < 4; ++t2) { u32x2 ow; ow.x = pk2(o2[t2][0], o2[t2][1]); ow.y = pk2(o2[t2][2], o2[t2][3]); *(u32x2*)(op + 16 * t2) = ow; }
            } else { bf16* op = VCMPT + (size_t)(b * 2 + g) * 64 * NCP + i;
#pragma unroll
                for (int t2 = 0; t2 < 4; ++t2)
#pragma unroll
                    for (int r2 = 0; r2 < 4; ++r2) op[(size_t)(16 * t2 + 4 * q + r2) * NCP] = f2bf(o2[t2][r2]); }
        }
    }
    for (int z = gw * 64 + lane; z < NB * 2 * 64; z += ngw * 64) { const int bg = z >> 6, dd = z & 63; KCMP[((size_t)bg * NCP + NC) * 64 + dd] = 0; VCMPT[((size_t)bg * 64 + dd) * NCP + NC] = 0; }
}
DI void nsa_vt_phase(const bf16* Y1, bf16* VST, bf16* VWT, int gw, int ngw, int lane) {
    for (int task = gw; task < 2 * NB * 2 * 128; task += ngw) {
        const int which = task & 1, g = (task >> 1) & 1, b = (task >> 2) & 3, blk = task >> 4;
        const int t = blk * 64 + lane;
        const bf16* src = Y1 + (size_t)(b * T + t) * OINP + (which ? 1664 : 1408) + g * 64;
        bf16* dst = (which ? VWT : VST) + (size_t)(b * 2 + g) * 64 * T + t;
        u32x4 v[8];
#pragma unroll
        for (int c = 0; c < 8; ++c) v[c] = *(const u32x4*)(src + 8 * c);
#pragma unroll
        for (int c = 0; c < 8; ++c) {
            dst[(size_t)(8 * c + 0) * T] = (bf16)(v[c].x & 0xffff); dst[(size_t)(8 * c + 1) * T] = (bf16)(v[c].x >> 16);
            dst[(size_t)(8 * c + 2) * T] = (bf16)(v[c].y & 0xffff); dst[(size_t)(8 * c + 3) * T] = (bf16)(v[c].y >> 16);
            dst[(size_t)(8 * c + 4) * T] = (bf16)(v[c].z & 0xffff); dst[(size_t)(8 * c + 5) * T] = (bf16)(v[c].z >> 16);
            dst[(size_t)(8 * c + 6) * T] = (bf16)(v[c].w & 0xffff); dst[(size_t)(8 * c + 7) * T] = (bf16)(v[c].w >> 16);
        }
    }
}
#define LDS_BAR() do { asm volatile("s_waitcnt lgkmcnt(0)" ::: "memory"); __builtin_amdgcn_s_barrier(); asm volatile("" ::: "memory"); } while (0)
constexpr int TL = 80;
constexpr int SLAB_LD = 132;
constexpr float C1 = 0.125f * LOG2E;
DI void tile_fetch(const bf16* kg, int ldk, const bf16* vg, int ldv, int tid, u32x4& kr, u32x4& vr) {
    const int r = tid >> 3, c = (tid & 7) * 8;
    kr = *(const u32x4*)(kg + (size_t)r * ldk + c); vr = *(const u32x4*)(vg + (size_t)r * ldv + c);
    asm volatile("" ::: "memory");
}
DI void tile_store(LAS bf16* Kb, LAS bf16* Vb, int tid, u32x4 kr, u32x4 vr) {
    const int r = tid >> 3, c = (tid & 7) * 8;
    *(LAS u32x4*)(Kb + r * TL + c) = kr;
    const int g32 = c & 32, k0 = c & 31, k1 = k0 + 4;
    const int p0 = 8 * ((k0 & 15) >> 2) + 4 * (k0 >> 4), p1 = 8 * ((k1 & 15) >> 2) + 4 * (k1 >> 4);
    *(LAS u32x2*)(Vb + r * TL + g32 + p0) = (u32x2){vr.x, vr.y}; *(LAS u32x2*)(Vb + r * TL + g32 + p1) = (u32x2){vr.z, vr.w};
}
DI void tile_scores(const LAS bf16* Kb, const bf16x8 (&qf)[2], int l15, int q, f32x4 (&sc)[4]) {
#pragma unroll
    for (int x = 0; x < 4; ++x) { sc[x] = (f32x4){0.f, 0.f, 0.f, 0.f};
#pragma unroll
        for (int ks = 0; ks < 2; ++ks) { const bf16x8 a = *(const LAS bf16x8*)(Kb + (16 * x + l15) * TL + 32 * ks + 8 * q); sc[x] = MFMA16(a, qf[ks], sc[x]); } }
}
DI void tile_pv(const LAS bf16* Vb, const float (&p)[16], f32x4 (&acc)[4], int l15, int q) {
#pragma unroll
    for (int k2 = 0; k2 < 2; ++k2) {
        u32x4 pw; pw.x = pk2(p[8 * k2], p[8 * k2 + 1]); pw.y = pk2(p[8 * k2 + 2], p[8 * k2 + 3]); pw.z = pk2(p[8 * k2 + 4], p[8 * k2 + 5]); pw.w = pk2(p[8 * k2 + 6], p[8 * k2 + 7]);
        const bf16x8 pf = __builtin_bit_cast(bf16x8, pw);
#pragma unroll
        for (int dt = 0; dt < 4; ++dt) { const bf16x8 av = *(const LAS bf16x8*)(Vb + (16 * dt + l15) * TL + 32 * k2 + 8 * q); acc[dt] = MFMA16(av, pf, acc[dt]); }
    }
}
template <bool MASKED, int KS>
DI float tile_probs(const f32x4 (&sc)[4], float (&p)[16], int d0, float slope2, unsigned lim, bool extra) {
    const float A = -slope2 * (float)d0; f32x2 ps = {0.f, 0.f};
    const f32x2 r01 = {0.f, slope2 * (float)KS}, r23 = {slope2 * (float)(2 * KS), slope2 * (float)(3 * KS)};
#pragma unroll
    for (int x = 0; x < 4; ++x) { const float bx = slope2 * (float)(16 * KS * x) + A;
        const f32x2 s01 = {sc[x][0], sc[x][1]}, s23 = {sc[x][2], sc[x][3]};
        f32x2 v01 = s01 * C1 + (r01 + bx), v23 = s23 * C1 + (r23 + bx);
        if (MASKED) { const int kb = 16 * KS * x;
            v01.x = (extra && ((unsigned)(d0 - kb) < lim)) ? v01.x : -INFINITY; v01.y = (extra && ((unsigned)(d0 - kb - KS) < lim)) ? v01.y : -INFINITY;
            v23.x = (extra && ((unsigned)(d0 - kb - 2 * KS) < lim)) ? v23.x : -INFINITY; v23.y = (extra && ((unsigned)(d0 - kb - 3 * KS) < lim)) ? v23.y : -INFINITY; }
        f32x2 p01, p23; p01.x = ex2(v01.x); p01.y = ex2(v01.y); p23.x = ex2(v23.x); p23.y = ex2(v23.y); ps += p01; ps += p23;
        p[4 * x] = p01.x; p[4 * x + 1] = p01.y; p[4 * x + 2] = p23.x; p[4 * x + 3] = p23.y; }
    return ps.x + ps.y;
}
template <bool MASKED>
DI void tile_step(const LAS bf16* Kb, const LAS bf16* Vb, const bf16x8 (&qf)[2], f32x4 (&acc)[4], float& lp, int d0, float slope2, unsigned lim, bool extra, int l15, int q) {
    f32x4 sc[4]; tile_scores(Kb, qf, l15, q, sc);
    float p[16]; lp += tile_probs<MASKED, 1>(sc, p, d0, slope2, lim, extra);
    tile_pv(Vb, p, acc, l15, q);
}
DI void nsa_attn_phase(const bf16* Y1, const bf16* KCMP, const bf16* VCMPT, const bf16* VST, const bf16* VWT, bf16* MIX, LAS unsigned char* lds) {
    LAS bf16* KB0 = (LAS bf16*)lds;
    LAS bf16* VB0 = KB0 + 2 * 64 * TL;
    LAS float* slab = (LAS float*)(lds + 4 * 64 * TL * 2);
    LAS float* pslc = slab + 8 * 16 * SLAB_LD;
    LAS unsigned* selm = (LAS unsigned*)(pslc + 16 * 128);
    LAS unsigned* uni = selm + 64;
    LAS unsigned* blist = uni + 4;
    LAS float* invl = (LAS float*)(blist + 132);
    const int tid = threadIdx.x, lane = tid & 63, w = tid >> 6, l15 = lane & 15, q = lane >> 4;
    LAS float* myslab = slab + w * 16 * SLAB_LD;
#define KBUF(i) (KB0 + ((i) & 1) * 64 * TL)
#define VBUF(i) (VB0 + ((i) & 1) * 64 * TL)
    for (int u = blockIdx.x; u < NB * 2 * (T / 16); u += gridDim.x) {
        const int b = u & 3, g = (u >> 2) & 1, tile = u >> 3, t0 = tile * 16, qblk = t0 >> 6;
        const int h = g * 8 + w; const float slope = exp2f(-0.5f * (float)(h + 1)), slope2 = slope * LOG2E;
        const int t = t0 + l15; const size_t row = (size_t)b * T + t;
        bf16x8 qf[2];
        qf[0] = *(const bf16x8*)(Y1 + row * OINP + h * 64 + 8 * q); qf[1] = *(const bf16x8*)(Y1 + row * OINP + h * 64 + 32 + 8 * q);
        const bf16* gl = Y1 + row * OINP + 1792 + h * 3;
        const float g0 = sigmoidf_(bf2f(gl[0])), g1 = sigmoidf_(bf2f(gl[1])), g2 = sigmoidf_(bf2f(gl[2]));
        for (int i = lane; i < 16 * SLAB_LD / 4; i += 64) ((LAS f32x4*)myslab)[i] = (f32x4){0.f, 0.f, 0.f, 0.f};
        f32x4 ot[4];
        u32x4 kr, vr, kr2, vr2;
        {
            const bf16* kc = KCMP + (size_t)(b * 2 + g) * NCP * 64; const bf16* vct = VCMPT + (size_t)(b * 2 + g) * 64 * NCP;
            const int nst = tile >= 1 ? ((tile - 1) >> 6) + 1 : 0;
            const int dc = t - 31 - 64 * q;
            float lp = 0.f;
            f32x4 acc[4];
#pragma unroll
            for (int dt = 0; dt < 4; ++dt) acc[dt] = (f32x4){0.f, 0.f, 0.f, 0.f};
            float inv = 0.f;
            {
#define CMP_FETCH(idx, KR, VR) { const int i_ = (idx) < nst ? (idx) : nst - 1; tile_fetch(kc + (size_t)(64 * i_) * 64, 64, vct + 64 * i_, NCP, tid, KR, VR); }
#define CMP_COMPUTE(s, KB, VB) { \
                    f32x4 sc[4]; tile_scores(KB, qf, l15, q, sc); \
                    float sv[16]; \
                    const int d0 = dc - 1024 * (s); \
                    if (64 * (s) + 63 <= tile - 2) lp += tile_probs<false, 16>(sc, sv, d0, slope2, 0x7fffffffu, true); \
                    else lp += tile_probs<true, 16>(sc, sv, d0, slope2, 0x7fffffffu, true); \
                    _Pragma("unroll") for (int x = 0; x < 4; ++x) { const int j = 16 * (s) + 4 * x + q; \
                        __hip_atomic_fetch_add(&myslab[l15 * SLAB_LD + j], (sv[4 * x] + sv[4 * x + 1]) + (sv[4 * x + 2] + 0.5f * sv[4 * x + 3]), __ATOMIC_RELAXED, __HIP_MEMORY_SCOPE_WORKGROUP); \
                        __hip_atomic_fetch_add(&myslab[l15 * SLAB_LD + j + 1], 0.5f * sv[4 * x + 3], __ATOMIC_RELAXED, __HIP_MEMORY_SCOPE_WORKGROUP); } \
                    tile_pv(VB, sv, acc, l15, q); }
                if (nst > 0) {
                    CMP_FETCH(0, kr, vr) tile_store(KBUF(0), VBUF(0), tid, kr, vr); CMP_FETCH(1, kr, vr)
                    LDS_BAR();
                    int s = 0;
                    for (; s + 1 < nst; s += 2) {
                        CMP_FETCH(s + 2, kr2, vr2) CMP_COMPUTE(s, KBUF(0), VBUF(0)) tile_store(KBUF(1), VBUF(1), tid, kr, vr); LDS_BAR();
                        CMP_FETCH(s + 3, kr, vr) CMP_COMPUTE(s + 1, KBUF(1), VBUF(1)) tile_store(KBUF(0), VBUF(0), tid, kr2, vr2); LDS_BAR();
                    }
                    if (s < nst) { CMP_COMPUTE(s, KBUF(0), VBUF(0)) LDS_BAR(); }
                }
#undef CMP_FETCH
#undef CMP_COMPUTE
                float l = lp; l += __shfl_xor(l, 16); l += __shfl_xor(l, 32); inv = l > 0.f ? 1.0f / l : 0.f;
                if (q == 0) invl[w * 16 + l15] = inv;
            }
            const float gi = g0 * inv;
#pragma unroll
            for (int dt = 0; dt < 4; ++dt) { ot[dt][0] = gi * acc[dt][0]; ot[dt][1] = gi * acc[dt][1]; ot[dt][2] = gi * acc[dt][2]; ot[dt][3] = gi * acc[dt][3]; }
        }
        LDS_BAR();
#pragma unroll 1
        for (int tt = 0; tt < 2; ++tt) {
            const int tok = 2 * w + tt;
            float s0 = 0.f, s1 = 0.f;
#pragma unroll
            for (int ww = 0; ww < 8; ++ww) { const float il = invl[ww * 16 + tok]; s0 += slab[(ww * 16 + tok) * SLAB_LD + lane] * il; s1 += slab[(ww * 16 + tok) * SLAB_LD + lane + 64] * il; }
            const int j0 = lane, j1 = lane + 64;
            const bool v0 = j0 <= qblk, v1 = j1 <= qblk;
            const bool f0 = (j0 == 0) || (j0 == qblk) || (j0 == qblk - 1), f1 = (j1 == qblk) || (j1 == qblk - 1);
            const unsigned k0 = f0 ? 0x7f000000u : __float_as_uint(s0), k1 = f1 ? 0x7f000000u : __float_as_uint(s1);
            unsigned Tk = 0u;
#pragma unroll 1
            for (int bit = 30; bit >= 0; --bit) { const unsigned trial = Tk | (1u << bit);
                const int c = __popcll(__ballot(v0 && k0 >= trial)) + __popcll(__ballot(v1 && k1 >= trial)); if (c >= 16) Tk = trial; }
            const bool gt0 = v0 && k0 > Tk, gt1 = v1 && k1 > Tk, eq0 = v0 && k0 == Tk, eq1 = v1 && k1 == Tk;
            const unsigned long long mq0 = __ballot(eq0), mq1 = __ballot(eq1);
            const int need = 16 - (__popcll(__ballot(gt0)) + __popcll(__ballot(gt1)));
            const unsigned long long lt = (1ull << lane) - 1ull;
            const int r0 = __popcll(mq0 & lt), r1 = __popcll(mq0) + __popcll(mq1 & lt);
            const unsigned long long m0 = __ballot(gt0 || (eq0 && r0 < need)), m1 = __ballot(gt1 || (eq1 && r1 < need));
            if (lane == 0) { selm[tok * 4 + 0] = (unsigned)m0; selm[tok * 4 + 1] = (unsigned)(m0 >> 32); selm[tok * 4 + 2] = (unsigned)m1; selm[tok * 4 + 3] = (unsigned)(m1 >> 32); }
        }
        LDS_BAR();
        unsigned om = selm[lane], am = om;
        om |= __shfl_xor(om, 4); om |= __shfl_xor(om, 8); om |= __shfl_xor(om, 16); om |= __shfl_xor(om, 32);
        am &= __shfl_xor(am, 4); am &= __shfl_xor(am, 8); am &= __shfl_xor(am, 16); am &= __shfl_xor(am, 32);
        const unsigned u0 = __builtin_amdgcn_readlane(om, 0), u1 = __builtin_amdgcn_readlane(om, 1), u2 = __builtin_amdgcn_readlane(om, 2), u3 = __builtin_amdgcn_readlane(om, 3);
        const unsigned am0 = __builtin_amdgcn_readlane(am, 0), am1 = __builtin_amdgcn_readlane(am, 1), am2 = __builtin_amdgcn_readlane(am, 2), am3 = __builtin_amdgcn_readlane(am, 3);
        if (tid < 128) { const int wd = tid >> 5, bt = tid & 31;
            const unsigned uw = wd == 0 ? u0 : wd == 1 ? u1 : wd == 2 ? u2 : u3;
            if ((uw >> bt) & 1u) { const int pos = (wd > 0 ? __popc(u0) : 0) + (wd > 1 ? __popc(u1) : 0) + (wd > 2 ? __popc(u2) : 0) + __popc(uw & ((1u << bt) - 1u)); blist[pos] = (unsigned)tid; } }
        const int nsel = __popc(u0) + __popc(u1) + __popc(u2) + __popc(u3);
        LDS_BAR();
#ifndef SEL_REP
#define SEL_REP 1
#endif
#pragma unroll 1
        for (int rep2_ = 0; rep2_ < SEL_REP; ++rep2_) {
            const bf16* kb = Y1 + (size_t)b * T * OINP + 1280 + g * 64; const bf16* vt = VST + (size_t)(b * 2 + g) * 64 * T;
            float lp = 0.f; f32x4 acc[4];
#pragma unroll
            for (int dt = 0; dt < 4; ++dt) acc[dt] = (f32x4){0.f, 0.f, 0.f, 0.f};
#define SEL_FETCH(idx, KR, VR) { const int i_ = (idx) < nsel ? (idx) : nsel - 1; const int j_ = (int)__builtin_amdgcn_readfirstlane((int)blist[i_]); tile_fetch(kb + (size_t)(64 * j_) * OINP, OINP, vt + 64 * j_, T, tid, KR, VR); }
#define SEL_COMPUTE(i, KB, VB) { \
                const int j = (int)__builtin_amdgcn_readfirstlane((int)blist[i]); \
                const int wd = j >> 5; const unsigned aw = wd == 0 ? am0 : wd == 1 ? am1 : wd == 2 ? am2 : am3; \
                const int d0 = t - 64 * j - 4 * q; \
                if (((aw >> (j & 31)) & 1u) && j < qblk) tile_step<false>(KB, VB, qf, acc, lp, d0, slope2, 0x7fffffffu, true, l15, q); \
                else { const bool selb = (selm[l15 * 4 + wd] >> (j & 31)) & 1u; tile_step<true>(KB, VB, qf, acc, lp, d0, slope2, 0x7fffffffu, selb, l15, q); } }
            {
                SEL_FETCH(0, kr, vr) tile_store(KBUF(0), VBUF(0), tid, kr, vr); SEL_FETCH(1, kr, vr)
                LDS_BAR();
                int i = 0;
                for (; i + 1 < nsel; i += 2) {
                    SEL_FETCH(i + 2, kr2, vr2) SEL_COMPUTE(i, KBUF(0), VBUF(0)) tile_store(KBUF(1), VBUF(1), tid, kr, vr); LDS_BAR();
                    SEL_FETCH(i + 3, kr, vr) SEL_COMPUTE(i + 1, KBUF(1), VBUF(1)) tile_store(KBUF(0), VBUF(0), tid, kr2, vr2); LDS_BAR();
                }
                if (i < nsel) { SEL_COMPUTE(i, KBUF(0), VBUF(0)) LDS_BAR(); }
            }
#undef SEL_FETCH
#undef SEL_COMPUTE
            float l = lp; l += __shfl_xor(l, 16); l += __shfl_xor(l, 32);
            const float sc = l > 0.f ? g1 * (1.0f / SEL_REP) / l : 0.f;
#pragma unroll
            for (int dt = 0; dt < 4; ++dt) { ot[dt][0] += sc * acc[dt][0]; ot[dt][1] += sc * acc[dt][1]; ot[dt][2] += sc * acc[dt][2]; ot[dt][3] += sc * acc[dt][3]; }
        }
#ifndef WIN_REP
#define WIN_REP 1
#endif
#pragma unroll 1
        for (int rep_ = 0; rep_ < WIN_REP; ++rep_) {
            const bf16* kb = Y1 + (size_t)b * T * OINP + 1536 + g * 64; const bf16* vt = VWT + (size_t)(b * 2 + g) * 64 * T;
            float lp = 0.f; f32x4 acc[4];
#pragma unroll
            for (int dt = 0; dt < 4; ++dt) acc[dt] = (f32x4){0.f, 0.f, 0.f, 0.f};
            int kstart = t0 - 511; kstart = kstart < 0 ? 0 : (kstart & ~63);
            const int nw = ((t0 + 15 - kstart) >> 6) + 1;
#define WIN_FETCH(idx, KR, VR) { const int i_ = (idx) < nw ? (idx) : nw - 1; const int k_ = kstart + 64 * i_; tile_fetch(kb + (size_t)k_ * OINP, OINP, vt + k_, T, tid, KR, VR); }
#define WIN_COMPUTE(i, KB, VB) { \
                const int key0 = kstart + 64 * (i); \
                const int d0 = t - key0 - 4 * q; \
                if (key0 + 63 <= t0 && key0 >= t0 - 496) tile_step<false>(KB, VB, qf, acc, lp, d0, slope2, 512u, true, l15, q); \
                else tile_step<true>(KB, VB, qf, acc, lp, d0, slope2, 512u, true, l15, q); }
            {
                WIN_FETCH(0, kr, vr) tile_store(KBUF(0), VBUF(0), tid, kr, vr); WIN_FETCH(1, kr, vr)
                LDS_BAR();
                int i = 0;
                for (; i + 1 < nw; i += 2) {
                    WIN_FETCH(i + 2, kr2, vr2) WIN_COMPUTE(i, KBUF(0), VBUF(0)) tile_store(KBUF(1), VBUF(1), tid, kr, vr); LDS_BAR();
                    WIN_FETCH(i + 3, kr, vr) WIN_COMPUTE(i + 1, KBUF(1), VBUF(1)) tile_store(KBUF(0), VBUF(0), tid, kr2, vr2); LDS_BAR();
                }
                if (i < nw) { WIN_COMPUTE(i, KBUF(0), VBUF(0)) LDS_BAR(); }
            }
#undef WIN_FETCH
#undef WIN_COMPUTE
            float l = lp; l += __shfl_xor(l, 16); l += __shfl_xor(l, 32);
            const float sc = l > 0.f ? g2 * (1.0f / WIN_REP) / l : 0.f;
#pragma unroll
            for (int dt = 0; dt < 4; ++dt) { ot[dt][0] += sc * acc[dt][0]; ot[dt][1] += sc * acc[dt][1]; ot[dt][2] += sc * acc[dt][2]; ot[dt][3] += sc * acc[dt][3]; }
        }
        bf16* op = MIX + row * D + h * 64 + 4 * q;
#pragma unroll
        for (int dt = 0; dt < 4; ++dt) { u32x2 ow; ow.x = pk2(ot[dt][0], ot[dt][1]); ow.y = pk2(ot[dt][2], ot[dt][3]); *(u32x2*)(op + 16 * dt) = ow; }
    }
#undef KBUF
#undef VBUF
}
struct Args { const float* in[19]; float* out; unsigned char* ws; int ph_lo, ph_hi; };
constexpr int N_PHASES = 18;
template <class Epi>
DI void run_gemm(LAS unsigned char* lds, const bf16* A, const bf16* Bt, int N, int K, const Epi& E) {
    pg8::Gemm g{A, Bt, M, N, K}; pg8::StaticOrder S; S.init(M, N, (int)gridDim.x, (int)blockIdx.x);
    pg8::gemm_phase<Epi, pg8::StaticOrder, true, true>(lds, g, S, E);
}
__global__ void __launch_bounds__(512, 2) mega(Args a) {
    extern __shared__ __attribute__((aligned(16))) unsigned char lds_raw[];
    LAS unsigned char* lds = (LAS unsigned char*)lds_raw;
    cg::grid_group grid = cg::this_grid();
    volatile LAS unsigned* bst = (volatile LAS unsigned*)(lds + 147456 - 64);
    if (threadIdx.x < 2) bst[threadIdx.x] = 0u;
    __syncthreads();
    XcdBarrier xbar = xcd_barrier_post((unsigned*)(a.ws + WS_CTL), bst);
    const int tid = threadIdx.x, lane = tid & 63, wave = __builtin_amdgcn_readfirstlane(tid >> 6);
    const int gw = blockIdx.x * 8 + wave, ngw = gridDim.x * 8;
#define WSP(off) ((bf16*)(a.ws + (off)))
#define W_EIN WSP(WS_EIN)
#define W_EOUT WSP(WS_EOUT)
#define W_OIN WSP(WS_OIN)
#define W_OOUT WSP(WS_OOUT)
#define W_GU WSP(WS_GU)
#define W_DN WSP(WS_DN)
#define W1K WSP(WS_W1K)
#define W1V WSP(WS_W1V)
#define W2K WSP(WS_W2K)
#define W2V WSP(WS_W2V)
#define DEC ((float*)(a.ws + WS_DEC))
#define KCMP WSP(WS_KCMP)
#define VCMPT WSP(WS_VCMPT)
#define Y WSP(WS_Y)
#define VST WSP(WS_VST)
#define VWT WSP(WS_VWT)
#define HN WSP(WS_HN)
#define ST WSP(WS_ST)
#define RS ((float*)(a.ws + WS_RS))
#define HB WSP(WS_HB)
    const int lo = a.ph_lo, hi = a.ph_hi;
#define PH(k) if (lo <= (k) && (k) < hi)
#define SEAM(k) if (lo <= (k) && (k) + 1 < hi && hi > 0) { if ((k) == 0) grid.sync(); else xcd_barrier(xbar); }
    PH(0) {
        LAS float* scr = (LAS float*)(lds + wave * 8448);
        constexpr int I0 = 2048, I1 = 512, I2 = 1024, I3 = 512, I4 = 2816, I5 = 1408, I6 = 64, I7 = 2;
        constexpr int NIT = I0 + I1 + I2 + I3 + 2 * I4 + 2 * I5 + 2 * I6 + 2 * I7;
        for (int it = gw; it < NIT; it += ngw) {
            int r = it;
            if (r < I0) { transpose_item(a.in[4], 1024, EIN, EIN, W_EIN, 0, scr, r, lane); continue; } r -= I0;
            if (r < I1) { transpose_item(a.in[8], 1024, 1024, 1024, W_EOUT, 0, scr, r, lane); continue; } r -= I1;
            if (r < I2) { transpose_item(a.in[9], 1024, OIN, OINP, W_OIN, 0, scr, r, lane, a.in[1] + D); continue; } r -= I2;
            if (r < I3) { transpose_item(a.in[16], 1024, 1024, 1024, W_OOUT, 0, scr, r, lane); continue; } r -= I3;
            if (r < 2 * I4) { const int l = r / I4; transpose_item(a.in[17] + (size_t)l * D * 2 * FF, 1024, 2 * FF, 2 * FF, W_GU + (size_t)l * GU_STRIDE, 1, scr, r % I4, lane, a.in[2] + l * D); continue; } r -= 2 * I4;
            if (r < 2 * I5) { const int l = r / I5; transpose_item(a.in[18] + (size_t)l * FF * D, FF, 1024, 1024, W_DN + (size_t)l * DN_STRIDE, 0, scr, r % I5, lane); continue; } r -= 2 * I5;
            if (r < I6) { transpose_item(a.in[12], 2048, 64, 64, W1K, 0, scr, r, lane); continue; } r -= I6;
            if (r < I6) { transpose_item(a.in[14], 2048, 64, 64, W1V, 0, scr, r, lane); continue; } r -= I6;
            if (r < I7) { transpose_item(a.in[13], 64, 64, 64, W2K, 0, scr, r, lane); continue; } r -= I7;
            transpose_item(a.in[15], 64, 64, 64, W2V, 0, scr, r, lane);
        }
        norm_rows_bf16(a.in[0], a.in[1], HN, gw, ngw, lane);
    }
    SEAM(0);
    PH(1) { EpiStore E{Y, EIN, nullptr}; run_gemm(lds, HN, W_EIN, EIN, 1024, E); }
    SEAM(1);
    PH(2) { la_state_phase(Y, a.in[5], ST, DEC, lds); }
    SEAM(2);
    PH(3) { la_scan_phase(ST, DEC); }
    SEAM(3);
    PH(4) { la_out_phase(Y, a.in[5], ST, a.in[6], a.in[7], HN, lds); }
    SEAM(4);
    PH(5) { EpiResid E{a.in[0], a.out, HB, RS}; run_gemm(lds, HN, W_EOUT, 1024, 1024, E); }
    SEAM(5);
    PH(7) { EpiSwiglu E{Y, RS}; run_gemm(lds, HB, W_GU, 2 * FF, 1024, E); }
    SEAM(7);
    PH(8) { EpiResid E{a.out, a.out, HB, RS + 16 * M}; run_gemm(lds, Y, W_DN, 1024, FF, E); }
    SEAM(8);
    PH(10) { EpiStore E{Y, OINP, RS + 16 * M}; run_gemm(lds, HB, W_OIN, OINP, 1024, E); }
    SEAM(10);
    PH(11) { nsa_compress_phase(Y, a.in[10], a.in[11], W1K, W1V, W2K, W2V, KCMP, VCMPT, gw, ngw, lane); nsa_vt_phase(Y, VST, VWT, gw, ngw, lane); }
    SEAM(11);
    PH(12) { nsa_attn_phase(Y, KCMP, VCMPT, VST, VWT, HN, lds); }
    SEAM(12);
    PH(13) { EpiResid E{a.out, a.out, HB, RS + 32 * M}; run_gemm(lds, HN, W_OOUT, 1024, 1024, E); }
    SEAM(13);
    PH(15) { EpiSwiglu E{Y, RS + 32 * M}; run_gemm(lds, HB, W_GU + GU_STRIDE, 2 * FF, 1024, E); }
    SEAM(15);
    PH(16) { EpiResid E{a.out, a.out, nullptr, nullptr}; run_gemm(lds, Y, W_DN + DN_STRIDE, 1024, FF, E); }
    SEAM(16);
    PH(17) { norm_rows_f32_inplace(a.out, a.in[3], gw, ngw, lane); }
#undef PH
#undef SEAM
}

extern "C" void kernel_launch(void* const* d_in, const int* in_sizes, int n_in, void* d_out, int out_size, void* d_ws, size_t ws_size, hipStream_t stream) {
    static int grid = 0;
    if (grid == 0) {
        if (n_in != 19 || in_sizes[0] != M * D || out_size != M * D || ws_size < WS_END) { fprintf(stderr, "kernel_launch: unexpected shapes (n_in %d, in0 %d, out %d, ws %zu)\n", n_in, n_in > 0 ? in_sizes[0] : -1, out_size, ws_size); grid = -1; return; }
        int dev = 0, cus = 0, per_cu = 0;
        (void)hipGetDevice(&dev); (void)hipDeviceGetAttribute(&cus, hipDeviceAttributeMultiprocessorCount, dev);
        if (hipFuncSetAttribute((const void*)mega, hipFuncAttributeMaxDynamicSharedMemorySize, LDS_BYTES) != hipSuccess) { fprintf(stderr, "kernel_launch: hipFuncSetAttribute failed\n"); grid = -1; return; }
        if (hipOccupancyMaxActiveBlocksPerMultiprocessor(&per_cu, (const void*)mega, 512, LDS_BYTES) != hipSuccess || per_cu < 1) { fprintf(stderr, "kernel_launch: occupancy query says %d\n", per_cu); per_cu = 1; }
        (void)hipGetLastError();
        grid = cus * 1;
    }
    if (grid < 0) return;
    if (hipMemsetAsync((char*)d_ws + WS_CTL, 0, CTL_BYTES, stream) != hipSuccess) { fprintf(stderr, "kernel_launch: memset failed\n"); return; }
    Args a{};
    for (int i = 0; i < 19; ++i) a.in[i] = (const float*)d_in[i];
    a.out = (float*)d_out; a.ws = (unsigned char*)d_ws; a.ph_lo = 0; a.ph_hi = N_PHASES;
    void* args[] = {&a};
    hipError_t e = hipLaunchCooperativeKernel((const void*)mega, dim3(grid), dim3(512), args, LDS_BYTES, stream);
    if (e != hipSuccess) fprintf(stderr, "kernel_launch: cooperative launch failed: %s (grid %d)\n", hipGetErrorString(e), grid);
#ifdef PROBE_PHASES
    { const int pp[] = {PROBE_PHASES};
      for (unsigned i = 0; i < sizeof(pp) / sizeof(pp[0]); ++i) { a.ph_lo = pp[i]; a.ph_hi = pp[i] + 1; (void)hipLaunchCooperativeKernel((const void*)mega, dim3(grid), dim3(512), args, LDS_BYTES, stream); } }
#endif
}
```

```cpp
#include <hip/hip_runtime.h>
#include <hip/hip_cooperative_groups.h>
#include <cstdio>
#include <cstdint>
namespace cg = cooperative_groups;
namespace pg8 {
#define PG8_LAS __attribute__((address_space(3)))
typedef unsigned short bf16_t;
typedef short bf16x8 __attribute__((ext_vector_type(8)));
typedef float f32x4 __attribute__((ext_vector_type(4)));
typedef unsigned u32x4 __attribute__((ext_vector_type(4)));
constexpr int BM = 256, BK = 64, HALF = 128, HTB = HALF * BK * 2  , STAGE_BYTES = 8 * HTB, NXCD = 8, WGM = 8;

__host__ __device__ __forceinline__ int lds_byte(int r, int c) { const int st = (r >> 4) * 2 + (c >> 5), rr = r & 15, cc = c & 31, ob = rr * 64 + cc * 2; return st * 1024 + (ob ^ (((ob >> 9) & 1) << 5)); }
__host__ __device__ __forceinline__ void stage_rc(int b, int& R, int& C) { const int st = b / 1024, sb = b % 1024, swz = sb ^ (((sb >> 9) & 1) << 5); R = (st >> 1) * 16 + swz / 64; C = (st & 1) * 32 + (swz % 64) / 2; }
__host__ __device__ __forceinline__ int perm32(int rho) { const int n = rho >> 4, i = rho & 15; return 8 * (i >> 2) + 4 * n + (i & 3); }

struct Unit { int pm, pn; };
struct Gemm { const bf16_t* A; const bf16_t* Bt; int M, N, K; };

struct StaticOrder {
    int nM, nN, nwg, G, c;
    __host__ __device__ void init(int M, int N, int G_, int c_) { nM = M / BM; nN = N / BM; nwg = nM * nN; G = G_; c = c_; }
    __host__ __device__ bool next(int i, Unit& u) const {
        const long L = (long)i * G + c; if (L >= nwg) return false;
        int wgid = (int)L; { const int q = nwg / NXCD, r = nwg % NXCD, xcd = wgid % NXCD, off = wgid / NXCD; wgid = (xcd < r ? xcd * (q + 1) : r * (q + 1) + (xcd - r) * q) + off; }
        const int nig = WGM * nN, gid = wgid / nig, fm = gid * WGM, gsz = (nM - fm) < WGM ? (nM - fm) : WGM;
        u.pm = fm + ((wgid % nig) % gsz); u.pn = (wgid % nig) / gsz; return true;
    }
    __device__ __forceinline__ void a_ready(const Unit&) const {}
    __device__ __forceinline__ void done(const Unit&) const {}
};

__device__ __forceinline__ unsigned cvt_pk_bf16(float lo, float hi) { unsigned r; asm volatile("v_cvt_pk_bf16_f32 %0, %1, %2" : "=v"(r) : "v"(lo), "v"(hi)); return r; }
template <class Epi, class Sched, bool ALIGN_EPI = false, bool SP2 = false>
__device__ __forceinline__ void gemm_phase(PG8_LAS unsigned char* lds, const Gemm g, const Sched& S, const Epi& E) {
    const int tid = threadIdx.x, wid = __builtin_amdgcn_readfirstlane(tid >> 6), lane = tid & 63, wr = wid >> 2, wc = wid & 3, fr = lane & 15, fq = lane >> 4;
    const int K = g.K, nt = K / BK;
    unsigned voffA[2], voffB[2];
#pragma unroll
    for (int i = 0; i < 2; ++i) { int R, C; stage_rc(tid * 16 + i * 8192, R, C); const int Rb = Epi::PERM ? ((R & ~31) + perm32(R & 31)) : R;
        voffA[i] = (unsigned)(R * K + C) * 2u; voffB[i] = (unsigned)(Rb * K + C) * 2u; }
    const size_t kstep = (size_t)(BK * 2);
    const size_t hstep = (size_t)HALF * K * 2;
    const size_t tstep = 2 * hstep;
    const unsigned ldsw = (unsigned)wid * 1024u;
    const int aoff = lds_byte(wr * 64 + fr, fq * 8), boff = lds_byte(wc * 32 + fr, fq * 8);
#define PG8_SA(b, h) (((b) * 2 + (h)) * HTB)
#define PG8_SB(b, h) ((4 + (b) * 2 + (h)) * HTB)
#define PG8_STAGE(bufoff, gbase, voff) do { _Pragma("unroll") for (int _i = 0; _i < 2; ++_i) \
        __builtin_amdgcn_global_load_lds((const unsigned*)((const char*)(gbase) + (voff)[_i]), (PG8_LAS unsigned*)(lds + (bufoff) + ldsw + _i * 8192), 16, 0, 0); } while (0)
#define PG8_LDA(dst, b, h) do { _Pragma("unroll") for (int m = 0; m < 4; ++m) _Pragma("unroll") for (int k = 0; k < 2; ++k) dst[m][k] = *(const PG8_LAS bf16x8*)(lds + PG8_SA(b, h) + aoff + m * 2048 + k * 1024); } while (0)
#define PG8_LDB(dst, b, h) do { _Pragma("unroll") for (int n = 0; n < 2; ++n) _Pragma("unroll") for (int k = 0; k < 2; ++k) dst[n][k] = *(const PG8_LAS bf16x8*)(lds + PG8_SB(b, h) + boff + n * 2048 + k * 1024); } while (0)
#define PG8_MMA(ai, bj, At, Bt) do { __builtin_amdgcn_s_setprio(1); _Pragma("unroll") for (int m = 0; m < 4; ++m) _Pragma("unroll") for (int n = 0; n < 2; ++n) _Pragma("unroll") for (int k = 0; k < 2; ++k) \
        acc[ai][bj][m][n] = __builtin_amdgcn_mfma_f32_16x16x32_bf16(Bt[n][k], At[m][k], acc[ai][bj][m][n], 0, 0, 0); __builtin_amdgcn_s_setprio(0); } while (0)
#define PG8_WAIT_V(n) asm volatile("s_waitcnt vmcnt(" #n ")" ::: "memory")
#define PG8_WAIT_L(n) asm volatile("s_waitcnt lgkmcnt(" #n ")" ::: "memory")
#define PG8_BAR __builtin_amdgcn_s_barrier()
#define PG8_SCHED __builtin_amdgcn_sched_barrier(0)
    Unit cur, nxt; int ui = 0;
    if (!S.next(0, cur)) return;
    f32x4 acc[2][2][4][2];
#pragma unroll
    for (int a = 0; a < 2; ++a)
#pragma unroll
        for (int b = 0; b < 2; ++b)
#pragma unroll
            for (int m = 0; m < 4; ++m)
#pragma unroll
                for (int n = 0; n < 2; ++n) acc[a][b][m][n] = (f32x4){0.f, 0.f, 0.f, 0.f};
    bf16x8 At[4][2], B0[2][2], B1[2][2];
    const char* cA = (const char*)g.A + (size_t)cur.pm * tstep; const char* cB = (const char*)g.Bt + (size_t)cur.pn * tstep;
    S.a_ready(cur);
    if constexpr (SP2) {
        PG8_STAGE(PG8_SB(0, 0), cB, voffB); PG8_STAGE(PG8_SB(0, 1), cB + hstep, voffB); PG8_STAGE(PG8_SA(0, 0), cA, voffA); PG8_STAGE(PG8_SA(0, 1), cA + hstep, voffA);
        if (wr == 1) PG8_BAR;
        PG8_WAIT_V(2); PG8_BAR;
        PG8_STAGE(PG8_SB(1, 0), cB + kstep, voffB); PG8_STAGE(PG8_SA(1, 0), cA + kstep, voffA); PG8_STAGE(PG8_SB(1, 1), cB + hstep + kstep, voffB);
        PG8_WAIT_V(6); PG8_BAR;
    } else {
        PG8_STAGE(PG8_SB(0, 0), cB, voffB); PG8_STAGE(PG8_SA(0, 0), cA, voffA); PG8_STAGE(PG8_SB(0, 1), cB + hstep, voffB); PG8_STAGE(PG8_SA(0, 1), cA + hstep, voffA);
        if (wr == 1) PG8_BAR;
        PG8_WAIT_V(4); PG8_BAR;
        PG8_STAGE(PG8_SB(1, 0), cB + kstep, voffB); PG8_STAGE(PG8_SA(1, 0), cA + kstep, voffA); PG8_STAGE(PG8_SB(1, 1), cB + hstep + kstep, voffB);
        PG8_WAIT_V(6); PG8_BAR;
    }
    for (;;) {
        const bool has_next = S.next(ui + 1, nxt);
        const char* nA = has_next ? (const char*)g.A + (size_t)nxt.pm * tstep : cA; const char* nB = has_next ? (const char*)g.Bt + (size_t)nxt.pn * tstep : cB;
        for (int t = 0; t < nt; t += 2) {
            const bool last = (t == nt - 2);
            const char* a1 = cA + (size_t)(t + 1) * kstep;
            const char* a2 = last ? nA : cA + (size_t)(t + 2) * kstep; const char* b2 = last ? nB : cB + (size_t)(t + 2) * kstep;
            const char* a3 = a2 + kstep; const char* b3 = b2 + kstep;
            if (last && has_next) S.a_ready(nxt);
            if constexpr (SP2) {
            PG8_LDB(B0, 0, 0); PG8_LDB(B1, 0, 1); PG8_SCHED; PG8_LDA(At, 0, 0); PG8_STAGE(PG8_SA(1, 1), a1 + hstep, voffA);
            PG8_WAIT_V(8); PG8_WAIT_L(0); PG8_BAR; PG8_MMA(0, 0, At, B0); PG8_MMA(0, 1, At, B1); PG8_BAR; PG8_SCHED;
            PG8_LDA(At, 0, 1); PG8_STAGE(PG8_SB(0, 0), b2, voffB); PG8_STAGE(PG8_SB(0, 1), b2 + hstep, voffB); PG8_STAGE(PG8_SA(0, 0), a2, voffA);
            PG8_WAIT_V(8); PG8_WAIT_L(0); PG8_BAR; PG8_MMA(1, 0, At, B0); PG8_MMA(1, 1, At, B1); PG8_BAR; PG8_SCHED;
            PG8_LDB(B0, 1, 0); PG8_LDB(B1, 1, 1); PG8_SCHED; PG8_LDA(At, 1, 0); PG8_STAGE(PG8_SA(0, 1), a2 + hstep, voffA);
            PG8_WAIT_V(8); PG8_WAIT_L(0); PG8_BAR; PG8_MMA(0, 0, At, B0); PG8_MMA(0, 1, At, B1); PG8_BAR; PG8_SCHED;
            PG8_LDA(At, 1, 1); PG8_STAGE(PG8_SB(1, 0), b3, voffB); PG8_STAGE(PG8_SB(1, 1), b3 + hstep, voffB); PG8_STAGE(PG8_SA(1, 0), a3, voffA);
            PG8_WAIT_V(8); PG8_WAIT_L(0); PG8_BAR; PG8_MMA(1, 0, At, B0); PG8_MMA(1, 1, At, B1); PG8_BAR; PG8_SCHED;
            } else {
            PG8_LDB(B0, 0, 0); PG8_SCHED; PG8_LDA(At, 0, 0); PG8_STAGE(PG8_SA(1, 1), a1 + hstep, voffA);
            PG8_WAIT_L(8); PG8_BAR; PG8_WAIT_L(0); PG8_MMA(0, 0, At, B0); PG8_BAR; PG8_SCHED;
            PG8_LDB(B1, 0, 1); PG8_STAGE(PG8_SB(0, 0), b2, voffB);
            PG8_BAR; PG8_WAIT_L(0); PG8_MMA(0, 1, At, B1); PG8_BAR;
            PG8_LDA(At, 0, 1); PG8_STAGE(PG8_SA(0, 0), a2, voffA);
            PG8_BAR; PG8_WAIT_L(0); PG8_MMA(1, 0, At, B0); PG8_BAR; PG8_SCHED;
            PG8_STAGE(PG8_SB(0, 1), b2 + hstep, voffB);
            PG8_WAIT_V(6); PG8_BAR; PG8_MMA(1, 1, At, B1); PG8_BAR;
            PG8_LDB(B0, 1, 0); PG8_SCHED; PG8_LDA(At, 1, 0); PG8_STAGE(PG8_SA(0, 1), a2 + hstep, voffA);
            PG8_WAIT_L(8); PG8_BAR; PG8_WAIT_L(0); PG8_MMA(0, 0, At, B0); PG8_BAR; PG8_SCHED;
            PG8_LDB(B1, 1, 1); PG8_STAGE(PG8_SB(1, 0), b3, voffB);
            PG8_BAR; PG8_WAIT_L(0); PG8_MMA(0, 1, At, B1); PG8_BAR;
            PG8_LDA(At, 1, 1); PG8_STAGE(PG8_SA(1, 0), a3, voffA);
            PG8_BAR; PG8_WAIT_L(0); PG8_MMA(1, 0, At, B0); PG8_BAR; PG8_SCHED;
            PG8_STAGE(PG8_SB(1, 1), b3 + hstep, voffB);
            PG8_WAIT_V(6); PG8_BAR; PG8_MMA(1, 1, At, B1); PG8_BAR;
            }
        }
        if constexpr (ALIGN_EPI) { if (wr == 0) PG8_BAR; }
        if constexpr (!Epi::AFTER_DRAIN) { E(acc, cur, wr, wc, fr, fq); S.done(cur); }
        if (!has_next) break;
#pragma unroll
        for (int a = 0; a < 2; ++a)
#pragma unroll
            for (int b = 0; b < 2; ++b)
#pragma unroll
                for (int m = 0; m < 4; ++m)
#pragma unroll
                    for (int n = 0; n < 2; ++n) acc[a][b][m][n] = (f32x4){0.f, 0.f, 0.f, 0.f};
        cur = nxt; cA = nA; cB = nB; ++ui;
        if constexpr (ALIGN_EPI) { if (wr == 1) PG8_BAR; }
    }
    PG8_WAIT_V(0);
    if constexpr (!ALIGN_EPI) { if (wr == 0) PG8_BAR; }
    PG8_BAR;
    if constexpr (Epi::AFTER_DRAIN) { E.fused(acc, cur, wr, wc, fr, fq, lds, wid, lane); S.done(cur); }
#undef PG8_SA
#undef PG8_SB
#undef PG8_STAGE
#undef PG8_LDA
#undef PG8_LDB
#undef PG8_MMA
#undef PG8_WAIT_V
#undef PG8_WAIT_L
#undef PG8_BAR
#undef PG8_SCHED
}
}
#define GAS __attribute__((address_space(1)))
#define LAS __attribute__((address_space(3)))
#define DI __device__ __forceinline__
typedef unsigned short bf16;
typedef short bf16x8 __attribute__((ext_vector_type(8)));
typedef short s16x4 __attribute__((ext_vector_type(4)));
typedef float f32x4 __attribute__((ext_vector_type(4)));
typedef float f32x2 __attribute__((ext_vector_type(2)));
typedef unsigned u32x4 __attribute__((ext_vector_type(4)));
typedef unsigned u32x2 __attribute__((ext_vector_type(2)));
typedef __bf16 bf16x2_t __attribute__((ext_vector_type(2)));
#define MFMA16(a, b, c) __builtin_amdgcn_mfma_f32_16x16x32_bf16((a), (b), (c), 0, 0, 0)

constexpr int NB = 4, T = 8192, D = 1024, M = NB * T, FF = 2816;
constexpr int EIN = 4096, OIN = 1840, OINP = 2048;
constexpr float RMS_EPS = 1e-6f, LOG2E = 1.4426950408889634f;
constexpr size_t MiB = 1u << 20;
constexpr size_t WS_EIN = 0, WS_EOUT = 8 * MiB, WS_OIN = 10 * MiB, WS_OOUT = 14 * MiB, WS_GU = 16 * MiB, WS_DN = 38 * MiB;
constexpr size_t WS_W1K = 49 * MiB, WS_W1V = WS_W1K + 256 * 1024, WS_W2K = WS_W1V + 256 * 1024, WS_W2V = WS_W2K + 8192;
constexpr size_t WS_CTL = 56 * MiB, CTL_BYTES = 16384, WS_RS = 57 * MiB;
constexpr size_t WS_DEC = 52 * MiB, WS_KCMP = 54 * MiB, WS_VCMPT = WS_KCMP + 512 * 1024;
constexpr size_t WS_Y = 64 * MiB;
constexpr size_t WS_VST = 192 * MiB, WS_VWT = 200 * MiB, WS_HB = 240 * MiB;
constexpr size_t WS_HN = 320 * MiB, WS_ST = 384 * MiB, WS_END = 512 * MiB;
constexpr size_t GU_STRIDE = (size_t)2 * FF * D, DN_STRIDE = (size_t)D * FF;
constexpr int LDS_BYTES = 147456;

DI unsigned pk2(float lo, float hi) { f32x2 v = {lo, hi}; return __builtin_bit_cast(unsigned, __builtin_convertvector(v, bf16x2_t)); }
DI bf16 f2bf(float f) { return (bf16)(pk2(f, 0.f) & 0xffffu); }
DI float bf2f(bf16 x) { return __uint_as_float(((unsigned)x) << 16); }
DI float bflo(unsigned w) { return __uint_as_float(w << 16); }
DI float bfhi(unsigned w) { return __uint_as_float(w & 0xffff0000u); }
DI float wave_sum(float v) {
#pragma unroll
    for (int o = 1; o < 64; o <<= 1) v += __shfl_xor(v, o);
    return v;
}
DI float ex2(float x) { return __builtin_amdgcn_exp2f(x); }
DI float sigmoidf_(float x) { return __builtin_amdgcn_rcpf(1.0f + __expf(-x)); }
DI float siluf_(float x) { return x * __builtin_amdgcn_rcpf(1.0f + __expf(-x)); }

DI float rowscale(const float* rs, int row, int fq) {
    const f32x4 p = *(const f32x4*)(rs + (size_t)row * 16 + 4 * fq);
    float s = (p.x + p.y) + (p.z + p.w); s += __shfl_xor(s, 16); s += __shfl_xor(s, 32);
    return rsqrtf(s * (1.f / D) + RMS_EPS);
}
struct EpiStore {
    static constexpr bool PERM = true, AFTER_DRAIN = false;
    bf16* O; int ldc; const float* rs;
    DI void operator()(const pg8::f32x4 (&acc)[2][2][4][2], const pg8::Unit& u, int wr, int wc, int fr, int fq) const {
        const int row0 = u.pm * 256 + wr * 64 + fr, col0 = u.pn * 256 + wc * 32 + 8 * fq;
#pragma unroll
        for (int ai = 0; ai < 2; ++ai)
#pragma unroll
            for (int m = 0; m < 4; ++m) { const int row = row0 + ai * 128 + m * 16; bf16* rowp = O + (size_t)row * ldc + col0;
                const float r = rs ? rowscale(rs, row, fq) : 1.f;
#pragma unroll
                for (int bj = 0; bj < 2; ++bj) { const pg8::f32x4 v0 = acc[ai][bj][m][0] * r, v1 = acc[ai][bj][m][1] * r;
                    u32x4 w; w.x = pk2(v0[0], v0[1]); w.y = pk2(v0[2], v0[3]); w.z = pk2(v1[0], v1[1]); w.w = pk2(v1[2], v1[3]);
                    *(u32x4*)(rowp + bj * 128) = w; } }
    }
};
struct EpiSwiglu {
    static constexpr bool PERM = true, AFTER_DRAIN = false;
    bf16* O; const float* rs;
    DI void operator()(const pg8::f32x4 (&acc)[2][2][4][2], const pg8::Unit& u, int wr, int wc, int fr, int fq) const {
        const int row0 = u.pm * 256 + wr * 64 + fr, col0 = u.pn * 128 + wc * 32 + 8 * fq;
#pragma unroll
        for (int ai = 0; ai < 2; ++ai)
#pragma unroll
            for (int m = 0; m < 4; ++m) { const int row = row0 + ai * 128 + m * 16; bf16* rowp = O + (size_t)row * FF + col0;
                const float rsc = rowscale(rs, row, fq);
                float r[8];
#pragma unroll
                for (int n = 0; n < 2; ++n)
#pragma unroll
                    for (int e = 0; e < 4; ++e) { const float g = acc[ai][0][m][n][e] * rsc, up = acc[ai][1][m][n][e] * rsc; r[n * 4 + e] = g * __builtin_amdgcn_rcpf(1.0f + __expf(-g)) * up; }
                u32x4 w; w.x = pk2(r[0], r[1]); w.y = pk2(r[2], r[3]); w.z = pk2(r[4], r[5]); w.w = pk2(r[6], r[7]);
                *(u32x4*)rowp = w; }
    }
};
struct EpiResid {
    static constexpr bool PERM = false, AFTER_DRAIN = false;
    const float* base; float* out; bf16* hb; float* rs;
    DI void operator()(const pg8::f32x4 (&acc)[2][2][4][2], const pg8::Unit& u, int wr, int wc, int fr, int fq) const {
        const int row0 = u.pm * 256 + wr * 64 + fr, col0 = u.pn * 256 + wc * 32 + 4 * fq;
#pragma unroll
        for (int ai = 0; ai < 2; ++ai)
#pragma unroll
            for (int m = 0; m < 4; ++m) { const int row = row0 + ai * 128 + m * 16; const size_t off = (size_t)row * D + col0; float ss = 0.f;
#pragma unroll
                for (int bj = 0; bj < 2; ++bj)
#pragma unroll
                    for (int n = 0; n < 2; ++n) { const f32x4 bs = *(const f32x4*)(base + off + bj * 128 + n * 16); const pg8::f32x4 a = acc[ai][bj][m][n];
                        f32x4 o; o.x = bs.x + a[0]; o.y = bs.y + a[1]; o.z = bs.z + a[2]; o.w = bs.w + a[3]; *(f32x4*)(out + off + bj * 128 + n * 16) = o;
                        if (hb) { u32x2 hw; hw.x = pk2(o.x, o.y); hw.y = pk2(o.z, o.w); *(u32x2*)(hb + off + bj * 128 + n * 16) = hw; ss += (o.x * o.x + o.y * o.y) + (o.z * o.z + o.w * o.w); } }
                if (hb) { ss += __shfl_xor(ss, 16); ss += __shfl_xor(ss, 32); if (fq == 0) rs[(size_t)row * 16 + u.pn * 4 + wc] = ss; } }
    }
};

DI void transpose_item(const float* W, int K, int N, int Npad, bf16* WT, int mode, LAS float* scr, int item, int lane, const float* gk = nullptr) {
    const int nblk = Npad / 32, kb = item / nblk, nb = item % nblk, k0 = 64 * kb, n0 = 32 * nb;
    const int nl = n0 + (lane & 31);
#pragma unroll 8
    for (int i = 0; i < 32; ++i) { const int kk = 2 * i + (lane >> 5); const float gv = gk ? gk[k0 + kk] : 1.f; scr[kk * 33 + (lane & 31)] = (nl < N) ? W[(size_t)(k0 + kk) * N + nl] * gv : 0.f; }
    asm volatile("s_waitcnt lgkmcnt(0)" ::: "memory");
    const int c = lane & 7;
    int drow0 = n0;
    if (mode == 1) { drow0 = (n0 < FF) ? (256 * (n0 >> 7) + (n0 & 127)) : (256 * ((n0 - FF) >> 7) + 128 + ((n0 - FF) & 127)); }
#pragma unroll
    for (int j = 0; j < 4; ++j) { const int n = (lane >> 3) + 8 * j; const LAS float* s = scr + (8 * c) * 33 + n;
        u32x4 o; o.x = pk2(s[0 * 33], s[1 * 33]); o.y = pk2(s[2 * 33], s[3 * 33]); o.z = pk2(s[4 * 33], s[5 * 33]); o.w = pk2(s[6 * 33], s[7 * 33]);
        *(u32x4*)(WT + (size_t)(drow0 + n) * K + k0 + 8 * c) = o; }
    asm volatile("s_waitcnt lgkmcnt(0)" ::: "memory");
}
DI void norm_rows_bf16(const float* h, const float* g, bf16* out, int gw, int ngw, int lane) {
    f32x4 gv[4];
#pragma unroll
    for (int j = 0; j < 4; ++j) gv[j] = *((const f32x4*)g + lane + 64 * j);
    for (int m = gw; m < M; m += ngw) {
        const f32x4* xr = (const f32x4*)(h + (size_t)m * D) + lane; f32x4 v[4]; float s = 0.f;
#pragma unroll
        for (int j = 0; j < 4; ++j) { v[j] = xr[64 * j]; s += (v[j].x * v[j].x + v[j].y * v[j].y) + (v[j].z * v[j].z + v[j].w * v[j].w); }
        const float r = rsqrtf(wave_sum(s) * (1.f / D) + RMS_EPS);
        u32x2* o8 = (u32x2*)(out + (size_t)m * D) + lane;
#pragma unroll
        for (int j = 0; j < 4; ++j) { u32x2 w; w.x = pk2(v[j].x * r * gv[j].x, v[j].y * r * gv[j].y); w.y = pk2(v[j].z * r * gv[j].z, v[j].w * r * gv[j].w); o8[64 * j] = w; }
    }
}
DI void norm_rows_f32_inplace(float* h, const float* g, int gw, int ngw, int lane) {
    f32x4 gv[4];
#pragma unroll
    for (int j = 0; j < 4; ++j) gv[j] = *((const f32x4*)g + lane + 64 * j);
    for (int m = gw; m < M; m += ngw) {
        f32x4* xr = (f32x4*)(h + (size_t)m * D) + lane; f32x4 v[4]; float s = 0.f;
#pragma unroll
        for (int j = 0; j < 4; ++j) { v[j] = xr[64 * j]; s += (v[j].x * v[j].x + v[j].y * v[j].y) + (v[j].z * v[j].z + v[j].w * v[j].w); }
        const float r = rsqrtf(wave_sum(s) * (1.f / D) + RMS_EPS);
#pragma unroll
        for (int j = 0; j < 4; ++j) { f32x4 o; o.x = v[j].x * r * gv[j].x; o.y = v[j].y * r * gv[j].y; o.z = v[j].z * r * gv[j].z; o.w = v[j].w * r * gv[j].w; xr[64 * j] = o; }
    }
}
typedef GAS unsigned gu32;
#define XB_TMO      128
#define XB_XCNT(j)  (256  + 64 * (j))
#define XB_XSUB(j)  (1280 + 64 * (j))
#define XB_XGEN(j)  (2304 + 64 * (j))
#define XB_TOP      3328
#define XB_TOPGEN   3392
#define XCD_BAR_WORDS 3456
#define XB_SPIN_CAP (1u << 18)

__device__ __forceinline__ unsigned xb_ld(unsigned* p)              { return __hip_atomic_load(p, __ATOMIC_RELAXED, __HIP_MEMORY_SCOPE_AGENT); }
__device__ __forceinline__ unsigned xb_add(unsigned* p, unsigned v) { return __hip_atomic_fetch_add(p, v, __ATOMIC_RELAXED, __HIP_MEMORY_SCOPE_AGENT); }
__device__ __forceinline__ unsigned xb_xcc_id() { return (unsigned)__builtin_amdgcn_s_getreg((3 << 11) | 20) & 0xFu; }
#define XB_SPIN(cond, bar) do { unsigned _sp = 0; while (cond) { __builtin_amdgcn_s_sleep(1); \
    if ((++_sp & 255u) == 0u) { if (xb_ld(&(bar)[XB_TMO])) break; if (_sp > XB_SPIN_CAP) { atomicAdd(&(bar)[XB_TMO], 1u); break; } } } } while (0)

struct XcdBarrier {
    unsigned* bar; unsigned x;
    volatile LAS unsigned* st;
};

__device__ __forceinline__ XcdBarrier xcd_barrier_post(unsigned* bar, volatile LAS unsigned* st) {
    XcdBarrier b; b.bar = bar; b.x = xb_xcc_id(); b.st = st;
    if (threadIdx.x == 0) (void)xb_add(&bar[XB_XCNT(b.x)], 1u);
    return b;
}
__device__ __forceinline__ void xcd_barrier_complete(unsigned* bar, unsigned x, unsigned& nloc, unsigned& nx) {
    const unsigned G = gridDim.x * gridDim.y * gridDim.z;
    unsigned sum, cnt, mine, sp = 0u;
    for (;;) {
        sum = 0u; cnt = 0u; mine = 0u;
#pragma unroll
        for (unsigned j = 0; j < 16; ++j) { const unsigned c = xb_ld(&bar[XB_XCNT(j)]); sum += c; cnt += (c > 0u) ? 1u : 0u; mine = (j == x) ? c : mine; }
        if (sum == G) break;
        __builtin_amdgcn_s_sleep(1);
        if ((++sp & 255u) == 0u) { if (xb_ld(&bar[XB_TMO])) break; if (sp > XB_SPIN_CAP) { atomicAdd(&bar[XB_TMO], 1u); break; } }
    }
    nloc = mine > 0u ? mine : 1u; nx = cnt > 0u ? cnt : 1u;
}

__device__ __forceinline__ void xcd_barrier(const XcdBarrier& b) {
    asm volatile("s_waitcnt vmcnt(0)" ::: "memory");
    __syncthreads();
    if (threadIdx.x == 0) {
        unsigned* bar = b.bar;
        __builtin_amdgcn_s_waitcnt(0);
        unsigned nloc = b.st[0], nx = b.st[1];
        if (nloc == 0u) { xcd_barrier_complete(bar, b.x, nloc, nx); b.st[0] = nloc; b.st[1] = nx; }
        const unsigned old = xb_add(&bar[XB_XSUB(b.x)], 1u);
        const unsigned gen = old / nloc;
        if (old + 1u == (gen + 1u) * nloc) {
            __builtin_amdgcn_fence(__ATOMIC_RELEASE, "agent");
            asm volatile("s_waitcnt vmcnt(0)" ::: "memory");
            const unsigned og = xb_add(&bar[XB_TOP], 1u);
            const unsigned tg = og / nx;
            if (og + 1u == (tg + 1u) * nx) xb_add(&bar[XB_TOPGEN], 1u);
            else XB_SPIN(xb_ld(&bar[XB_TOPGEN]) == tg, bar);
            __builtin_amdgcn_fence(__ATOMIC_ACQUIRE, "agent");
            xb_add(&bar[XB_XGEN(b.x)], 1u);
            asm volatile("s_waitcnt vmcnt(0)" ::: "memory");
        } else {
            XB_SPIN(xb_ld(&bar[XB_XGEN(b.x)]) == gen, bar);
            __builtin_amdgcn_fence(__ATOMIC_ACQUIRE, "agent");
            asm volatile("s_waitcnt vmcnt(0)" ::: "memory");
        }
    }
    __syncthreads();
}
constexpr int LA_UNITS = NB * 8 * 128;
constexpr int KT_LD = 72, QT_LD = 136;
#define LA_BAR() do { asm volatile("s_waitcnt lgkmcnt(0)" ::: "memory"); __builtin_amdgcn_s_barrier(); asm volatile("" ::: "memory"); } while (0)
struct LaRaw { unsigned f[16], qv[16], v[16]; float lba, lbb; };
template <bool WANT_Q>
DI void la_issue(const bf16* Y0, const float* lbraw, int unit, int d, int rg, LaRaw& R) {
    const int b = unit >> 10, hh = (unit >> 7) & 7, n = unit & 127;
    const bf16* Yb = Y0 + (size_t)(b * T + n * 64 + 16 * rg) * EIN + d;
    const int cf = hh < 4 ? 512 + hh * 128 : 2560 + (hh - 4) * 128;
    const int cq = hh < 4 ? hh * 128 : 2048 + (hh - 4) * 128;
    const int cv = hh < 4 ? 1024 + hh * 128 : 3072 + (hh - 4) * 128;
#pragma unroll
    for (int e = 0; e < 16; ++e) { R.f[e] = Yb[(size_t)e * EIN + cf]; if (WANT_Q) R.qv[e] = Yb[(size_t)e * EIN + cq]; R.v[e] = Yb[(size_t)e * EIN + cv]; }
    const int li = (hh & 3) * 128 + d; R.lba = lbraw[li]; R.lbb = lbraw[512 + li];
    asm volatile("" ::: "memory");
}
template <bool WANT_Q>
DI void la_math(const LaRaw& R, int hh, float (&lg)[16], float (&kk)[16], float (&qq)[16]) {
    if (hh < 4) {
        const float mx = fmaxf(R.lba, R.lbb), ea = __expf(R.lba - mx), eb = __expf(R.lbb - mx), lbv = ea / (ea + eb);
#pragma unroll
        for (int e = 0; e < 16; ++e) { const float x = bf2f((bf16)R.f[e]); const float f = lbv + (1.f - lbv) * sigmoidf_(x); lg[e] = __logf(f); kk[e] = 1.f - f;
            if (WANT_Q) qq[e] = siluf_(bf2f((bf16)R.qv[e])); }
    } else {
        const int r = hh - 4; const float lgam = __logf(1.f - exp2f(-5.f - (float)r));
#pragma unroll
        for (int e = 0; e < 16; ++e) { lg[e] = lgam; kk[e] = bf2f((bf16)R.f[e]) * 0.08838834764831845f; if (WANT_Q) qq[e] = bf2f((bf16)R.qv[e]); }
    }
    float run = 0.f;
#pragma unroll
    for (int e = 0; e < 16; ++e) { run += lg[e]; lg[e] = run; }
}
DI void la_store_vt(const LaRaw& R, int d, int rg, LAS bf16* VT) {
    LAS u32x4* dst = (LAS u32x4*)(VT + d * KT_LD + 16 * rg);
    dst[0] = (u32x4){R.v[0] | (R.v[1] << 16), R.v[2] | (R.v[3] << 16), R.v[4] | (R.v[5] << 16), R.v[6] | (R.v[7] << 16)};
    dst[1] = (u32x4){R.v[8] | (R.v[9] << 16), R.v[10] | (R.v[11] << 16), R.v[12] | (R.v[13] << 16), R.v[14] | (R.v[15] << 16)};
}
DI void la_state_phase(const bf16* Y0, const float* lbraw, bf16* ST, float* DEC, LAS unsigned char* lds) {
    LAS bf16* KT = (LAS bf16*)lds; LAS bf16* VT = KT + 128 * KT_LD; LAS float* tot = (LAS float*)(VT + 128 * KT_LD);
    const int tid = threadIdx.x, lane = tid & 63, w = tid >> 6, l15 = lane & 15, q = lane >> 4, d = tid & 127, rg = tid >> 7;
    LaRaw R;
    if ((int)blockIdx.x < LA_UNITS) la_issue<false>(Y0, lbraw, blockIdx.x, d, rg, R);
    for (int unit = blockIdx.x; unit < LA_UNITS; unit += gridDim.x) {
        const int hh = (unit >> 7) & 7;
        float lg[16], kk[16], qq[16];
        la_math<false>(R, hh, lg, kk, qq);
        tot[rg * 128 + d] = lg[15];
        la_store_vt(R, d, rg, VT);
        { const int nx = unit + (int)gridDim.x; la_issue<false>(Y0, lbraw, nx < LA_UNITS ? nx : unit, d, rg, R); }
        LA_BAR();
        float pre = 0.f, last = 0.f;
#pragma unroll
        for (int g2 = 0; g2 < 4; ++g2) { const float tv = tot[g2 * 128 + d]; if (g2 < rg) pre += tv; last += tv; }
        unsigned wv[8];
#pragma unroll
        for (int e = 0; e < 8; ++e) { const float c0 = pre + lg[2 * e], c1 = pre + lg[2 * e + 1]; wv[e] = pk2(kk[2 * e] * __expf(last - c0), kk[2 * e + 1] * __expf(last - c1)); }
        LAS u32x4* dst = (LAS u32x4*)(KT + d * KT_LD + 16 * rg);
        dst[0] = (u32x4){wv[0], wv[1], wv[2], wv[3]}; dst[1] = (u32x4){wv[4], wv[5], wv[6], wv[7]};
        if (rg == 0) DEC[(size_t)unit * 128 + d] = __expf(last);
        LA_BAR();
        f32x4 acc[8];
#pragma unroll
        for (int dt = 0; dt < 8; ++dt) acc[dt] = (f32x4){0.f, 0.f, 0.f, 0.f};
#pragma unroll
        for (int ks = 0; ks < 2; ++ks) { const bf16x8 bv = *(const LAS bf16x8*)(VT + (16 * w + l15) * KT_LD + 32 * ks + 8 * q);
#pragma unroll
            for (int dt = 0; dt < 8; ++dt) { const bf16x8 ak = *(const LAS bf16x8*)(KT + (16 * dt + l15) * KT_LD + 32 * ks + 8 * q); acc[dt] = MFMA16(ak, bv, acc[dt]); } }
        bf16* so = ST + (size_t)unit * 16384 + (16 * w + l15) * 128 + 4 * q;
#pragma unroll
        for (int dt = 0; dt < 8; ++dt) { u32x2 o; o.x = pk2(acc[dt][0], acc[dt][1]); o.y = pk2(acc[dt][2], acc[dt][3]); *(u32x2*)(so + 16 * dt) = o; }
        LA_BAR();
    }
}
DI void la_scan_phase(bf16* ST, const float* DEC) {
    const int gid = blockIdx.x * 512 + threadIdx.x, nth = gridDim.x * 512;
    for (int wk = gid; wk < 32 * 4096; wk += nth) {
        const int bh = wk >> 12, e4 = (wk & 4095) * 4, d = e4 & 127;
        f32x4 s = {0.f, 0.f, 0.f, 0.f};
        bf16* sp = ST + (size_t)bh * 128 * 16384 + e4; const float* dp = DEC + (size_t)bh * 128 * 128 + d;
        for (int n0 = 0; n0 < 128; n0 += 8) {
            u32x2 uv[8]; f32x4 dv[8];
#pragma unroll
            for (int i = 0; i < 8; ++i) { uv[i] = *(const u32x2*)(sp + (size_t)(n0 + i) * 16384); dv[i] = *(const f32x4*)(dp + (size_t)(n0 + i) * 128); }
#pragma unroll
            for (int i = 0; i < 8; ++i) { u32x2 o; o.x = pk2(s.x, s.y); o.y = pk2(s.z, s.w); *(u32x2*)(sp + (size_t)(n0 + i) * 16384) = o;
                s.x = dv[i].x * s.x + bflo(uv[i].x); s.y = dv[i].y * s.y + bfhi(uv[i].x); s.z = dv[i].z * s.z + bflo(uv[i].y); s.w = dv[i].w * s.w + bfhi(uv[i].y); }
        }
    }
}
DI void la_out_phase(const bf16* Y0, const float* lbraw, const bf16* ST, const float* gh, const float* gr, bf16* MIX, LAS unsigned char* lds) {
    LAS bf16* QT = (LAS bf16*)lds; LAS bf16* K2 = QT + 64 * QT_LD; LAS bf16* QS = K2 + 64 * QT_LD; LAS bf16* VT = QS + 64 * QT_LD;
    LAS float* tot = (LAS float*)(VT + 128 * KT_LD); LAS float* ssq = tot + 512; LAS float* gnl = ssq + 128;
    const int tid = threadIdx.x, lane = tid & 63, w = tid >> 6, l15 = lane & 15, q = lane >> 4, d = tid & 127, rg = tid >> 7;
    const int it = w & 3, vh = w >> 2;
    if (tid < 256) gnl[tid] = tid < 128 ? gh[tid] : gr[tid - 128];
    __syncthreads();
    const int irow = 16 * it + l15;
    LaRaw R;
    if ((int)blockIdx.x < LA_UNITS) la_issue<true>(Y0, lbraw, blockIdx.x, d, rg, R);
    for (int unit = blockIdx.x; unit < LA_UNITS; unit += gridDim.x) {
        const int b = unit >> 10, hh = (unit >> 7) & 7, n = unit & 127;
        const int row0 = b * T + n * 64;
        const bf16* gp = Y0 + (size_t)(row0 + irow) * EIN + (hh < 4 ? 1536 + hh * 128 : 3584 + (hh - 4) * 128) + 64 * vh + 4 * q;
        u32x2 gw[4];
#pragma unroll
        for (int vt = 0; vt < 4; ++vt) gw[vt] = *(const u32x2*)(gp + 16 * vt);
        const bf16* sb = ST + (size_t)unit * 16384;
        bf16x8 sfr[4][4];
#pragma unroll
        for (int ks = 0; ks < 4; ++ks)
#pragma unroll
            for (int vt = 0; vt < 4; ++vt) sfr[ks][vt] = *(const bf16x8*)(sb + (64 * vh + 16 * vt + l15) * 128 + 32 * ks + 8 * q);
        asm volatile("" ::: "memory");
        float lg[16], kk[16], qq[16];
        la_math<true>(R, hh, lg, kk, qq);
        tot[rg * 128 + d] = lg[15];
        la_store_vt(R, d, rg, VT);
        { const int nx = unit + (int)gridDim.x; la_issue<true>(Y0, lbraw, nx < LA_UNITS ? nx : unit, d, rg, R); }
        LA_BAR();
        float pre = 0.f;
#pragma unroll
        for (int g2 = 0; g2 < 4; ++g2) { const float tv = tot[g2 * 128 + d]; if (g2 < rg) pre += tv; }
        const float ref = tot[d] + tot[128 + d];
#pragma unroll
        for (int e = 0; e < 16; ++e) { const float c = pre + lg[e]; const int j = 16 * rg + e;
            QT[j * QT_LD + d] = f2bf(qq[e] * __expf(c - ref)); K2[j * QT_LD + d] = f2bf(kk[e] * __expf(ref - c)); QS[j * QT_LD + d] = f2bf(qq[e] * __expf(c)); }
        LA_BAR();
        f32x4 at[4];
#pragma unroll
        for (int jt = 0; jt < 4; ++jt) at[jt] = (f32x4){0.f, 0.f, 0.f, 0.f};
#pragma unroll
        for (int ks = 0; ks < 4; ++ks) { const bf16x8 bq = *(const LAS bf16x8*)(QT + (16 * it + l15) * QT_LD + 32 * ks + 8 * q);
#pragma unroll
            for (int jt = 0; jt < 4; ++jt) { const bf16x8 ak = *(const LAS bf16x8*)(K2 + (16 * jt + l15) * QT_LD + 32 * ks + 8 * q); at[jt] = MFMA16(ak, bq, at[jt]); } }
#pragma unroll
        for (int jt = 0; jt < 4; ++jt)
#pragma unroll
            for (int r = 0; r < 4; ++r) { const int j = 16 * jt + 4 * q + r; if (j > irow) at[jt][r] = 0.f; }
        f32x4 o[4];
#pragma unroll
        for (int vt = 0; vt < 4; ++vt) o[vt] = (f32x4){0.f, 0.f, 0.f, 0.f};
#pragma unroll
        for (int k2 = 0; k2 < 2; ++k2) {
            u32x4 pw; pw.x = pk2(at[2 * k2][0], at[2 * k2][1]); pw.y = pk2(at[2 * k2][2], at[2 * k2][3]); pw.z = pk2(at[2 * k2 + 1][0], at[2 * k2 + 1][1]); pw.w = pk2(at[2 * k2 + 1][2], at[2 * k2 + 1][3]);
            const bf16x8 pf = __builtin_bit_cast(bf16x8, pw);
#pragma unroll
            for (int vt = 0; vt < 4; ++vt) { const LAS bf16* vp = VT + (64 * vh + 16 * vt + l15) * KT_LD + 32 * k2 + 4 * q;
                const u32x2 lo = *(const LAS u32x2*)vp, hi = *(const LAS u32x2*)(vp + 16);
                const bf16x8 av = __builtin_bit_cast(bf16x8, ((u32x4){lo.x, lo.y, hi.x, hi.y})); o[vt] = MFMA16(av, pf, o[vt]); }
        }
#pragma unroll
        for (int ks = 0; ks < 4; ++ks) { const bf16x8 bq = *(const LAS bf16x8*)(QS + (16 * it + l15) * QT_LD + 32 * ks + 8 * q);
#pragma unroll
            for (int vt = 0; vt < 4; ++vt) o[vt] = MFMA16(sfr[ks][vt], bq, o[vt]); }
        float ss = 0.f;
#pragma unroll
        for (int vt = 0; vt < 4; ++vt) ss += (o[vt][0] * o[vt][0] + o[vt][1] * o[vt][1]) + (o[vt][2] * o[vt][2] + o[vt][3] * o[vt][3]);
        ss += __shfl_xor(ss, 16); ss += __shfl_xor(ss, 32);
        if (q == 0) ssq[vh * 64 + irow] = ss;
        LA_BAR();
        const float rs = rsqrtf((ssq[irow] + ssq[64 + irow]) * (1.f / 128.f) + RMS_EPS);
        const LAS float* gn = gnl + (hh < 4 ? 0 : 128);
        bf16* op = MIX + (size_t)(row0 + irow) * D + hh * 128;
#pragma unroll
        for (int vt = 0; vt < 4; ++vt) { const int v0 = 64 * vh + 16 * vt + 4 * q; const f32x4 gv = *(const LAS f32x4*)(gn + v0);
            u32x2 ow; ow.x = pk2(o[vt][0] * rs * gv.x * siluf_(bflo(gw[vt].x)), o[vt][1] * rs * gv.y * siluf_(bfhi(gw[vt].x)));
            ow.y = pk2(o[vt][2] * rs * gv.z * siluf_(bflo(gw[vt].y)), o[vt][3] * rs * gv.w * siluf_(bfhi(gw[vt].y))); *(u32x2*)(op + v0) = ow; }
        LA_BAR();
    }
}
constexpr int NC = 511, NCP = 512;
DI void nsa_compress_phase(const bf16* Y1, const float* posk, const float* posv, const bf16* w1kT, const bf16* w1vT, const bf16* w2kT, const bf16* w2vT,
                           bf16* KCMP, bf16* VCMPT, LAS unsigned char* lds, int gw, int ngw, int lane) {
    const int l15 = lane & 15, q = lane >> 4, wv = (threadIdx.x >> 6), grp = wv >> 2, nt = wv & 3;
    LAS bf16* h1s = (LAS bf16*)lds + grp * 16 * 72;
    for (int base = 0; base < 512; base += ngw / 4) {
        int task = base + (gw >> 2); const bool tvalid = task < 512; if (!tvalid) task = 511;
        const int kv = task & 1, rt = task >> 1;
        int r = rt * 16 + l15; const bool rvalid = tvalid && (r < NB * NC * 2); if (r >= NB * NC * 2) r = NB * NC * 2 - 1;
        const int b = r / (NC * 2), rem = r % (NC * 2), i = rem >> 1, g = rem & 1;
        const bf16* src = Y1 + (size_t)(b * T + 16 * i) * OINP + (kv ? 1152 : 1024) + g * 64;
        const float* pos = kv ? posv : posk; const bf16* w1 = (kv ? w1vT : w1kT) + (size_t)(16 * nt + l15) * 2048; const bf16* w2 = kv ? w2vT : w2kT;
        f32x4 acc = {0.f, 0.f, 0.f, 0.f};
#pragma unroll 8
        for (int ks = 0; ks < 64; ++ks) {
            const int p = ks >> 1, d0 = (ks & 1) * 32 + 8 * q;
            const u32x4 xv = *(const u32x4*)(src + (size_t)p * OINP + d0);
            const f32x4 p0 = *(const f32x4*)(pos + p * 64 + d0), p1 = *(const f32x4*)(pos + p * 64 + d0 + 4);
            u32x4 bw; bw.x = pk2(bflo(xv.x) + p0.x, bfhi(xv.x) + p0.y); bw.y = pk2(bflo(xv.y) + p0.z, bfhi(xv.y) + p0.w);
            bw.z = pk2(bflo(xv.z) + p1.x, bfhi(xv.z) + p1.y); bw.w = pk2(bflo(xv.w) + p1.z, bfhi(xv.w) + p1.w);
            const bf16x8 af = *(const bf16x8*)(w1 + 32 * ks + 8 * q);
            acc = MFMA16(af, __builtin_bit_cast(bf16x8, bw), acc);
        }
        { u32x2 hw; hw.x = pk2(siluf_(acc[0]), siluf_(acc[1])); hw.y = pk2(siluf_(acc[2]), siluf_(acc[3])); *(LAS u32x2*)(h1s + l15 * 72 + 16 * nt + 4 * q) = hw; }
        __syncthreads();
        f32x4 o2 = {0.f, 0.f, 0.f, 0.f};
#pragma unroll
        for (int k2 = 0; k2 < 2; ++k2) { const bf16x8 bf = *(const LAS bf16x8*)(h1s + l15 * 72 + 32 * k2 + 8 * q);
            const bf16x8 av = *(const bf16x8*)(w2 + (16 * nt + l15) * 64 + 32 * k2 + 8 * q); o2 = MFMA16(av, bf, o2); }
        if (rvalid) {
            if (kv == 0) { u32x2 ow; ow.x = pk2(o2[0], o2[1]); ow.y = pk2(o2[2], o2[3]); *(u32x2*)(KCMP + ((size_t)(b * 2 + g) * NCP + i) * 64 + 16 * nt + 4 * q) = ow; }
            else { bf16* op = VCMPT + (size_t)(b * 2 + g) * 64 * NCP + i;
#pragma unroll
                for (int r2 = 0; r2 < 4; ++r2) op[(size_t)(16 * nt + 4 * q + r2) * NCP] = f2bf(o2[r2]); }
        }
        __syncthreads();
    }
    for (int z = gw * 64 + lane; z < NB * 2 * 64; z += ngw * 64) { const int bg = z >> 6, dd = z & 63; KCMP[((size_t)bg * NCP + NC) * 64 + dd] = 0; VCMPT[((size_t)bg * 64 + dd) * NCP + NC] = 0; }
}
DI void nsa_vt_phase(const bf16* Y1, bf16* VST, bf16* VWT, int gw, int ngw, int lane) {
    for (int task = gw; task < 2 * NB * 2 * 128; task += ngw) {
        const int which = task & 1, g = (task >> 1) & 1, b = (task >> 2) & 3, blk = task >> 4;
        const int t = blk * 64 + lane;
        const bf16* src = Y1 + (size_t)(b * T + t) * OINP + (which ? 1664 : 1408) + g * 64;
        bf16* dst = (which ? VWT : VST) + (size_t)(b * 2 + g) * 64 * T + t;
        u32x4 v[8];
#pragma unroll
        for (int c = 0; c < 8; ++c) v[c] = *(const u32x4*)(src + 8 * c);
#pragma unroll
        for (int c = 0; c < 8; ++c) {
            dst[(size_t)(8 * c + 0) * T] = (bf16)(v[c].x & 0xffff); dst[(size_t)(8 * c + 1) * T] = (bf16)(v[c].x >> 16);
            dst[(size_t)(8 * c + 2) * T] = (bf16)(v[c].y & 0xffff); dst[(size_t)(8 * c + 3) * T] = (bf16)(v[c].y >> 16);
            dst[(size_t)(8 * c + 4) * T] = (bf16)(v[c].z & 0xffff); dst[(size_t)(8 * c + 5) * T] = (bf16)(v[c].z >> 16);
            dst[(size_t)(8 * c + 6) * T] = (bf16)(v[c].w & 0xffff); dst[(size_t)(8 * c + 7) * T] = (bf16)(v[c].w >> 16);
        }
    }
}
#define LDS_BAR() do { asm volatile("s_waitcnt lgkmcnt(0)" ::: "memory"); __builtin_amdgcn_s_barrier(); asm volatile("" ::: "memory"); } while (0)
constexpr int TL = 80;
constexpr int SLAB_LD = 132;
constexpr float C1 = 0.125f * LOG2E;
DI void tile_fetch(const bf16* kg, int ldk, const bf16* vg, int ldv, int tid, u32x4& kr, u32x4& vr) {
    const int r = tid >> 3, c = (tid & 7) * 8;
    kr = *(const u32x4*)(kg + (size_t)r * ldk + c); vr = *(const u32x4*)(vg + (size_t)r * ldv + c);
    asm volatile("" ::: "memory");
}
DI void tile_store(LAS bf16* Kb, LAS bf16* Vb, int tid, u32x4 kr, u32x4 vr) {
    const int r = tid >> 3, c = (tid & 7) * 8;
    *(LAS u32x4*)(Kb + r * TL + c) = kr;
    const int g32 = c & 32, k0 = c & 31, k1 = k0 + 4;
    const int p0 = 8 * ((k0 & 15) >> 2) + 4 * (k0 >> 4), p1 = 8 * ((k1 & 15) >> 2) + 4 * (k1 >> 4);
    *(LAS u32x2*)(Vb + r * TL + g32 + p0) = (u32x2){vr.x, vr.y}; *(LAS u32x2*)(Vb + r * TL + g32 + p1) = (u32x2){vr.z, vr.w};
}
DI void tile_scores(const LAS bf16* Kb, const bf16x8 (&qf)[2], int l15, int q, f32x4 (&sc)[4]) {
#pragma unroll
    for (int x = 0; x < 4; ++x) { sc[x] = (f32x4){0.f, 0.f, 0.f, 0.f};
#pragma unroll
        for (int ks = 0; ks < 2; ++ks) { const bf16x8 a = *(const LAS bf16x8*)(Kb + (16 * x + l15) * TL + 32 * ks + 8 * q); sc[x] = MFMA16(a, qf[ks], sc[x]); } }
}
DI void tile_pv(const LAS bf16* Vb, const float (&p)[16], f32x4 (&acc)[4], int l15, int q) {
#pragma unroll
    for (int k2 = 0; k2 < 2; ++k2) {
        u32x4 pw; pw.x = pk2(p[8 * k2], p[8 * k2 + 1]); pw.y = pk2(p[8 * k2 + 2], p[8 * k2 + 3]); pw.z = pk2(p[8 * k2 + 4], p[8 * k2 + 5]); pw.w = pk2(p[8 * k2 + 6], p[8 * k2 + 7]);
        const bf16x8 pf = __builtin_bit_cast(bf16x8, pw);
#pragma unroll
        for (int dt = 0; dt < 4; ++dt) { const bf16x8 av = *(const LAS bf16x8*)(Vb + (16 * dt + l15) * TL + 32 * k2 + 8 * q); acc[dt] = MFMA16(av, pf, acc[dt]); }
    }
}
template <bool MASKED, int KS>
DI float tile_probs(const f32x4 (&sc)[4], float (&p)[16], int d0, float slope2, unsigned lim, bool extra) {
    const float A = -slope2 * (float)d0; f32x2 ps = {0.f, 0.f};
    const f32x2 r01 = {0.f, slope2 * (float)KS}, r23 = {slope2 * (float)(2 * KS), slope2 * (float)(3 * KS)};
#pragma unroll
    for (int x = 0; x < 4; ++x) { const float bx = slope2 * (float)(16 * KS * x) + A;
        const f32x2 s01 = {sc[x][0], sc[x][1]}, s23 = {sc[x][2], sc[x][3]};
        f32x2 v01 = s01 * C1 + (r01 + bx), v23 = s23 * C1 + (r23 + bx);
        if (MASKED) { const int kb = 16 * KS * x;
            v01.x = (extra && ((unsigned)(d0 - kb) < lim)) ? v01.x : -INFINITY; v01.y = (extra && ((unsigned)(d0 - kb - KS) < lim)) ? v01.y : -INFINITY;
            v23.x = (extra && ((unsigned)(d0 - kb - 2 * KS) < lim)) ? v23.x : -INFINITY; v23.y = (extra && ((unsigned)(d0 - kb - 3 * KS) < lim)) ? v23.y : -INFINITY; }
        f32x2 p01, p23; p01.x = ex2(v01.x); p01.y = ex2(v01.y); p23.x = ex2(v23.x); p23.y = ex2(v23.y); ps += p01; ps += p23;
        p[4 * x] = p01.x; p[4 * x + 1] = p01.y; p[4 * x + 2] = p23.x; p[4 * x + 3] = p23.y; }
    return ps.x + ps.y;
}
template <bool MASKED>
DI void tile_step(const LAS bf16* Kb, const LAS bf16* Vb, const bf16x8 (&qf)[2], f32x4 (&acc)[4], float& lp, int d0, float slope2, unsigned lim, bool extra, int l15, int q) {
    f32x4 sc[4]; tile_scores(Kb, qf, l15, q, sc);
    float p[16]; lp += tile_probs<MASKED, 1>(sc, p, d0, slope2, lim, extra);
    tile_pv(Vb, p, acc, l15, q);
}
DI void nsa_attn_phase(const bf16* Y1, const bf16* KCMP, const bf16* VCMPT, const bf16* VST, const bf16* VWT, bf16* MIX, LAS unsigned char* lds) {
    LAS bf16* KB0 = (LAS bf16*)lds;
    LAS bf16* VB0 = KB0 + 2 * 64 * TL;
    LAS float* slab = (LAS float*)(lds + 4 * 64 * TL * 2);
    LAS float* pslc = slab + 8 * 16 * SLAB_LD;
    LAS unsigned* selm = (LAS unsigned*)(pslc + 16 * 128);
    LAS unsigned* uni = selm + 64;
    LAS unsigned* blist = uni + 4;
    LAS float* invl = (LAS float*)(blist + 132);
    const int tid = threadIdx.x, lane = tid & 63, w = tid >> 6, l15 = lane & 15, q = lane >> 4;
    LAS float* myslab = slab + w * 16 * SLAB_LD;
#define KBUF(i) (KB0 + ((i) & 1) * 64 * TL)
#define VBUF(i) (VB0 + ((i) & 1) * 64 * TL)
    for (int u = blockIdx.x; u < NB * 2 * (T / 16); u += gridDim.x) {
        const int b = u & 3, g = (u >> 2) & 1;
        int tile = u >> 3;
        if ((int)gridDim.x == 256) { const int wq = (int)blockIdx.x >> 3, k = u >> 8; tile = k < 8 ? 8 * wq + k : 512 - 8 * (wq + 1) + (k - 8); }
        const int t0 = tile * 16, qblk = t0 >> 6;
        const int h = g * 8 + w; const float slope = exp2f(-0.5f * (float)(h + 1)), slope2 = slope * LOG2E;
        const int t = t0 + l15; const size_t row = (size_t)b * T + t;
        bf16x8 qf[2];
        qf[0] = *(const bf16x8*)(Y1 + row * OINP + h * 64 + 8 * q); qf[1] = *(const bf16x8*)(Y1 + row * OINP + h * 64 + 32 + 8 * q);
        const bf16* gl = Y1 + row * OINP + 1792 + h * 3;
        const float g0 = sigmoidf_(bf2f(gl[0])), g1 = sigmoidf_(bf2f(gl[1])), g2 = sigmoidf_(bf2f(gl[2]));
        f32x4 ot[4];
        u32x4 kr, vr, kr2, vr2;
        {
            const bf16* kc = KCMP + (size_t)(b * 2 + g) * NCP * 64; const bf16* vct = VCMPT + (size_t)(b * 2 + g) * 64 * NCP;
            const int nst = tile >= 1 ? ((tile - 1) >> 6) + 1 : 0;
            const int dc = t - 31 - 64 * q;
            float lp = 0.f, carry = 0.f;
            f32x4 acc[4];
#pragma unroll
            for (int dt = 0; dt < 4; ++dt) acc[dt] = (f32x4){0.f, 0.f, 0.f, 0.f};
            float inv = 0.f;
            {
#define CMP_FETCH(idx, KR, VR) { const int i_ = (idx) < nst ? (idx) : nst - 1; tile_fetch(kc + (size_t)(64 * i_) * 64, 64, vct + 64 * i_, NCP, tid, KR, VR); }
#define CMP_COMPUTE(s, KB, VB) { \
                    f32x4 sc[4]; tile_scores(KB, qf, l15, q, sc); \
                    float sv[16]; \
                    const int d0 = dc - 1024 * (s); \
                    if (64 * (s) + 63 <= tile - 2) lp += tile_probs<false, 16>(sc, sv, d0, slope2, 0x7fffffffu, true); \
                    else lp += tile_probs<true, 16>(sc, sv, d0, slope2, 0x7fffffffu, true); \
                    _Pragma("unroll") for (int x = 0; x < 4; ++x) { const float hf_ = 0.5f * sv[4 * x + 3]; \
                        const float up_ = __shfl(hf_, (lane + 48) & 63);     \
                        myslab[l15 * SLAB_LD + 16 * (s) + 4 * x + q] = ((sv[4 * x] + sv[4 * x + 1]) + (sv[4 * x + 2] + hf_)) + (q > 0 ? up_ : carry); \
                        carry = up_; } \
                    tile_pv(VB, sv, acc, l15, q); }
                if (nst > 0) {
                    CMP_FETCH(0, kr, vr) tile_store(KBUF(0), VBUF(0), tid, kr, vr); CMP_FETCH(1, kr, vr)
                    LDS_BAR();
                    int s = 0;
                    for (; s + 1 < nst; s += 2) {
                        CMP_FETCH(s + 2, kr2, vr2) CMP_COMPUTE(s, KBUF(0), VBUF(0)) tile_store(KBUF(1), VBUF(1), tid, kr, vr); LDS_BAR();
                        CMP_FETCH(s + 3, kr, vr) CMP_COMPUTE(s + 1, KBUF(1), VBUF(1)) tile_store(KBUF(0), VBUF(0), tid, kr2, vr2); LDS_BAR();
                    }
                    if (s < nst) { CMP_COMPUTE(s, KBUF(0), VBUF(0)) LDS_BAR(); }
                }
#undef CMP_FETCH
#undef CMP_COMPUTE
                float l = lp; l += __shfl_xor(l, 16); l += __shfl_xor(l, 32); inv = l > 0.f ? 1.0f / l : 0.f;
                if (q == 0) { invl[w * 16 + l15] = inv; myslab[l15 * SLAB_LD + 16 * nst] = carry; }
            }
            const float gi = g0 * inv;
#pragma unroll
            for (int dt = 0; dt < 4; ++dt) { ot[dt][0] = gi * acc[dt][0]; ot[dt][1] = gi * acc[dt][1]; ot[dt][2] = gi * acc[dt][2]; ot[dt][3] = gi * acc[dt][3]; }
        }
        LDS_BAR();
#ifndef SELN_REP
#define SELN_REP 1
#endif
        unsigned u0 = 0, u1 = 0, u2 = 0, u3 = 0, am0 = 0, am1 = 0, am2 = 0, am3 = 0;
#pragma unroll 1
        for (int rep3_ = 0; rep3_ < SELN_REP; ++rep3_) {
#pragma unroll 1
        for (int tt = 0; tt < 2; ++tt) {
            const int tok = 2 * w + tt;
            float s0 = 0.f, s1 = 0.f;
#pragma unroll
            for (int ww = 0; ww < 8; ++ww) { const float il = invl[ww * 16 + tok]; s0 += slab[(ww * 16 + tok) * SLAB_LD + lane] * il; s1 += slab[(ww * 16 + tok) * SLAB_LD + lane + 64] * il; }
            const int j0 = lane, j1 = lane + 64;
            const bool v0 = j0 <= qblk, v1 = j1 <= qblk;
            const bool f0 = (j0 == 0) || (j0 == qblk) || (j0 == qblk - 1), f1 = (j1 == qblk) || (j1 == qblk - 1);
            const unsigned k0 = f0 ? 0x7f000000u : __float_as_uint(s0), k1 = f1 ? 0x7f000000u : __float_as_uint(s1);
            unsigned Tk = 0u;
#pragma unroll 1
            for (int bit = 30; bit >= 0; --bit) { const unsigned trial = Tk | (1u << bit);
                const int c = __popcll(__ballot(v0 && k0 >= trial)) + __popcll(__ballot(v1 && k1 >= trial)); if (c >= 16) Tk = trial; }
            const bool gt0 = v0 && k0 > Tk, gt1 = v1 && k1 > Tk, eq0 = v0 && k0 == Tk, eq1 = v1 && k1 == Tk;
            const unsigned long long mq0 = __ballot(eq0), mq1 = __ballot(eq1);
            const int need = 16 - (__popcll(__ballot(gt0)) + __popcll(__ballot(gt1)));
            const unsigned long long lt = (1ull << lane) - 1ull;
            const int r0 = __popcll(mq0 & lt), r1 = __popcll(mq0) + __popcll(mq1 & lt);
            const unsigned long long m0 = __ballot(gt0 || (eq0 && r0 < need)), m1 = __ballot(gt1 || (eq1 && r1 < need));
            if (lane == 0) { selm[tok * 4 + 0] = (unsigned)m0; selm[tok * 4 + 1] = (unsigned)(m0 >> 32); selm[tok * 4 + 2] = (unsigned)m1; selm[tok * 4 + 3] = (unsigned)(m1 >> 32); }
        }
        LDS_BAR();
        unsigned om = selm[lane], am = om;
        om |= __shfl_xor(om, 4); om |= __shfl_xor(om, 8); om |= __shfl_xor(om, 16); om |= __shfl_xor(om, 32);
        am &= __shfl_xor(am, 4); am &= __shfl_xor(am, 8); am &= __shfl_xor(am, 16); am &= __shfl_xor(am, 32);
        u0 = __builtin_amdgcn_readlane(om, 0); u1 = __builtin_amdgcn_readlane(om, 1); u2 = __builtin_amdgcn_readlane(om, 2); u3 = __builtin_amdgcn_readlane(om, 3);
        am0 = __builtin_amdgcn_readlane(am, 0); am1 = __builtin_amdgcn_readlane(am, 1); am2 = __builtin_amdgcn_readlane(am, 2); am3 = __builtin_amdgcn_readlane(am, 3);
        if (tid < 128) { const int wd = tid >> 5, bt = tid & 31;
            const unsigned uw = wd == 0 ? u0 : wd == 1 ? u1 : wd == 2 ? u2 : u3;
            if ((uw >> bt) & 1u) { const int pos = (wd > 0 ? __popc(u0) : 0) + (wd > 1 ? __popc(u1) : 0) + (wd > 2 ? __popc(u2) : 0) + __popc(uw & ((1u << bt) - 1u)); blist[pos] = (unsigned)tid; } }
        if (SELN_REP > 1) LDS_BAR();
        }
        const int nsel = __popc(u0) + __popc(u1) + __popc(u2) + __popc(u3);
        LDS_BAR();
#ifndef SEL_REP
#define SEL_REP 1
#endif
#pragma unroll 1
        for (int rep2_ = 0; rep2_ < SEL_REP; ++rep2_) {
            const bf16* kb = Y1 + (size_t)b * T * OINP + 1280 + g * 64; const bf16* vt = VST + (size_t)(b * 2 + g) * 64 * T;
            float lp = 0.f; f32x4 acc[4];
#pragma unroll
            for (int dt = 0; dt < 4; ++dt) acc[dt] = (f32x4){0.f, 0.f, 0.f, 0.f};
#define SEL_FETCH(idx, KR, VR) { const int i_ = (idx) < nsel ? (idx) : nsel - 1; const int j_ = (int)__builtin_amdgcn_readfirstlane((int)blist[i_]); tile_fetch(kb + (size_t)(64 * j_) * OINP, OINP, vt + 64 * j_, T, tid, KR, VR); }
#define SEL_COMPUTE(i, KB, VB) { \
                const int j = (int)__builtin_amdgcn_readfirstlane((int)blist[i]); \
                const int wd = j >> 5; const unsigned aw = wd == 0 ? am0 : wd == 1 ? am1 : wd == 2 ? am2 : am3; \
                const int d0 = t - 64 * j - 4 * q; \
                if (((aw >> (j & 31)) & 1u) && j < qblk) tile_step<false>(KB, VB, qf, acc, lp, d0, slope2, 0x7fffffffu, true, l15, q); \
                else { const bool selb = (selm[l15 * 4 + wd] >> (j & 31)) & 1u; tile_step<true>(KB, VB, qf, acc, lp, d0, slope2, 0x7fffffffu, selb, l15, q); } }
            {
                SEL_FETCH(0, kr, vr) tile_store(KBUF(0), VBUF(0), tid, kr, vr); SEL_FETCH(1, kr, vr)
                LDS_BAR();
                int i = 0;
                for (; i + 1 < nsel; i += 2) {
                    SEL_FETCH(i + 2, kr2, vr2) SEL_COMPUTE(i, KBUF(0), VBUF(0)) tile_store(KBUF(1), VBUF(1), tid, kr, vr); LDS_BAR();
                    SEL_FETCH(i + 3, kr, vr) SEL_COMPUTE(i + 1, KBUF(1), VBUF(1)) tile_store(KBUF(0), VBUF(0), tid, kr2, vr2); LDS_BAR();
                }
                if (i < nsel) { SEL_COMPUTE(i, KBUF(0), VBUF(0)) LDS_BAR(); }
            }
#undef SEL_FETCH
#undef SEL_COMPUTE
            float l = lp; l += __shfl_xor(l, 16); l += __shfl_xor(l, 32);
            const float sc = l > 0.f ? g1 * (1.0f / SEL_REP) / l : 0.f;
#pragma unroll
            for (int dt = 0; dt < 4; ++dt) { ot[dt][0] += sc * acc[dt][0]; ot[dt][1] += sc * acc[dt][1]; ot[dt][2] += sc * acc[dt][2]; ot[dt][3] += sc * acc[dt][3]; }
        }
#ifndef WIN_REP
#define WIN_REP 1
#endif
#pragma unroll 1
        for (int rep_ = 0; rep_ < WIN_REP; ++rep_) {
            const bf16* kb = Y1 + (size_t)b * T * OINP + 1536 + g * 64; const bf16* vt = VWT + (size_t)(b * 2 + g) * 64 * T;
            float lp = 0.f; f32x4 acc[4];
#pragma unroll
            for (int dt = 0; dt < 4; ++dt) acc[dt] = (f32x4){0.f, 0.f, 0.f, 0.f};
            int kstart = t0 - 511; kstart = kstart < 0 ? 0 : (kstart & ~63);
            const int nw = ((t0 + 15 - kstart) >> 6) + 1;
#define WIN_FETCH(idx, KR, VR) { const int i_ = (idx) < nw ? (idx) : nw - 1; const int k_ = kstart + 64 * i_; tile_fetch(kb + (size_t)k_ * OINP, OINP, vt + k_, T, tid, KR, VR); }
#define WIN_COMPUTE(i, KB, VB) { \
                const int key0 = kstart + 64 * (i); \
                const int d0 = t - key0 - 4 * q; \
                if (key0 + 63 <= t0 && key0 >= t0 - 496) tile_step<false>(KB, VB, qf, acc, lp, d0, slope2, 512u, true, l15, q); \
                else tile_step<true>(KB, VB, qf, acc, lp, d0, slope2, 512u, true, l15, q); }
            {
                WIN_FETCH(0, kr, vr) tile_store(KBUF(0), VBUF(0), tid, kr, vr); WIN_FETCH(1, kr, vr)
                LDS_BAR();
                int i = 0;
                for (; i + 1 < nw; i += 2) {
                    WIN_FETCH(i + 2, kr2, vr2) WIN_COMPUTE(i, KBUF(0), VBUF(0)) tile_store(KBUF(1), VBUF(1), tid, kr, vr); LDS_BAR();
                    WIN_FETCH(i + 3, kr, vr) WIN_COMPUTE(i + 1, KBUF(1), VBUF(1)) tile_store(KBUF(0), VBUF(0), tid, kr2, vr2); LDS_BAR();
                }
                if (i < nw) { WIN_COMPUTE(i, KBUF(0), VBUF(0)) LDS_BAR(); }
            }
#undef WIN_FETCH
#undef WIN_COMPUTE
            float l = lp; l += __shfl_xor(l, 16); l += __shfl_xor(l, 32);
            const float sc = l > 0.f ? g2 * (1.0f / WIN_REP) / l : 0.f;
#pragma unroll
            for (int dt = 0; dt < 4; ++dt) { ot[dt][0] += sc * acc[dt][0]; ot[dt][1] += sc * acc[dt][1]; ot[dt][2] += sc * acc[dt][2]; ot[dt][3] += sc * acc[dt][3]; }
        }
        bf16* op = MIX + row * D + h * 64 + 4 * q;
#pragma unroll
        for (int dt = 0; dt < 4; ++dt) { u32x2 ow; ow.x = pk2(ot[dt][0], ot[dt][1]); ow.y = pk2(ot[dt][2], ot[dt][3]); *(u32x2*)(op + 16 * dt) = ow; }
    }
#undef KBUF
#undef VBUF
}
struct Args { const float* in[19]; float* out; unsigned char* ws; int ph_lo, ph_hi; };
constexpr int N_PHASES = 18;
template <class Epi>
DI void run_gemm(LAS unsigned char* lds, const bf16* A, const bf16* Bt, int N, int K, const Epi& E) {
    pg8::Gemm g{A, Bt, M, N, K}; pg8::StaticOrder S; S.init(M, N, (int)gridDim.x, (int)blockIdx.x);
    pg8::gemm_phase<Epi, pg8::StaticOrder, true, true>(lds, g, S, E);
}
__global__ void __launch_bounds__(512, 2) mega(Args a) {
    extern __shared__ __attribute__((aligned(16))) unsigned char lds_raw[];
    LAS unsigned char* lds = (LAS unsigned char*)lds_raw;
    cg::grid_group grid = cg::this_grid();
    volatile LAS unsigned* bst = (volatile LAS unsigned*)(lds + 147456 - 64);
    if (threadIdx.x < 2) bst[threadIdx.x] = 0u;
    __syncthreads();
    XcdBarrier xbar = xcd_barrier_post((unsigned*)(a.ws + WS_CTL), bst);
    const int tid = threadIdx.x, lane = tid & 63, wave = __builtin_amdgcn_readfirstlane(tid >> 6);
    const int gw = blockIdx.x * 8 + wave, ngw = gridDim.x * 8;
#define WSP(off) ((bf16*)(a.ws + (off)))
#define W_EIN WSP(WS_EIN)
#define W_EOUT WSP(WS_EOUT)
#define W_OIN WSP(WS_OIN)
#define W_OOUT WSP(WS_OOUT)
#define W_GU WSP(WS_GU)
#define W_DN WSP(WS_DN)
#define W1K WSP(WS_W1K)
#define W1V WSP(WS_W1V)
#define W2K WSP(WS_W2K)
#define W2V WSP(WS_W2V)
#define DEC ((float*)(a.ws + WS_DEC))
#define KCMP WSP(WS_KCMP)
#define VCMPT WSP(WS_VCMPT)
#define Y WSP(WS_Y)
#define VST WSP(WS_VST)
#define VWT WSP(WS_VWT)
#define HN WSP(WS_HN)
#define ST WSP(WS_ST)
#define RS ((float*)(a.ws + WS_RS))
#define HB WSP(WS_HB)
    const int lo = a.ph_lo, hi = a.ph_hi;
#define PH(k) if (lo <= (k) && (k) < hi)
#define SEAM(k) if (lo <= (k) && (k) + 1 < hi && hi > 0) { if ((k) == 0) grid.sync(); else xcd_barrier(xbar); }
    PH(0) {
        LAS float* scr = (LAS float*)(lds + wave * 8448);
        constexpr int I0 = 2048, I1 = 512, I2 = 1024, I3 = 512, I4 = 2816, I5 = 1408, I6 = 64, I7 = 2;
        constexpr int NIT = I0 + I1 + I2 + I3 + 2 * I4 + 2 * I5 + 2 * I6 + 2 * I7;
        for (int it = gw; it < NIT; it += ngw) {
            int r = it;
            if (r < I0) { transpose_item(a.in[4], 1024, EIN, EIN, W_EIN, 0, scr, r, lane); continue; } r -= I0;
            if (r < I1) { transpose_item(a.in[8], 1024, 1024, 1024, W_EOUT, 0, scr, r, lane); continue; } r -= I1;
            if (r < I2) { transpose_item(a.in[9], 1024, OIN, OINP, W_OIN, 0, scr, r, lane, a.in[1] + D); continue; } r -= I2;
            if (r < I3) { transpose_item(a.in[16], 1024, 1024, 1024, W_OOUT, 0, scr, r, lane); continue; } r -= I3;
            if (r < 2 * I4) { const int l = r / I4; transpose_item(a.in[17] + (size_t)l * D * 2 * FF, 1024, 2 * FF, 2 * FF, W_GU + (size_t)l * GU_STRIDE, 1, scr, r % I4, lane, a.in[2] + l * D); continue; } r -= 2 * I4;
            if (r < 2 * I5) { const int l = r / I5; transpose_item(a.in[18] + (size_t)l * FF * D, FF, 1024, 1024, W_DN + (size_t)l * DN_STRIDE, 0, scr, r % I5, lane); continue; } r -= 2 * I5;
            if (r < I6) { transpose_item(a.in[12], 2048, 64, 64, W1K, 0, scr, r, lane); continue; } r -= I6;
            if (r < I6) { transpose_item(a.in[14], 2048, 64, 64, W1V, 0, scr, r, lane); continue; } r -= I6;
            if (r < I7) { transpose_item(a.in[13], 64, 64, 64, W2K, 0, scr, r, lane); continue; } r -= I7;
            transpose_item(a.in[15], 64, 64, 64, W2V, 0, scr, r, lane);
        }
        norm_rows_bf16(a.in[0], a.in[1], HN, gw, ngw, lane);
    }
    SEAM(0);
    PH(1) { EpiStore E{Y, EIN, nullptr}; run_gemm(lds, HN, W_EIN, EIN, 1024, E); }
    SEAM(1);
    PH(2) { la_state_phase(Y, a.in[5], ST, DEC, lds); }
    SEAM(2);
    PH(3) { la_scan_phase(ST, DEC); }
    SEAM(3);
    PH(4) { la_out_phase(Y, a.in[5], ST, a.in[6], a.in[7], HN, lds); }
    SEAM(4);
    PH(5) { EpiResid E{a.in[0], a.out, HB, RS}; run_gemm(lds, HN, W_EOUT, 1024, 1024, E); }
    SEAM(5);
    PH(7) { EpiSwiglu E{Y, RS}; run_gemm(lds, HB, W_GU, 2 * FF, 1024, E); }
    SEAM(7);
    PH(8) { EpiResid E{a.out, a.out, HB, RS + 16 * M}; run_gemm(lds, Y, W_DN, 1024, FF, E); }
    SEAM(8);
    PH(10) { EpiStore E{Y, OINP, RS + 16 * M}; run_gemm(lds, HB, W_OIN, OINP, 1024, E); }
    SEAM(10);
    PH(11) { nsa_compress_phase(Y, a.in[10], a.in[11], W1K, W1V, W2K, W2V, KCMP, VCMPT, lds, gw, ngw, lane); nsa_vt_phase(Y, VST, VWT, gw, ngw, lane); }
    SEAM(11);
    PH(12) { nsa_attn_phase(Y, KCMP, VCMPT, VST, VWT, HN, lds); }
    SEAM(12);
    PH(13) { EpiResid E{a.out, a.out, HB, RS + 32 * M}; run_gemm(lds, HN, W_OOUT, 1024, 1024, E); }
    SEAM(13);
    PH(15) { EpiSwiglu E{Y, RS + 32 * M}; run_gemm(lds, HB, W_GU + GU_STRIDE, 2 * FF, 1024, E); }
    SEAM(15);
    PH(16) { EpiResid E{a.out, a.out, nullptr, nullptr}; run_gemm(lds, Y, W_DN + DN_STRIDE, 1024, FF, E); }
    SEAM(16);
    PH(17) { norm_rows_f32_inplace(a.out, a.in[3], gw, ngw, lane); }
#undef PH
#undef SEAM
}

extern "C" void kernel_launch(void* const* d_in, const int* in_sizes, int n_in, void* d_out, int out_size, void* d_ws, size_t ws_size, hipStream_t stream) {
    static int grid = 0;
    if (grid == 0) {
        if (n_in != 19 || in_sizes[0] != M * D || out_size != M * D || ws_size < WS_END) { fprintf(stderr, "kernel_launch: unexpected shapes (n_in %d, in0 %d, out %d, ws %zu)\n", n_in, n_in > 0 ? in_sizes[0] : -1, out_size, ws_size); grid = -1; return; }
        int dev = 0, cus = 0, per_cu = 0;
        (void)hipGetDevice(&dev); (void)hipDeviceGetAttribute(&cus, hipDeviceAttributeMultiprocessorCount, dev);
        if (hipFuncSetAttribute((const void*)mega, hipFuncAttributeMaxDynamicSharedMemorySize, LDS_BYTES) != hipSuccess) { fprintf(stderr, "kernel_launch: hipFuncSetAttribute failed\n"); grid = -1; return; }
        if (hipOccupancyMaxActiveBlocksPerMultiprocessor(&per_cu, (const void*)mega, 512, LDS_BYTES) != hipSuccess || per_cu < 1) { fprintf(stderr, "kernel_launch: occupancy query says %d\n", per_cu); per_cu = 1; }
        (void)hipGetLastError();
        grid = cus * 1;
    }
    if (grid < 0) return;
    if (hipMemsetAsync((char*)d_ws + WS_CTL, 0, CTL_BYTES, stream) != hipSuccess) { fprintf(stderr, "kernel_launch: memset failed\n"); return; }
    Args a{};
    for (int i = 0; i < 19; ++i) a.in[i] = (const float*)d_in[i];
    a.out = (float*)d_out; a.ws = (unsigned char*)d_ws; a.ph_lo = 0; a.ph_hi = N_PHASES;
    void* args[] = {&a};
    hipError_t e = hipLaunchCooperativeKernel((const void*)mega, dim3(grid), dim3(512), args, LDS_BYTES, stream);
    if (e != hipSuccess) fprintf(stderr, "kernel_launch: cooperative launch failed: %s (grid %d)\n", hipGetErrorString(e), grid);
#ifdef PROBE_PHASES
    { const int pp[] = {PROBE_PHASES};
      for (unsigned i = 0; i < sizeof(pp) / sizeof(pp[0]); ++i) { a.ph_lo = pp[i]; a.ph_hi = pp[i] + 1; (void)hipLaunchCooperativeKernel((const void*)mega, dim3(grid), dim3(512), args, LDS_BYTES, stream); } }
#endif
}
```

```cpp
#include <hip/hip_runtime.h>
#include <hip/hip_cooperative_groups.h>
#include <cstdio>
#include <cstdint>
namespace cg = cooperative_groups;
namespace pg8 {
#define PG8_LAS __attribute__((address_space(3)))
typedef unsigned short bf16_t;
typedef short bf16x8 __attribute__((ext_vector_type(8)));
typedef float f32x4 __attribute__((ext_vector_type(4)));
typedef unsigned u32x4 __attribute__((ext_vector_type(4)));
constexpr int BM = 256, BK = 64, HALF = 128, HTB = HALF * BK * 2  , STAGE_BYTES = 8 * HTB, NXCD = 8, WGM = 8;

__host__ __device__ __forceinline__ int lds_byte(int r, int c) { const int st = (r >> 4) * 2 + (c >> 5), rr = r & 15, cc = c & 31, ob = rr * 64 + cc * 2; return st * 1024 + (ob ^ (((ob >> 9) & 1) << 5)); }
__host__ __device__ __forceinline__ void stage_rc(int b, int& R, int& C) { const int st = b / 1024, sb = b % 1024, swz = sb ^ (((sb >> 9) & 1) << 5); R = (st >> 1) * 16 + swz / 64; C = (st & 1) * 32 + (swz % 64) / 2; }
__host__ __device__ __forceinline__ int perm32(int rho) { const int n = rho >> 4, i = rho & 15; return 8 * (i >> 2) + 4 * n + (i & 3); }

struct Unit { int pm, pn; };
struct Gemm { const bf16_t* A; const bf16_t* Bt; int M, N, K; };

struct StaticOrder {
    int nM, nN, nwg, G, c;
    __host__ __device__ void init(int M, int N, int G_, int c_) { nM = M / BM; nN = N / BM; nwg = nM * nN; G = G_; c = c_; }
    __host__ __device__ bool next(int i, Unit& u) const {
        const long L = (long)i * G + c; if (L >= nwg) return false;
        int wgid = (int)L; { const int q = nwg / NXCD, r = nwg % NXCD, xcd = wgid % NXCD, off = wgid / NXCD; wgid = (xcd < r ? xcd * (q + 1) : r * (q + 1) + (xcd - r) * q) + off; }
        const int nig = WGM * nN, gid = wgid / nig, fm = gid * WGM, gsz = (nM - fm) < WGM ? (nM - fm) : WGM;
        u.pm = fm + ((wgid % nig) % gsz); u.pn = (wgid % nig) / gsz; return true;
    }
    __device__ __forceinline__ void a_ready(const Unit&) const {}
    __device__ __forceinline__ void done(const Unit&) const {}
};

__device__ __forceinline__ unsigned cvt_pk_bf16(float lo, float hi) { unsigned r; asm volatile("v_cvt_pk_bf16_f32 %0, %1, %2" : "=v"(r) : "v"(lo), "v"(hi)); return r; }
template <class Epi, class Sched, bool ALIGN_EPI = false, bool SP2 = false>
__device__ __forceinline__ void gemm_phase(PG8_LAS unsigned char* lds, const Gemm g, const Sched& S, const Epi& E) {
    const int tid = threadIdx.x, wid = __builtin_amdgcn_readfirstlane(tid >> 6), lane = tid & 63, wr = wid >> 2, wc = wid & 3, fr = lane & 15, fq = lane >> 4;
    const int K = g.K, nt = K / BK;
    unsigned voffA[2], voffB[2];
#pragma unroll
    for (int i = 0; i < 2; ++i) { int R, C; stage_rc(tid * 16 + i * 8192, R, C); const int Rb = Epi::PERM ? ((R & ~31) + perm32(R & 31)) : R;
        voffA[i] = (unsigned)(R * K + C) * 2u; voffB[i] = (unsigned)(Rb * K + C) * 2u; }
    const size_t kstep = (size_t)(BK * 2);
    const size_t hstep = (size_t)HALF * K * 2;
    const size_t tstep = 2 * hstep;
    const unsigned ldsw = (unsigned)wid * 1024u;
    const int aoff = lds_byte(wr * 64 + fr, fq * 8), boff = lds_byte(wc * 32 + fr, fq * 8);
#define PG8_SA(b, h) (((b) * 2 + (h)) * HTB)
#define PG8_SB(b, h) ((4 + (b) * 2 + (h)) * HTB)
#define PG8_STAGE(bufoff, gbase, voff) do { _Pragma("unroll") for (int _i = 0; _i < 2; ++_i) \
        __builtin_amdgcn_global_load_lds((const unsigned*)((const char*)(gbase) + (voff)[_i]), (PG8_LAS unsigned*)(lds + (bufoff) + ldsw + _i * 8192), 16, 0, 0); } while (0)
#define PG8_LDA(dst, b, h) do { _Pragma("unroll") for (int m = 0; m < 4; ++m) _Pragma("unroll") for (int k = 0; k < 2; ++k) dst[m][k] = *(const PG8_LAS bf16x8*)(lds + PG8_SA(b, h) + aoff + m * 2048 + k * 1024); } while (0)
#define PG8_LDB(dst, b, h) do { _Pragma("unroll") for (int n = 0; n < 2; ++n) _Pragma("unroll") for (int k = 0; k < 2; ++k) dst[n][k] = *(const PG8_LAS bf16x8*)(lds + PG8_SB(b, h) + boff + n * 2048 + k * 1024); } while (0)
#define PG8_MMA(ai, bj, At, Bt) do { __builtin_amdgcn_s_setprio(1); _Pragma("unroll") for (int m = 0; m < 4; ++m) _Pragma("unroll") for (int n = 0; n < 2; ++n) _Pragma("unroll") for (int k = 0; k < 2; ++k) \
        acc[ai][bj][m][n] = __builtin_amdgcn_mfma_f32_16x16x32_bf16(Bt[n][k], At[m][k], acc[ai][bj][m][n], 0, 0, 0); __builtin_amdgcn_s_setprio(0); } while (0)
#define PG8_WAIT_V(n) asm volatile("s_waitcnt vmcnt(" #n ")" ::: "memory")
#define PG8_WAIT_L(n) asm volatile("s_waitcnt lgkmcnt(" #n ")" ::: "memory")
#define PG8_BAR __builtin_amdgcn_s_barrier()
#define PG8_SCHED __builtin_amdgcn_sched_barrier(0)
    Unit cur, nxt; int ui = 0;
    if (!S.next(0, cur)) return;
    f32x4 acc[2][2][4][2];
#pragma unroll
    for (int a = 0; a < 2; ++a)
#pragma unroll
        for (int b = 0; b < 2; ++b)
#pragma unroll
            for (int m = 0; m < 4; ++m)
#pragma unroll
                for (int n = 0; n < 2; ++n) acc[a][b][m][n] = (f32x4){0.f, 0.f, 0.f, 0.f};
    bf16x8 At[4][2], B0[2][2], B1[2][2];
    const char* cA = (const char*)g.A + (size_t)cur.pm * tstep; const char* cB = (const char*)g.Bt + (size_t)cur.pn * tstep;
    S.a_ready(cur);
    if constexpr (SP2) {
        PG8_STAGE(PG8_SB(0, 0), cB, voffB); PG8_STAGE(PG8_SB(0, 1), cB + hstep, voffB); PG8_STAGE(PG8_SA(0, 0), cA, voffA); PG8_STAGE(PG8_SA(0, 1), cA + hstep, voffA);
        if (wr == 1) PG8_BAR;
        PG8_WAIT_V(2); PG8_BAR;
        PG8_STAGE(PG8_SB(1, 0), cB + kstep, voffB); PG8_STAGE(PG8_SA(1, 0), cA + kstep, voffA); PG8_STAGE(PG8_SB(1, 1), cB + hstep + kstep, voffB);
        PG8_WAIT_V(6); PG8_BAR;
    } else {
        PG8_STAGE(PG8_SB(0, 0), cB, voffB); PG8_STAGE(PG8_SA(0, 0), cA, voffA); PG8_STAGE(PG8_SB(0, 1), cB + hstep, voffB); PG8_STAGE(PG8_SA(0, 1), cA + hstep, voffA);
        if (wr == 1) PG8_BAR;
        PG8_WAIT_V(4); PG8_BAR;
        PG8_STAGE(PG8_SB(1, 0), cB + kstep, voffB); PG8_STAGE(PG8_SA(1, 0), cA + kstep, voffA); PG8_STAGE(PG8_SB(1, 1), cB + hstep + kstep, voffB);
        PG8_WAIT_V(6); PG8_BAR;
    }
    for (;;) {
        const bool has_next = S.next(ui + 1, nxt);
        const char* nA = has_next ? (const char*)g.A + (size_t)nxt.pm * tstep : cA; const char* nB = has_next ? (const char*)g.Bt + (size_t)nxt.pn * tstep : cB;
        for (int t = 0; t < nt; t += 2) {
            const bool last = (t == nt - 2);
            const char* a1 = cA + (size_t)(t + 1) * kstep;
            const char* a2 = last ? nA : cA + (size_t)(t + 2) * kstep; const char* b2 = last ? nB : cB + (size_t)(t + 2) * kstep;
            const char* a3 = a2 + kstep; const char* b3 = b2 + kstep;
            if (last && has_next) S.a_ready(nxt);
            if constexpr (SP2) {
            PG8_LDB(B0, 0, 0); PG8_LDB(B1, 0, 1); PG8_SCHED; PG8_LDA(At, 0, 0); PG8_STAGE(PG8_SA(1, 1), a1 + hstep, voffA);
            PG8_WAIT_V(8); PG8_WAIT_L(0); PG8_BAR; PG8_MMA(0, 0, At, B0); PG8_MMA(0, 1, At, B1); PG8_BAR; PG8_SCHED;
            PG8_LDA(At, 0, 1); PG8_STAGE(PG8_SB(0, 0), b2, voffB); PG8_STAGE(PG8_SB(0, 1), b2 + hstep, voffB); PG8_STAGE(PG8_SA(0, 0), a2, voffA);
            PG8_WAIT_V(8); PG8_WAIT_L(0); PG8_BAR; PG8_MMA(1, 0, At, B0); PG8_MMA(1, 1, At, B1); PG8_BAR; PG8_SCHED;
            PG8_LDB(B0, 1, 0); PG8_LDB(B1, 1, 1); PG8_SCHED; PG8_LDA(At, 1, 0); PG8_STAGE(PG8_SA(0, 1), a2 + hstep, voffA);
            PG8_WAIT_V(8); PG8_WAIT_L(0); PG8_BAR; PG8_MMA(0, 0, At, B0); PG8_MMA(0, 1, At, B1); PG8_BAR; PG8_SCHED;
            PG8_LDA(At, 1, 1); PG8_STAGE(PG8_SB(1, 0), b3, voffB); PG8_STAGE(PG8_SB(1, 1), b3 + hstep, voffB); PG8_STAGE(PG8_SA(1, 0), a3, voffA);
            PG8_WAIT_V(8); PG8_WAIT_L(0); PG8_BAR; PG8_MMA(1, 0, At, B0); PG8_MMA(1, 1, At, B1); PG8_BAR; PG8_SCHED;
            } else {
            PG8_LDB(B0, 0, 0); PG8_SCHED; PG8_LDA(At, 0, 0); PG8_STAGE(PG8_SA(1, 1), a1 + hstep, voffA);
            PG8_WAIT_L(8); PG8_BAR; PG8_WAIT_L(0); PG8_MMA(0, 0, At, B0); PG8_BAR; PG8_SCHED;
            PG8_LDB(B1, 0, 1); PG8_STAGE(PG8_SB(0, 0), b2, voffB);
            PG8_BAR; PG8_WAIT_L(0); PG8_MMA(0, 1, At, B1); PG8_BAR;
            PG8_LDA(At, 0, 1); PG8_STAGE(PG8_SA(0, 0), a2, voffA);
            PG8_BAR; PG8_WAIT_L(0); PG8_MMA(1, 0, At, B0); PG8_BAR; PG8_SCHED;
            PG8_STAGE(PG8_SB(0, 1), b2 + hstep, voffB);
            PG8_WAIT_V(6); PG8_BAR; PG8_MMA(1, 1, At, B1); PG8_BAR;
            PG8_LDB(B0, 1, 0); PG8_SCHED; PG8_LDA(At, 1, 0); PG8_STAGE(PG8_SA(0, 1), a2 + hstep, voffA);
            PG8_WAIT_L(8); PG8_BAR; PG8_WAIT_L(0); PG8_MMA(0, 0, At, B0); PG8_BAR; PG8_SCHED;
            PG8_LDB(B1, 1, 1); PG8_STAGE(PG8_SB(1, 0), b3, voffB);
            PG8_BAR; PG8_WAIT_L(0); PG8_MMA(0, 1, At, B1); PG8_BAR;
            PG8_LDA(At, 1, 1); PG8_STAGE(PG8_SA(1, 0), a3, voffA);
            PG8_BAR; PG8_WAIT_L(0); PG8_MMA(1, 0, At, B0); PG8_BAR; PG8_SCHED;
            PG8_STAGE(PG8_SB(1, 1), b3 + hstep, voffB);
            PG8_WAIT_V(6); PG8_BAR; PG8_MMA(1, 1, At, B1); PG8_BAR;
            }
        }
        if constexpr (ALIGN_EPI) { if (wr == 0) PG8_BAR; }
        if constexpr (!Epi::AFTER_DRAIN) { E(acc, cur, wr, wc, fr, fq); S.done(cur); }
        if (!has_next) break;
#pragma unroll
        for (int a = 0; a < 2; ++a)
#pragma unroll
            for (int b = 0; b < 2; ++b)
#pragma unroll
                for (int m = 0; m < 4; ++m)
#pragma unroll
                    for (int n = 0; n < 2; ++n) acc[a][b][m][n] = (f32x4){0.f, 0.f, 0.f, 0.f};
        cur = nxt; cA = nA; cB = nB; ++ui;
        if constexpr (ALIGN_EPI) { if (wr == 1) PG8_BAR; }
    }
    PG8_WAIT_V(0);
    if constexpr (!ALIGN_EPI) { if (wr == 0) PG8_BAR; }
    PG8_BAR;
    if constexpr (Epi::AFTER_DRAIN) { E.fused(acc, cur, wr, wc, fr, fq, lds, wid, lane); S.done(cur); }
#undef PG8_SA
#undef PG8_SB
#undef PG8_STAGE
#undef PG8_LDA
#undef PG8_LDB
#undef PG8_MMA
#undef PG8_WAIT_V
#undef PG8_WAIT_L
#undef PG8_BAR
#undef PG8_SCHED
}
}
#define GAS __attribute__((address_space(1)))
#define LAS __attribute__((address_space(3)))
#define DI __device__ __forceinline__
typedef unsigned short bf16;
typedef short bf16x8 __attribute__((ext_vector_type(8)));
typedef short s16x4 __attribute__((ext_vector_type(4)));
typedef float f32x4 __attribute__((ext_vector_type(4)));
typedef float f32x2 __attribute__((ext_vector_type(2)));
typedef unsigned u32x4 __attribute__((ext_vector_type(4)));
typedef unsigned u32x2 __attribute__((ext_vector_type(2)));
typedef __bf16 bf16x2_t __attribute__((ext_vector_type(2)));
#define MFMA16(a, b, c) __builtin_amdgcn_mfma_f32_16x16x32_bf16((a), (b), (c), 0, 0, 0)

constexpr int NB = 4, T = 8192, D = 1024, M = NB * T, FF = 2816;
constexpr int EIN = 4096, OIN = 1840, OINP = 2048;
constexpr float RMS_EPS = 1e-6f, LOG2E = 1.4426950408889634f;
constexpr size_t MiB = 1u << 20;
constexpr size_t WS_EIN = 0, WS_EOUT = 8 * MiB, WS_OIN = 10 * MiB, WS_OOUT = 14 * MiB, WS_GU = 16 * MiB, WS_DN = 38 * MiB;
constexpr size_t WS_W1K = 49 * MiB, WS_W1V = WS_W1K + 256 * 1024, WS_W2K = WS_W1V + 256 * 1024, WS_W2V = WS_W2K + 8192;
constexpr size_t WS_CTL = 56 * MiB, CTL_BYTES = 16384, WS_RS = 57 * MiB;
constexpr size_t WS_DEC = 52 * MiB, WS_KCMP = 54 * MiB, WS_VCMPT = WS_KCMP + 512 * 1024;
constexpr size_t WS_Y = 64 * MiB;
constexpr size_t WS_VST = 192 * MiB, WS_VWT = 200 * MiB, WS_HB = 240 * MiB;
constexpr size_t WS_HN = 320 * MiB, WS_ST = 384 * MiB, WS_END = 512 * MiB;
constexpr size_t GU_STRIDE = (size_t)2 * FF * D, DN_STRIDE = (size_t)D * FF;
constexpr int LDS_BYTES = 147456;

DI unsigned pk2(float lo, float hi) { f32x2 v = {lo, hi}; return __builtin_bit_cast(unsigned, __builtin_convertvector(v, bf16x2_t)); }
DI bf16 f2bf(float f) { return (bf16)(pk2(f, 0.f) & 0xffffu); }
DI float bf2f(bf16 x) { return __uint_as_float(((unsigned)x) << 16); }
DI float bflo(unsigned w) { return __uint_as_float(w << 16); }
DI float bfhi(unsigned w) { return __uint_as_float(w & 0xffff0000u); }
DI float wave_sum(float v) {
#pragma unroll
    for (int o = 1; o < 64; o <<= 1) v += __shfl_xor(v, o);
    return v;
}
DI float ex2(float x) { return __builtin_amdgcn_exp2f(x); }
DI float sigmoidf_(float x) { return __builtin_amdgcn_rcpf(1.0f + __expf(-x)); }
DI float siluf_(float x) { return x * __builtin_amdgcn_rcpf(1.0f + __expf(-x)); }

DI float rowscale(const float* rs, int row, int fq) {
    const f32x4 p = *(const f32x4*)(rs + (size_t)row * 16 + 4 * fq);
    float s = (p.x + p.y) + (p.z + p.w); s += __shfl_xor(s, 16); s += __shfl_xor(s, 32);
    return rsqrtf(s * (1.f / D) + RMS_EPS);
}
struct EpiStore {
    static constexpr bool PERM = true, AFTER_DRAIN = false;
    bf16* O; int ldc; const float* rs;
    DI void operator()(const pg8::f32x4 (&acc)[2][2][4][2], const pg8::Unit& u, int wr, int wc, int fr, int fq) const {
        const int row0 = u.pm * 256 + wr * 64 + fr, col0 = u.pn * 256 + wc * 32 + 8 * fq;
#pragma unroll
        for (int ai = 0; ai < 2; ++ai)
#pragma unroll
            for (int m = 0; m < 4; ++m) { const int row = row0 + ai * 128 + m * 16; bf16* rowp = O + (size_t)row * ldc + col0;
                const float r = rs ? rowscale(rs, row, fq) : 1.f;
#pragma unroll
                for (int bj = 0; bj < 2; ++bj) { const pg8::f32x4 v0 = acc[ai][bj][m][0] * r, v1 = acc[ai][bj][m][1] * r;
                    u32x4 w; w.x = pk2(v0[0], v0[1]); w.y = pk2(v0[2], v0[3]); w.z = pk2(v1[0], v1[1]); w.w = pk2(v1[2], v1[3]);
                    *(u32x4*)(rowp + bj * 128) = w; } }
    }
};
struct EpiStoreLA {
    static constexpr bool PERM = true, AFTER_DRAIN = false;
    bf16* O;
    DI void operator()(const pg8::f32x4 (&acc)[2][2][4][2], const pg8::Unit& u, int wr, int wc, int fr, int fq) const {
        const int row0 = u.pm * 256 + wr * 64 + fr, col0 = u.pn * 256 + wc * 32 + 8 * fq;
#pragma unroll
        for (int ai = 0; ai < 2; ++ai)
#pragma unroll
            for (int m = 0; m < 4; ++m) { const int row = row0 + ai * 128 + m * 16; const int bb = row >> 13, n = (row >> 6) & 127, r = row & 63;
#pragma unroll
                for (int bj = 0; bj < 2; ++bj) { const int col = col0 + bj * 128; const int arr = (col >> 9) & 3, hh = ((col >> 11) << 2) | ((col >> 7) & 3), c = col & 127;
                    const pg8::f32x4 v0 = acc[ai][bj][m][0], v1 = acc[ai][bj][m][1];
                    u32x4 w; w.x = pk2(v0[0], v0[1]); w.y = pk2(v0[2], v0[3]); w.z = pk2(v1[0], v1[1]); w.w = pk2(v1[2], v1[3]);
                    *(u32x4*)(O + ((size_t)((((bb * 8 + hh) * 128 + n) * 4 + arr)) << 13) + r * 128 + c) = w; } }
    }
};
struct EpiSwiglu {
    static constexpr bool PERM = true, AFTER_DRAIN = false;
    bf16* O; const float* rs;
    DI void operator()(const pg8::f32x4 (&acc)[2][2][4][2], const pg8::Unit& u, int wr, int wc, int fr, int fq) const {
        const int row0 = u.pm * 256 + wr * 64 + fr, col0 = u.pn * 128 + wc * 32 + 8 * fq;
#pragma unroll
        for (int ai = 0; ai < 2; ++ai)
#pragma unroll
            for (int m = 0; m < 4; ++m) { const int row = row0 + ai * 128 + m * 16; bf16* rowp = O + (size_t)row * FF + col0;
                const float rsc = rowscale(rs, row, fq);
                float r[8];
#pragma unroll
                for (int n = 0; n < 2; ++n)
#pragma unroll
                    for (int e = 0; e < 4; ++e) { const float g = acc[ai][0][m][n][e] * rsc, up = acc[ai][1][m][n][e] * rsc; r[n * 4 + e] = g * __builtin_amdgcn_rcpf(1.0f + __expf(-g)) * up; }
                u32x4 w; w.x = pk2(r[0], r[1]); w.y = pk2(r[2], r[3]); w.z = pk2(r[4], r[5]); w.w = pk2(r[6], r[7]);
                *(u32x4*)rowp = w; }
    }
};
struct EpiResid {
    static constexpr bool PERM = false, AFTER_DRAIN = false;
    const float* base; float* out; bf16* hb; float* rs;
    DI void operator()(const pg8::f32x4 (&acc)[2][2][4][2], const pg8::Unit& u, int wr, int wc, int fr, int fq) const {
        const int row0 = u.pm * 256 + wr * 64 + fr, col0 = u.pn * 256 + wc * 32 + 4 * fq;
#pragma unroll
        for (int ai = 0; ai < 2; ++ai)
#pragma unroll
            for (int m = 0; m < 4; ++m) { const int row = row0 + ai * 128 + m * 16; const size_t off = (size_t)row * D + col0; float ss = 0.f;
#pragma unroll
                for (int bj = 0; bj < 2; ++bj)
#pragma unroll
                    for (int n = 0; n < 2; ++n) { const f32x4 bs = *(const f32x4*)(base + off + bj * 128 + n * 16); const pg8::f32x4 a = acc[ai][bj][m][n];
                        f32x4 o; o.x = bs.x + a[0]; o.y = bs.y + a[1]; o.z = bs.z + a[2]; o.w = bs.w + a[3]; *(f32x4*)(out + off + bj * 128 + n * 16) = o;
                        if (hb) { u32x2 hw; hw.x = pk2(o.x, o.y); hw.y = pk2(o.z, o.w); *(u32x2*)(hb + off + bj * 128 + n * 16) = hw; ss += (o.x * o.x + o.y * o.y) + (o.z * o.z + o.w * o.w); } }
                if (hb) { ss += __shfl_xor(ss, 16); ss += __shfl_xor(ss, 32); if (fq == 0) rs[(size_t)row * 16 + u.pn * 4 + wc] = ss; } }
    }
};

DI void transpose_item(const float* W, int K, int N, int Npad, bf16* WT, int mode, LAS float* scr, int item, int lane, const float* gk = nullptr) {
    const int nblk = Npad / 32, kb = item / nblk, nb = item % nblk, k0 = 64 * kb, n0 = 32 * nb;
    const int nl = n0 + (lane & 31);
#pragma unroll 8
    for (int i = 0; i < 32; ++i) { const int kk = 2 * i + (lane >> 5); const float gv = gk ? gk[k0 + kk] : 1.f; scr[kk * 33 + (lane & 31)] = (nl < N) ? W[(size_t)(k0 + kk) * N + nl] * gv : 0.f; }
    asm volatile("s_waitcnt lgkmcnt(0)" ::: "memory");
    const int c = lane & 7;
    int drow0 = n0;
    if (mode == 1) { drow0 = (n0 < FF) ? (256 * (n0 >> 7) + (n0 & 127)) : (256 * ((n0 - FF) >> 7) + 128 + ((n0 - FF) & 127)); }
#pragma unroll
    for (int j = 0; j < 4; ++j) { const int n = (lane >> 3) + 8 * j; const LAS float* s = scr + (8 * c) * 33 + n;
        u32x4 o; o.x = pk2(s[0 * 33], s[1 * 33]); o.y = pk2(s[2 * 33], s[3 * 33]); o.z = pk2(s[4 * 33], s[5 * 33]); o.w = pk2(s[6 * 33], s[7 * 33]);
        *(u32x4*)(WT + (size_t)(drow0 + n) * K + k0 + 8 * c) = o; }
    asm volatile("s_waitcnt lgkmcnt(0)" ::: "memory");
}
DI void norm_rows_bf16(const float* h, const float* g, bf16* out, int gw, int ngw, int lane) {
    f32x4 gv[4];
#pragma unroll
    for (int j = 0; j < 4; ++j) gv[j] = *((const f32x4*)g + lane + 64 * j);
    for (int m = gw; m < M; m += ngw) {
        const f32x4* xr = (const f32x4*)(h + (size_t)m * D) + lane; f32x4 v[4]; float s = 0.f;
#pragma unroll
        for (int j = 0; j < 4; ++j) { v[j] = xr[64 * j]; s += (v[j].x * v[j].x + v[j].y * v[j].y) + (v[j].z * v[j].z + v[j].w * v[j].w); }
        const float r = rsqrtf(wave_sum(s) * (1.f / D) + RMS_EPS);
        u32x2* o8 = (u32x2*)(out + (size_t)m * D) + lane;
#pragma unroll
        for (int j = 0; j < 4; ++j) { u32x2 w; w.x = pk2(v[j].x * r * gv[j].x, v[j].y * r * gv[j].y); w.y = pk2(v[j].z * r * gv[j].z, v[j].w * r * gv[j].w); o8[64 * j] = w; }
    }
}
DI void norm_rows_f32_inplace(float* h, const float* g, int gw, int ngw, int lane) {
    f32x4 gv[4];
#pragma unroll
    for (int j = 0; j < 4; ++j) gv[j] = *((const f32x4*)g + lane + 64 * j);
    for (int m = gw; m < M; m += ngw) {
        f32x4* xr = (f32x4*)(h + (size_t)m * D) + lane; f32x4 v[4]; float s = 0.f;
#pragma unroll
        for (int j = 0; j < 4; ++j) { v[j] = xr[64 * j]; s += (v[j].x * v[j].x + v[j].y * v[j].y) + (v[j].z * v[j].z + v[j].w * v[j].w); }
        const float r = rsqrtf(wave_sum(s) * (1.f / D) + RMS_EPS);
#pragma unroll
        for (int j = 0; j < 4; ++j) { f32x4 o; o.x = v[j].x * r * gv[j].x; o.y = v[j].y * r * gv[j].y; o.z = v[j].z * r * gv[j].z; o.w = v[j].w * r * gv[j].w; xr[64 * j] = o; }
    }
}
typedef GAS unsigned gu32;
#define XB_TMO      128
#define XB_XCNT(j)  (256  + 64 * (j))
#define XB_XSUB(j)  (1280 + 64 * (j))
#define XB_XGEN(j)  (2304 + 64 * (j))
#define XB_TOP      3328
#define XB_TOPGEN   3392
#define XCD_BAR_WORDS 3456
#define XB_SPIN_CAP (1u << 18)

__device__ __forceinline__ unsigned xb_ld(unsigned* p)              { return __hip_atomic_load(p, __ATOMIC_RELAXED, __HIP_MEMORY_SCOPE_AGENT); }
__device__ __forceinline__ unsigned xb_add(unsigned* p, unsigned v) { return __hip_atomic_fetch_add(p, v, __ATOMIC_RELAXED, __HIP_MEMORY_SCOPE_AGENT); }
__device__ __forceinline__ unsigned xb_xcc_id() { return (unsigned)__builtin_amdgcn_s_getreg((3 << 11) | 20) & 0xFu; }
#define XB_SPIN(cond, bar) do { unsigned _sp = 0; while (cond) { __builtin_amdgcn_s_sleep(1); \
    if ((++_sp & 255u) == 0u) { if (xb_ld(&(bar)[XB_TMO])) break; if (_sp > XB_SPIN_CAP) { atomicAdd(&(bar)[XB_TMO], 1u); break; } } } } while (0)

struct XcdBarrier {
    unsigned* bar; unsigned x;
    volatile LAS unsigned* st;
};

__device__ __forceinline__ XcdBarrier xcd_barrier_post(unsigned* bar, volatile LAS unsigned* st) {
    XcdBarrier b; b.bar = bar; b.x = xb_xcc_id(); b.st = st;
    if (threadIdx.x == 0) (void)xb_add(&bar[XB_XCNT(b.x)], 1u);
    return b;
}
__device__ __forceinline__ void xcd_barrier_complete(unsigned* bar, unsigned x, unsigned& nloc, unsigned& nx) {
    const unsigned G = gridDim.x * gridDim.y * gridDim.z;
    unsigned sum, cnt, mine, sp = 0u;
    for (;;) {
        sum = 0u; cnt = 0u; mine = 0u;
#pragma unroll
        for (unsigned j = 0; j < 16; ++j) { const unsigned c = xb_ld(&bar[XB_XCNT(j)]); sum += c; cnt += (c > 0u) ? 1u : 0u; mine = (j == x) ? c : mine; }
        if (sum == G) break;
        __builtin_amdgcn_s_sleep(1);
        if ((++sp & 255u) == 0u) { if (xb_ld(&bar[XB_TMO])) break; if (sp > XB_SPIN_CAP) { atomicAdd(&bar[XB_TMO], 1u); break; } }
    }
    nloc = mine > 0u ? mine : 1u; nx = cnt > 0u ? cnt : 1u;
}

__device__ __forceinline__ void xcd_barrier(const XcdBarrier& b) {
    asm volatile("s_waitcnt vmcnt(0)" ::: "memory");
    __syncthreads();
    if (threadIdx.x == 0) {
        unsigned* bar = b.bar;
        __builtin_amdgcn_s_waitcnt(0);
        unsigned nloc = b.st[0], nx = b.st[1];
        if (nloc == 0u) { xcd_barrier_complete(bar, b.x, nloc, nx); b.st[0] = nloc; b.st[1] = nx; }
        const unsigned old = xb_add(&bar[XB_XSUB(b.x)], 1u);
        const unsigned gen = old / nloc;
        if (old + 1u == (gen + 1u) * nloc) {
            __builtin_amdgcn_fence(__ATOMIC_RELEASE, "agent");
            asm volatile("s_waitcnt vmcnt(0)" ::: "memory");
            const unsigned og = xb_add(&bar[XB_TOP], 1u);
            const unsigned tg = og / nx;
            if (og + 1u == (tg + 1u) * nx) xb_add(&bar[XB_TOPGEN], 1u);
            else XB_SPIN(xb_ld(&bar[XB_TOPGEN]) == tg, bar);
            __builtin_amdgcn_fence(__ATOMIC_ACQUIRE, "agent");
            xb_add(&bar[XB_XGEN(b.x)], 1u);
            asm volatile("s_waitcnt vmcnt(0)" ::: "memory");
        } else {
            XB_SPIN(xb_ld(&bar[XB_XGEN(b.x)]) == gen, bar);
            __builtin_amdgcn_fence(__ATOMIC_ACQUIRE, "agent");
            asm volatile("s_waitcnt vmcnt(0)" ::: "memory");
        }
    }
    __syncthreads();
}
constexpr int LA_UNITS = NB * 8 * 128;
constexpr int KT_LD = 72, QT_LD = 136;
#define LA_BAR() do { asm volatile("s_waitcnt lgkmcnt(0)" ::: "memory"); __builtin_amdgcn_s_barrier(); asm volatile("" ::: "memory"); } while (0)
struct LaRaw { unsigned f[16], qv[16], v[16]; float lba, lbb; };
template <bool WANT_Q>
DI void la_issue(const bf16* Y0, const float* lbraw, int unit, int d, int rg, LaRaw& R) {
    const int hh = (unit >> 7) & 7;
    const bf16* Yb = Y0 + ((size_t)unit << 15) + (16 * rg) * 128 + d;
#pragma unroll
    for (int e = 0; e < 16; ++e) { R.f[e] = Yb[8192 + e * 128]; if (WANT_Q) R.qv[e] = Yb[e * 128]; R.v[e] = Yb[16384 + e * 128]; }
    const int li = (hh & 3) * 128 + d; R.lba = lbraw[li]; R.lbb = lbraw[512 + li];
    asm volatile("" ::: "memory");
}
template <bool WANT_Q>
DI void la_math(const LaRaw& R, int hh, float (&fd)[16], float (&kk)[16], float (&qq)[16]) {
    if (hh < 4) {
        const float mx = fmaxf(R.lba, R.lbb), ea = __expf(R.lba - mx), eb = __expf(R.lbb - mx), lbv = ea / (ea + eb);
#pragma unroll
        for (int e = 0; e < 16; ++e) { const float x = bf2f((bf16)R.f[e]); const float f = lbv + (1.f - lbv) * sigmoidf_(x); fd[e] = f; kk[e] = 1.f - f;
            if (WANT_Q) qq[e] = siluf_(bf2f((bf16)R.qv[e])); }
    } else {
        const int r = hh - 4; const float gam = 1.f - exp2f(-5.f - (float)r);
#pragma unroll
        for (int e = 0; e < 16; ++e) { fd[e] = gam; kk[e] = bf2f((bf16)R.f[e]) * 0.08838834764831845f; if (WANT_Q) qq[e] = bf2f((bf16)R.qv[e]); }
    }
}
DI void la_store_vt(const LaRaw& R, int d, int rg, LAS bf16* VT) {
    LAS u32x4* dst = (LAS u32x4*)(VT + d * KT_LD + 16 * rg);
    dst[0] = (u32x4){R.v[0] | (R.v[1] << 16), R.v[2] | (R.v[3] << 16), R.v[4] | (R.v[5] << 16), R.v[6] | (R.v[7] << 16)};
    dst[1] = (u32x4){R.v[8] | (R.v[9] << 16), R.v[10] | (R.v[11] << 16), R.v[12] | (R.v[13] << 16), R.v[14] | (R.v[15] << 16)};
}
DI void la_state_phase(const bf16* Y0, const float* lbraw, bf16* ST, float* DEC, LAS unsigned char* lds) {
    LAS bf16* KT = (LAS bf16*)lds; LAS bf16* VT = KT + 128 * KT_LD; LAS float* tot = (LAS float*)(VT + 128 * KT_LD);
    const int tid = threadIdx.x, lane = tid & 63, w = tid >> 6, l15 = lane & 15, q = lane >> 4, d = tid & 127, rg = tid >> 7;
    LaRaw R;
    if ((int)blockIdx.x < LA_UNITS) la_issue<false>(Y0, lbraw, blockIdx.x, d, rg, R);
    for (int unit = blockIdx.x; unit < LA_UNITS; unit += gridDim.x) {
        const int hh = (unit >> 7) & 7;
        float fd[16], kk[16], qq[16];
        LaRaw R2; { const int nx = unit + (int)gridDim.x; la_issue<false>(Y0, lbraw, nx < LA_UNITS ? nx : unit, d, rg, R2); }
        la_math<false>(R, hh, fd, kk, qq);
        float run = 1.f;
#pragma unroll
        for (int e = 15; e >= 0; --e) { kk[e] *= run; run *= fd[e]; }
        tot[rg * 128 + d] = run;
        la_store_vt(R, d, rg, VT);
        LA_BAR();
        float post = 1.f, last = 1.f;
#pragma unroll
        for (int g2 = 0; g2 < 4; ++g2) { const float tv = tot[g2 * 128 + d]; if (g2 > rg) post *= tv; last *= tv; }
        unsigned wv[8];
#pragma unroll
        for (int e = 0; e < 8; ++e) wv[e] = pk2(kk[2 * e] * post, kk[2 * e + 1] * post);
        LAS u32x4* dst = (LAS u32x4*)(KT + d * KT_LD + 16 * rg);
        dst[0] = (u32x4){wv[0], wv[1], wv[2], wv[3]}; dst[1] = (u32x4){wv[4], wv[5], wv[6], wv[7]};
        if (rg == 0) DEC[(size_t)unit * 128 + d] = last;
        LA_BAR();
        f32x4 acc[8];
#pragma unroll
        for (int dt = 0; dt < 8; ++dt) acc[dt] = (f32x4){0.f, 0.f, 0.f, 0.f};
#pragma unroll
        for (int ks = 0; ks < 2; ++ks) { const bf16x8 bv = *(const LAS bf16x8*)(VT + (16 * w + l15) * KT_LD + 32 * ks + 8 * q);
#pragma unroll
            for (int dt = 0; dt < 8; ++dt) { const bf16x8 ak = *(const LAS bf16x8*)(KT + (16 * dt + l15) * KT_LD + 32 * ks + 8 * q); acc[dt] = MFMA16(ak, bv, acc[dt]); } }
        bf16* so = ST + (size_t)unit * 16384 + (16 * w + l15) * 128 + 4 * q;
#pragma unroll
        for (int dt = 0; dt < 8; ++dt) { u32x2 o; o.x = pk2(acc[dt][0], acc[dt][1]); o.y = pk2(acc[dt][2], acc[dt][3]); *(u32x2*)(so + 16 * dt) = o; }
        R = R2;
        LA_BAR();
    }
}
DI void la_scan_phase(bf16* ST, const float* DEC) {
    const int gid = blockIdx.x * 512 + threadIdx.x, nth = gridDim.x * 512;
    for (int wk = gid; wk < 32 * 4096; wk += nth) {
        const int bh = wk >> 12, e4 = (wk & 4095) * 4, d = e4 & 127;
        f32x4 s = {0.f, 0.f, 0.f, 0.f};
        bf16* sp = ST + (size_t)bh * 128 * 16384 + e4; const float* dp = DEC + (size_t)bh * 128 * 128 + d;
        for (int n0 = 0; n0 < 128; n0 += 8) {
            u32x2 uv[8]; f32x4 dv[8];
#pragma unroll
            for (int i = 0; i < 8; ++i) { uv[i] = *(const u32x2*)(sp + (size_t)(n0 + i) * 16384); dv[i] = *(const f32x4*)(dp + (size_t)(n0 + i) * 128); }
#pragma unroll
            for (int i = 0; i < 8; ++i) { u32x2 o; o.x = pk2(s.x, s.y); o.y = pk2(s.z, s.w); *(u32x2*)(sp + (size_t)(n0 + i) * 16384) = o;
                s.x = dv[i].x * s.x + bflo(uv[i].x); s.y = dv[i].y * s.y + bfhi(uv[i].x); s.z = dv[i].z * s.z + bflo(uv[i].y); s.w = dv[i].w * s.w + bfhi(uv[i].y); }
        }
    }
}
DI void la_out_phase(const bf16* Y0, const float* lbraw, const bf16* ST, const float* gh, const float* gr, bf16* MIX, LAS unsigned char* lds) {
    LAS bf16* QT = (LAS bf16*)lds; LAS bf16* K2 = QT + 64 * QT_LD; LAS bf16* QS = K2 + 64 * QT_LD; LAS bf16* VT = QS + 64 * QT_LD;
    LAS float* tot = (LAS float*)(VT + 128 * KT_LD); LAS float* ssq = tot + 512; LAS float* gnl = ssq + 128;
    LAS bf16* SB = (LAS bf16*)(gnl + 256);
    LAS bf16* GB = SB + 128 * QT_LD;
    const int tid = threadIdx.x, lane = tid & 63, w = tid >> 6, l15 = lane & 15, q = lane >> 4, d = tid & 127, rg = tid >> 7;
    const int it = w & 3, vh = w >> 2;
    if (tid < 256) gnl[tid] = tid < 128 ? gh[tid] : gr[tid - 128];
    __syncthreads();
    const int irow = 16 * it + l15;
    LaRaw R;
    if ((int)blockIdx.x < LA_UNITS) la_issue<true>(Y0, lbraw, blockIdx.x, d, rg, R);
    u32x4 s2[4], g2r[2];
#define LA_FETCH_SG(un) { const bf16* sp_ = ST + ((size_t)(un) << 14); const bf16* gq_ = Y0 + ((size_t)(un) << 15) + 24576; \
        _Pragma("unroll") for (int c_ = 0; c_ < 4; ++c_) s2[c_] = *(const u32x4*)(sp_ + (size_t)(tid + 512 * c_) * 8); \
        _Pragma("unroll") for (int c_ = 0; c_ < 2; ++c_) g2r[c_] = *(const u32x4*)(gq_ + (size_t)(tid + 512 * c_) * 8); asm volatile("" ::: "memory"); }
#define LA_STORE_SG() { \
        _Pragma("unroll") for (int c_ = 0; c_ < 4; ++c_) { const int ch_ = tid + 512 * c_; *(LAS u32x4*)(SB + (ch_ >> 4) * QT_LD + (ch_ & 15) * 8) = s2[c_]; } \
        _Pragma("unroll") for (int c_ = 0; c_ < 2; ++c_) { const int ch_ = tid + 512 * c_; *(LAS u32x4*)(GB + (ch_ >> 4) * QT_LD + (ch_ & 15) * 8) = g2r[c_]; } }
    LA_FETCH_SG(blockIdx.x)
    LA_STORE_SG()
    for (int unit = blockIdx.x; unit < LA_UNITS; unit += gridDim.x) {
        const int b = unit >> 10, hh = (unit >> 7) & 7, n = unit & 127;
        const int row0 = b * T + n * 64;
        float fd[16], kk[16], qq[16];
        LaRaw R2; { const int nx = unit + (int)gridDim.x, un = nx < LA_UNITS ? nx : unit; la_issue<true>(Y0, lbraw, un, d, rg, R2); LA_FETCH_SG(un) }
#ifndef A3_REP
#define A3_REP 1
#endif
#pragma unroll 1
        for (int rep5_ = 0; rep5_ < A3_REP; ++rep5_) {
        la_math<true>(R, hh, fd, kk, qq);
        float run = 1.f;
#pragma unroll
        for (int e = 0; e < 16; ++e) { run *= fd[e]; fd[e] = run; }
        tot[rg * 128 + d] = run;
        la_store_vt(R, d, rg, VT);
        LA_BAR();
        float pre = 1.f;
#pragma unroll
        for (int g2 = 0; g2 < 4; ++g2) { const float tv = tot[g2 * 128 + d]; if (g2 < rg) pre *= tv; }
        const float ref = tot[d] * tot[128 + d], iref = __builtin_amdgcn_rcpf(ref);
#pragma unroll
        for (int e = 0; e < 16; ++e) { const float P = pre * fd[e], qP = qq[e] * P; const int j = 16 * rg + e;
            QT[j * QT_LD + d] = f2bf(qP * iref); K2[j * QT_LD + d] = f2bf(kk[e] * ref * __builtin_amdgcn_rcpf(P)); QS[j * QT_LD + d] = f2bf(qP); }
        LA_BAR();
        }
#ifndef A3B_REP
#define A3B_REP 1
#endif
#pragma unroll 1
        for (int rep6_ = 0; rep6_ < A3B_REP; ++rep6_) {
        f32x4 at[4];
#pragma unroll
        for (int jt = 0; jt < 4; ++jt) at[jt] = (f32x4){0.f, 0.f, 0.f, 0.f};
#pragma unroll
        for (int ks = 0; ks < 4; ++ks) { const bf16x8 bq = *(const LAS bf16x8*)(QT + (16 * it + l15) * QT_LD + 32 * ks + 8 * q);
#pragma unroll
            for (int jt = 0; jt < 4; ++jt) { const bf16x8 ak = *(const LAS bf16x8*)(K2 + (16 * jt + l15) * QT_LD + 32 * ks + 8 * q); at[jt] = MFMA16(ak, bq, at[jt]); } }
#pragma unroll
        for (int jt = 0; jt < 4; ++jt)
#pragma unroll
            for (int r = 0; r < 4; ++r) { const int j = 16 * jt + 4 * q + r; if (j > irow) at[jt][r] = 0.f; }
        f32x4 o[4];
#pragma unroll
        for (int vt = 0; vt < 4; ++vt) o[vt] = (f32x4){0.f, 0.f, 0.f, 0.f};
#pragma unroll
        for (int k2 = 0; k2 < 2; ++k2) {
            u32x4 pw; pw.x = pk2(at[2 * k2][0], at[2 * k2][1]); pw.y = pk2(at[2 * k2][2], at[2 * k2][3]); pw.z = pk2(at[2 * k2 + 1][0], at[2 * k2 + 1][1]); pw.w = pk2(at[2 * k2 + 1][2], at[2 * k2 + 1][3]);
            const bf16x8 pf = __builtin_bit_cast(bf16x8, pw);
#pragma unroll
            for (int vt = 0; vt < 4; ++vt) { const LAS bf16* vp = VT + (64 * vh + 16 * vt + l15) * KT_LD + 32 * k2 + 4 * q;
                const u32x2 lo = *(const LAS u32x2*)vp, hi = *(const LAS u32x2*)(vp + 16);
                const bf16x8 av = __builtin_bit_cast(bf16x8, ((u32x4){lo.x, lo.y, hi.x, hi.y})); o[vt] = MFMA16(av, pf, o[vt]); }
        }
#pragma unroll
        for (int ks = 0; ks < 4; ++ks) { const bf16x8 bq = *(const LAS bf16x8*)(QS + (16 * it + l15) * QT_LD + 32 * ks + 8 * q);
#pragma unroll
            for (int vt = 0; vt < 4; ++vt) { const bf16x8 as = *(const LAS bf16x8*)(SB + (64 * vh + 16 * vt + l15) * QT_LD + 32 * ks + 8 * q); o[vt] = MFMA16(as, bq, o[vt]); } }
        float ss = 0.f;
#pragma unroll
        for (int vt = 0; vt < 4; ++vt) ss += (o[vt][0] * o[vt][0] + o[vt][1] * o[vt][1]) + (o[vt][2] * o[vt][2] + o[vt][3] * o[vt][3]);
        ss += __shfl_xor(ss, 16); ss += __shfl_xor(ss, 32);
        if (q == 0) ssq[vh * 64 + irow] = ss;
        LA_BAR();
        const float rs = rsqrtf((ssq[irow] + ssq[64 + irow]) * (1.f / 128.f) + RMS_EPS);
        const LAS float* gn = gnl + (hh < 4 ? 0 : 128);
        bf16* op = MIX + (size_t)(row0 + irow) * D + hh * 128;
#pragma unroll
        for (int vt = 0; vt < 4; ++vt) { const int v0 = 64 * vh + 16 * vt + 4 * q; const f32x4 gv = *(const LAS f32x4*)(gn + v0); const u32x2 gw = *(const LAS u32x2*)(GB + irow * QT_LD + v0);
            u32x2 ow; ow.x = pk2(o[vt][0] * rs * gv.x * siluf_(bflo(gw.x)), o[vt][1] * rs * gv.y * siluf_(bfhi(gw.x)));
            ow.y = pk2(o[vt][2] * rs * gv.z * siluf_(bflo(gw.y)), o[vt][3] * rs * gv.w * siluf_(bfhi(gw.y))); *(u32x2*)(op + v0) = ow; }
        if (A3B_REP > 1) LA_BAR();
        }
        LA_BAR();
        LA_STORE_SG()
        R = R2;
        LA_BAR();
    }
#undef LA_FETCH_SG
#undef LA_STORE_SG
}
constexpr int NC = 511, NCP = 512;
DI void nsa_compress_phase(const bf16* Y1, const float* posk, const float* posv, const bf16* w1kT, const bf16* w1vT, const bf16* w2kT, const bf16* w2vT,
                           bf16* KCMP, bf16* VCMPT, LAS unsigned char* lds, int gw, int ngw, int lane) {
    const int l15 = lane & 15, q = lane >> 4, wv = (threadIdx.x >> 6), grp = wv >> 2, nt = wv & 3;
    LAS bf16* h1s = (LAS bf16*)lds + grp * 16 * 72;
    for (int base = 0; base < 512; base += ngw / 4) {
        int task = base + (gw >> 2); const bool tvalid = task < 512; if (!tvalid) task = 511;
        const int kv = task & 1, rt = task >> 1;
        int r = rt * 16 + l15; const bool rvalid = tvalid && (r < NB * NC * 2); if (r >= NB * NC * 2) r = NB * NC * 2 - 1;
        const int b = r / (NC * 2), rem = r % (NC * 2), i = rem >> 1, g = rem & 1;
        const bf16* src = Y1 + (size_t)(b * T + 16 * i) * OINP + (kv ? 1152 : 1024) + g * 64;
        const float* pos = kv ? posv : posk; const bf16* w1 = (kv ? w1vT : w1kT) + (size_t)(16 * nt + l15) * 2048; const bf16* w2 = kv ? w2vT : w2kT;
        f32x4 acc = {0.f, 0.f, 0.f, 0.f};
#pragma unroll 8
        for (int ks = 0; ks < 64; ++ks) {
            const int p = ks >> 1, d0 = (ks & 1) * 32 + 8 * q;
            const u32x4 xv = *(const u32x4*)(src + (size_t)p * OINP + d0);
            const f32x4 p0 = *(const f32x4*)(pos + p * 64 + d0), p1 = *(const f32x4*)(pos + p * 64 + d0 + 4);
            u32x4 bw; bw.x = pk2(bflo(xv.x) + p0.x, bfhi(xv.x) + p0.y); bw.y = pk2(bflo(xv.y) + p0.z, bfhi(xv.y) + p0.w);
            bw.z = pk2(bflo(xv.z) + p1.x, bfhi(xv.z) + p1.y); bw.w = pk2(bflo(xv.w) + p1.z, bfhi(xv.w) + p1.w);
            const bf16x8 af = *(const bf16x8*)(w1 + 32 * ks + 8 * q);
            acc = MFMA16(af, __builtin_bit_cast(bf16x8, bw), acc);
        }
        { u32x2 hw; hw.x = pk2(siluf_(acc[0]), siluf_(acc[1])); hw.y = pk2(siluf_(acc[2]), siluf_(acc[3])); *(LAS u32x2*)(h1s + l15 * 72 + 16 * nt + 4 * q) = hw; }
        __syncthreads();
        f32x4 o2 = {0.f, 0.f, 0.f, 0.f};
#pragma unroll
        for (int k2 = 0; k2 < 2; ++k2) { const bf16x8 bf = *(const LAS bf16x8*)(h1s + l15 * 72 + 32 * k2 + 8 * q);
            const bf16x8 av = *(const bf16x8*)(w2 + (16 * nt + l15) * 64 + 32 * k2 + 8 * q); o2 = MFMA16(av, bf, o2); }
        if (rvalid) {
            if (kv == 0) { u32x2 ow; ow.x = pk2(o2[0], o2[1]); ow.y = pk2(o2[2], o2[3]); *(u32x2*)(KCMP + ((size_t)(b * 2 + g) * NCP + i) * 64 + 16 * nt + 4 * q) = ow; }
            else { bf16* op = VCMPT + (size_t)(b * 2 + g) * 64 * NCP + i;
#pragma unroll
                for (int r2 = 0; r2 < 4; ++r2) op[(size_t)(16 * nt + 4 * q + r2) * NCP] = f2bf(o2[r2]); }
        }
        __syncthreads();
    }
    for (int z = gw * 64 + lane; z < NB * 2 * 64; z += ngw * 64) { const int bg = z >> 6, dd = z & 63; KCMP[((size_t)bg * NCP + NC) * 64 + dd] = 0; VCMPT[((size_t)bg * 64 + dd) * NCP + NC] = 0; }
}
DI void nsa_vt_phase(const bf16* Y1, bf16* VST, bf16* VWT, int gw, int ngw, int lane) {
    for (int task = gw; task < 2 * NB * 2 * 128; task += ngw) {
        const int which = task & 1, g = (task >> 1) & 1, b = (task >> 2) & 3, blk = task >> 4;
        const int t = blk * 64 + lane;
        const bf16* src = Y1 + (size_t)(b * T + t) * OINP + (which ? 1664 : 1408) + g * 64;
        bf16* dst = (which ? VWT : VST) + (size_t)(b * 2 + g) * 64 * T + t;
        u32x4 v[8];
#pragma unroll
        for (int c = 0; c < 8; ++c) v[c] = *(const u32x4*)(src + 8 * c);
#pragma unroll
        for (int c = 0; c < 8; ++c) {
            dst[(size_t)(8 * c + 0) * T] = (bf16)(v[c].x & 0xffff); dst[(size_t)(8 * c + 1) * T] = (bf16)(v[c].x >> 16);
            dst[(size_t)(8 * c + 2) * T] = (bf16)(v[c].y & 0xffff); dst[(size_t)(8 * c + 3) * T] = (bf16)(v[c].y >> 16);
            dst[(size_t)(8 * c + 4) * T] = (bf16)(v[c].z & 0xffff); dst[(size_t)(8 * c + 5) * T] = (bf16)(v[c].z >> 16);
            dst[(size_t)(8 * c + 6) * T] = (bf16)(v[c].w & 0xffff); dst[(size_t)(8 * c + 7) * T] = (bf16)(v[c].w >> 16);
        }
    }
}
#define LDS_BAR() do { asm volatile("s_waitcnt lgkmcnt(0)" ::: "memory"); __builtin_amdgcn_s_barrier(); asm volatile("" ::: "memory"); } while (0)
constexpr int TL = 80;
constexpr int SLAB_LD = 132;
constexpr float C1 = 0.125f * LOG2E;
DI void tile_fetch(const bf16* kg, int ldk, const bf16* vg, int ldv, int tid, u32x4& kr, u32x4& vr) {
    const int r = tid >> 3, c = (tid & 7) * 8;
    kr = *(const u32x4*)(kg + (size_t)r * ldk + c); vr = *(const u32x4*)(vg + (size_t)r * ldv + c);
    asm volatile("" ::: "memory");
}
DI void tile_store(LAS bf16* Kb, LAS bf16* Vb, int tid, u32x4 kr, u32x4 vr) {
    const int r = tid >> 3, c = (tid & 7) * 8;
    *(LAS u32x4*)(Kb + r * TL + c) = kr;
    const int g32 = c & 32, k0 = c & 31, k1 = k0 + 4;
    const int p0 = 8 * ((k0 & 15) >> 2) + 4 * (k0 >> 4), p1 = 8 * ((k1 & 15) >> 2) + 4 * (k1 >> 4);
    *(LAS u32x2*)(Vb + r * TL + g32 + p0) = (u32x2){vr.x, vr.y}; *(LAS u32x2*)(Vb + r * TL + g32 + p1) = (u32x2){vr.z, vr.w};
}
DI void tile_scores(const LAS bf16* Kb, const bf16x8 (&qf)[2], int l15, int q, f32x4 (&sc)[4]) {
#pragma unroll
    for (int x = 0; x < 4; ++x) { sc[x] = (f32x4){0.f, 0.f, 0.f, 0.f};
#pragma unroll
        for (int ks = 0; ks < 2; ++ks) { const bf16x8 a = *(const LAS bf16x8*)(Kb + (16 * x + l15) * TL + 32 * ks + 8 * q); sc[x] = MFMA16(a, qf[ks], sc[x]); } }
}
DI void tile_pv(const LAS bf16* Vb, const float (&p)[16], f32x4 (&acc)[4], int l15, int q) {
#pragma unroll
    for (int k2 = 0; k2 < 2; ++k2) {
        u32x4 pw; pw.x = pk2(p[8 * k2], p[8 * k2 + 1]); pw.y = pk2(p[8 * k2 + 2], p[8 * k2 + 3]); pw.z = pk2(p[8 * k2 + 4], p[8 * k2 + 5]); pw.w = pk2(p[8 * k2 + 6], p[8 * k2 + 7]);
        const bf16x8 pf = __builtin_bit_cast(bf16x8, pw);
#pragma unroll
        for (int dt = 0; dt < 4; ++dt) { const bf16x8 av = *(const LAS bf16x8*)(Vb + (16 * dt + l15) * TL + 32 * k2 + 8 * q); acc[dt] = MFMA16(av, pf, acc[dt]); }
    }
}
template <bool MASKED, int KS>
DI float tile_probs(const f32x4 (&sc)[4], float (&p)[16], int d0, float slope2, unsigned lim, bool extra) {
    const float A = -slope2 * (float)d0; f32x2 ps = {0.f, 0.f};
    const f32x2 r01 = {0.f, slope2 * (float)KS}, r23 = {slope2 * (float)(2 * KS), slope2 * (float)(3 * KS)};
#pragma unroll
    for (int x = 0; x < 4; ++x) { const float bx = slope2 * (float)(16 * KS * x) + A;
        const f32x2 s01 = {sc[x][0], sc[x][1]}, s23 = {sc[x][2], sc[x][3]};
        f32x2 v01 = s01 * C1 + (r01 + bx), v23 = s23 * C1 + (r23 + bx);
        if (MASKED) { const int kb = 16 * KS * x;
            v01.x = (extra && ((unsigned)(d0 - kb) < lim)) ? v01.x : -INFINITY; v01.y = (extra && ((unsigned)(d0 - kb - KS) < lim)) ? v01.y : -INFINITY;
            v23.x = (extra && ((unsigned)(d0 - kb - 2 * KS) < lim)) ? v23.x : -INFINITY; v23.y = (extra && ((unsigned)(d0 - kb - 3 * KS) < lim)) ? v23.y : -INFINITY; }
        f32x2 p01, p23; p01.x = ex2(v01.x); p01.y = ex2(v01.y); p23.x = ex2(v23.x); p23.y = ex2(v23.y); ps += p01; ps += p23;
        p[4 * x] = p01.x; p[4 * x + 1] = p01.y; p[4 * x + 2] = p23.x; p[4 * x + 3] = p23.y; }
    return ps.x + ps.y;
}
template <bool MASKED>
DI void tile_step(const LAS bf16* Kb, const LAS bf16* Vb, const bf16x8 (&qf)[2], f32x4 (&acc)[4], float& lp, int d0, float slope2, unsigned lim, bool extra, int l15, int q) {
    f32x4 sc[4]; tile_scores(Kb, qf, l15, q, sc);
    float p[16]; lp += tile_probs<MASKED, 1>(sc, p, d0, slope2, lim, extra);
    tile_pv(Vb, p, acc, l15, q);
}
DI void nsa_attn_phase(const bf16* Y1, const bf16* KCMP, const bf16* VCMPT, const bf16* VST, const bf16* VWT, bf16* MIX, LAS unsigned char* lds) {
    LAS bf16* KB0 = (LAS bf16*)lds;
    LAS bf16* VB0 = KB0 + 2 * 64 * TL;
    LAS float* slab = (LAS float*)(lds + 4 * 64 * TL * 2);
    LAS float* pslc = slab + 8 * 16 * SLAB_LD;
    LAS unsigned* selm = (LAS unsigned*)(pslc + 16 * 128);
    LAS unsigned* uni = selm + 64;
    LAS unsigned* blist = uni + 4;
    LAS float* invl = (LAS float*)(blist + 132);
    const int tid = threadIdx.x, lane = tid & 63, w = tid >> 6, l15 = lane & 15, q = lane >> 4;
    LAS float* myslab = slab + w * 16 * SLAB_LD;
#define KBUF(i) (KB0 + ((i) & 1) * 64 * TL)
#define VBUF(i) (VB0 + ((i) & 1) * 64 * TL)
    for (int u = blockIdx.x; u < NB * 2 * (T / 16); u += gridDim.x) {
        const int b = u & 3, g = (u >> 2) & 1;
        int tile = u >> 3;
        if ((int)gridDim.x == 256) { const int wq = (int)blockIdx.x >> 3, k = u >> 8; tile = k < 8 ? 8 * wq + k : 512 - 8 * (wq + 1) + (k - 8); }
        const int t0 = tile * 16, qblk = t0 >> 6;
        const int h = g * 8 + w; const float slope = exp2f(-0.5f * (float)(h + 1)), slope2 = slope * LOG2E;
        const int t = t0 + l15; const size_t row = (size_t)b * T + t;
        bf16x8 qf[2];
        qf[0] = *(const bf16x8*)(Y1 + row * OINP + h * 64 + 8 * q); qf[1] = *(const bf16x8*)(Y1 + row * OINP + h * 64 + 32 + 8 * q);
        const bf16* gl = Y1 + row * OINP + 1792 + h * 3;
        const float g0 = sigmoidf_(bf2f(gl[0])), g1 = sigmoidf_(bf2f(gl[1])), g2 = sigmoidf_(bf2f(gl[2]));
        f32x4 ot[4];
        u32x4 kr, vr, kr2, vr2;
        {
            const bf16* kc = KCMP + (size_t)(b * 2 + g) * NCP * 64; const bf16* vct = VCMPT + (size_t)(b * 2 + g) * 64 * NCP;
            const int nst = tile >= 1 ? ((tile - 1) >> 6) + 1 : 0;
            const int dc = t - 31 - 64 * q;
            float lp = 0.f, carry = 0.f;
            f32x4 acc[4];
#pragma unroll
            for (int dt = 0; dt < 4; ++dt) acc[dt] = (f32x4){0.f, 0.f, 0.f, 0.f};
            float inv = 0.f;
            {
#define CMP_FETCH(idx, KR, VR) { const int i_ = (idx) < nst ? (idx) : nst - 1; tile_fetch(kc + (size_t)(64 * i_) * 64, 64, vct + 64 * i_, NCP, tid, KR, VR); }
#define CMP_COMPUTE(s, KB, VB) { \
                    f32x4 sc[4]; tile_scores(KB, qf, l15, q, sc); \
                    float sv[16]; \
                    const int d0 = dc - 1024 * (s); \
                    if (64 * (s) + 63 <= tile - 2) lp += tile_probs<false, 16>(sc, sv, d0, slope2, 0x7fffffffu, true); \
                    else lp += tile_probs<true, 16>(sc, sv, d0, slope2, 0x7fffffffu, true); \
                    _Pragma("unroll") for (int x = 0; x < 4; ++x) { const float hf_ = 0.5f * sv[4 * x + 3]; \
                        const float up_ = __shfl(hf_, (lane + 48) & 63);     \
                        myslab[l15 * SLAB_LD + 16 * (s) + 4 * x + q] = ((sv[4 * x] + sv[4 * x + 1]) + (sv[4 * x + 2] + hf_)) + (q > 0 ? up_ : carry); \
                        carry = up_; } \
                    tile_pv(VB, sv, acc, l15, q); }
                if (nst > 0) {
                    CMP_FETCH(0, kr, vr) tile_store(KBUF(0), VBUF(0), tid, kr, vr); CMP_FETCH(1, kr, vr)
                    LDS_BAR();
                    int s = 0;
                    for (; s + 1 < nst; s += 2) {
                        CMP_FETCH(s + 2, kr2, vr2) CMP_COMPUTE(s, KBUF(0), VBUF(0)) tile_store(KBUF(1), VBUF(1), tid, kr, vr); LDS_BAR();
                        CMP_FETCH(s + 3, kr, vr) CMP_COMPUTE(s + 1, KBUF(1), VBUF(1)) tile_store(KBUF(0), VBUF(0), tid, kr2, vr2); LDS_BAR();
                    }
                    if (s < nst) { CMP_COMPUTE(s, KBUF(0), VBUF(0)) LDS_BAR(); }
                }
#undef CMP_FETCH
#undef CMP_COMPUTE
                float l = lp; l += __shfl_xor(l, 16); l += __shfl_xor(l, 32); inv = l > 0.f ? 1.0f / l : 0.f;
                if (q == 0) { invl[w * 16 + l15] = inv; myslab[l15 * SLAB_LD + 16 * nst] = carry; }
            }
            const float gi = g0 * inv;
#pragma unroll
            for (int dt = 0; dt < 4; ++dt) { ot[dt][0] = gi * acc[dt][0]; ot[dt][1] = gi * acc[dt][1]; ot[dt][2] = gi * acc[dt][2]; ot[dt][3] = gi * acc[dt][3]; }
        }
        LDS_BAR();
#ifndef SELN_REP
#define SELN_REP 1
#endif
        unsigned u0 = 0, u1 = 0, u2 = 0, u3 = 0, am0 = 0, am1 = 0, am2 = 0, am3 = 0;
#pragma unroll 1
        for (int rep3_ = 0; rep3_ < SELN_REP; ++rep3_) {
        {
            const int tokA = 2 * w, tokB = 2 * w + 1;
            float sA0 = 0.f, sA1 = 0.f, sB0 = 0.f, sB1 = 0.f;
#pragma unroll
            for (int ww = 0; ww < 8; ++ww) { const float ilA = invl[ww * 16 + tokA], ilB = invl[ww * 16 + tokB];
                sA0 += slab[(ww * 16 + tokA) * SLAB_LD + lane] * ilA; sA1 += slab[(ww * 16 + tokA) * SLAB_LD + lane + 64] * ilA;
                sB0 += slab[(ww * 16 + tokB) * SLAB_LD + lane] * ilB; sB1 += slab[(ww * 16 + tokB) * SLAB_LD + lane + 64] * ilB; }
            const int j0 = lane, j1 = lane + 64;
            const bool v0 = j0 <= qblk, v1 = j1 <= qblk;
            const bool f0 = (j0 == 0) || (j0 == qblk) || (j0 == qblk - 1), f1 = (j1 == qblk) || (j1 == qblk - 1);
            const unsigned kA0 = f0 ? 0x7f000000u : __float_as_uint(sA0), kA1 = f1 ? 0x7f000000u : __float_as_uint(sA1);
            const unsigned kB0 = f0 ? 0x7f000000u : __float_as_uint(sB0), kB1 = f1 ? 0x7f000000u : __float_as_uint(sB1);
            unsigned TA = 0u, TB = 0u;
#pragma unroll 1
            for (int bit = 30; bit >= 0; --bit) { const unsigned trA = TA | (1u << bit), trB = TB | (1u << bit);
                const int cA = __popcll(__ballot(v0 && kA0 >= trA)) + __popcll(__ballot(v1 && kA1 >= trA));
                const int cB = __popcll(__ballot(v0 && kB0 >= trB)) + __popcll(__ballot(v1 && kB1 >= trB));
                if (cA >= 16) TA = trA; if (cB >= 16) TB = trB; }
            const unsigned long long lt = (1ull << lane) - 1ull;
#define SEL_FINISH(tok, k0, k1, Tk) { \
                const bool gt0 = v0 && k0 > Tk, gt1 = v1 && k1 > Tk, eq0 = v0 && k0 == Tk, eq1 = v1 && k1 == Tk; \
                const unsigned long long mq0 = __ballot(eq0), mq1 = __ballot(eq1); \
                const int need = 16 - (__popcll(__ballot(gt0)) + __popcll(__ballot(gt1))); \
                const int r0 = __popcll(mq0 & lt), r1 = __popcll(mq0) + __popcll(mq1 & lt);        \
                const unsigned long long m0 = __ballot(gt0 || (eq0 && r0 < need)), m1 = __ballot(gt1 || (eq1 && r1 < need)); \
                if (lane == 0) { selm[(tok) * 4 + 0] = (unsigned)m0; selm[(tok) * 4 + 1] = (unsigned)(m0 >> 32); selm[(tok) * 4 + 2] = (unsigned)m1; selm[(tok) * 4 + 3] = (unsigned)(m1 >> 32); } }
            SEL_FINISH(tokA, kA0, kA1, TA)
            SEL_FINISH(tokB, kB0, kB1, TB)
#undef SEL_FINISH
        }
        LDS_BAR();
        unsigned om = selm[lane], am = om;
        om |= __shfl_xor(om, 4); om |= __shfl_xor(om, 8); om |= __shfl_xor(om, 16); om |= __shfl_xor(om, 32);
        am &= __shfl_xor(am, 4); am &= __shfl_xor(am, 8); am &= __shfl_xor(am, 16); am &= __shfl_xor(am, 32);
        u0 = __builtin_amdgcn_readlane(om, 0); u1 = __builtin_amdgcn_readlane(om, 1); u2 = __builtin_amdgcn_readlane(om, 2); u3 = __builtin_amdgcn_readlane(om, 3);
        am0 = __builtin_amdgcn_readlane(am, 0); am1 = __builtin_amdgcn_readlane(am, 1); am2 = __builtin_amdgcn_readlane(am, 2); am3 = __builtin_amdgcn_readlane(am, 3);
        if (tid < 128) { const int wd = tid >> 5, bt = tid & 31;
            const unsigned uw = wd == 0 ? u0 : wd == 1 ? u1 : wd == 2 ? u2 : u3;
            if ((uw >> bt) & 1u) { const int pos = (wd > 0 ? __popc(u0) : 0) + (wd > 1 ? __popc(u1) : 0) + (wd > 2 ? __popc(u2) : 0) + __popc(uw & ((1u << bt) - 1u)); blist[pos] = (unsigned)tid; } }
        if (SELN_REP > 1) LDS_BAR();
        }
        const int nsel = __popc(u0) + __popc(u1) + __popc(u2) + __popc(u3);
        LDS_BAR();
#ifndef SEL_REP
#define SEL_REP 1
#endif
#pragma unroll 1
        for (int rep2_ = 0; rep2_ < SEL_REP; ++rep2_) {
            const bf16* kb = Y1 + (size_t)b * T * OINP + 1280 + g * 64; const bf16* vt = VST + (size_t)(b * 2 + g) * 64 * T;
            float lp = 0.f; f32x4 acc[4];
#pragma unroll
            for (int dt = 0; dt < 4; ++dt) acc[dt] = (f32x4){0.f, 0.f, 0.f, 0.f};
#define SEL_FETCH(idx, KR, VR) { const int i_ = (idx) < nsel ? (idx) : nsel - 1; const int j_ = (int)__builtin_amdgcn_readfirstlane((int)blist[i_]); tile_fetch(kb + (size_t)(64 * j_) * OINP, OINP, vt + 64 * j_, T, tid, KR, VR); }
#define SEL_COMPUTE(i, KB, VB) { \
                const int j = (int)__builtin_amdgcn_readfirstlane((int)blist[i]); \
                const int wd = j >> 5; const unsigned aw = wd == 0 ? am0 : wd == 1 ? am1 : wd == 2 ? am2 : am3; \
                const int d0 = t - 64 * j - 4 * q; \
                if (((aw >> (j & 31)) & 1u) && j < qblk) tile_step<false>(KB, VB, qf, acc, lp, d0, slope2, 0x7fffffffu, true, l15, q); \
                else { const bool selb = (selm[l15 * 4 + wd] >> (j & 31)) & 1u; tile_step<true>(KB, VB, qf, acc, lp, d0, slope2, 0x7fffffffu, selb, l15, q); } }
            {
                SEL_FETCH(0, kr, vr) tile_store(KBUF(0), VBUF(0), tid, kr, vr); SEL_FETCH(1, kr, vr)
                LDS_BAR();
                int i = 0;
                for (; i + 1 < nsel; i += 2) {
                    SEL_FETCH(i + 2, kr2, vr2) SEL_COMPUTE(i, KBUF(0), VBUF(0)) tile_store(KBUF(1), VBUF(1), tid, kr, vr); LDS_BAR();
                    SEL_FETCH(i + 3, kr, vr) SEL_COMPUTE(i + 1, KBUF(1), VBUF(1)) tile_store(KBUF(0), VBUF(0), tid, kr2, vr2); LDS_BAR();
                }
                if (i < nsel) { SEL_COMPUTE(i, KBUF(0), VBUF(0)) LDS_BAR(); }
            }
#undef SEL_FETCH
#undef SEL_COMPUTE
            float l = lp; l += __shfl_xor(l, 16); l += __shfl_xor(l, 32);
            const float sc = l > 0.f ? g1 * (1.0f / SEL_REP) / l : 0.f;
#pragma unroll
            for (int dt = 0; dt < 4; ++dt) { ot[dt][0] += sc * acc[dt][0]; ot[dt][1] += sc * acc[dt][1]; ot[dt][2] += sc * acc[dt][2]; ot[dt][3] += sc * acc[dt][3]; }
        }
#ifndef WIN_REP
#define WIN_REP 1
#endif
#pragma unroll 1
        for (int rep_ = 0; rep_ < WIN_REP; ++rep_) {
            const bf16* kb = Y1 + (size_t)b * T * OINP + 1536 + g * 64; const bf16* vt = VWT + (size_t)(b * 2 + g) * 64 * T;
            float lp = 0.f; f32x4 acc[4];
#pragma unroll
            for (int dt = 0; dt < 4; ++dt) acc[dt] = (f32x4){0.f, 0.f, 0.f, 0.f};
            int kstart = t0 - 511; kstart = kstart < 0 ? 0 : (kstart & ~63);
            const int nw = ((t0 + 15 - kstart) >> 6) + 1;
#define WIN_FETCH(idx, KR, VR) { const int i_ = (idx) < nw ? (idx) : nw - 1; const int k_ = kstart + 64 * i_; tile_fetch(kb + (size_t)k_ * OINP, OINP, vt + k_, T, tid, KR, VR); }
#define WIN_COMPUTE(i, KB, VB) { \
                const int key0 = kstart + 64 * (i); \
                const int d0 = t - key0 - 4 * q; \
                if (key0 + 63 <= t0 && key0 >= t0 - 496) tile_step<false>(KB, VB, qf, acc, lp, d0, slope2, 512u, true, l15, q); \
                else tile_step<true>(KB, VB, qf, acc, lp, d0, slope2, 512u, true, l15, q); }
            {
                WIN_FETCH(0, kr, vr) tile_store(KBUF(0), VBUF(0), tid, kr, vr); WIN_FETCH(1, kr, vr)
                LDS_BAR();
                int i = 0;
                for (; i + 1 < nw; i += 2) {
                    WIN_FETCH(i + 2, kr2, vr2) WIN_COMPUTE(i, KBUF(0), VBUF(0)) tile_store(KBUF(1), VBUF(1), tid, kr, vr); LDS_BAR();
                    WIN_FETCH(i + 3, kr, vr) WIN_COMPUTE(i + 1, KBUF(1), VBUF(1)) tile_store(KBUF(0), VBUF(0), tid, kr2, vr2); LDS_BAR();
                }
                if (i < nw) { WIN_COMPUTE(i, KBUF(0), VBUF(0)) LDS_BAR(); }
            }
#undef WIN_FETCH
#undef WIN_COMPUTE
            float l = lp; l += __shfl_xor(l, 16); l += __shfl_xor(l, 32);
            const float sc = l > 0.f ? g2 * (1.0f / WIN_REP) / l : 0.f;
#pragma unroll
            for (int dt = 0; dt < 4; ++dt) { ot[dt][0] += sc * acc[dt][0]; ot[dt][1] += sc * acc[dt][1]; ot[dt][2] += sc * acc[dt][2]; ot[dt][3] += sc * acc[dt][3]; }
        }
        bf16* op = MIX + row * D + h * 64 + 4 * q;
#pragma unroll
        for (int dt = 0; dt < 4; ++dt) { u32x2 ow; ow.x = pk2(ot[dt][0], ot[dt][1]); ow.y = pk2(ot[dt][2], ot[dt][3]); *(u32x2*)(op + 16 * dt) = ow; }
    }
#undef KBUF
#undef VBUF
}
struct Args { const float* in[19]; float* out; unsigned char* ws; int ph_lo, ph_hi; };
constexpr int N_PHASES = 18;
template <class Epi>
DI void run_gemm(LAS unsigned char* lds, const bf16* A, const bf16* Bt, int N, int K, const Epi& E) {
    pg8::Gemm g{A, Bt, M, N, K}; pg8::StaticOrder S; S.init(M, N, (int)gridDim.x, (int)blockIdx.x);
    pg8::gemm_phase<Epi, pg8::StaticOrder, true, true>(lds, g, S, E);
}
__global__ void __launch_bounds__(512, 2) mega(Args a) {
    extern __shared__ __attribute__((aligned(16))) unsigned char lds_raw[];
    LAS unsigned char* lds = (LAS unsigned char*)lds_raw;
    cg::grid_group grid = cg::this_grid();
    volatile LAS unsigned* bst = (volatile LAS unsigned*)(lds + 147456 - 64);
    if (threadIdx.x < 2) bst[threadIdx.x] = 0u;
    __syncthreads();
    XcdBarrier xbar = xcd_barrier_post((unsigned*)(a.ws + WS_CTL), bst);
    const int tid = threadIdx.x, lane = tid & 63, wave = __builtin_amdgcn_readfirstlane(tid >> 6);
    const int gw = blockIdx.x * 8 + wave, ngw = gridDim.x * 8;
#define WSP(off) ((bf16*)(a.ws + (off)))
#define W_EIN WSP(WS_EIN)
#define W_EOUT WSP(WS_EOUT)
#define W_OIN WSP(WS_OIN)
#define W_OOUT WSP(WS_OOUT)
#define W_GU WSP(WS_GU)
#define W_DN WSP(WS_DN)
#define W1K WSP(WS_W1K)
#define W1V WSP(WS_W1V)
#define W2K WSP(WS_W2K)
#define W2V WSP(WS_W2V)
#define DEC ((float*)(a.ws + WS_DEC))
#define KCMP WSP(WS_KCMP)
#define VCMPT WSP(WS_VCMPT)
#define Y WSP(WS_Y)
#define VST WSP(WS_VST)
#define VWT WSP(WS_VWT)
#define HN WSP(WS_HN)
#define ST WSP(WS_ST)
#define RS ((float*)(a.ws + WS_RS))
#define HB WSP(WS_HB)
    const int lo = a.ph_lo, hi = a.ph_hi;
#define PH(k) if (lo <= (k) && (k) < hi)
#define SEAM(k) if (lo <= (k) && (k) + 1 < hi && hi > 0) { if (a.ph_lo < 0) grid.sync();   xcd_barrier(xbar); }
    PH(0) {
        LAS float* scr = (LAS float*)(lds + wave * 8448);
        constexpr int I0 = 2048, I1 = 512, I2 = 1024, I3 = 512, I4 = 2816, I5 = 1408, I6 = 64, I7 = 2;
        constexpr int NIT = I0 + I1 + I2 + I3 + 2 * I4 + 2 * I5 + 2 * I6 + 2 * I7;
        for (int it = gw; it < NIT; it += ngw) {
            int r = it;
            if (r < I0) { transpose_item(a.in[4], 1024, EIN, EIN, W_EIN, 0, scr, r, lane); continue; } r -= I0;
            if (r < I1) { transpose_item(a.in[8], 1024, 1024, 1024, W_EOUT, 0, scr, r, lane); continue; } r -= I1;
            if (r < I2) { transpose_item(a.in[9], 1024, OIN, OINP, W_OIN, 0, scr, r, lane, a.in[1] + D); continue; } r -= I2;
            if (r < I3) { transpose_item(a.in[16], 1024, 1024, 1024, W_OOUT, 0, scr, r, lane); continue; } r -= I3;
            if (r < 2 * I4) { const int l = r / I4; transpose_item(a.in[17] + (size_t)l * D * 2 * FF, 1024, 2 * FF, 2 * FF, W_GU + (size_t)l * GU_STRIDE, 1, scr, r % I4, lane, a.in[2] + l * D); continue; } r -= 2 * I4;
            if (r < 2 * I5) { const int l = r / I5; transpose_item(a.in[18] + (size_t)l * FF * D, FF, 1024, 1024, W_DN + (size_t)l * DN_STRIDE, 0, scr, r % I5, lane); continue; } r -= 2 * I5;
            if (r < I6) { transpose_item(a.in[12], 2048, 64, 64, W1K, 0, scr, r, lane); continue; } r -= I6;
            if (r < I6) { transpose_item(a.in[14], 2048, 64, 64, W1V, 0, scr, r, lane); continue; } r -= I6;
            if (r < I7) { transpose_item(a.in[13], 64, 64, 64, W2K, 0, scr, r, lane); continue; } r -= I7;
            transpose_item(a.in[15], 64, 64, 64, W2V, 0, scr, r, lane);
        }
        norm_rows_bf16(a.in[0], a.in[1], HN, gw, ngw, lane);
    }
    SEAM(0);
    PH(1) { EpiStoreLA E{Y}; run_gemm(lds, HN, W_EIN, EIN, 1024, E); }
    SEAM(1);
    PH(2) { la_state_phase(Y, a.in[5], ST, DEC, lds); }
    SEAM(2);
    PH(3) { la_scan_phase(ST, DEC); }
    SEAM(3);
    PH(4) { la_out_phase(Y, a.in[5], ST, a.in[6], a.in[7], HN, lds); }
    SEAM(4);
    PH(5) { EpiResid E{a.in[0], a.out, HB, RS}; run_gemm(lds, HN, W_EOUT, 1024, 1024, E); }
    SEAM(5);
    PH(7) { EpiSwiglu E{Y, RS}; run_gemm(lds, HB, W_GU, 2 * FF, 1024, E); }
    SEAM(7);
    PH(8) { EpiResid E{a.out, a.out, HB, RS + 16 * M}; run_gemm(lds, Y, W_DN, 1024, FF, E); }
    SEAM(8);
    PH(10) { EpiStore E{Y, OINP, RS + 16 * M}; run_gemm(lds, HB, W_OIN, OINP, 1024, E); }
    SEAM(10);
    PH(11) { nsa_compress_phase(Y, a.in[10], a.in[11], W1K, W1V, W2K, W2V, KCMP, VCMPT, lds, gw, ngw, lane); nsa_vt_phase(Y, VST, VWT, gw, ngw, lane); }
    SEAM(11);
    PH(12) { nsa_attn_phase(Y, KCMP, VCMPT, VST, VWT, HN, lds); }
    SEAM(12);
    PH(13) { EpiResid E{a.out, a.out, HB, RS + 32 * M}; run_gemm(lds, HN, W_OOUT, 1024, 1024, E); }
    SEAM(13);
    PH(15) { EpiSwiglu E{Y, RS + 32 * M}; run_gemm(lds, HB, W_GU + GU_STRIDE, 2 * FF, 1024, E); }
    SEAM(15);
    PH(16) { EpiResid E{a.out, a.out, nullptr, nullptr}; run_gemm(lds, Y, W_DN + DN_STRIDE, 1024, FF, E); }
    SEAM(16);
    PH(17) { norm_rows_f32_inplace(a.out, a.in[3], gw, ngw, lane); }
#undef PH
#undef SEAM
}

extern "C" void kernel_launch(void* const* d_in, const int* in_sizes, int n_in, void* d_out, int out_size, void* d_ws, size_t ws_size, hipStream_t stream) {
    static int grid = 0;
    if (grid == 0) {
        if (n_in != 19 || in_sizes[0] != M * D || out_size != M * D || ws_size < WS_END) { fprintf(stderr, "kernel_launch: unexpected shapes (n_in %d, in0 %d, out %d, ws %zu)\n", n_in, n_in > 0 ? in_sizes[0] : -1, out_size, ws_size); grid = -1; return; }
        int dev = 0, cus = 0, per_cu = 0;
        (void)hipGetDevice(&dev); (void)hipDeviceGetAttribute(&cus, hipDeviceAttributeMultiprocessorCount, dev);
        if (hipFuncSetAttribute((const void*)mega, hipFuncAttributeMaxDynamicSharedMemorySize, LDS_BYTES) != hipSuccess) { fprintf(stderr, "kernel_launch: hipFuncSetAttribute failed\n"); grid = -1; return; }
        if (hipOccupancyMaxActiveBlocksPerMultiprocessor(&per_cu, (const void*)mega, 512, LDS_BYTES) != hipSuccess || per_cu < 1) { fprintf(stderr, "kernel_launch: occupancy query says %d\n", per_cu); per_cu = 1; }
        (void)hipGetLastError();
        grid = cus * 1;
    }
    if (grid < 0) return;
    if (hipMemsetAsync((char*)d_ws + WS_CTL, 0, CTL_BYTES, stream) != hipSuccess) { fprintf(stderr, "kernel_launch: memset failed\n"); return; }
    Args a{};
    for (int i = 0; i < 19; ++i) a.in[i] = (const float*)d_in[i];
    a.out = (float*)d_out; a.ws = (unsigned char*)d_ws; a.ph_lo = 0; a.ph_hi = N_PHASES;
    void* args[] = {&a};
    hipError_t e = hipLaunchCooperativeKernel((const void*)mega, dim3(grid), dim3(512), args, LDS_BYTES, stream);
    if (e != hipSuccess) fprintf(stderr, "kernel_launch: cooperative launch failed: %s (grid %d)\n", hipGetErrorString(e), grid);
#ifdef PROBE_PHASES
    { const int pp[] = {PROBE_PHASES};
      for (unsigned i = 0; i < sizeof(pp) / sizeof(pp[0]); ++i) { a.ph_lo = pp[i]; a.ph_hi = pp[i] + 1; (void)hipLaunchCooperativeKernel((const void*)mega, dim3(grid), dim3(512), args, LDS_BYTES, stream); } }
#endif
}
```

```cpp
#include <hip/hip_runtime.h>
#include <hip/hip_cooperative_groups.h>
#include <cstdio>
#include <cstdint>
namespace cg = cooperative_groups;
namespace pg8 {
#define PG8_LAS __attribute__((address_space(3)))
typedef unsigned short bf16_t;
typedef short bf16x8 __attribute__((ext_vector_type(8)));
typedef float f32x4 __attribute__((ext_vector_type(4)));
typedef unsigned u32x4 __attribute__((ext_vector_type(4)));
constexpr int BM = 256, BK = 64, HALF = 128, HTB = HALF * BK * 2  , STAGE_BYTES = 8 * HTB, NXCD = 8, WGM = 8;

__host__ __device__ __forceinline__ int lds_byte(int r, int c) { const int st = (r >> 4) * 2 + (c >> 5), rr = r & 15, cc = c & 31, ob = rr * 64 + cc * 2; return st * 1024 + (ob ^ (((ob >> 9) & 1) << 5)); }
__host__ __device__ __forceinline__ void stage_rc(int b, int& R, int& C) { const int st = b / 1024, sb = b % 1024, swz = sb ^ (((sb >> 9) & 1) << 5); R = (st >> 1) * 16 + swz / 64; C = (st & 1) * 32 + (swz % 64) / 2; }
__host__ __device__ __forceinline__ int perm32(int rho) { const int n = rho >> 4, i = rho & 15; return 8 * (i >> 2) + 4 * n + (i & 3); }

struct Unit { int pm, pn; };
struct Gemm { const bf16_t* A; const bf16_t* Bt; int M, N, K; };

struct StaticOrder {
    int nM, nN, nwg, G, c;
    __host__ __device__ void init(int M, int N, int G_, int c_) { nM = M / BM; nN = N / BM; nwg = nM * nN; G = G_; c = c_; }
    __host__ __device__ bool next(int i, Unit& u) const {
        const long L = (long)i * G + c; if (L >= nwg) return false;
        int wgid = (int)L; { const int q = nwg / NXCD, r = nwg % NXCD, xcd = wgid % NXCD, off = wgid / NXCD; wgid = (xcd < r ? xcd * (q + 1) : r * (q + 1) + (xcd - r) * q) + off; }
        const int nig = WGM * nN, gid = wgid / nig, fm = gid * WGM, gsz = (nM - fm) < WGM ? (nM - fm) : WGM;
        u.pm = fm + ((wgid % nig) % gsz); u.pn = (wgid % nig) / gsz; return true;
    }
    __device__ __forceinline__ void a_ready(const Unit&) const {}
    __device__ __forceinline__ void done(const Unit&) const {}
};

__device__ __forceinline__ unsigned cvt_pk_bf16(float lo, float hi) { unsigned r; asm volatile("v_cvt_pk_bf16_f32 %0, %1, %2" : "=v"(r) : "v"(lo), "v"(hi)); return r; }
template <class Epi, class Sched, bool ALIGN_EPI = false, bool SP2 = false>
__device__ __forceinline__ void gemm_phase(PG8_LAS unsigned char* lds, const Gemm g, const Sched& S, const Epi& E) {
    const int tid = threadIdx.x, wid = __builtin_amdgcn_readfirstlane(tid >> 6), lane = tid & 63, wr = wid >> 2, wc = wid & 3, fr = lane & 15, fq = lane >> 4;
    const int K = g.K, nt = K / BK;
    unsigned voffA[2], voffB[2];
#pragma unroll
    for (int i = 0; i < 2; ++i) { int R, C; stage_rc(tid * 16 + i * 8192, R, C); const int Rb = Epi::PERM ? ((R & ~31) + perm32(R & 31)) : R;
        voffA[i] = (unsigned)(R * K + C) * 2u; voffB[i] = (unsigned)(Rb * K + C) * 2u; }
    const size_t kstep = (size_t)(BK * 2);
    const size_t hstep = (size_t)HALF * K * 2;
    const size_t tstep = 2 * hstep;
    const unsigned ldsw = (unsigned)wid * 1024u;
    const int aoff = lds_byte(wr * 64 + fr, fq * 8), boff = lds_byte(wc * 32 + fr, fq * 8);
#define PG8_SA(b, h) (((b) * 2 + (h)) * HTB)
#define PG8_SB(b, h) ((4 + (b) * 2 + (h)) * HTB)
#define PG8_STAGE(bufoff, gbase, voff) do { _Pragma("unroll") for (int _i = 0; _i < 2; ++_i) \
        __builtin_amdgcn_global_load_lds((const unsigned*)((const char*)(gbase) + (voff)[_i]), (PG8_LAS unsigned*)(lds + (bufoff) + ldsw + _i * 8192), 16, 0, 0); } while (0)
#define PG8_LDA(dst, b, h) do { _Pragma("unroll") for (int m = 0; m < 4; ++m) _Pragma("unroll") for (int k = 0; k < 2; ++k) dst[m][k] = *(const PG8_LAS bf16x8*)(lds + PG8_SA(b, h) + aoff + m * 2048 + k * 1024); } while (0)
#define PG8_LDB(dst, b, h) do { _Pragma("unroll") for (int n = 0; n < 2; ++n) _Pragma("unroll") for (int k = 0; k < 2; ++k) dst[n][k] = *(const PG8_LAS bf16x8*)(lds + PG8_SB(b, h) + boff + n * 2048 + k * 1024); } while (0)
#define PG8_MMA(ai, bj, At, Bt) do { __builtin_amdgcn_s_setprio(1); _Pragma("unroll") for (int m = 0; m < 4; ++m) _Pragma("unroll") for (int n = 0; n < 2; ++n) _Pragma("unroll") for (int k = 0; k < 2; ++k) \
        acc[ai][bj][m][n] = __builtin_amdgcn_mfma_f32_16x16x32_bf16(Bt[n][k], At[m][k], acc[ai][bj][m][n], 0, 0, 0); __builtin_amdgcn_s_setprio(0); } while (0)
#define PG8_WAIT_V(n) asm volatile("s_waitcnt vmcnt(" #n ")" ::: "memory")
#define PG8_WAIT_L(n) asm volatile("s_waitcnt lgkmcnt(" #n ")" ::: "memory")
#define PG8_BAR __builtin_amdgcn_s_barrier()
#define PG8_SCHED __builtin_amdgcn_sched_barrier(0)
    Unit cur, nxt; int ui = 0;
    if (!S.next(0, cur)) return;
    f32x4 acc[2][2][4][2];
#pragma unroll
    for (int a = 0; a < 2; ++a)
#pragma unroll
        for (int b = 0; b < 2; ++b)
#pragma unroll
            for (int m = 0; m < 4; ++m)
#pragma unroll
                for (int n = 0; n < 2; ++n) acc[a][b][m][n] = (f32x4){0.f, 0.f, 0.f, 0.f};
    bf16x8 At[4][2], B0[2][2], B1[2][2];
    const char* cA = (const char*)g.A + (size_t)cur.pm * tstep; const char* cB = (const char*)g.Bt + (size_t)cur.pn * tstep;
    S.a_ready(cur);
    if constexpr (SP2) {
        PG8_STAGE(PG8_SB(0, 0), cB, voffB); PG8_STAGE(PG8_SB(0, 1), cB + hstep, voffB); PG8_STAGE(PG8_SA(0, 0), cA, voffA); PG8_STAGE(PG8_SA(0, 1), cA + hstep, voffA);
        if (wr == 1) PG8_BAR;
        PG8_WAIT_V(2); PG8_BAR;
        PG8_STAGE(PG8_SB(1, 0), cB + kstep, voffB); PG8_STAGE(PG8_SA(1, 0), cA + kstep, voffA); PG8_STAGE(PG8_SB(1, 1), cB + hstep + kstep, voffB);
        PG8_WAIT_V(6); PG8_BAR;
    } else {
        PG8_STAGE(PG8_SB(0, 0), cB, voffB); PG8_STAGE(PG8_SA(0, 0), cA, voffA); PG8_STAGE(PG8_SB(0, 1), cB + hstep, voffB); PG8_STAGE(PG8_SA(0, 1), cA + hstep, voffA);
        if (wr == 1) PG8_BAR;
        PG8_WAIT_V(4); PG8_BAR;
        PG8_STAGE(PG8_SB(1, 0), cB + kstep, voffB); PG8_STAGE(PG8_SA(1, 0), cA + kstep, voffA); PG8_STAGE(PG8_SB(1, 1), cB + hstep + kstep, voffB);
        PG8_WAIT_V(6); PG8_BAR;
    }
    for (;;) {
        const bool has_next = S.next(ui + 1, nxt);
        const char* nA = has_next ? (const char*)g.A + (size_t)nxt.pm * tstep : cA; const char* nB = has_next ? (const char*)g.Bt + (size_t)nxt.pn * tstep : cB;
        for (int t = 0; t < nt; t += 2) {
            const bool last = (t == nt - 2);
            const char* a1 = cA + (size_t)(t + 1) * kstep;
            const char* a2 = last ? nA : cA + (size_t)(t + 2) * kstep; const char* b2 = last ? nB : cB + (size_t)(t + 2) * kstep;
            const char* a3 = a2 + kstep; const char* b3 = b2 + kstep;
            if (last && has_next) S.a_ready(nxt);
            if constexpr (SP2) {
            PG8_LDB(B0, 0, 0); PG8_LDB(B1, 0, 1); PG8_SCHED; PG8_LDA(At, 0, 0); PG8_STAGE(PG8_SA(1, 1), a1 + hstep, voffA);
            PG8_WAIT_V(8); PG8_WAIT_L(0); PG8_BAR; PG8_MMA(0, 0, At, B0); PG8_MMA(0, 1, At, B1); PG8_BAR; PG8_SCHED;
            PG8_LDA(At, 0, 1); PG8_STAGE(PG8_SB(0, 0), b2, voffB); PG8_STAGE(PG8_SB(0, 1), b2 + hstep, voffB); PG8_STAGE(PG8_SA(0, 0), a2, voffA);
            PG8_WAIT_V(8); PG8_WAIT_L(0); PG8_BAR; PG8_MMA(1, 0, At, B0); PG8_MMA(1, 1, At, B1); PG8_BAR; PG8_SCHED;
            PG8_LDB(B0, 1, 0); PG8_LDB(B1, 1, 1); PG8_SCHED; PG8_LDA(At, 1, 0); PG8_STAGE(PG8_SA(0, 1), a2 + hstep, voffA);
            PG8_WAIT_V(8); PG8_WAIT_L(0); PG8_BAR; PG8_MMA(0, 0, At, B0); PG8_MMA(0, 1, At, B1); PG8_BAR; PG8_SCHED;
            PG8_LDA(At, 1, 1); PG8_STAGE(PG8_SB(1, 0), b3, voffB); PG8_STAGE(PG8_SB(1, 1), b3 + hstep, voffB); PG8_STAGE(PG8_SA(1, 0), a3, voffA);
            PG8_WAIT_V(8); PG8_WAIT_L(0); PG8_BAR; PG8_MMA(1, 0, At, B0); PG8_MMA(1, 1, At, B1); PG8_BAR; PG8_SCHED;
            } else {
            PG8_LDB(B0, 0, 0); PG8_SCHED; PG8_LDA(At, 0, 0); PG8_STAGE(PG8_SA(1, 1), a1 + hstep, voffA);
            PG8_WAIT_L(8); PG8_BAR; PG8_WAIT_L(0); PG8_MMA(0, 0, At, B0); PG8_BAR; PG8_SCHED;
            PG8_LDB(B1, 0, 1); PG8_STAGE(PG8_SB(0, 0), b2, voffB);
            PG8_BAR; PG8_WAIT_L(0); PG8_MMA(0, 1, At, B1); PG8_BAR;
            PG8_LDA(At, 0, 1); PG8_STAGE(PG8_SA(0, 0), a2, voffA);
            PG8_BAR; PG8_WAIT_L(0); PG8_MMA(1, 0, At, B0); PG8_BAR; PG8_SCHED;
            PG8_STAGE(PG8_SB(0, 1), b2 + hstep, voffB);
            PG8_WAIT_V(6); PG8_BAR; PG8_MMA(1, 1, At, B1); PG8_BAR;
            PG8_LDB(B0, 1, 0); PG8_SCHED; PG8_LDA(At, 1, 0); PG8_STAGE(PG8_SA(0, 1), a2 + hstep, voffA);
            PG8_WAIT_L(8); PG8_BAR; PG8_WAIT_L(0); PG8_MMA(0, 0, At, B0); PG8_BAR; PG8_SCHED;
            PG8_LDB(B1, 1, 1); PG8_STAGE(PG8_SB(1, 0), b3, voffB);
            PG8_BAR; PG8_WAIT_L(0); PG8_MMA(0, 1, At, B1); PG8_BAR;
            PG8_LDA(At, 1, 1); PG8_STAGE(PG8_SA(1, 0), a3, voffA);
            PG8_BAR; PG8_WAIT_L(0); PG8_MMA(1, 0, At, B0); PG8_BAR; PG8_SCHED;
            PG8_STAGE(PG8_SB(1, 1), b3 + hstep, voffB);
            PG8_WAIT_V(6); PG8_BAR; PG8_MMA(1, 1, At, B1); PG8_BAR;
            }
        }
        if constexpr (ALIGN_EPI) { if (wr == 0) PG8_BAR; }
        if constexpr (!Epi::AFTER_DRAIN) { E(acc, cur, wr, wc, fr, fq); S.done(cur); }
        if (!has_next) break;
#pragma unroll
        for (int a = 0; a < 2; ++a)
#pragma unroll
            for (int b = 0; b < 2; ++b)
#pragma unroll
                for (int m = 0; m < 4; ++m)
#pragma unroll
                    for (int n = 0; n < 2; ++n) acc[a][b][m][n] = (f32x4){0.f, 0.f, 0.f, 0.f};
        cur = nxt; cA = nA; cB = nB; ++ui;
        if constexpr (ALIGN_EPI) { if (wr == 1) PG8_BAR; }
    }
    PG8_WAIT_V(0);
    if constexpr (!ALIGN_EPI) { if (wr == 0) PG8_BAR; }
    PG8_BAR;
    if constexpr (Epi::AFTER_DRAIN) { E.fused(acc, cur, wr, wc, fr, fq, lds, wid, lane); S.done(cur); }
#undef PG8_SA
#undef PG8_SB
#undef PG8_STAGE
#undef PG8_LDA
#undef PG8_LDB
#undef PG8_MMA
#undef PG8_WAIT_V
#undef PG8_WAIT_L
#undef PG8_BAR
#undef PG8_SCHED
}
}
#define GAS __attribute__((address_space(1)))
#define LAS __attribute__((address_space(3)))
#define DI __device__ __forceinline__
typedef unsigned short bf16;
typedef short bf16x8 __attribute__((ext_vector_type(8)));
typedef short s16x4 __attribute__((ext_vector_type(4)));
typedef float f32x4 __attribute__((ext_vector_type(4)));
typedef float f32x2 __attribute__((ext_vector_type(2)));
typedef unsigned u32x4 __attribute__((ext_vector_type(4)));
typedef unsigned u32x2 __attribute__((ext_vector_type(2)));
typedef __bf16 bf16x2_t __attribute__((ext_vector_type(2)));
#define MFMA16(a, b, c) __builtin_amdgcn_mfma_f32_16x16x32_bf16((a), (b), (c), 0, 0, 0)

constexpr int NB = 4, T = 8192, D = 1024, M = NB * T, FF = 2816;
constexpr int EIN = 4096, OIN = 1840, OINP = 2048;
constexpr float RMS_EPS = 1e-6f, LOG2E = 1.4426950408889634f;
constexpr size_t MiB = 1u << 20;
constexpr size_t WS_EIN = 0, WS_EOUT = 8 * MiB, WS_OIN = 10 * MiB, WS_OOUT = 14 * MiB, WS_GU = 16 * MiB, WS_DN = 38 * MiB;
constexpr size_t WS_W1K = 49 * MiB, WS_W1V = WS_W1K + 256 * 1024, WS_W2K = WS_W1V + 256 * 1024, WS_W2V = WS_W2K + 8192;
constexpr size_t WS_CTL = 56 * MiB, CTL_BYTES = 16384, WS_RS = 57 * MiB;
constexpr size_t WS_DEC = 52 * MiB, WS_KCMP = 54 * MiB, WS_VCMPT = WS_KCMP + 512 * 1024;
constexpr size_t WS_Y = 64 * MiB;
constexpr size_t WS_VST = 192 * MiB, WS_VWT = 200 * MiB, WS_HB = 240 * MiB;
constexpr size_t WS_HN = 320 * MiB, WS_ST = 384 * MiB, WS_END = 512 * MiB;
constexpr size_t GU_STRIDE = (size_t)2 * FF * D, DN_STRIDE = (size_t)D * FF;
constexpr int LDS_BYTES = 163840;

DI unsigned pk2(float lo, float hi) { f32x2 v = {lo, hi}; return __builtin_bit_cast(unsigned, __builtin_convertvector(v, bf16x2_t)); }
DI bf16 f2bf(float f) { return (bf16)(pk2(f, 0.f) & 0xffffu); }
DI float bf2f(bf16 x) { return __uint_as_float(((unsigned)x) << 16); }
DI float bflo(unsigned w) { return __uint_as_float(w << 16); }
DI float bfhi(unsigned w) { return __uint_as_float(w & 0xffff0000u); }
DI float wave_sum(float v) {
#pragma unroll
    for (int o = 1; o < 64; o <<= 1) v += __shfl_xor(v, o);
    return v;
}
DI float ex2(float x) { return __builtin_amdgcn_exp2f(x); }
DI float sigmoidf_(float x) { return __builtin_amdgcn_rcpf(1.0f + __expf(-x)); }
DI float siluf_(float x) { return x * __builtin_amdgcn_rcpf(1.0f + __expf(-x)); }

DI float rowscale(const float* rs, int row, int fq) {
    const f32x4 p = *(const f32x4*)(rs + (size_t)row * 16 + 4 * fq);
    float s = (p.x + p.y) + (p.z + p.w); s += __shfl_xor(s, 16); s += __shfl_xor(s, 32);
    return rsqrtf(s * (1.f / D) + RMS_EPS);
}
struct EpiStore {
    static constexpr bool PERM = true, AFTER_DRAIN = false;
    bf16* O; int ldc; const float* rs;
    DI void operator()(const pg8::f32x4 (&acc)[2][2][4][2], const pg8::Unit& u, int wr, int wc, int fr, int fq) const {
        const int row0 = u.pm * 256 + wr * 64 + fr, col0 = u.pn * 256 + wc * 32 + 8 * fq;
#pragma unroll
        for (int ai = 0; ai < 2; ++ai)
#pragma unroll
            for (int m = 0; m < 4; ++m) { const int row = row0 + ai * 128 + m * 16; bf16* rowp = O + (size_t)row * ldc + col0;
                const float r = rs ? rowscale(rs, row, fq) : 1.f;
#pragma unroll
                for (int bj = 0; bj < 2; ++bj) { const pg8::f32x4 v0 = acc[ai][bj][m][0] * r, v1 = acc[ai][bj][m][1] * r;
                    u32x4 w; w.x = pk2(v0[0], v0[1]); w.y = pk2(v0[2], v0[3]); w.z = pk2(v1[0], v1[1]); w.w = pk2(v1[2], v1[3]);
                    *(u32x4*)(rowp + bj * 128) = w; } }
    }
};
struct EpiStoreLA {
    static constexpr bool PERM = true, AFTER_DRAIN = false;
    bf16* O;
    DI void operator()(const pg8::f32x4 (&acc)[2][2][4][2], const pg8::Unit& u, int wr, int wc, int fr, int fq) const {
        const int row0 = u.pm * 256 + wr * 64 + fr, col0 = u.pn * 256 + wc * 32 + 8 * fq;
#pragma unroll
        for (int ai = 0; ai < 2; ++ai)
#pragma unroll
            for (int m = 0; m < 4; ++m) { const int row = row0 + ai * 128 + m * 16; const int bb = row >> 13, n = (row >> 6) & 127, r = row & 63;
#pragma unroll
                for (int bj = 0; bj < 2; ++bj) { const int col = col0 + bj * 128; const int arr = (col >> 9) & 3, hh = ((col >> 11) << 2) | ((col >> 7) & 3), c = col & 127;
                    const pg8::f32x4 v0 = acc[ai][bj][m][0], v1 = acc[ai][bj][m][1];
                    u32x4 w; w.x = pk2(v0[0], v0[1]); w.y = pk2(v0[2], v0[3]); w.z = pk2(v1[0], v1[1]); w.w = pk2(v1[2], v1[3]);
                    *(u32x4*)(O + ((size_t)((((bb * 8 + hh) * 128 + n) * 4 + arr)) << 13) + r * 128 + c) = w; } }
    }
};
struct EpiSwiglu {
    static constexpr bool PERM = true, AFTER_DRAIN = false;
    bf16* O; const float* rs;
    DI void operator()(const pg8::f32x4 (&acc)[2][2][4][2], const pg8::Unit& u, int wr, int wc, int fr, int fq) const {
        const int row0 = u.pm * 256 + wr * 64 + fr, col0 = u.pn * 128 + wc * 32 + 8 * fq;
#pragma unroll
        for (int ai = 0; ai < 2; ++ai)
#pragma unroll
            for (int m = 0; m < 4; ++m) { const int row = row0 + ai * 128 + m * 16; bf16* rowp = O + (size_t)row * FF + col0;
                const float rsc = rowscale(rs, row, fq);
                float r[8];
#pragma unroll
                for (int n = 0; n < 2; ++n)
#pragma unroll
                    for (int e = 0; e < 4; ++e) { const float g = acc[ai][0][m][n][e] * rsc, up = acc[ai][1][m][n][e] * rsc; r[n * 4 + e] = g * __builtin_amdgcn_rcpf(1.0f + __expf(-g)) * up; }
                u32x4 w; w.x = pk2(r[0], r[1]); w.y = pk2(r[2], r[3]); w.z = pk2(r[4], r[5]); w.w = pk2(r[6], r[7]);
                *(u32x4*)rowp = w; }
    }
};
struct EpiResid {
    static constexpr bool PERM = false, AFTER_DRAIN = false;
    const float* base; float* out; bf16* hb; float* rs;
    DI void operator()(const pg8::f32x4 (&acc)[2][2][4][2], const pg8::Unit& u, int wr, int wc, int fr, int fq) const {
        const int row0 = u.pm * 256 + wr * 64 + fr, col0 = u.pn * 256 + wc * 32 + 4 * fq;
#pragma unroll
        for (int ai = 0; ai < 2; ++ai)
#pragma unroll
            for (int m = 0; m < 4; ++m) { const int row = row0 + ai * 128 + m * 16; const size_t off = (size_t)row * D + col0; float ss = 0.f;
#pragma unroll
                for (int bj = 0; bj < 2; ++bj)
#pragma unroll
                    for (int n = 0; n < 2; ++n) { const f32x4 bs = *(const f32x4*)(base + off + bj * 128 + n * 16); const pg8::f32x4 a = acc[ai][bj][m][n];
                        f32x4 o; o.x = bs.x + a[0]; o.y = bs.y + a[1]; o.z = bs.z + a[2]; o.w = bs.w + a[3]; *(f32x4*)(out + off + bj * 128 + n * 16) = o;
                        if (hb) { u32x2 hw; hw.x = pk2(o.x, o.y); hw.y = pk2(o.z, o.w); *(u32x2*)(hb + off + bj * 128 + n * 16) = hw; ss += (o.x * o.x + o.y * o.y) + (o.z * o.z + o.w * o.w); } }
                if (hb) { ss += __shfl_xor(ss, 16); ss += __shfl_xor(ss, 32); if (fq == 0) rs[(size_t)row * 16 + u.pn * 4 + wc] = ss; } }
    }
};

DI void transpose_item(const float* W, int K, int N, int Npad, bf16* WT, int mode, LAS float* scr, int item, int lane, const float* gk = nullptr) {
    const int nblk = Npad / 32, kb = item / nblk, nb = item % nblk, k0 = 64 * kb, n0 = 32 * nb;
    const int nl = n0 + (lane & 31);
#pragma unroll 8
    for (int i = 0; i < 32; ++i) { const int kk = 2 * i + (lane >> 5); const float gv = gk ? gk[k0 + kk] : 1.f; scr[kk * 33 + (lane & 31)] = (nl < N) ? W[(size_t)(k0 + kk) * N + nl] * gv : 0.f; }
    asm volatile("s_waitcnt lgkmcnt(0)" ::: "memory");
    const int c = lane & 7;
    int drow0 = n0;
    if (mode == 1) { drow0 = (n0 < FF) ? (256 * (n0 >> 7) + (n0 & 127)) : (256 * ((n0 - FF) >> 7) + 128 + ((n0 - FF) & 127)); }
#pragma unroll
    for (int j = 0; j < 4; ++j) { const int n = (lane >> 3) + 8 * j; const LAS float* s = scr + (8 * c) * 33 + n;
        u32x4 o; o.x = pk2(s[0 * 33], s[1 * 33]); o.y = pk2(s[2 * 33], s[3 * 33]); o.z = pk2(s[4 * 33], s[5 * 33]); o.w = pk2(s[6 * 33], s[7 * 33]);
        *(u32x4*)(WT + (size_t)(drow0 + n) * K + k0 + 8 * c) = o; }
    asm volatile("s_waitcnt lgkmcnt(0)" ::: "memory");
}
DI void norm_rows_bf16(const float* h, const float* g, bf16* out, int gw, int ngw, int lane) {
    f32x4 gv[4];
#pragma unroll
    for (int j = 0; j < 4; ++j) gv[j] = *((const f32x4*)g + lane + 64 * j);
    for (int m0 = gw; m0 < M; m0 += 4 * ngw) {
        f32x4 v[4][4];
#pragma unroll
        for (int r = 0; r < 4; ++r) { const int m = m0 + r * ngw < M ? m0 + r * ngw : m0; const f32x4* xr = (const f32x4*)(h + (size_t)m * D) + lane;
#pragma unroll
            for (int j = 0; j < 4; ++j) v[r][j] = xr[64 * j]; }
#pragma unroll
        for (int r = 0; r < 4; ++r) { const int m = m0 + r * ngw; float s = 0.f;
#pragma unroll
            for (int j = 0; j < 4; ++j) s += (v[r][j].x * v[r][j].x + v[r][j].y * v[r][j].y) + (v[r][j].z * v[r][j].z + v[r][j].w * v[r][j].w);
            const float rr = rsqrtf(wave_sum(s) * (1.f / D) + RMS_EPS);
            if (m < M) { u32x2* o8 = (u32x2*)(out + (size_t)m * D) + lane;
#pragma unroll
                for (int j = 0; j < 4; ++j) { u32x2 w; w.x = pk2(v[r][j].x * rr * gv[j].x, v[r][j].y * rr * gv[j].y); w.y = pk2(v[r][j].z * rr * gv[j].z, v[r][j].w * rr * gv[j].w); o8[64 * j] = w; } } }
    }
}
DI void norm_rows_f32_inplace(float* h, const float* g, int gw, int ngw, int lane) {
    f32x4 gv[4];
#pragma unroll
    for (int j = 0; j < 4; ++j) gv[j] = *((const f32x4*)g + lane + 64 * j);
    for (int m0 = gw; m0 < M; m0 += 4 * ngw) {
        f32x4 v[4][4];
#pragma unroll
        for (int r = 0; r < 4; ++r) { const int m = m0 + r * ngw < M ? m0 + r * ngw : m0; const f32x4* xr = (const f32x4*)(h + (size_t)m * D) + lane;
#pragma unroll
            for (int j = 0; j < 4; ++j) v[r][j] = xr[64 * j]; }
        asm volatile("" ::: "memory");
#pragma unroll
        for (int r = 0; r < 4; ++r) { const int m = m0 + r * ngw; float s = 0.f;
#pragma unroll
            for (int j = 0; j < 4; ++j) s += (v[r][j].x * v[r][j].x + v[r][j].y * v[r][j].y) + (v[r][j].z * v[r][j].z + v[r][j].w * v[r][j].w);
            const float rr = rsqrtf(wave_sum(s) * (1.f / D) + RMS_EPS);
            if (m < M) { f32x4* xo = (f32x4*)(h + (size_t)m * D) + lane;
#pragma unroll
                for (int j = 0; j < 4; ++j) { f32x4 o; o.x = v[r][j].x * rr * gv[j].x; o.y = v[r][j].y * rr * gv[j].y; o.z = v[r][j].z * rr * gv[j].z; o.w = v[r][j].w * rr * gv[j].w; xo[64 * j] = o; } } }
    }
}
typedef GAS unsigned gu32;
#define XB_TMO      128
#define XB_XCNT(j)  (256  + 64 * (j))
#define XB_XSUB(j)  (1280 + 64 * (j))
#define XB_XGEN(j)  (2304 + 64 * (j))
#define XB_TOP      3328
#define XB_TOPGEN   3392
#define XCD_BAR_WORDS 3456
#define XB_SPIN_CAP (1u << 18)

__device__ __forceinline__ unsigned xb_ld(unsigned* p)              { return __hip_atomic_load(p, __ATOMIC_RELAXED, __HIP_MEMORY_SCOPE_AGENT); }
__device__ __forceinline__ unsigned xb_add(unsigned* p, unsigned v) { return __hip_atomic_fetch_add(p, v, __ATOMIC_RELAXED, __HIP_MEMORY_SCOPE_AGENT); }
__device__ __forceinline__ unsigned xb_xcc_id() { return (unsigned)__builtin_amdgcn_s_getreg((3 << 11) | 20) & 0xFu; }
#define XB_SPIN(cond, bar) do { unsigned _sp = 0; while (cond) { __builtin_amdgcn_s_sleep(1); \
    if ((++_sp & 255u) == 0u) { if (xb_ld(&(bar)[XB_TMO])) break; if (_sp > XB_SPIN_CAP) { atomicAdd(&(bar)[XB_TMO], 1u); break; } } } } while (0)

struct XcdBarrier {
    unsigned* bar; unsigned x;
    volatile LAS unsigned* st;
};

__device__ __forceinline__ XcdBarrier xcd_barrier_post(unsigned* bar, volatile LAS unsigned* st) {
    XcdBarrier b; b.bar = bar; b.x = xb_xcc_id(); b.st = st;
    if (threadIdx.x == 0) (void)xb_add(&bar[XB_XCNT(b.x)], 1u);
    return b;
}
__device__ __forceinline__ void xcd_barrier_complete(unsigned* bar, unsigned x, unsigned& nloc, unsigned& nx) {
    const unsigned G = gridDim.x * gridDim.y * gridDim.z;
    unsigned sum, cnt, mine, sp = 0u;
    for (;;) {
        sum = 0u; cnt = 0u; mine = 0u;
#pragma unroll
        for (unsigned j = 0; j < 16; ++j) { const unsigned c = xb_ld(&bar[XB_XCNT(j)]); sum += c; cnt += (c > 0u) ? 1u : 0u; mine = (j == x) ? c : mine; }
        if (sum == G) break;
        __builtin_amdgcn_s_sleep(1);
        if ((++sp & 255u) == 0u) { if (xb_ld(&bar[XB_TMO])) break; if (sp > XB_SPIN_CAP) { atomicAdd(&bar[XB_TMO], 1u); break; } }
    }
    nloc = mine > 0u ? mine : 1u; nx = cnt > 0u ? cnt : 1u;
}

__device__ __forceinline__ void xcd_barrier(const XcdBarrier& b) {
    asm volatile("s_waitcnt vmcnt(0)" ::: "memory");
    __syncthreads();
    if (threadIdx.x == 0) {
        unsigned* bar = b.bar;
        __builtin_amdgcn_s_waitcnt(0);
        unsigned nloc = b.st[0], nx = b.st[1];
        if (nloc == 0u) { xcd_barrier_complete(bar, b.x, nloc, nx); b.st[0] = nloc; b.st[1] = nx; }
        const unsigned old = xb_add(&bar[XB_XSUB(b.x)], 1u);
        const unsigned gen = old / nloc;
        if (old + 1u == (gen + 1u) * nloc) {
            __builtin_amdgcn_fence(__ATOMIC_RELEASE, "agent");
            asm volatile("s_waitcnt vmcnt(0)" ::: "memory");
            const unsigned og = xb_add(&bar[XB_TOP], 1u);
            const unsigned tg = og / nx;
            if (og + 1u == (tg + 1u) * nx) xb_add(&bar[XB_TOPGEN], 1u);
            else XB_SPIN(xb_ld(&bar[XB_TOPGEN]) == tg, bar);
            __builtin_amdgcn_fence(__ATOMIC_ACQUIRE, "agent");
            xb_add(&bar[XB_XGEN(b.x)], 1u);
            asm volatile("s_waitcnt vmcnt(0)" ::: "memory");
        } else {
            XB_SPIN(xb_ld(&bar[XB_XGEN(b.x)]) == gen, bar);
            __builtin_amdgcn_fence(__ATOMIC_ACQUIRE, "agent");
            asm volatile("s_waitcnt vmcnt(0)" ::: "memory");
        }
    }
    __syncthreads();
}
constexpr int LA_UNITS = NB * 8 * 128;
constexpr int KT_LD = 72, QT_LD = 136;
#define LA_BAR() do { asm volatile("s_waitcnt lgkmcnt(0)" ::: "memory"); __builtin_amdgcn_s_barrier(); asm volatile("" ::: "memory"); } while (0)
struct LaRaw { unsigned f[16], qv[16], v[16]; float lba, lbb; };
DI void la_read_col(const LAS bf16* tile, int d, int rg, unsigned (&out)[16]) {
#pragma unroll
    for (int e = 0; e < 16; ++e) out[e] = tile[(16 * rg + e) * QT_LD + d];
}
template <bool WANT_Q>
DI void la_math(const LaRaw& R, int hh, float (&fd)[16], float (&kk)[16], float (&qq)[16]) {
    if (hh < 4) {
        const float mx = fmaxf(R.lba, R.lbb), ea = __expf(R.lba - mx), eb = __expf(R.lbb - mx), lbv = ea / (ea + eb);
#pragma unroll
        for (int e = 0; e < 16; ++e) { const float x = bf2f((bf16)R.f[e]); const float f = lbv + (1.f - lbv) * sigmoidf_(x); fd[e] = f; kk[e] = 1.f - f;
            if (WANT_Q) qq[e] = siluf_(bf2f((bf16)R.qv[e])); }
    } else {
        const int r = hh - 4; const float gam = 1.f - exp2f(-5.f - (float)r);
#pragma unroll
        for (int e = 0; e < 16; ++e) { fd[e] = gam; kk[e] = bf2f((bf16)R.f[e]) * 0.08838834764831845f; if (WANT_Q) qq[e] = bf2f((bf16)R.qv[e]); }
    }
}
DI void la_store_vt(const LaRaw& R, int d, int rg, LAS bf16* VT) {
    LAS u32x4* dst = (LAS u32x4*)(VT + d * KT_LD + 16 * rg);
    dst[0] = (u32x4){R.v[0] | (R.v[1] << 16), R.v[2] | (R.v[3] << 16), R.v[4] | (R.v[5] << 16), R.v[6] | (R.v[7] << 16)};
    dst[1] = (u32x4){R.v[8] | (R.v[9] << 16), R.v[10] | (R.v[11] << 16), R.v[12] | (R.v[13] << 16), R.v[14] | (R.v[15] << 16)};
}
#define LA_CH_LDS(base, ch) ((LAS u32x4*)((base) + ((ch) >> 4) * QT_LD + ((ch) & 15) * 8))
DI void la_state_phase(const bf16* Y0, const float* lbraw, bf16* ST, float* DEC, LAS unsigned char* lds) {
    LAS bf16* KT = (LAS bf16*)lds; LAS bf16* VT = KT + 128 * KT_LD; LAS float* tot = (LAS float*)(VT + 128 * KT_LD);
    LAS bf16* RF = KT; LAS bf16* RV = VT;
    const int tid = threadIdx.x, lane = tid & 63, w = tid >> 6, l15 = lane & 15, q = lane >> 4, d = tid & 127, rg = tid >> 7;
    u32x4 rf[2], rv[2]; float lba, lbb;
#define A1_FETCH(un) { const bf16* yb_ = Y0 + ((size_t)(un) << 15); const int li_ = ((((un) >> 7) & 3) << 7) + d; \
        _Pragma("unroll") for (int c_ = 0; c_ < 2; ++c_) { rf[c_] = *(const u32x4*)(yb_ + 8192 + (size_t)(tid + 512 * c_) * 8); rv[c_] = *(const u32x4*)(yb_ + 16384 + (size_t)(tid + 512 * c_) * 8); } \
        lba = lbraw[li_]; lbb = lbraw[512 + li_]; asm volatile("" ::: "memory"); }
#define A1_STORE() { _Pragma("unroll") for (int c_ = 0; c_ < 2; ++c_) { *LA_CH_LDS(RF, tid + 512 * c_) = rf[c_]; *LA_CH_LDS(RV, tid + 512 * c_) = rv[c_]; } }
    A1_FETCH(blockIdx.x)
    A1_STORE()
    LaRaw R; R.lba = lba; R.lbb = lbb;
    LA_BAR();
    for (int unit = blockIdx.x; unit < LA_UNITS; unit += gridDim.x) {
        const int hh = (unit >> 7) & 7;
        { const int nx = unit + (int)gridDim.x, un = nx < LA_UNITS ? nx : unit; A1_FETCH(un) }
        la_read_col(RF, d, rg, R.f); la_read_col(RV, d, rg, R.v);
        LA_BAR();
        float fd[16], kk[16], qq[16];
        la_math<false>(R, hh, fd, kk, qq);
        float run = 1.f;
#pragma unroll
        for (int e = 15; e >= 0; --e) { kk[e] *= run; run *= fd[e]; }
        tot[rg * 128 + d] = run;
        la_store_vt(R, d, rg, VT);
        LA_BAR();
        float post = 1.f, last = 1.f;
#pragma unroll
        for (int g2 = 0; g2 < 4; ++g2) { const float tv = tot[g2 * 128 + d]; if (g2 > rg) post *= tv; last *= tv; }
        unsigned wv[8];
#pragma unroll
        for (int e = 0; e < 8; ++e) wv[e] = pk2(kk[2 * e] * post, kk[2 * e + 1] * post);
        LAS u32x4* dst = (LAS u32x4*)(KT + d * KT_LD + 16 * rg);
        dst[0] = (u32x4){wv[0], wv[1], wv[2], wv[3]}; dst[1] = (u32x4){wv[4], wv[5], wv[6], wv[7]};
        if (rg == 0) DEC[(size_t)unit * 128 + d] = last;
        LA_BAR();
        f32x4 acc[8];
#pragma unroll
        for (int dt = 0; dt < 8; ++dt) acc[dt] = (f32x4){0.f, 0.f, 0.f, 0.f};
#pragma unroll
        for (int ks = 0; ks < 2; ++ks) { const bf16x8 bv = *(const LAS bf16x8*)(VT + (16 * w + l15) * KT_LD + 32 * ks + 8 * q);
#pragma unroll
            for (int dt = 0; dt < 8; ++dt) { const bf16x8 ak = *(const LAS bf16x8*)(KT + (16 * dt + l15) * KT_LD + 32 * ks + 8 * q); acc[dt] = MFMA16(ak, bv, acc[dt]); } }
        bf16* so = ST + (size_t)unit * 16384 + (16 * w + l15) * 128 + 4 * q;
#pragma unroll
        for (int dt = 0; dt < 8; ++dt) { u32x2 o; o.x = pk2(acc[dt][0], acc[dt][1]); o.y = pk2(acc[dt][2], acc[dt][3]); *(u32x2*)(so + 16 * dt) = o; }
        LA_BAR();
        A1_STORE()
        R.lba = lba; R.lbb = lbb;
        LA_BAR();
    }
#undef A1_FETCH
#undef A1_STORE
}
DI void la_scan_phase(bf16* ST, const float* DEC) {
    const int gid = blockIdx.x * 512 + threadIdx.x, nth = gridDim.x * 512;
    for (int wk = gid; wk < 32 * 4096; wk += nth) {
        const int bh = wk >> 12, e4 = (wk & 4095) * 4, d = e4 & 127;
        f32x4 s = {0.f, 0.f, 0.f, 0.f};
        bf16* sp = ST + (size_t)bh * 128 * 16384 + e4; const float* dp = DEC + (size_t)bh * 128 * 128 + d;
        for (int n0 = 0; n0 < 128; n0 += 8) {
            u32x2 uv[8]; f32x4 dv[8];
#pragma unroll
            for (int i = 0; i < 8; ++i) { uv[i] = *(const u32x2*)(sp + (size_t)(n0 + i) * 16384); dv[i] = *(const f32x4*)(dp + (size_t)(n0 + i) * 128); }
#pragma unroll
            for (int i = 0; i < 8; ++i) { u32x2 o; o.x = pk2(s.x, s.y); o.y = pk2(s.z, s.w); *(u32x2*)(sp + (size_t)(n0 + i) * 16384) = o;
                s.x = dv[i].x * s.x + bflo(uv[i].x); s.y = dv[i].y * s.y + bfhi(uv[i].x); s.z = dv[i].z * s.z + bflo(uv[i].y); s.w = dv[i].w * s.w + bfhi(uv[i].y); }
        }
    }
}
DI void la_out_phase(const bf16* Y0, const float* lbraw, const bf16* ST, const float* gh, const float* gr, bf16* MIX, LAS unsigned char* lds) {
    LAS bf16* QT = (LAS bf16*)lds; LAS bf16* K2 = QT + 64 * QT_LD; LAS bf16* QS = K2 + 64 * QT_LD; LAS bf16* VT = QS + 64 * QT_LD;
    LAS float* tot = (LAS float*)(VT + 128 * KT_LD); LAS float* ssq = tot + 512; LAS float* gnl = ssq + 128;
    LAS bf16* SB = (LAS bf16*)(gnl + 256);
    LAS bf16* GB = SB + 128 * QT_LD;
    LAS bf16* RQ = QT; LAS bf16* RF = K2; LAS bf16* RV = QS;
    const int tid = threadIdx.x, lane = tid & 63, w = tid >> 6, l15 = lane & 15, q = lane >> 4, d = tid & 127, rg = tid >> 7;
    const int it = w & 3, vh = w >> 2;
    const int irow = 16 * it + l15;
    if (tid < 256) gnl[tid] = tid < 128 ? gh[tid] : gr[tid - 128];
    u32x4 rr[6], s2[4], g2r[2]; float lba, lbb;
#define A3_FETCH(un) { const bf16* yb_ = Y0 + ((size_t)(un) << 15); const bf16* sp_ = ST + ((size_t)(un) << 14); const int li_ = ((((un) >> 7) & 3) << 7) + d; \
        _Pragma("unroll") for (int c_ = 0; c_ < 2; ++c_) { rr[c_] = *(const u32x4*)(yb_ + (size_t)(tid + 512 * c_) * 8); rr[2 + c_] = *(const u32x4*)(yb_ + 8192 + (size_t)(tid + 512 * c_) * 8); \
            rr[4 + c_] = *(const u32x4*)(yb_ + 16384 + (size_t)(tid + 512 * c_) * 8); g2r[c_] = *(const u32x4*)(yb_ + 24576 + (size_t)(tid + 512 * c_) * 8); } \
        _Pragma("unroll") for (int c_ = 0; c_ < 4; ++c_) s2[c_] = *(const u32x4*)(sp_ + (size_t)(tid + 512 * c_) * 8); \
        lba = lbraw[li_]; lbb = lbraw[512 + li_]; asm volatile("" ::: "memory"); }
#define A3_STORE() { _Pragma("unroll") for (int c_ = 0; c_ < 2; ++c_) { const int ch_ = tid + 512 * c_; *LA_CH_LDS(RQ, ch_) = rr[c_]; *LA_CH_LDS(RF, ch_) = rr[2 + c_]; *LA_CH_LDS(RV, ch_) = rr[4 + c_]; *LA_CH_LDS(GB, ch_) = g2r[c_]; } \
        _Pragma("unroll") for (int c_ = 0; c_ < 4; ++c_) *LA_CH_LDS(SB, tid + 512 * c_) = s2[c_]; }
    A3_FETCH(blockIdx.x)
    A3_STORE()
    LaRaw R; R.lba = lba; R.lbb = lbb;
    LA_BAR();
    for (int unit = blockIdx.x; unit < LA_UNITS; unit += gridDim.x) {
        const int b = unit >> 10, hh = (unit >> 7) & 7, n = unit & 127;
        const int row0 = b * T + n * 64;
        { const int nx = unit + (int)gridDim.x, un = nx < LA_UNITS ? nx : unit; A3_FETCH(un) }
        la_read_col(RQ, d, rg, R.qv); la_read_col(RF, d, rg, R.f); la_read_col(RV, d, rg, R.v);
        LA_BAR();
        float fd[16], kk[16], qq[16];
        la_math<true>(R, hh, fd, kk, qq);
        float run = 1.f;
#pragma unroll
        for (int e = 0; e < 16; ++e) { run *= fd[e]; fd[e] = run; }
        tot[rg * 128 + d] = run;
        la_store_vt(R, d, rg, VT);
        LA_BAR();
        float pre = 1.f;
#pragma unroll
        for (int g2 = 0; g2 < 4; ++g2) { const float tv = tot[g2 * 128 + d]; if (g2 < rg) pre *= tv; }
        const float ref = tot[d] * tot[128 + d], iref = __builtin_amdgcn_rcpf(ref);
#pragma unroll
        for (int e = 0; e < 16; ++e) { const float P = pre * fd[e], qP = qq[e] * P; const int j = 16 * rg + e;
            QT[j * QT_LD + d] = f2bf(qP * iref); K2[j * QT_LD + d] = f2bf(kk[e] * ref * __builtin_amdgcn_rcpf(P)); QS[j * QT_LD + d] = f2bf(qP); }
        LA_BAR();
        f32x4 at[4];
#pragma unroll
        for (int jt = 0; jt < 4; ++jt) at[jt] = (f32x4){0.f, 0.f, 0.f, 0.f};
#pragma unroll
        for (int ks = 0; ks < 4; ++ks) { const bf16x8 bq = *(const LAS bf16x8*)(QT + (16 * it + l15) * QT_LD + 32 * ks + 8 * q);
#pragma unroll
            for (int jt = 0; jt < 4; ++jt) { const bf16x8 ak = *(const LAS bf16x8*)(K2 + (16 * jt + l15) * QT_LD + 32 * ks + 8 * q); at[jt] = MFMA16(ak, bq, at[jt]); } }
#pragma unroll
        for (int jt = 0; jt < 4; ++jt)
#pragma unroll
            for (int r = 0; r < 4; ++r) { const int j = 16 * jt + 4 * q + r; if (j > irow) at[jt][r] = 0.f; }
        f32x4 o[4];
#pragma unroll
        for (int vt = 0; vt < 4; ++vt) o[vt] = (f32x4){0.f, 0.f, 0.f, 0.f};
#pragma unroll
        for (int k2 = 0; k2 < 2; ++k2) {
            u32x4 pw; pw.x = pk2(at[2 * k2][0], at[2 * k2][1]); pw.y = pk2(at[2 * k2][2], at[2 * k2][3]); pw.z = pk2(at[2 * k2 + 1][0], at[2 * k2 + 1][1]); pw.w = pk2(at[2 * k2 + 1][2], at[2 * k2 + 1][3]);
            const bf16x8 pf = __builtin_bit_cast(bf16x8, pw);
#pragma unroll
            for (int vt = 0; vt < 4; ++vt) { const LAS bf16* vp = VT + (64 * vh + 16 * vt + l15) * KT_LD + 32 * k2 + 4 * q;
                const u32x2 lo = *(const LAS u32x2*)vp, hi = *(const LAS u32x2*)(vp + 16);
                const bf16x8 av = __builtin_bit_cast(bf16x8, ((u32x4){lo.x, lo.y, hi.x, hi.y})); o[vt] = MFMA16(av, pf, o[vt]); }
        }
#pragma unroll
        for (int ks = 0; ks < 4; ++ks) { const bf16x8 bq = *(const LAS bf16x8*)(QS + (16 * it + l15) * QT_LD + 32 * ks + 8 * q);
#pragma unroll
            for (int vt = 0; vt < 4; ++vt) { const bf16x8 as = *(const LAS bf16x8*)(SB + (64 * vh + 16 * vt + l15) * QT_LD + 32 * ks + 8 * q); o[vt] = MFMA16(as, bq, o[vt]); } }
        float ss = 0.f;
#pragma unroll
        for (int vt = 0; vt < 4; ++vt) ss += (o[vt][0] * o[vt][0] + o[vt][1] * o[vt][1]) + (o[vt][2] * o[vt][2] + o[vt][3] * o[vt][3]);
        ss += __shfl_xor(ss, 16); ss += __shfl_xor(ss, 32);
        if (q == 0) ssq[vh * 64 + irow] = ss;
        LA_BAR();
        const float rs = rsqrtf((ssq[irow] + ssq[64 + irow]) * (1.f / 128.f) + RMS_EPS);
        const LAS float* gn = gnl + (hh < 4 ? 0 : 128);
        bf16* op = MIX + (size_t)(row0 + irow) * D + hh * 128;
#pragma unroll
        for (int vt = 0; vt < 4; ++vt) { const int v0 = 64 * vh + 16 * vt + 4 * q; const f32x4 gv = *(const LAS f32x4*)(gn + v0); const u32x2 gw = *(const LAS u32x2*)(GB + irow * QT_LD + v0);
            u32x2 ow; ow.x = pk2(o[vt][0] * rs * gv.x * siluf_(bflo(gw.x)), o[vt][1] * rs * gv.y * siluf_(bfhi(gw.x)));
            ow.y = pk2(o[vt][2] * rs * gv.z * siluf_(bflo(gw.y)), o[vt][3] * rs * gv.w * siluf_(bfhi(gw.y))); *(u32x2*)(op + v0) = ow; }
        LA_BAR();
        A3_STORE()
        R.lba = lba; R.lbb = lbb;
        LA_BAR();
    }
#undef A3_FETCH
#undef A3_STORE
}
constexpr int NC = 511, NCP = 512;
DI void nsa_compress_phase(const bf16* Y1, const float* posk, const float* posv, const bf16* w1kT, const bf16* w1vT, const bf16* w2kT, const bf16* w2vT,
                           bf16* KCMP, bf16* VCMPT, LAS unsigned char* lds, int gw, int ngw, int lane) {
    const int l15 = lane & 15, q = lane >> 4, wv = (threadIdx.x >> 6), grp = wv >> 2, nt = wv & 3;
    LAS bf16* h1s = (LAS bf16*)lds + grp * 16 * 72;
    for (int base = 0; base < 512; base += ngw / 4) {
        int task = base + (gw >> 2); const bool tvalid = task < 512; if (!tvalid) task = 511;
        const int kv = task & 1, rt = task >> 1;
        int r = rt * 16 + l15; const bool rvalid = tvalid && (r < NB * NC * 2); if (r >= NB * NC * 2) r = NB * NC * 2 - 1;
        const int b = r / (NC * 2), rem = r % (NC * 2), i = rem >> 1, g = rem & 1;
        const bf16* src = Y1 + (size_t)(b * T + 16 * i) * OINP + (kv ? 1152 : 1024) + g * 64;
        const float* pos = kv ? posv : posk; const bf16* w1 = (kv ? w1vT : w1kT) + (size_t)(16 * nt + l15) * 2048; const bf16* w2 = kv ? w2vT : w2kT;
        f32x4 acc = {0.f, 0.f, 0.f, 0.f};
#pragma unroll 8
        for (int ks = 0; ks < 64; ++ks) {
            const int p = ks >> 1, d0 = (ks & 1) * 32 + 8 * q;
            const u32x4 xv = *(const u32x4*)(src + (size_t)p * OINP + d0);
            const f32x4 p0 = *(const f32x4*)(pos + p * 64 + d0), p1 = *(const f32x4*)(pos + p * 64 + d0 + 4);
            u32x4 bw; bw.x = pk2(bflo(xv.x) + p0.x, bfhi(xv.x) + p0.y); bw.y = pk2(bflo(xv.y) + p0.z, bfhi(xv.y) + p0.w);
            bw.z = pk2(bflo(xv.z) + p1.x, bfhi(xv.z) + p1.y); bw.w = pk2(bflo(xv.w) + p1.z, bfhi(xv.w) + p1.w);
            const bf16x8 af = *(const bf16x8*)(w1 + 32 * ks + 8 * q);
            acc = MFMA16(af, __builtin_bit_cast(bf16x8, bw), acc);
        }
        { u32x2 hw; hw.x = pk2(siluf_(acc[0]), siluf_(acc[1])); hw.y = pk2(siluf_(acc[2]), siluf_(acc[3])); *(LAS u32x2*)(h1s + l15 * 72 + 16 * nt + 4 * q) = hw; }
        __syncthreads();
        f32x4 o2 = {0.f, 0.f, 0.f, 0.f};
#pragma unroll
        for (int k2 = 0; k2 < 2; ++k2) { const bf16x8 bf = *(const LAS bf16x8*)(h1s + l15 * 72 + 32 * k2 + 8 * q);
            const bf16x8 av = *(const bf16x8*)(w2 + (16 * nt + l15) * 64 + 32 * k2 + 8 * q); o2 = MFMA16(av, bf, o2); }
        if (rvalid) {
            if (kv == 0) { u32x2 ow; ow.x = pk2(o2[0], o2[1]); ow.y = pk2(o2[2], o2[3]); *(u32x2*)(KCMP + ((size_t)(b * 2 + g) * NCP + i) * 64 + 16 * nt + 4 * q) = ow; }
            else { bf16* op = VCMPT + (size_t)(b * 2 + g) * 64 * NCP + i;
#pragma unroll
                for (int r2 = 0; r2 < 4; ++r2) op[(size_t)(16 * nt + 4 * q + r2) * NCP] = f2bf(o2[r2]); }
        }
        __syncthreads();
    }
    for (int z = gw * 64 + lane; z < NB * 2 * 64; z += ngw * 64) { const int bg = z >> 6, dd = z & 63; KCMP[((size_t)bg * NCP + NC) * 64 + dd] = 0; VCMPT[((size_t)bg * 64 + dd) * NCP + NC] = 0; }
}
DI void nsa_vt_phase(const bf16* Y1, bf16* VST, bf16* VWT, int gw, int ngw, int lane) {
    for (int task = gw; task < 2 * NB * 2 * 128; task += ngw) {
        const int which = task & 1, g = (task >> 1) & 1, b = (task >> 2) & 3, blk = task >> 4;
        const int t = blk * 64 + lane;
        const bf16* src = Y1 + (size_t)(b * T + t) * OINP + (which ? 1664 : 1408) + g * 64;
        bf16* dst = (which ? VWT : VST) + (size_t)(b * 2 + g) * 64 * T + t;
        u32x4 v[8];
#pragma unroll
        for (int c = 0; c < 8; ++c) v[c] = *(const u32x4*)(src + 8 * c);
#pragma unroll
        for (int c = 0; c < 8; ++c) {
            dst[(size_t)(8 * c + 0) * T] = (bf16)(v[c].x & 0xffff); dst[(size_t)(8 * c + 1) * T] = (bf16)(v[c].x >> 16);
            dst[(size_t)(8 * c + 2) * T] = (bf16)(v[c].y & 0xffff); dst[(size_t)(8 * c + 3) * T] = (bf16)(v[c].y >> 16);
            dst[(size_t)(8 * c + 4) * T] = (bf16)(v[c].z & 0xffff); dst[(size_t)(8 * c + 5) * T] = (bf16)(v[c].z >> 16);
            dst[(size_t)(8 * c + 6) * T] = (bf16)(v[c].w & 0xffff); dst[(size_t)(8 * c + 7) * T] = (bf16)(v[c].w >> 16);
        }
    }
}
#define LDS_BAR() do { asm volatile("s_waitcnt lgkmcnt(0)" ::: "memory"); __builtin_amdgcn_s_barrier(); asm volatile("" ::: "memory"); } while (0)
constexpr int TL = 80;
constexpr int SLAB_LD = 132;
constexpr float C1 = 0.125f * LOG2E;
DI void tile_fetch(const bf16* kg, int ldk, const bf16* vg, int ldv, int tid, u32x4& kr, u32x4& vr) {
    const int r = tid >> 3, c = (tid & 7) * 8;
    kr = *(const u32x4*)(kg + (size_t)r * ldk + c); vr = *(const u32x4*)(vg + (size_t)r * ldv + c);
    asm volatile("" ::: "memory");
}
DI void tile_store(LAS bf16* Kb, LAS bf16* Vb, int tid, u32x4 kr, u32x4 vr) {
    const int r = tid >> 3, c = (tid & 7) * 8;
    *(LAS u32x4*)(Kb + r * TL + c) = kr;
    const int g32 = c & 32, k0 = c & 31, k1 = k0 + 4;
    const int p0 = 8 * ((k0 & 15) >> 2) + 4 * (k0 >> 4), p1 = 8 * ((k1 & 15) >> 2) + 4 * (k1 >> 4);
    *(LAS u32x2*)(Vb + r * TL + g32 + p0) = (u32x2){vr.x, vr.y}; *(LAS u32x2*)(Vb + r * TL + g32 + p1) = (u32x2){vr.z, vr.w};
}
DI void tile_scores(const LAS bf16* Kb, const bf16x8 (&qf)[2], int l15, int q, f32x4 (&sc)[4]) {
#pragma unroll
    for (int x = 0; x < 4; ++x) { sc[x] = (f32x4){0.f, 0.f, 0.f, 0.f};
#pragma unroll
        for (int ks = 0; ks < 2; ++ks) { const bf16x8 a = *(const LAS bf16x8*)(Kb + (16 * x + l15) * TL + 32 * ks + 8 * q); sc[x] = MFMA16(a, qf[ks], sc[x]); } }
}
DI void tile_pv(const LAS bf16* Vb, const float (&p)[16], f32x4 (&acc)[4], int l15, int q) {
#pragma unroll
    for (int k2 = 0; k2 < 2; ++k2) {
        u32x4 pw; pw.x = pk2(p[8 * k2], p[8 * k2 + 1]); pw.y = pk2(p[8 * k2 + 2], p[8 * k2 + 3]); pw.z = pk2(p[8 * k2 + 4], p[8 * k2 + 5]); pw.w = pk2(p[8 * k2 + 6], p[8 * k2 + 7]);
        const bf16x8 pf = __builtin_bit_cast(bf16x8, pw);
#pragma unroll
        for (int dt = 0; dt < 4; ++dt) { const bf16x8 av = *(const LAS bf16x8*)(Vb + (16 * dt + l15) * TL + 32 * k2 + 8 * q); acc[dt] = MFMA16(av, pf, acc[dt]); }
    }
}
template <bool MASKED, int KS>
DI float tile_probs(const f32x4 (&sc)[4], float (&p)[16], int d0, float slope2, unsigned lim, bool extra) {
    const float A = (MASKED || extra) ? -slope2 * (float)d0 : -INFINITY;
    const float r1 = slope2 * (float)KS, r2 = slope2 * (float)(2 * KS), r3 = slope2 * (float)(3 * KS);
    float psa = 0.f, psb = 0.f;
#pragma unroll
    for (int x = 0; x < 4; ++x) { const float bx = slope2 * (float)(16 * KS * x) + A;
        float v0 = sc[x][0] * C1 + bx, v1 = sc[x][1] * C1 + (bx + r1), v2 = sc[x][2] * C1 + (bx + r2), v3 = sc[x][3] * C1 + (bx + r3);
        asm("" : "+v"(v0)); asm("" : "+v"(v1)); asm("" : "+v"(v2)); asm("" : "+v"(v3));
        if (MASKED) { const int kb = 16 * KS * x;
            v0 = (extra && ((unsigned)(d0 - kb) < lim)) ? v0 : -INFINITY; v1 = (extra && ((unsigned)(d0 - kb - KS) < lim)) ? v1 : -INFINITY;
            v2 = (extra && ((unsigned)(d0 - kb - 2 * KS) < lim)) ? v2 : -INFINITY; v3 = (extra && ((unsigned)(d0 - kb - 3 * KS) < lim)) ? v3 : -INFINITY; }
        float p0 = ex2(v0), p1 = ex2(v1), p2 = ex2(v2), p3 = ex2(v3);
        asm("" : "+v"(p0)); asm("" : "+v"(p1)); asm("" : "+v"(p2)); asm("" : "+v"(p3));
        psa += p0; psb += p1; psa += p2; psb += p3;
        p[4 * x] = p0; p[4 * x + 1] = p1; p[4 * x + 2] = p2; p[4 * x + 3] = p3; }
    return psa + psb;
}
template <bool MASKED>
DI void tile_step(const LAS bf16* Kb, const LAS bf16* Vb, const bf16x8 (&qf)[2], f32x4 (&acc)[4], float& lp, int d0, float slope2, unsigned lim, bool extra, int l15, int q) {
    f32x4 sc[4]; tile_scores(Kb, qf, l15, q, sc);
    float p[16]; lp += tile_probs<MASKED, 1>(sc, p, d0, slope2, lim, extra);
    tile_pv(Vb, p, acc, l15, q);
}
DI void nsa_attn_phase(const bf16* Y1, const bf16* KCMP, const bf16* VCMPT, const bf16* VST, const bf16* VWT, bf16* MIX, LAS unsigned char* lds) {
    LAS bf16* KB0 = (LAS bf16*)lds;
    LAS bf16* VB0 = KB0 + 4 * 64 * TL;
    LAS float* slab = (LAS float*)(lds + 8 * 64 * TL * 2);
    LAS unsigned* selm = (LAS unsigned*)(slab + 8 * 16 * SLAB_LD);
    LAS unsigned* blist = selm + 64;
    LAS float* invl = (LAS float*)(blist + 132);
    const int tid = threadIdx.x, lane = tid & 63, w = tid >> 6, l15 = lane & 15, q = lane >> 4;
    LAS float* myslab = slab + w * 16 * SLAB_LD;
#define KSLOT(i) (KB0 + ((i) & 3) * 64 * TL)
#define VSLOT(i) (VB0 + ((i) & 3) * 64 * TL)
#define PAIR_PIPE(n, FETCH, COMP1, COMP2) { \
        FETCH(0, kr0, vr0) FETCH(1, kr1, vr1) tile_store(KSLOT(0), VSLOT(0), tid, kr0, vr0); tile_store(KSLOT(1), VSLOT(1), tid, kr1, vr1); \
        FETCH(2, kr0, vr0) FETCH(3, kr1, vr1) \
        LDS_BAR(); \
        int i_ = 0; \
        for (; i_ + 1 < (n); i_ += 2) { \
            COMP2(i_, i_ + 1) \
            tile_store(KSLOT(i_ + 2), VSLOT(i_ + 2), tid, kr0, vr0); tile_store(KSLOT(i_ + 3), VSLOT(i_ + 3), tid, kr1, vr1); \
            FETCH(i_ + 4, kr0, vr0) FETCH(i_ + 5, kr1, vr1) \
            LDS_BAR(); } \
        if (i_ < (n)) { COMP1(i_) LDS_BAR(); } }
    for (int u = blockIdx.x; u < NB * 2 * (T / 16); u += gridDim.x) {
        const int b = u & 3, g = (u >> 2) & 1;
        int tile = u >> 3;
        if ((int)gridDim.x == 256) { const int wq = (int)blockIdx.x >> 3, k = u >> 8; tile = k < 8 ? 8 * wq + k : 512 - 8 * (wq + 1) + (k - 8); }
        const int t0 = tile * 16, qblk = t0 >> 6;
        const int h = g * 8 + w; const float slope = exp2f(-0.5f * (float)(h + 1)), slope2 = slope * LOG2E;
        const int t = t0 + l15; const size_t row = (size_t)b * T + t;
        bf16x8 qf[2];
        qf[0] = *(const bf16x8*)(Y1 + row * OINP + h * 64 + 8 * q); qf[1] = *(const bf16x8*)(Y1 + row * OINP + h * 64 + 32 + 8 * q);
        const bf16* gl = Y1 + row * OINP + 1792 + h * 3;
        const float g0 = sigmoidf_(bf2f(gl[0])), g1 = sigmoidf_(bf2f(gl[1])), g2 = sigmoidf_(bf2f(gl[2]));
        f32x4 ot[4];
        u32x4 kr0, vr0, kr1, vr1;
        {
            const bf16* kc = KCMP + (size_t)(b * 2 + g) * NCP * 64; const bf16* vct = VCMPT + (size_t)(b * 2 + g) * 64 * NCP;
            const int nst = tile >= 1 ? ((tile - 1) >> 6) + 1 : 0;
            const int dc = t - 31 - 64 * q;
            float lp = 0.f, carry = 0.f;
            f32x4 acc[4];
#pragma unroll
            for (int dt = 0; dt < 4; ++dt) acc[dt] = (f32x4){0.f, 0.f, 0.f, 0.f};
            float inv = 0.f;
#define CMP_FETCH(idx, KR, VR) { const int i2_ = (idx) < nst ? (idx) : nst - 1; tile_fetch(kc + (size_t)(64 * i2_) * 64, 64, vct + 64 * i2_, NCP, tid, KR, VR); }
#define CMP_COMP1(s) { \
                f32x4 sc[4]; tile_scores(KSLOT(s), qf, l15, q, sc); \
                float sv[16]; \
                const int d0 = dc - 1024 * (s); \
                if (64 * (s) + 63 <= tile - 2) lp += tile_probs<false, 16>(sc, sv, d0, slope2, 0x7fffffffu, true); \
                else lp += tile_probs<true, 16>(sc, sv, d0, slope2, 0x7fffffffu, true); \
                _Pragma("unroll") for (int x = 0; x < 4; ++x) { const float hf_ = 0.5f * sv[4 * x + 3]; \
                    const float up_ = __shfl(hf_, (lane + 48) & 63);     \
                    myslab[l15 * SLAB_LD + 16 * (s) + 4 * x + q] = ((sv[4 * x] + sv[4 * x + 1]) + (sv[4 * x + 2] + hf_)) + (q > 0 ? up_ : carry); \
                    carry = up_; } \
                tile_pv(VSLOT(s), sv, acc, l15, q); }
#define CMP_COMP2(s, s2) { CMP_COMP1(s) CMP_COMP1(s2) }
            if (nst > 0) PAIR_PIPE(nst, CMP_FETCH, CMP_COMP1, CMP_COMP2)
#undef CMP_FETCH
#undef CMP_COMP1
#undef CMP_COMP2
            { float l = lp; l += __shfl_xor(l, 16); l += __shfl_xor(l, 32); inv = l > 0.f ? 1.0f / l : 0.f;
              if (q == 0) { invl[w * 16 + l15] = inv; myslab[l15 * SLAB_LD + 16 * nst] = carry; } }
            const float gi = g0 * inv;
#pragma unroll
            for (int dt = 0; dt < 4; ++dt) { ot[dt][0] = gi * acc[dt][0]; ot[dt][1] = gi * acc[dt][1]; ot[dt][2] = gi * acc[dt][2]; ot[dt][3] = gi * acc[dt][3]; }
        }
        LDS_BAR();
        unsigned u0 = 0, u1 = 0, u2 = 0, u3 = 0, am0 = 0, am1 = 0, am2 = 0, am3 = 0;
        {
            const int tokA = 2 * w, tokB = 2 * w + 1;
            float sA0 = 0.f, sA1 = 0.f, sB0 = 0.f, sB1 = 0.f;
#pragma unroll
            for (int ww = 0; ww < 8; ++ww) { const float ilA = invl[ww * 16 + tokA], ilB = invl[ww * 16 + tokB];
                sA0 += slab[(ww * 16 + tokA) * SLAB_LD + lane] * ilA; sA1 += slab[(ww * 16 + tokA) * SLAB_LD + lane + 64] * ilA;
                sB0 += slab[(ww * 16 + tokB) * SLAB_LD + lane] * ilB; sB1 += slab[(ww * 16 + tokB) * SLAB_LD + lane + 64] * ilB; }
            const int j0 = lane, j1 = lane + 64;
            const bool v0 = j0 <= qblk, v1 = j1 <= qblk;
            const bool f0 = (j0 == 0) || (j0 == qblk) || (j0 == qblk - 1), f1 = (j1 == qblk) || (j1 == qblk - 1);
            const unsigned kA0 = f0 ? 0x7f000000u : __float_as_uint(sA0), kA1 = f1 ? 0x7f000000u : __float_as_uint(sA1);
            const unsigned kB0 = f0 ? 0x7f000000u : __float_as_uint(sB0), kB1 = f1 ? 0x7f000000u : __float_as_uint(sB1);
            unsigned TA = 0u, TB = 0u;
#pragma unroll 1
            for (int bit = 30; bit >= 0; --bit) { const unsigned trA = TA | (1u << bit), trB = TB | (1u << bit);
                const int cA = __popcll(__ballot(v0 && kA0 >= trA)) + __popcll(__ballot(v1 && kA1 >= trA));
                const int cB = __popcll(__ballot(v0 && kB0 >= trB)) + __popcll(__ballot(v1 && kB1 >= trB));
                if (cA >= 16) TA = trA; if (cB >= 16) TB = trB; }
            const unsigned long long lt = (1ull << lane) - 1ull;
#define SEL_FINISH(tok, k0, k1, Tk) { \
                const bool gt0 = v0 && k0 > Tk, gt1 = v1 && k1 > Tk, eq0 = v0 && k0 == Tk, eq1 = v1 && k1 == Tk; \
                const unsigned long long mq0 = __ballot(eq0), mq1 = __ballot(eq1); \
                const int need = 16 - (__popcll(__ballot(gt0)) + __popcll(__ballot(gt1))); \
                const int r0 = __popcll(mq0 & lt), r1 = __popcll(mq0) + __popcll(mq1 & lt);        \
                const unsigned long long m0 = __ballot(gt0 || (eq0 && r0 < need)), m1 = __ballot(gt1 || (eq1 && r1 < need)); \
                if (lane == 0) { selm[(tok) * 4 + 0] = (unsigned)m0; selm[(tok) * 4 + 1] = (unsigned)(m0 >> 32); selm[(tok) * 4 + 2] = (unsigned)m1; selm[(tok) * 4 + 3] = (unsigned)(m1 >> 32); } }
            SEL_FINISH(tokA, kA0, kA1, TA)
            SEL_FINISH(tokB, kB0, kB1, TB)
#undef SEL_FINISH
        }
        LDS_BAR();
        {
            unsigned om = selm[lane], am = om;
            om |= __shfl_xor(om, 4); om |= __shfl_xor(om, 8); om |= __shfl_xor(om, 16); om |= __shfl_xor(om, 32);
            am &= __shfl_xor(am, 4); am &= __shfl_xor(am, 8); am &= __shfl_xor(am, 16); am &= __shfl_xor(am, 32);
            u0 = __builtin_amdgcn_readlane(om, 0); u1 = __builtin_amdgcn_readlane(om, 1); u2 = __builtin_amdgcn_readlane(om, 2); u3 = __builtin_amdgcn_readlane(om, 3);
            am0 = __builtin_amdgcn_readlane(am, 0); am1 = __builtin_amdgcn_readlane(am, 1); am2 = __builtin_amdgcn_readlane(am, 2); am3 = __builtin_amdgcn_readlane(am, 3);
            if (tid < 128) { const int wd = tid >> 5, bt = tid & 31;
                const unsigned uw = wd == 0 ? u0 : wd == 1 ? u1 : wd == 2 ? u2 : u3;
                if ((uw >> bt) & 1u) { const int pos = (wd > 0 ? __popc(u0) : 0) + (wd > 1 ? __popc(u1) : 0) + (wd > 2 ? __popc(u2) : 0) + __popc(uw & ((1u << bt) - 1u)); blist[pos] = (unsigned)tid; } }
        }
        const int nsel = __popc(u0) + __popc(u1) + __popc(u2) + __popc(u3);
        LDS_BAR();
        {
            const bf16* kb = Y1 + (size_t)b * T * OINP + 1280 + g * 64; const bf16* vt = VST + (size_t)(b * 2 + g) * 64 * T;
            float lp = 0.f; f32x4 acc[4];
#pragma unroll
            for (int dt = 0; dt < 4; ++dt) acc[dt] = (f32x4){0.f, 0.f, 0.f, 0.f};
#define SEL_FETCH(idx, KR, VR) { const int i2_ = (idx) < nsel ? (idx) : nsel - 1; const int j2_ = (int)__builtin_amdgcn_readfirstlane((int)blist[i2_]); tile_fetch(kb + (size_t)(64 * j2_) * OINP, OINP, vt + 64 * j2_, T, tid, KR, VR); }
#define SEL_PREP(i, j, selb, d0) \
                const int j = (int)__builtin_amdgcn_readfirstlane((int)blist[i]); \
                const int wd##j = j >> 5; const unsigned aw##j = wd##j == 0 ? am0 : wd##j == 1 ? am1 : wd##j == 2 ? am2 : am3; \
                const bool selb = (((aw##j >> (j & 31)) & 1u) != 0u) || (((selm[l15 * 4 + wd##j] >> (j & 31)) & 1u) != 0u); \
                const int d0 = t - 64 * j - 4 * q;
#define SEL_COMP1(i) { SEL_PREP(i, ja, sa_, da_) \
                if (ja < qblk) tile_step<false>(KSLOT(i), VSLOT(i), qf, acc, lp, da_, slope2, 0x7fffffffu, sa_, l15, q);        \
                else tile_step<true>(KSLOT(i), VSLOT(i), qf, acc, lp, da_, slope2, 0x7fffffffu, sa_, l15, q); }
#define SEL_COMP2(i, i2) { SEL_PREP(i, ja, sa_, da_) SEL_PREP(i2, jb, sb_, db_) \
                if (ja < qblk && jb < qblk) { tile_step<false>(KSLOT(i), VSLOT(i), qf, acc, lp, da_, slope2, 0x7fffffffu, sa_, l15, q); tile_step<false>(KSLOT(i2), VSLOT(i2), qf, acc, lp, db_, slope2, 0x7fffffffu, sb_, l15, q); } \
                else { tile_step<true>(KSLOT(i), VSLOT(i), qf, acc, lp, da_, slope2, 0x7fffffffu, sa_, l15, q); tile_step<true>(KSLOT(i2), VSLOT(i2), qf, acc, lp, db_, slope2, 0x7fffffffu, sb_, l15, q); } }
            PAIR_PIPE(nsel, SEL_FETCH, SEL_COMP1, SEL_COMP2)
#undef SEL_FETCH
#undef SEL_PREP
#undef SEL_COMP1
#undef SEL_COMP2
            float l = lp; l += __shfl_xor(l, 16); l += __shfl_xor(l, 32);
            const float sc = l > 0.f ? g1 / l : 0.f;
#pragma unroll
            for (int dt = 0; dt < 4; ++dt) { ot[dt][0] += sc * acc[dt][0]; ot[dt][1] += sc * acc[dt][1]; ot[dt][2] += sc * acc[dt][2]; ot[dt][3] += sc * acc[dt][3]; }
        }
        {
            const bf16* kb = Y1 + (size_t)b * T * OINP + 1536 + g * 64; const bf16* vt = VWT + (size_t)(b * 2 + g) * 64 * T;
            float lp = 0.f; f32x4 acc[4];
#pragma unroll
            for (int dt = 0; dt < 4; ++dt) acc[dt] = (f32x4){0.f, 0.f, 0.f, 0.f};
            int kstart = t0 - 511; kstart = kstart < 0 ? 0 : (kstart & ~63);
            const int nw = ((t0 + 15 - kstart) >> 6) + 1;
#define WIN_FETCH(idx, KR, VR) { const int i2_ = (idx) < nw ? (idx) : nw - 1; const int k2_ = kstart + 64 * i2_; tile_fetch(kb + (size_t)k2_ * OINP, OINP, vt + k2_, T, tid, KR, VR); }
#define WIN_INT(i) ((kstart + 64 * (i)) + 63 <= t0 && (kstart + 64 * (i)) >= t0 - 496)
#define WIN_COMP1(i) { const int d0_ = t - (kstart + 64 * (i)) - 4 * q; \
                if (WIN_INT(i)) tile_step<false>(KSLOT(i), VSLOT(i), qf, acc, lp, d0_, slope2, 512u, true, l15, q); \
                else tile_step<true>(KSLOT(i), VSLOT(i), qf, acc, lp, d0_, slope2, 512u, true, l15, q); }
#define WIN_COMP2(i, i2) { const int da_ = t - (kstart + 64 * (i)) - 4 * q, db_ = da_ - 64; \
                if (WIN_INT(i) && WIN_INT(i2)) { tile_step<false>(KSLOT(i), VSLOT(i), qf, acc, lp, da_, slope2, 512u, true, l15, q); tile_step<false>(KSLOT(i2), VSLOT(i2), qf, acc, lp, db_, slope2, 512u, true, l15, q); } \
                else { tile_step<true>(KSLOT(i), VSLOT(i), qf, acc, lp, da_, slope2, 512u, true, l15, q); tile_step<true>(KSLOT(i2), VSLOT(i2), qf, acc, lp, db_, slope2, 512u, true, l15, q); } }
            PAIR_PIPE(nw, WIN_FETCH, WIN_COMP1, WIN_COMP2)
#undef WIN_FETCH
#undef WIN_INT
#undef WIN_COMP1
#undef WIN_COMP2
            float l = lp; l += __shfl_xor(l, 16); l += __shfl_xor(l, 32);
            const float sc = l > 0.f ? g2 / l : 0.f;
#pragma unroll
            for (int dt = 0; dt < 4; ++dt) { ot[dt][0] += sc * acc[dt][0]; ot[dt][1] += sc * acc[dt][1]; ot[dt][2] += sc * acc[dt][2]; ot[dt][3] += sc * acc[dt][3]; }
        }
        bf16* op = MIX + row * D + h * 64 + 4 * q;
#pragma unroll
        for (int dt = 0; dt < 4; ++dt) { u32x2 ow; ow.x = pk2(ot[dt][0], ot[dt][1]); ow.y = pk2(ot[dt][2], ot[dt][3]); *(u32x2*)(op + 16 * dt) = ow; }
    }
#undef KSLOT
#undef VSLOT
#undef PAIR_PIPE
}
struct Args { const float* in[19]; float* out; unsigned char* ws; int ph_lo, ph_hi; };
constexpr int N_PHASES = 18;
template <class Epi>
DI void run_gemm(LAS unsigned char* lds, const bf16* A, const bf16* Bt, int N, int K, const Epi& E) {
    pg8::Gemm g{A, Bt, M, N, K}; pg8::StaticOrder S; S.init(M, N, (int)gridDim.x, (int)blockIdx.x);
    pg8::gemm_phase<Epi, pg8::StaticOrder, true, true>(lds, g, S, E);
}
__global__ void __launch_bounds__(512, 2) mega(Args a) {
    extern __shared__ __attribute__((aligned(16))) unsigned char lds_raw[];
    LAS unsigned char* lds = (LAS unsigned char*)lds_raw;
    cg::grid_group grid = cg::this_grid();
    volatile LAS unsigned* bst = (volatile LAS unsigned*)(lds + LDS_BYTES - 64);
    if (threadIdx.x < 2) bst[threadIdx.x] = 0u;
    __syncthreads();
    XcdBarrier xbar = xcd_barrier_post((unsigned*)(a.ws + WS_CTL), bst);
    const int tid = threadIdx.x, lane = tid & 63, wave = __builtin_amdgcn_readfirstlane(tid >> 6);
    const int gw = blockIdx.x * 8 + wave, ngw = gridDim.x * 8;
#define WSP(off) ((bf16*)(a.ws + (off)))
#define W_EIN WSP(WS_EIN)
#define W_EOUT WSP(WS_EOUT)
#define W_OIN WSP(WS_OIN)
#define W_OOUT WSP(WS_OOUT)
#define W_GU WSP(WS_GU)
#define W_DN WSP(WS_DN)
#define W1K WSP(WS_W1K)
#define W1V WSP(WS_W1V)
#define W2K WSP(WS_W2K)
#define W2V WSP(WS_W2V)
#define DEC ((float*)(a.ws + WS_DEC))
#define KCMP WSP(WS_KCMP)
#define VCMPT WSP(WS_VCMPT)
#define Y WSP(WS_Y)
#define VST WSP(WS_VST)
#define VWT WSP(WS_VWT)
#define HN WSP(WS_HN)
#define ST WSP(WS_ST)
#define RS ((float*)(a.ws + WS_RS))
#define HB WSP(WS_HB)
    const int lo = a.ph_lo, hi = a.ph_hi;
#define PH(k) if (lo <= (k) && (k) < hi)
#define SEAM(k) if (lo <= (k) && (k) + 1 < hi && hi > 0) { if (a.ph_lo < 0) grid.sync();   xcd_barrier(xbar); }
    PH(0) {
        LAS float* scr = (LAS float*)(lds + wave * 8448);
        constexpr int I0 = 2048, I1 = 512, I2 = 1024, I3 = 512, I4 = 2816, I5 = 1408, I6 = 64, I7 = 2;
        constexpr int NIT = I0 + I1 + I2 + I3 + 2 * I4 + 2 * I5 + 2 * I6 + 2 * I7;
        for (int it = gw; it < NIT; it += ngw) {
            int r = it;
            if (r < I0) { transpose_item(a.in[4], 1024, EIN, EIN, W_EIN, 0, scr, r, lane); continue; } r -= I0;
            if (r < I1) { transpose_item(a.in[8], 1024, 1024, 1024, W_EOUT, 0, scr, r, lane); continue; } r -= I1;
            if (r < I2) { transpose_item(a.in[9], 1024, OIN, OINP, W_OIN, 0, scr, r, lane, a.in[1] + D); continue; } r -= I2;
            if (r < I3) { transpose_item(a.in[16], 1024, 1024, 1024, W_OOUT, 0, scr, r, lane); continue; } r -= I3;
            if (r < 2 * I4) { const int l = r / I4; transpose_item(a.in[17] + (size_t)l * D * 2 * FF, 1024, 2 * FF, 2 * FF, W_GU + (size_t)l * GU_STRIDE, 1, scr, r % I4, lane, a.in[2] + l * D); continue; } r -= 2 * I4;
            if (r < 2 * I5) { const int l = r / I5; transpose_item(a.in[18] + (size_t)l * FF * D, FF, 1024, 1024, W_DN + (size_t)l * DN_STRIDE, 0, scr, r % I5, lane); continue; } r -= 2 * I5;
            if (r < I6) { transpose_item(a.in[12], 2048, 64, 64, W1K, 0, scr, r, lane); continue; } r -= I6;
            if (r < I6) { transpose_item(a.in[14], 2048, 64, 64, W1V, 0, scr, r, lane); continue; } r -= I6;
            if (r < I7) { transpose_item(a.in[13], 64, 64, 64, W2K, 0, scr, r, lane); continue; } r -= I7;
            transpose_item(a.in[15], 64, 64, 64, W2V, 0, scr, r, lane);
        }
        norm_rows_bf16(a.in[0], a.in[1], HN, gw, ngw, lane);
    }
    SEAM(0);
    PH(1) { EpiStoreLA E{Y}; run_gemm(lds, HN, W_EIN, EIN, 1024, E); }
    SEAM(1);
    PH(2) { la_state_phase(Y, a.in[5], ST, DEC, lds); }
    SEAM(2);
    PH(3) { la_scan_phase(ST, DEC); }
    SEAM(3);
    PH(4) { la_out_phase(Y, a.in[5], ST, a.in[6], a.in[7], HN, lds); }
    SEAM(4);
    PH(5) { EpiResid E{a.in[0], a.out, HB, RS}; run_gemm(lds, HN, W_EOUT, 1024, 1024, E); }
    SEAM(5);
    PH(7) { EpiSwiglu E{Y, RS}; run_gemm(lds, HB, W_GU, 2 * FF, 1024, E); }
    SEAM(7);
    PH(8) { EpiResid E{a.out, a.out, HB, RS + 16 * M}; run_gemm(lds, Y, W_DN, 1024, FF, E); }
    SEAM(8);
    PH(10) { EpiStore E{Y, OINP, RS + 16 * M}; run_gemm(lds, HB, W_OIN, OINP, 1024, E); }
    SEAM(10);
    PH(11) { nsa_compress_phase(Y, a.in[10], a.in[11], W1K, W1V, W2K, W2V, KCMP, VCMPT, lds, gw, ngw, lane); nsa_vt_phase(Y, VST, VWT, gw, ngw, lane); }
    SEAM(11);
    PH(12) { nsa_attn_phase(Y, KCMP, VCMPT, VST, VWT, HN, lds); }
    SEAM(12);
    PH(13) { EpiResid E{a.out, a.out, HB, RS + 32 * M}; run_gemm(lds, HN, W_OOUT, 1024, 1024, E); }
    SEAM(13);
    PH(15) { EpiSwiglu E{Y, RS + 32 * M}; run_gemm(lds, HB, W_GU + GU_STRIDE, 2 * FF, 1024, E); }
    SEAM(15);
    PH(16) { EpiResid E{a.out, a.out, nullptr, nullptr}; run_gemm(lds, Y, W_DN + DN_STRIDE, 1024, FF, E); }
    SEAM(16);
    PH(17) { norm_rows_f32_inplace(a.out, a.in[3], gw, ngw, lane); }
#undef PH
#undef SEAM
}

extern "C" void kernel_launch(void* const* d_in, const int* in_sizes, int n_in, void* d_out, int out_size, void* d_ws, size_t ws_size, hipStream_t stream) {
    static int grid = 0;
    if (grid == 0) {
        if (n_in != 19 || in_sizes[0] != M * D || out_size != M * D || ws_size < WS_END) { fprintf(stderr, "kernel_launch: unexpected shapes (n_in %d, in0 %d, out %d, ws %zu)\n", n_in, n_in > 0 ? in_sizes[0] : -1, out_size, ws_size); grid = -1; return; }
        int dev = 0, cus = 0, per_cu = 0;
        (void)hipGetDevice(&dev); (void)hipDeviceGetAttribute(&cus, hipDeviceAttributeMultiprocessorCount, dev);
        if (hipFuncSetAttribute((const void*)mega, hipFuncAttributeMaxDynamicSharedMemorySize, LDS_BYTES) != hipSuccess) { fprintf(stderr, "kernel_launch: hipFuncSetAttribute failed\n"); grid = -1; return; }
        if (hipOccupancyMaxActiveBlocksPerMultiprocessor(&per_cu, (const void*)mega, 512, LDS_BYTES) != hipSuccess || per_cu < 1) { fprintf(stderr, "kernel_launch: occupancy query says %d\n", per_cu); per_cu = 1; }
        (void)hipGetLastError();
        grid = cus * 1;
    }
    if (grid < 0) return;
    if (hipMemsetAsync((char*)d_ws + WS_CTL, 0, CTL_BYTES, stream) != hipSuccess) { fprintf(stderr, "kernel_launch: memset failed\n"); return; }
    Args a{};
    for (int i = 0; i < 19; ++i) a.in[i] = (const float*)d_in[i];
    a.out = (float*)d_out; a.ws = (unsigned char*)d_ws; a.ph_lo = 0; a.ph_hi = N_PHASES;
    void* args[] = {&a};
    hipError_t e = hipLaunchCooperativeKernel((const void*)mega, dim3(grid), dim3(512), args, LDS_BYTES, stream);
    if (e != hipSuccess) fprintf(stderr, "kernel_launch: cooperative launch failed: %s (grid %d)\n", hipGetErrorString(e), grid);
#ifdef PROBE_PHASES
    { const int pp[] = {PROBE_PHASES};
      for (unsigned i = 0; i < sizeof(pp) / sizeof(pp[0]); ++i) { a.ph_lo = pp[i]; a.ph_hi = pp[i] + 1; (void)hipLaunchCooperativeKernel((const void*)mega, dim3(grid), dim3(512), args, LDS_BYTES, stream); } }
#endif
}
```

```cpp
#include <hip/hip_runtime.h>
#include <hip/hip_cooperative_groups.h>
#include <cstdio>
#include <cstdint>
namespace cg = cooperative_groups;
namespace pg8 {
#define PG8_LAS __attribute__((address_space(3)))
typedef unsigned short bf16_t;
typedef short bf16x8 __attribute__((ext_vector_type(8)));
typedef float f32x4 __attribute__((ext_vector_type(4)));
typedef unsigned u32x4 __attribute__((ext_vector_type(4)));
constexpr int BM = 256, BK = 64, HALF = 128, HTB = HALF * BK * 2  , STAGE_BYTES = 8 * HTB, NXCD = 8, WGM = 8;

__host__ __device__ __forceinline__ int lds_byte(int r, int c) { const int st = (r >> 4) * 2 + (c >> 5), rr = r & 15, cc = c & 31, ob = rr * 64 + cc * 2; return st * 1024 + (ob ^ (((ob >> 9) & 1) << 5)); }
__host__ __device__ __forceinline__ void stage_rc(int b, int& R, int& C) { const int st = b / 1024, sb = b % 1024, swz = sb ^ (((sb >> 9) & 1) << 5); R = (st >> 1) * 16 + swz / 64; C = (st & 1) * 32 + (swz % 64) / 2; }
__host__ __device__ __forceinline__ int perm32(int rho) { const int n = rho >> 4, i = rho & 15; return 8 * (i >> 2) + 4 * n + (i & 3); }

struct Unit { int pm, pn; };
struct Gemm { const bf16_t* A; const bf16_t* Bt; int M, N, K; };

struct StaticOrder {
    int nM, nN, nwg, G, c;
    __host__ __device__ void init(int M, int N, int G_, int c_) { nM = M / BM; nN = N / BM; nwg = nM * nN; G = G_; c = c_; }
    __host__ __device__ bool next(int i, Unit& u) const {
        const long L = (long)i * G + c; if (L >= nwg) return false;
        int wgid = (int)L; { const int q = nwg / NXCD, r = nwg % NXCD, xcd = wgid % NXCD, off = wgid / NXCD; wgid = (xcd < r ? xcd * (q + 1) : r * (q + 1) + (xcd - r) * q) + off; }
        const int nig = WGM * nN, gid = wgid / nig, fm = gid * WGM, gsz = (nM - fm) < WGM ? (nM - fm) : WGM;
        u.pm = fm + ((wgid % nig) % gsz); u.pn = (wgid % nig) / gsz; return true;
    }
    __device__ __forceinline__ void a_ready(const Unit&) const {}
    __device__ __forceinline__ void done(const Unit&) const {}
};

__device__ __forceinline__ unsigned cvt_pk_bf16(float lo, float hi) { unsigned r; asm volatile("v_cvt_pk_bf16_f32 %0, %1, %2" : "=v"(r) : "v"(lo), "v"(hi)); return r; }
template <class Epi, class Sched, bool ALIGN_EPI = false, bool SP2 = false>
__device__ __forceinline__ void gemm_phase(PG8_LAS unsigned char* lds, const Gemm g, const Sched& S, const Epi& E) {
    const int tid = threadIdx.x, wid = __builtin_amdgcn_readfirstlane(tid >> 6), lane = tid & 63, wr = wid >> 2, wc = wid & 3, fr = lane & 15, fq = lane >> 4;
    const int K = g.K, nt = K / BK;
    unsigned voffA[2], voffB[2];
#pragma unroll
    for (int i = 0; i < 2; ++i) { int R, C; stage_rc(tid * 16 + i * 8192, R, C); const int Rb = Epi::PERM ? ((R & ~31) + perm32(R & 31)) : R;
        voffA[i] = (unsigned)(R * K + C) * 2u; voffB[i] = (unsigned)(Rb * K + C) * 2u; }
    const size_t kstep = (size_t)(BK * 2);
    const size_t hstep = (size_t)HALF * K * 2;
    const size_t tstep = 2 * hstep;
    const unsigned ldsw = (unsigned)wid * 1024u;
    const int aoff = lds_byte(wr * 64 + fr, fq * 8), boff = lds_byte(wc * 32 + fr, fq * 8);
#define PG8_SA(b, h) (((b) * 2 + (h)) * HTB)
#define PG8_SB(b, h) ((4 + (b) * 2 + (h)) * HTB)
#define PG8_STAGE(bufoff, gbase, voff) do { _Pragma("unroll") for (int _i = 0; _i < 2; ++_i) \
        __builtin_amdgcn_global_load_lds((const unsigned*)((const char*)(gbase) + (voff)[_i]), (PG8_LAS unsigned*)(lds + (bufoff) + ldsw + _i * 8192), 16, 0, 0); } while (0)
#define PG8_LDA(dst, b, h) do { _Pragma("unroll") for (int m = 0; m < 4; ++m) _Pragma("unroll") for (int k = 0; k < 2; ++k) dst[m][k] = *(const PG8_LAS bf16x8*)(lds + PG8_SA(b, h) + aoff + m * 2048 + k * 1024); } while (0)
#define PG8_LDB(dst, b, h) do { _Pragma("unroll") for (int n = 0; n < 2; ++n) _Pragma("unroll") for (int k = 0; k < 2; ++k) dst[n][k] = *(const PG8_LAS bf16x8*)(lds + PG8_SB(b, h) + boff + n * 2048 + k * 1024); } while (0)
#define PG8_MMA(ai, bj, At, Bt) do { __builtin_amdgcn_s_setprio(1); _Pragma("unroll") for (int m = 0; m < 4; ++m) _Pragma("unroll") for (int n = 0; n < 2; ++n) _Pragma("unroll") for (int k = 0; k < 2; ++k) \
        acc[ai][bj][m][n] = __builtin_amdgcn_mfma_f32_16x16x32_bf16(Bt[n][k], At[m][k], acc[ai][bj][m][n], 0, 0, 0); __builtin_amdgcn_s_setprio(0); } while (0)
#define PG8_WAIT_V(n) asm volatile("s_waitcnt vmcnt(" #n ")" ::: "memory")
#define PG8_WAIT_L(n) asm volatile("s_waitcnt lgkmcnt(" #n ")" ::: "memory")
#define PG8_BAR __builtin_amdgcn_s_barrier()
#define PG8_SCHED __builtin_amdgcn_sched_barrier(0)
    Unit cur, nxt; int ui = 0;
    if (!S.next(0, cur)) return;
    f32x4 acc[2][2][4][2];
#pragma unroll
    for (int a = 0; a < 2; ++a)
#pragma unroll
        for (int b = 0; b < 2; ++b)
#pragma unroll
            for (int m = 0; m < 4; ++m)
#pragma unroll
                for (int n = 0; n < 2; ++n) acc[a][b][m][n] = (f32x4){0.f, 0.f, 0.f, 0.f};
    bf16x8 At[4][2], B0[2][2], B1[2][2];
    const char* cA = (const char*)g.A + (size_t)cur.pm * tstep; const char* cB = (const char*)g.Bt + (size_t)cur.pn * tstep;
    S.a_ready(cur);
    if constexpr (SP2) {
        PG8_STAGE(PG8_SB(0, 0), cB, voffB); PG8_STAGE(PG8_SB(0, 1), cB + hstep, voffB); PG8_STAGE(PG8_SA(0, 0), cA, voffA); PG8_STAGE(PG8_SA(0, 1), cA + hstep, voffA);
        if (wr == 1) PG8_BAR;
        PG8_WAIT_V(2); PG8_BAR;
        PG8_STAGE(PG8_SB(1, 0), cB + kstep, voffB); PG8_STAGE(PG8_SA(1, 0), cA + kstep, voffA); PG8_STAGE(PG8_SB(1, 1), cB + hstep + kstep, voffB);
        PG8_WAIT_V(6); PG8_BAR;
    } else {
        PG8_STAGE(PG8_SB(0, 0), cB, voffB); PG8_STAGE(PG8_SA(0, 0), cA, voffA); PG8_STAGE(PG8_SB(0, 1), cB + hstep, voffB); PG8_STAGE(PG8_SA(0, 1), cA + hstep, voffA);
        if (wr == 1) PG8_BAR;
        PG8_WAIT_V(4); PG8_BAR;
        PG8_STAGE(PG8_SB(1, 0), cB + kstep, voffB); PG8_STAGE(PG8_SA(1, 0), cA + kstep, voffA); PG8_STAGE(PG8_SB(1, 1), cB + hstep + kstep, voffB);
        PG8_WAIT_V(6); PG8_BAR;
    }
    for (;;) {
        const bool has_next = S.next(ui + 1, nxt);
        const char* nA = has_next ? (const char*)g.A + (size_t)nxt.pm * tstep : cA; const char* nB = has_next ? (const char*)g.Bt + (size_t)nxt.pn * tstep : cB;
        for (int t = 0; t < nt; t += 2) {
            const bool last = (t == nt - 2);
            const char* a1 = cA + (size_t)(t + 1) * kstep;
            const char* a2 = last ? nA : cA + (size_t)(t + 2) * kstep; const char* b2 = last ? nB : cB + (size_t)(t + 2) * kstep;
            const char* a3 = a2 + kstep; const char* b3 = b2 + kstep;
            if (last && has_next) S.a_ready(nxt);
            if constexpr (SP2) {
            PG8_LDB(B0, 0, 0); PG8_LDB(B1, 0, 1); PG8_SCHED; PG8_LDA(At, 0, 0); PG8_STAGE(PG8_SA(1, 1), a1 + hstep, voffA);
            PG8_WAIT_V(8); PG8_WAIT_L(0); PG8_BAR; PG8_MMA(0, 0, At, B0); PG8_MMA(0, 1, At, B1); PG8_BAR; PG8_SCHED;
            PG8_LDA(At, 0, 1); PG8_STAGE(PG8_SB(0, 0), b2, voffB); PG8_STAGE(PG8_SB(0, 1), b2 + hstep, voffB); PG8_STAGE(PG8_SA(0, 0), a2, voffA);
            PG8_WAIT_V(8); PG8_WAIT_L(0); PG8_BAR; PG8_MMA(1, 0, At, B0); PG8_MMA(1, 1, At, B1); PG8_BAR; PG8_SCHED;
            PG8_LDB(B0, 1, 0); PG8_LDB(B1, 1, 1); PG8_SCHED; PG8_LDA(At, 1, 0); PG8_STAGE(PG8_SA(0, 1), a2 + hstep, voffA);
            PG8_WAIT_V(8); PG8_WAIT_L(0); PG8_BAR; PG8_MMA(0, 0, At, B0); PG8_MMA(0, 1, At, B1); PG8_BAR; PG8_SCHED;
            PG8_LDA(At, 1, 1); PG8_STAGE(PG8_SB(1, 0), b3, voffB); PG8_STAGE(PG8_SB(1, 1), b3 + hstep, voffB); PG8_STAGE(PG8_SA(1, 0), a3, voffA);
            PG8_WAIT_V(8); PG8_WAIT_L(0); PG8_BAR; PG8_MMA(1, 0, At, B0); PG8_MMA(1, 1, At, B1); PG8_BAR; PG8_SCHED;
            } else {
            PG8_LDB(B0, 0, 0); PG8_SCHED; PG8_LDA(At, 0, 0); PG8_STAGE(PG8_SA(1, 1), a1 + hstep, voffA);
            PG8_WAIT_L(8); PG8_BAR; PG8_WAIT_L(0); PG8_MMA(0, 0, At, B0); PG8_BAR; PG8_SCHED;
            PG8_LDB(B1, 0, 1); PG8_STAGE(PG8_SB(0, 0), b2, voffB);
            PG8_BAR; PG8_WAIT_L(0); PG8_MMA(0, 1, At, B1); PG8_BAR;
            PG8_LDA(At, 0, 1); PG8_STAGE(PG8_SA(0, 0), a2, voffA);
            PG8_BAR; PG8_WAIT_L(0); PG8_MMA(1, 0, At, B0); PG8_BAR; PG8_SCHED;
            PG8_STAGE(PG8_SB(0, 1), b2 + hstep, voffB);
            PG8_WAIT_V(6); PG8_BAR; PG8_MMA(1, 1, At, B1); PG8_BAR;
            PG8_LDB(B0, 1, 0); PG8_SCHED; PG8_LDA(At, 1, 0); PG8_STAGE(PG8_SA(0, 1), a2 + hstep, voffA);
            PG8_WAIT_L(8); PG8_BAR; PG8_WAIT_L(0); PG8_MMA(0, 0, At, B0); PG8_BAR; PG8_SCHED;
            PG8_LDB(B1, 1, 1); PG8_STAGE(PG8_SB(1, 0), b3, voffB);
            PG8_BAR; PG8_WAIT_L(0); PG8_MMA(0, 1, At, B1); PG8_BAR;
            PG8_LDA(At, 1, 1); PG8_STAGE(PG8_SA(1, 0), a3, voffA);
            PG8_BAR; PG8_WAIT_L(0); PG8_MMA(1, 0, At, B0); PG8_BAR; PG8_SCHED;
            PG8_STAGE(PG8_SB(1, 1), b3 + hstep, voffB);
            PG8_WAIT_V(6); PG8_BAR; PG8_MMA(1, 1, At, B1); PG8_BAR;
            }
        }
        if constexpr (ALIGN_EPI) { if (wr == 0) PG8_BAR; }
        if constexpr (!Epi::AFTER_DRAIN) { E(acc, cur, wr, wc, fr, fq); S.done(cur); }
        if (!has_next) break;
#pragma unroll
        for (int a = 0; a < 2; ++a)
#pragma unroll
            for (int b = 0; b < 2; ++b)
#pragma unroll
                for (int m = 0; m < 4; ++m)
#pragma unroll
                    for (int n = 0; n < 2; ++n) acc[a][b][m][n] = (f32x4){0.f, 0.f, 0.f, 0.f};
        cur = nxt; cA = nA; cB = nB; ++ui;
        if constexpr (ALIGN_EPI) { if (wr == 1) PG8_BAR; }
    }
    PG8_WAIT_V(0);
    if constexpr (!ALIGN_EPI) { if (wr == 0) PG8_BAR; }
    PG8_BAR;
    if constexpr (Epi::AFTER_DRAIN) { E.fused(acc, cur, wr, wc, fr, fq, lds, wid, lane); S.done(cur); }
#undef PG8_SA
#undef PG8_SB
#undef PG8_STAGE
#undef PG8_LDA
#undef PG8_LDB
#undef PG8_MMA
#undef PG8_WAIT_V
#undef PG8_WAIT_L
#undef PG8_BAR
#undef PG8_SCHED
}
}
#define GAS __attribute__((address_space(1)))
#define LAS __attribute__((address_space(3)))
#define DI __device__ __forceinline__
typedef unsigned short bf16;
typedef short bf16x8 __attribute__((ext_vector_type(8)));
typedef short s16x4 __attribute__((ext_vector_type(4)));
typedef float f32x4 __attribute__((ext_vector_type(4)));
typedef float f32x2 __attribute__((ext_vector_type(2)));
typedef unsigned u32x4 __attribute__((ext_vector_type(4)));
typedef unsigned u32x2 __attribute__((ext_vector_type(2)));
typedef __bf16 bf16x2_t __attribute__((ext_vector_type(2)));
#define MFMA16(a, b, c) __builtin_amdgcn_mfma_f32_16x16x32_bf16((a), (b), (c), 0, 0, 0)

constexpr int NB = 4, T = 8192, D = 1024, M = NB * T, FF = 2816;
constexpr int EIN = 4096, OIN = 1840, OINP = 2048;
constexpr float RMS_EPS = 1e-6f, LOG2E = 1.4426950408889634f;
constexpr size_t MiB = 1u << 20;
constexpr size_t WS_EIN = 0, WS_EOUT = 8 * MiB, WS_OIN = 10 * MiB, WS_OOUT = 14 * MiB, WS_GU = 16 * MiB, WS_DN = 38 * MiB;
constexpr size_t WS_W1K = 49 * MiB, WS_W1V = WS_W1K + 256 * 1024, WS_W2K = WS_W1V + 256 * 1024, WS_W2V = WS_W2K + 8192;
constexpr size_t WS_CTL = 56 * MiB, CTL_BYTES = 16384, WS_RS = 57 * MiB;
constexpr size_t WS_DEC = 52 * MiB, WS_KCMP = 54 * MiB, WS_VCMPT = WS_KCMP + 512 * 1024;
constexpr size_t WS_Y = 64 * MiB;
constexpr size_t WS_VST = 192 * MiB, WS_VWT = 200 * MiB, WS_HB = 240 * MiB;
constexpr size_t WS_HN = 320 * MiB, WS_ST = 384 * MiB, WS_END = 512 * MiB;
constexpr size_t GU_STRIDE = (size_t)2 * FF * D, DN_STRIDE = (size_t)D * FF;
constexpr int LDS_BYTES = 163840;

DI unsigned pk2(float lo, float hi) { f32x2 v = {lo, hi}; return __builtin_bit_cast(unsigned, __builtin_convertvector(v, bf16x2_t)); }
DI bf16 f2bf(float f) { return (bf16)(pk2(f, 0.f) & 0xffffu); }
DI float bf2f(bf16 x) { return __uint_as_float(((unsigned)x) << 16); }
DI float bflo(unsigned w) { return __uint_as_float(w << 16); }
DI float bfhi(unsigned w) { return __uint_as_float(w & 0xffff0000u); }
DI float wave_sum(float v) {
#pragma unroll
    for (int o = 1; o < 64; o <<= 1) v += __shfl_xor(v, o);
    return v;
}
DI float ex2(float x) { return __builtin_amdgcn_exp2f(x); }
DI float sigmoidf_(float x) { return __builtin_amdgcn_rcpf(1.0f + __expf(-x)); }
DI float siluf_(float x) { return x * __builtin_amdgcn_rcpf(1.0f + __expf(-x)); }

DI float rowscale(const float* rs, int row, int fq) {
    const f32x4 p = *(const f32x4*)(rs + (size_t)row * 16 + 4 * fq);
    float s = (p.x + p.y) + (p.z + p.w); s += __shfl_xor(s, 16); s += __shfl_xor(s, 32);
    return rsqrtf(s * (1.f / D) + RMS_EPS);
}
struct EpiStore {
    static constexpr bool PERM = true, AFTER_DRAIN = false;
    bf16* O; int ldc; const float* rs;
    DI void operator()(const pg8::f32x4 (&acc)[2][2][4][2], const pg8::Unit& u, int wr, int wc, int fr, int fq) const {
        const int row0 = u.pm * 256 + wr * 64 + fr, col0 = u.pn * 256 + wc * 32 + 8 * fq;
#pragma unroll
        for (int ai = 0; ai < 2; ++ai)
#pragma unroll
            for (int m = 0; m < 4; ++m) { const int row = row0 + ai * 128 + m * 16; bf16* rowp = O + (size_t)row * ldc + col0;
                const float r = rs ? rowscale(rs, row, fq) : 1.f;
#pragma unroll
                for (int bj = 0; bj < 2; ++bj) { const pg8::f32x4 v0 = acc[ai][bj][m][0] * r, v1 = acc[ai][bj][m][1] * r;
                    u32x4 w; w.x = pk2(v0[0], v0[1]); w.y = pk2(v0[2], v0[3]); w.z = pk2(v1[0], v1[1]); w.w = pk2(v1[2], v1[3]);
                    *(u32x4*)(rowp + bj * 128) = w; } }
    }
};
struct EpiStoreLA {
    static constexpr bool PERM = true, AFTER_DRAIN = false;
    bf16* O;
    DI void operator()(const pg8::f32x4 (&acc)[2][2][4][2], const pg8::Unit& u, int wr, int wc, int fr, int fq) const {
        const int row0 = u.pm * 256 + wr * 64 + fr, col0 = u.pn * 256 + wc * 32 + 8 * fq;
#pragma unroll
        for (int ai = 0; ai < 2; ++ai)
#pragma unroll
            for (int m = 0; m < 4; ++m) { const int row = row0 + ai * 128 + m * 16; const int bb = row >> 13, n = (row >> 6) & 127, r = row & 63;
#pragma unroll
                for (int bj = 0; bj < 2; ++bj) { const int col = col0 + bj * 128; const int arr = (col >> 9) & 3, hh = ((col >> 11) << 2) | ((col >> 7) & 3), c = col & 127;
                    const pg8::f32x4 v0 = acc[ai][bj][m][0], v1 = acc[ai][bj][m][1];
                    u32x4 w; w.x = pk2(v0[0], v0[1]); w.y = pk2(v0[2], v0[3]); w.z = pk2(v1[0], v1[1]); w.w = pk2(v1[2], v1[3]);
                    *(u32x4*)(O + ((size_t)((((bb * 8 + hh) * 128 + n) * 4 + arr)) << 13) + r * 128 + c) = w; } }
    }
};
struct EpiSwiglu {
    static constexpr bool PERM = true, AFTER_DRAIN = false;
    bf16* O; const float* rs;
    DI void operator()(const pg8::f32x4 (&acc)[2][2][4][2], const pg8::Unit& u, int wr, int wc, int fr, int fq) const {
        const int row0 = u.pm * 256 + wr * 64 + fr, col0 = u.pn * 128 + wc * 32 + 8 * fq;
#pragma unroll
        for (int ai = 0; ai < 2; ++ai)
#pragma unroll
            for (int m = 0; m < 4; ++m) { const int row = row0 + ai * 128 + m * 16; bf16* rowp = O + (size_t)row * FF + col0;
                const float rsc = rowscale(rs, row, fq);
                float r[8];
#pragma unroll
                for (int n = 0; n < 2; ++n)
#pragma unroll
                    for (int e = 0; e < 4; ++e) { const float g = acc[ai][0][m][n][e] * rsc, up = acc[ai][1][m][n][e] * rsc; r[n * 4 + e] = g * __builtin_amdgcn_rcpf(1.0f + __expf(-g)) * up; }
                u32x4 w; w.x = pk2(r[0], r[1]); w.y = pk2(r[2], r[3]); w.z = pk2(r[4], r[5]); w.w = pk2(r[6], r[7]);
                *(u32x4*)rowp = w; }
    }
};
template <bool BASE_BF16, bool OUT_F32>
struct EpiResid {
    static constexpr bool PERM = false, AFTER_DRAIN = false;
    const float* basef; const bf16* baseh; float* out; bf16* hb; float* rs;
    DI void operator()(const pg8::f32x4 (&acc)[2][2][4][2], const pg8::Unit& u, int wr, int wc, int fr, int fq) const {
        const int row0 = u.pm * 256 + wr * 64 + fr, col0 = u.pn * 256 + wc * 32 + 4 * fq;
#pragma unroll
        for (int ai = 0; ai < 2; ++ai)
#pragma unroll
            for (int m = 0; m < 4; ++m) { const int row = row0 + ai * 128 + m * 16; const size_t off = (size_t)row * D + col0; float ss = 0.f;
#pragma unroll
                for (int bj = 0; bj < 2; ++bj)
#pragma unroll
                    for (int n = 0; n < 2; ++n) { const size_t o2 = off + bj * 128 + n * 16; const pg8::f32x4 a = acc[ai][bj][m][n];
                        f32x4 bs;
                        if (BASE_BF16) { const u32x2 bw = *(const u32x2*)(baseh + o2); bs = (f32x4){bflo(bw.x), bfhi(bw.x), bflo(bw.y), bfhi(bw.y)}; }
                        else bs = *(const f32x4*)(basef + o2);
                        f32x4 o; o.x = bs.x + a[0]; o.y = bs.y + a[1]; o.z = bs.z + a[2]; o.w = bs.w + a[3];
                        if (OUT_F32) *(f32x4*)(out + o2) = o;
                        else { u32x2 hw; hw.x = pk2(o.x, o.y); hw.y = pk2(o.z, o.w); *(u32x2*)(hb + o2) = hw; ss += (o.x * o.x + o.y * o.y) + (o.z * o.z + o.w * o.w); } }
                if (!OUT_F32) { ss += __shfl_xor(ss, 16); ss += __shfl_xor(ss, 32); if (fq == 0) rs[(size_t)row * 16 + u.pn * 4 + wc] = ss; } }
    }
};

DI void transpose_item(const float* W, int K, int N, int Npad, bf16* WT, int mode, LAS float* scr, int item, int lane, const float* gk = nullptr) {
    const int nblk = Npad / 32, kb = item / nblk, nb = item % nblk, k0 = 64 * kb, n0 = 32 * nb;
    const int nl = n0 + (lane & 31);
#pragma unroll 8
    for (int i = 0; i < 32; ++i) { const int kk = 2 * i + (lane >> 5); const float gv = gk ? gk[k0 + kk] : 1.f; scr[kk * 33 + (lane & 31)] = (nl < N) ? W[(size_t)(k0 + kk) * N + nl] * gv : 0.f; }
    asm volatile("s_waitcnt lgkmcnt(0)" ::: "memory");
    const int c = lane & 7;
    int drow0 = n0;
    if (mode == 1) { drow0 = (n0 < FF) ? (256 * (n0 >> 7) + (n0 & 127)) : (256 * ((n0 - FF) >> 7) + 128 + ((n0 - FF) & 127)); }
#pragma unroll
    for (int j = 0; j < 4; ++j) { const int n = (lane >> 3) + 8 * j; const LAS float* s = scr + (8 * c) * 33 + n;
        u32x4 o; o.x = pk2(s[0 * 33], s[1 * 33]); o.y = pk2(s[2 * 33], s[3 * 33]); o.z = pk2(s[4 * 33], s[5 * 33]); o.w = pk2(s[6 * 33], s[7 * 33]);
        *(u32x4*)(WT + (size_t)(drow0 + n) * K + k0 + 8 * c) = o; }
    asm volatile("s_waitcnt lgkmcnt(0)" ::: "memory");
}
DI void norm_rows_bf16(const float* h, const float* g, bf16* out, int gw, int ngw, int lane) {
    f32x4 gv[4];
#pragma unroll
    for (int j = 0; j < 4; ++j) gv[j] = *((const f32x4*)g + lane + 64 * j);
    for (int m0 = gw; m0 < M; m0 += 4 * ngw) {
        f32x4 v[4][4];
#pragma unroll
        for (int r = 0; r < 4; ++r) { const int m = m0 + r * ngw < M ? m0 + r * ngw : m0; const f32x4* xr = (const f32x4*)(h + (size_t)m * D) + lane;
#pragma unroll
            for (int j = 0; j < 4; ++j) v[r][j] = xr[64 * j]; }
#pragma unroll
        for (int r = 0; r < 4; ++r) { const int m = m0 + r * ngw; float s = 0.f;
#pragma unroll
            for (int j = 0; j < 4; ++j) s += (v[r][j].x * v[r][j].x + v[r][j].y * v[r][j].y) + (v[r][j].z * v[r][j].z + v[r][j].w * v[r][j].w);
            const float rr = rsqrtf(wave_sum(s) * (1.f / D) + RMS_EPS);
            if (m < M) { u32x2* o8 = (u32x2*)(out + (size_t)m * D) + lane;
#pragma unroll
                for (int j = 0; j < 4; ++j) { u32x2 w; w.x = pk2(v[r][j].x * rr * gv[j].x, v[r][j].y * rr * gv[j].y); w.y = pk2(v[r][j].z * rr * gv[j].z, v[r][j].w * rr * gv[j].w); o8[64 * j] = w; } } }
    }
}
DI void norm_rows_f32_inplace(float* h, const float* g, int gw, int ngw, int lane) {
    f32x4 gv[4];
#pragma unroll
    for (int j = 0; j < 4; ++j) gv[j] = *((const f32x4*)g + lane + 64 * j);
    for (int m0 = gw; m0 < M; m0 += 4 * ngw) {
        f32x4 v[4][4];
#pragma unroll
        for (int r = 0; r < 4; ++r) { const int m = m0 + r * ngw < M ? m0 + r * ngw : m0; const f32x4* xr = (const f32x4*)(h + (size_t)m * D) + lane;
#pragma unroll
            for (int j = 0; j < 4; ++j) v[r][j] = xr[64 * j]; }
        asm volatile("" ::: "memory");
#pragma unroll
        for (int r = 0; r < 4; ++r) { const int m = m0 + r * ngw; float s = 0.f;
#pragma unroll
            for (int j = 0; j < 4; ++j) s += (v[r][j].x * v[r][j].x + v[r][j].y * v[r][j].y) + (v[r][j].z * v[r][j].z + v[r][j].w * v[r][j].w);
            const float rr = rsqrtf(wave_sum(s) * (1.f / D) + RMS_EPS);
            if (m < M) { f32x4* xo = (f32x4*)(h + (size_t)m * D) + lane;
#pragma unroll
                for (int j = 0; j < 4; ++j) { f32x4 o; o.x = v[r][j].x * rr * gv[j].x; o.y = v[r][j].y * rr * gv[j].y; o.z = v[r][j].z * rr * gv[j].z; o.w = v[r][j].w * rr * gv[j].w; xo[64 * j] = o; } } }
    }
}
typedef GAS unsigned gu32;
#define XB_TMO      128
#define XB_XCNT(j)  (256  + 64 * (j))
#define XB_XSUB(j)  (1280 + 64 * (j))
#define XB_XGEN(j)  (2304 + 64 * (j))
#define XB_TOP      3328
#define XB_TOPGEN   3392
#define XCD_BAR_WORDS 3456
#define XB_SPIN_CAP (1u << 18)

__device__ __forceinline__ unsigned xb_ld(unsigned* p)              { return __hip_atomic_load(p, __ATOMIC_RELAXED, __HIP_MEMORY_SCOPE_AGENT); }
__device__ __forceinline__ unsigned xb_add(unsigned* p, unsigned v) { return __hip_atomic_fetch_add(p, v, __ATOMIC_RELAXED, __HIP_MEMORY_SCOPE_AGENT); }
__device__ __forceinline__ unsigned xb_xcc_id() { return (unsigned)__builtin_amdgcn_s_getreg((3 << 11) | 20) & 0xFu; }
#define XB_SPIN(cond, bar) do { unsigned _sp = 0; while (cond) { __builtin_amdgcn_s_sleep(1); \
    if ((++_sp & 255u) == 0u) { if (xb_ld(&(bar)[XB_TMO])) break; if (_sp > XB_SPIN_CAP) { atomicAdd(&(bar)[XB_TMO], 1u); break; } } } } while (0)

struct XcdBarrier {
    unsigned* bar; unsigned x;
    volatile LAS unsigned* st;
};

__device__ __forceinline__ XcdBarrier xcd_barrier_post(unsigned* bar, volatile LAS unsigned* st) {
    XcdBarrier b; b.bar = bar; b.x = xb_xcc_id(); b.st = st;
    if (threadIdx.x == 0) (void)xb_add(&bar[XB_XCNT(b.x)], 1u);
    return b;
}
__device__ __forceinline__ void xcd_barrier_complete(unsigned* bar, unsigned x, unsigned& nloc, unsigned& nx) {
    const unsigned G = gridDim.x * gridDim.y * gridDim.z;
    unsigned sum, cnt, mine, sp = 0u;
    for (;;) {
        sum = 0u; cnt = 0u; mine = 0u;
#pragma unroll
        for (unsigned j = 0; j < 16; ++j) { const unsigned c = xb_ld(&bar[XB_XCNT(j)]); sum += c; cnt += (c > 0u) ? 1u : 0u; mine = (j == x) ? c : mine; }
        if (sum == G) break;
        __builtin_amdgcn_s_sleep(1);
        if ((++sp & 255u) == 0u) { if (xb_ld(&bar[XB_TMO])) break; if (sp > XB_SPIN_CAP) { atomicAdd(&bar[XB_TMO], 1u); break; } }
    }
    nloc = mine > 0u ? mine : 1u; nx = cnt > 0u ? cnt : 1u;
}

__device__ __forceinline__ void xcd_barrier(const XcdBarrier& b) {
    asm volatile("s_waitcnt vmcnt(0)" ::: "memory");
    __syncthreads();
    if (threadIdx.x == 0) {
        unsigned* bar = b.bar;
        __builtin_amdgcn_s_waitcnt(0);
        unsigned nloc = b.st[0], nx = b.st[1];
        if (nloc == 0u) { xcd_barrier_complete(bar, b.x, nloc, nx); b.st[0] = nloc; b.st[1] = nx; }
        const unsigned old = xb_add(&bar[XB_XSUB(b.x)], 1u);
        const unsigned gen = old / nloc;
        if (old + 1u == (gen + 1u) * nloc) {
            __builtin_amdgcn_fence(__ATOMIC_RELEASE, "agent");
            asm volatile("s_waitcnt vmcnt(0)" ::: "memory");
            const unsigned og = xb_add(&bar[XB_TOP], 1u);
            const unsigned tg = og / nx;
            if (og + 1u == (tg + 1u) * nx) xb_add(&bar[XB_TOPGEN], 1u);
            else XB_SPIN(xb_ld(&bar[XB_TOPGEN]) == tg, bar);
            __builtin_amdgcn_fence(__ATOMIC_ACQUIRE, "agent");
            xb_add(&bar[XB_XGEN(b.x)], 1u);
            asm volatile("s_waitcnt vmcnt(0)" ::: "memory");
        } else {
            XB_SPIN(xb_ld(&bar[XB_XGEN(b.x)]) == gen, bar);
            __builtin_amdgcn_fence(__ATOMIC_ACQUIRE, "agent");
            asm volatile("s_waitcnt vmcnt(0)" ::: "memory");
        }
    }
    __syncthreads();
}
constexpr int LA_UNITS = NB * 8 * 128;
constexpr int KT_LD = 72, QT_LD = 136;
#define LA_BAR() do { asm volatile("s_waitcnt lgkmcnt(0)" ::: "memory"); __builtin_amdgcn_s_barrier(); asm volatile("" ::: "memory"); } while (0)
struct LaRaw { unsigned f[16], qv[16], v[16]; float lba, lbb; };
DI void la_read_col(const LAS bf16* tile, int d, int rg, unsigned (&out)[16]) {
#pragma unroll
    for (int e = 0; e < 16; ++e) out[e] = tile[(16 * rg + e) * QT_LD + d];
}
template <bool WANT_Q>
DI void la_math(const LaRaw& R, int hh, float (&fd)[16], float (&kk)[16], float (&qq)[16]) {
    if (hh < 4) {
        const float mx = fmaxf(R.lba, R.lbb), ea = __expf(R.lba - mx), eb = __expf(R.lbb - mx), lbv = ea / (ea + eb);
#pragma unroll
        for (int e = 0; e < 16; ++e) { const float x = bf2f((bf16)R.f[e]); const float f = lbv + (1.f - lbv) * sigmoidf_(x); fd[e] = f; kk[e] = 1.f - f;
            if (WANT_Q) qq[e] = siluf_(bf2f((bf16)R.qv[e])); }
    } else {
        const int r = hh - 4; const float gam = 1.f - exp2f(-5.f - (float)r);
#pragma unroll
        for (int e = 0; e < 16; ++e) { fd[e] = gam; kk[e] = bf2f((bf16)R.f[e]) * 0.08838834764831845f; if (WANT_Q) qq[e] = bf2f((bf16)R.qv[e]); }
    }
}
DI void la_store_vt(const LaRaw& R, int d, int rg, LAS bf16* VT) {
    LAS u32x4* dst = (LAS u32x4*)(VT + d * KT_LD + 16 * rg);
    dst[0] = (u32x4){R.v[0] | (R.v[1] << 16), R.v[2] | (R.v[3] << 16), R.v[4] | (R.v[5] << 16), R.v[6] | (R.v[7] << 16)};
    dst[1] = (u32x4){R.v[8] | (R.v[9] << 16), R.v[10] | (R.v[11] << 16), R.v[12] | (R.v[13] << 16), R.v[14] | (R.v[15] << 16)};
}
#define LA_CH_LDS(base, ch) ((LAS u32x4*)((base) + ((ch) >> 4) * QT_LD + ((ch) & 15) * 8))
DI void la_state_phase(const bf16* Y0, const float* lbraw, bf16* ST, float* DEC, LAS unsigned char* lds) {
    LAS bf16* KT = (LAS bf16*)lds; LAS bf16* VT = KT + 128 * KT_LD; LAS float* tot = (LAS float*)(VT + 128 * KT_LD);
    LAS bf16* RF = KT; LAS bf16* RV = VT;
    const int tid = threadIdx.x, lane = tid & 63, w = tid >> 6, l15 = lane & 15, q = lane >> 4, d = tid & 127, rg = tid >> 7;
    u32x4 rf[2], rv[2]; float lba, lbb;
#define A1_FETCH(un) { const bf16* yb_ = Y0 + ((size_t)(un) << 15); const int li_ = ((((un) >> 7) & 3) << 7) + d; \
        _Pragma("unroll") for (int c_ = 0; c_ < 2; ++c_) { rf[c_] = *(const u32x4*)(yb_ + 8192 + (size_t)(tid + 512 * c_) * 8); rv[c_] = *(const u32x4*)(yb_ + 16384 + (size_t)(tid + 512 * c_) * 8); } \
        lba = lbraw[li_]; lbb = lbraw[512 + li_]; asm volatile("" ::: "memory"); }
#define A1_STORE() { _Pragma("unroll") for (int c_ = 0; c_ < 2; ++c_) { *LA_CH_LDS(RF, tid + 512 * c_) = rf[c_]; *LA_CH_LDS(RV, tid + 512 * c_) = rv[c_]; } }
    A1_FETCH(blockIdx.x)
    A1_STORE()
    LaRaw R; R.lba = lba; R.lbb = lbb;
    LA_BAR();
    for (int unit = blockIdx.x; unit < LA_UNITS; unit += gridDim.x) {
        const int hh = (unit >> 7) & 7;
        { const int nx = unit + (int)gridDim.x, un = nx < LA_UNITS ? nx : unit; A1_FETCH(un) }
        la_read_col(RF, d, rg, R.f); la_read_col(RV, d, rg, R.v);
        LA_BAR();
        float fd[16], kk[16], qq[16];
        la_math<false>(R, hh, fd, kk, qq);
        float run = 1.f;
#pragma unroll
        for (int e = 15; e >= 0; --e) { kk[e] *= run; run *= fd[e]; }
        tot[rg * 128 + d] = run;
        la_store_vt(R, d, rg, VT);
        LA_BAR();
        float post = 1.f, last = 1.f;
#pragma unroll
        for (int g2 = 0; g2 < 4; ++g2) { const float tv = tot[g2 * 128 + d]; if (g2 > rg) post *= tv; last *= tv; }
        unsigned wv[8];
#pragma unroll
        for (int e = 0; e < 8; ++e) wv[e] = pk2(kk[2 * e] * post, kk[2 * e + 1] * post);
        LAS u32x4* dst = (LAS u32x4*)(KT + d * KT_LD + 16 * rg);
        dst[0] = (u32x4){wv[0], wv[1], wv[2], wv[3]}; dst[1] = (u32x4){wv[4], wv[5], wv[6], wv[7]};
        if (rg == 0) DEC[(size_t)unit * 128 + d] = last;
        LA_BAR();
        f32x4 acc[8];
#pragma unroll
        for (int dt = 0; dt < 8; ++dt) acc[dt] = (f32x4){0.f, 0.f, 0.f, 0.f};
#pragma unroll
        for (int ks = 0; ks < 2; ++ks) { const bf16x8 bv = *(const LAS bf16x8*)(VT + (16 * w + l15) * KT_LD + 32 * ks + 8 * q);
#pragma unroll
            for (int dt = 0; dt < 8; ++dt) { const bf16x8 ak = *(const LAS bf16x8*)(KT + (16 * dt + l15) * KT_LD + 32 * ks + 8 * q); acc[dt] = MFMA16(ak, bv, acc[dt]); } }
        bf16* so = ST + (size_t)unit * 16384 + (16 * w + l15) * 128 + 4 * q;
#pragma unroll
        for (int dt = 0; dt < 8; ++dt) { u32x2 o; o.x = pk2(acc[dt][0], acc[dt][1]); o.y = pk2(acc[dt][2], acc[dt][3]); *(u32x2*)(so + 16 * dt) = o; }
        LA_BAR();
        A1_STORE()
        R.lba = lba; R.lbb = lbb;
        LA_BAR();
    }
#undef A1_FETCH
#undef A1_STORE
}
DI void la_scan_phase(bf16* ST, const float* DEC) {
    const int gid = blockIdx.x * 512 + threadIdx.x, nth = gridDim.x * 512;
    for (int wk = gid; wk < 32 * 4096; wk += nth) {
        const int bh = wk >> 12, e4 = (wk & 4095) * 4, d = e4 & 127;
        f32x4 s = {0.f, 0.f, 0.f, 0.f};
        bf16* sp = ST + (size_t)bh * 128 * 16384 + e4; const float* dp = DEC + (size_t)bh * 128 * 128 + d;
        for (int n0 = 0; n0 < 128; n0 += 8) {
            u32x2 uv[8]; f32x4 dv[8];
#pragma unroll
            for (int i = 0; i < 8; ++i) { uv[i] = *(const u32x2*)(sp + (size_t)(n0 + i) * 16384); dv[i] = *(const f32x4*)(dp + (size_t)(n0 + i) * 128); }
#pragma unroll
            for (int i = 0; i < 8; ++i) { u32x2 o; o.x = pk2(s.x, s.y); o.y = pk2(s.z, s.w); *(u32x2*)(sp + (size_t)(n0 + i) * 16384) = o;
                s.x = dv[i].x * s.x + bflo(uv[i].x); s.y = dv[i].y * s.y + bfhi(uv[i].x); s.z = dv[i].z * s.z + bflo(uv[i].y); s.w = dv[i].w * s.w + bfhi(uv[i].y); }
        }
    }
}
DI void la_out_phase(const bf16* Y0, const float* lbraw, const bf16* ST, const float* gh, const float* gr, bf16* MIX, LAS unsigned char* lds) {
    LAS bf16* QT = (LAS bf16*)lds; LAS bf16* K2 = QT + 64 * QT_LD; LAS bf16* QS = K2 + 64 * QT_LD; LAS bf16* VT = QS + 64 * QT_LD;
    LAS float* tot = (LAS float*)(VT + 128 * KT_LD); LAS float* ssq = tot + 512; LAS float* gnl = ssq + 128;
    LAS bf16* SB = (LAS bf16*)(gnl + 256);
    LAS bf16* GB = SB + 128 * QT_LD;
    LAS bf16* RQ = QT; LAS bf16* RF = K2; LAS bf16* RV = QS;
    const int tid = threadIdx.x, lane = tid & 63, w = tid >> 6, l15 = lane & 15, q = lane >> 4, d = tid & 127, rg = tid >> 7;
    const int it = w & 3, vh = w >> 2;
    const int irow = 16 * it + l15;
    if (tid < 256) gnl[tid] = tid < 128 ? gh[tid] : gr[tid - 128];
    u32x4 rr[6], s2[4], g2r[2]; float lba, lbb;
#define A3_FETCH(un) { const bf16* yb_ = Y0 + ((size_t)(un) << 15); const bf16* sp_ = ST + ((size_t)(un) << 14); const int li_ = ((((un) >> 7) & 3) << 7) + d; \
        _Pragma("unroll") for (int c_ = 0; c_ < 2; ++c_) { rr[c_] = *(const u32x4*)(yb_ + (size_t)(tid + 512 * c_) * 8); rr[2 + c_] = *(const u32x4*)(yb_ + 8192 + (size_t)(tid + 512 * c_) * 8); \
            rr[4 + c_] = *(const u32x4*)(yb_ + 16384 + (size_t)(tid + 512 * c_) * 8); g2r[c_] = *(const u32x4*)(yb_ + 24576 + (size_t)(tid + 512 * c_) * 8); } \
        _Pragma("unroll") for (int c_ = 0; c_ < 4; ++c_) s2[c_] = *(const u32x4*)(sp_ + (size_t)(tid + 512 * c_) * 8); \
        lba = lbraw[li_]; lbb = lbraw[512 + li_]; asm volatile("" ::: "memory"); }
#define A3_STORE() { _Pragma("unroll") for (int c_ = 0; c_ < 2; ++c_) { const int ch_ = tid + 512 * c_; *LA_CH_LDS(RQ, ch_) = rr[c_]; *LA_CH_LDS(RF, ch_) = rr[2 + c_]; *LA_CH_LDS(RV, ch_) = rr[4 + c_]; *LA_CH_LDS(GB, ch_) = g2r[c_]; } \
        _Pragma("unroll") for (int c_ = 0; c_ < 4; ++c_) *LA_CH_LDS(SB, tid + 512 * c_) = s2[c_]; }
    A3_FETCH(blockIdx.x)
    A3_STORE()
    LaRaw R; R.lba = lba; R.lbb = lbb;
    LA_BAR();
    for (int unit = blockIdx.x; unit < LA_UNITS; unit += gridDim.x) {
        const int b = unit >> 10, hh = (unit >> 7) & 7, n = unit & 127;
        const int row0 = b * T + n * 64;
        { const int nx = unit + (int)gridDim.x, un = nx < LA_UNITS ? nx : unit; A3_FETCH(un) }
        la_read_col(RQ, d, rg, R.qv); la_read_col(RF, d, rg, R.f); la_read_col(RV, d, rg, R.v);
        LA_BAR();
        float fd[16], kk[16], qq[16];
        la_math<true>(R, hh, fd, kk, qq);
        float run = 1.f;
#pragma unroll
        for (int e = 0; e < 16; ++e) { run *= fd[e]; fd[e] = run; }
        tot[rg * 128 + d] = run;
        la_store_vt(R, d, rg, VT);
        LA_BAR();
        float pre = 1.f;
#pragma unroll
        for (int g2 = 0; g2 < 4; ++g2) { const float tv = tot[g2 * 128 + d]; if (g2 < rg) pre *= tv; }
        const float ref = tot[d] * tot[128 + d], iref = __builtin_amdgcn_rcpf(ref);
#pragma unroll
        for (int e = 0; e < 16; ++e) { const float P = pre * fd[e], qP = qq[e] * P; const int j = 16 * rg + e;
            QT[j * QT_LD + d] = f2bf(qP * iref); K2[j * QT_LD + d] = f2bf(kk[e] * ref * __builtin_amdgcn_rcpf(P)); QS[j * QT_LD + d] = f2bf(qP); }
        LA_BAR();
        f32x4 at[4];
#pragma unroll
        for (int jt = 0; jt < 4; ++jt) at[jt] = (f32x4){0.f, 0.f, 0.f, 0.f};
#pragma unroll
        for (int ks = 0; ks < 4; ++ks) { const bf16x8 bq = *(const LAS bf16x8*)(QT + (16 * it + l15) * QT_LD + 32 * ks + 8 * q);
#pragma unroll
            for (int jt = 0; jt < 4; ++jt) { const bf16x8 ak = *(const LAS bf16x8*)(K2 + (16 * jt + l15) * QT_LD + 32 * ks + 8 * q); at[jt] = MFMA16(ak, bq, at[jt]); } }
#pragma unroll
        for (int jt = 0; jt < 4; ++jt)
#pragma unroll
            for (int r = 0; r < 4; ++r) { const int j = 16 * jt + 4 * q + r; if (j > irow) at[jt][r] = 0.f; }
        f32x4 o[4];
#pragma unroll
        for (int vt = 0; vt < 4; ++vt) o[vt] = (f32x4){0.f, 0.f, 0.f, 0.f};
#pragma unroll
        for (int k2 = 0; k2 < 2; ++k2) {
            u32x4 pw; pw.x = pk2(at[2 * k2][0], at[2 * k2][1]); pw.y = pk2(at[2 * k2][2], at[2 * k2][3]); pw.z = pk2(at[2 * k2 + 1][0], at[2 * k2 + 1][1]); pw.w = pk2(at[2 * k2 + 1][2], at[2 * k2 + 1][3]);
            const bf16x8 pf = __builtin_bit_cast(bf16x8, pw);
#pragma unroll
            for (int vt = 0; vt < 4; ++vt) { const LAS bf16* vp = VT + (64 * vh + 16 * vt + l15) * KT_LD + 32 * k2 + 4 * q;
                const u32x2 lo = *(const LAS u32x2*)vp, hi = *(const LAS u32x2*)(vp + 16);
                const bf16x8 av = __builtin_bit_cast(bf16x8, ((u32x4){lo.x, lo.y, hi.x, hi.y})); o[vt] = MFMA16(av, pf, o[vt]); }
        }
#pragma unroll
        for (int ks = 0; ks < 4; ++ks) { const bf16x8 bq = *(const LAS bf16x8*)(QS + (16 * it + l15) * QT_LD + 32 * ks + 8 * q);
#pragma unroll
            for (int vt = 0; vt < 4; ++vt) { const bf16x8 as = *(const LAS bf16x8*)(SB + (64 * vh + 16 * vt + l15) * QT_LD + 32 * ks + 8 * q); o[vt] = MFMA16(as, bq, o[vt]); } }
        float ss = 0.f;
#pragma unroll
        for (int vt = 0; vt < 4; ++vt) ss += (o[vt][0] * o[vt][0] + o[vt][1] * o[vt][1]) + (o[vt][2] * o[vt][2] + o[vt][3] * o[vt][3]);
        ss += __shfl_xor(ss, 16); ss += __shfl_xor(ss, 32);
        if (q == 0) ssq[vh * 64 + irow] = ss;
        LA_BAR();
        const float rs = rsqrtf((ssq[irow] + ssq[64 + irow]) * (1.f / 128.f) + RMS_EPS);
        const LAS float* gn = gnl + (hh < 4 ? 0 : 128);
        bf16* op = MIX + (size_t)(row0 + irow) * D + hh * 128;
#pragma unroll
        for (int vt = 0; vt < 4; ++vt) { const int v0 = 64 * vh + 16 * vt + 4 * q; const f32x4 gv = *(const LAS f32x4*)(gn + v0); const u32x2 gw = *(const LAS u32x2*)(GB + irow * QT_LD + v0);
            u32x2 ow; ow.x = pk2(o[vt][0] * rs * gv.x * siluf_(bflo(gw.x)), o[vt][1] * rs * gv.y * siluf_(bfhi(gw.x)));
            ow.y = pk2(o[vt][2] * rs * gv.z * siluf_(bflo(gw.y)), o[vt][3] * rs * gv.w * siluf_(bfhi(gw.y))); *(u32x2*)(op + v0) = ow; }
        LA_BAR();
        A3_STORE()
        R.lba = lba; R.lbb = lbb;
        LA_BAR();
    }
#undef A3_FETCH
#undef A3_STORE
}
constexpr int NC = 511, NCP = 512;
DI void nsa_compress_phase(const bf16* Y1, const float* posk, const float* posv, const bf16* w1kT, const bf16* w1vT, const bf16* w2kT, const bf16* w2vT,
                           bf16* KCMP, bf16* VCMPT, LAS unsigned char* lds, int gw, int ngw, int lane) {
    const int l15 = lane & 15, q = lane >> 4, wv = (threadIdx.x >> 6), grp = wv >> 2, nt = wv & 3;
    LAS bf16* h1s = (LAS bf16*)lds + grp * 16 * 72;
    for (int base = 0; base < 512; base += ngw / 4) {
        int task = base + (gw >> 2); const bool tvalid = task < 512; if (!tvalid) task = 511;
        const int kv = task & 1, rt = task >> 1;
        int r = rt * 16 + l15; const bool rvalid = tvalid && (r < NB * NC * 2); if (r >= NB * NC * 2) r = NB * NC * 2 - 1;
        const int b = r / (NC * 2), rem = r % (NC * 2), i = rem >> 1, g = rem & 1;
        const bf16* src = Y1 + (size_t)(b * T + 16 * i) * OINP + (kv ? 1152 : 1024) + g * 64;
        const float* pos = kv ? posv : posk; const bf16* w1 = (kv ? w1vT : w1kT) + (size_t)(16 * nt + l15) * 2048; const bf16* w2 = kv ? w2vT : w2kT;
        f32x4 acc = {0.f, 0.f, 0.f, 0.f};
#pragma unroll 8
        for (int ks = 0; ks < 64; ++ks) {
            const int p = ks >> 1, d0 = (ks & 1) * 32 + 8 * q;
            const u32x4 xv = *(const u32x4*)(src + (size_t)p * OINP + d0);
            const f32x4 p0 = *(const f32x4*)(pos + p * 64 + d0), p1 = *(const f32x4*)(pos + p * 64 + d0 + 4);
            u32x4 bw; bw.x = pk2(bflo(xv.x) + p0.x, bfhi(xv.x) + p0.y); bw.y = pk2(bflo(xv.y) + p0.z, bfhi(xv.y) + p0.w);
            bw.z = pk2(bflo(xv.z) + p1.x, bfhi(xv.z) + p1.y); bw.w = pk2(bflo(xv.w) + p1.z, bfhi(xv.w) + p1.w);
            const bf16x8 af = *(const bf16x8*)(w1 + 32 * ks + 8 * q);
            acc = MFMA16(af, __builtin_bit_cast(bf16x8, bw), acc);
        }
        { u32x2 hw; hw.x = pk2(siluf_(acc[0]), siluf_(acc[1])); hw.y = pk2(siluf_(acc[2]), siluf_(acc[3])); *(LAS u32x2*)(h1s + l15 * 72 + 16 * nt + 4 * q) = hw; }
        __syncthreads();
        f32x4 o2 = {0.f, 0.f, 0.f, 0.f};
#pragma unroll
        for (int k2 = 0; k2 < 2; ++k2) { const bf16x8 bf = *(const LAS bf16x8*)(h1s + l15 * 72 + 32 * k2 + 8 * q);
            const bf16x8 av = *(const bf16x8*)(w2 + (16 * nt + l15) * 64 + 32 * k2 + 8 * q); o2 = MFMA16(av, bf, o2); }
        if (rvalid) {
            if (kv == 0) { u32x2 ow; ow.x = pk2(o2[0], o2[1]); ow.y = pk2(o2[2], o2[3]); *(u32x2*)(KCMP + ((size_t)(b * 2 + g) * NCP + i) * 64 + 16 * nt + 4 * q) = ow; }
            else { bf16* op = VCMPT + (size_t)(b * 2 + g) * 64 * NCP + i;
#pragma unroll
                for (int r2 = 0; r2 < 4; ++r2) op[(size_t)(16 * nt + 4 * q + r2) * NCP] = f2bf(o2[r2]); }
        }
        __syncthreads();
    }
    for (int z = gw * 64 + lane; z < NB * 2 * 64; z += ngw * 64) { const int bg = z >> 6, dd = z & 63; KCMP[((size_t)bg * NCP + NC) * 64 + dd] = 0; VCMPT[((size_t)bg * 64 + dd) * NCP + NC] = 0; }
}
DI void nsa_vt_phase(const bf16* Y1, bf16* VST, bf16* VWT, int gw, int ngw, int lane) {
    for (int task = gw; task < 2 * NB * 2 * 128; task += ngw) {
        const int which = task & 1, g = (task >> 1) & 1, b = (task >> 2) & 3, blk = task >> 4;
        const int t = blk * 64 + lane;
        const bf16* src = Y1 + (size_t)(b * T + t) * OINP + (which ? 1664 : 1408) + g * 64;
        bf16* dst = (which ? VWT : VST) + (size_t)(b * 2 + g) * 64 * T + t;
        u32x4 v[8];
#pragma unroll
        for (int c = 0; c < 8; ++c) v[c] = *(const u32x4*)(src + 8 * c);
#pragma unroll
        for (int c = 0; c < 8; ++c) {
            dst[(size_t)(8 * c + 0) * T] = (bf16)(v[c].x & 0xffff); dst[(size_t)(8 * c + 1) * T] = (bf16)(v[c].x >> 16);
            dst[(size_t)(8 * c + 2) * T] = (bf16)(v[c].y & 0xffff); dst[(size_t)(8 * c + 3) * T] = (bf16)(v[c].y >> 16);
            dst[(size_t)(8 * c + 4) * T] = (bf16)(v[c].z & 0xffff); dst[(size_t)(8 * c + 5) * T] = (bf16)(v[c].z >> 16);
            dst[(size_t)(8 * c + 6) * T] = (bf16)(v[c].w & 0xffff); dst[(size_t)(8 * c + 7) * T] = (bf16)(v[c].w >> 16);
        }
    }
}
#define LDS_BAR() do { asm volatile("s_waitcnt lgkmcnt(0)" ::: "memory"); __builtin_amdgcn_s_barrier(); asm volatile("" ::: "memory"); } while (0)
constexpr int TL = 80;
constexpr int SLAB_LD = 132;
constexpr float C1 = 0.125f * LOG2E;
DI void tile_fetch(const bf16* kg, int ldk, const bf16* vg, int ldv, int tid, u32x4& kr, u32x4& vr) {
    const int r = tid >> 3, c = (tid & 7) * 8;
    kr = *(const u32x4*)(kg + (size_t)r * ldk + c); vr = *(const u32x4*)(vg + (size_t)r * ldv + c);
    asm volatile("" ::: "memory");
}
DI void tile_store(LAS bf16* Kb, LAS bf16* Vb, int tid, u32x4 kr, u32x4 vr) {
    const int r = tid >> 3, c = (tid & 7) * 8;
    *(LAS u32x4*)(Kb + r * TL + c) = kr;
    const int g32 = c & 32, k0 = c & 31, k1 = k0 + 4;
    const int p0 = 8 * ((k0 & 15) >> 2) + 4 * (k0 >> 4), p1 = 8 * ((k1 & 15) >> 2) + 4 * (k1 >> 4);
    *(LAS u32x2*)(Vb + r * TL + g32 + p0) = (u32x2){vr.x, vr.y}; *(LAS u32x2*)(Vb + r * TL + g32 + p1) = (u32x2){vr.z, vr.w};
}
DI void tile_scores(const LAS bf16* Kb, const bf16x8 (&qf)[2], int l15, int q, f32x4 (&sc)[4]) {
#pragma unroll
    for (int x = 0; x < 4; ++x) { sc[x] = (f32x4){0.f, 0.f, 0.f, 0.f};
#pragma unroll
        for (int ks = 0; ks < 2; ++ks) { const bf16x8 a = *(const LAS bf16x8*)(Kb + (16 * x + l15) * TL + 32 * ks + 8 * q); sc[x] = MFMA16(a, qf[ks], sc[x]); } }
}
DI void tile_pv(const LAS bf16* Vb, const float (&p)[16], f32x4 (&acc)[4], int l15, int q) {
#pragma unroll
    for (int k2 = 0; k2 < 2; ++k2) {
        u32x4 pw; pw.x = pk2(p[8 * k2], p[8 * k2 + 1]); pw.y = pk2(p[8 * k2 + 2], p[8 * k2 + 3]); pw.z = pk2(p[8 * k2 + 4], p[8 * k2 + 5]); pw.w = pk2(p[8 * k2 + 6], p[8 * k2 + 7]);
        const bf16x8 pf = __builtin_bit_cast(bf16x8, pw);
#pragma unroll
        for (int dt = 0; dt < 4; ++dt) { const bf16x8 av = *(const LAS bf16x8*)(Vb + (16 * dt + l15) * TL + 32 * k2 + 8 * q); acc[dt] = MFMA16(av, pf, acc[dt]); }
    }
}
template <bool MASKED, int KS>
DI float tile_probs(const f32x4 (&sc)[4], float (&p)[16], int d0, float slope2, unsigned lim, bool extra) {
    const float A = (MASKED || extra) ? -slope2 * (float)d0 : -INFINITY;
    const float r1 = slope2 * (float)KS, r2 = slope2 * (float)(2 * KS), r3 = slope2 * (float)(3 * KS);
    float psa = 0.f, psb = 0.f;
#pragma unroll
    for (int x = 0; x < 4; ++x) { const float bx = slope2 * (float)(16 * KS * x) + A;
        float v0 = sc[x][0] * C1 + bx, v1 = sc[x][1] * C1 + (bx + r1), v2 = sc[x][2] * C1 + (bx + r2), v3 = sc[x][3] * C1 + (bx + r3);
        asm("" : "+v"(v0)); asm("" : "+v"(v1)); asm("" : "+v"(v2)); asm("" : "+v"(v3));
        if (MASKED) { const int kb = 16 * KS * x;
            v0 = (extra && ((unsigned)(d0 - kb) < lim)) ? v0 : -INFINITY; v1 = (extra && ((unsigned)(d0 - kb - KS) < lim)) ? v1 : -INFINITY;
            v2 = (extra && ((unsigned)(d0 - kb - 2 * KS) < lim)) ? v2 : -INFINITY; v3 = (extra && ((unsigned)(d0 - kb - 3 * KS) < lim)) ? v3 : -INFINITY; }
        float p0 = ex2(v0), p1 = ex2(v1), p2 = ex2(v2), p3 = ex2(v3);
        asm("" : "+v"(p0)); asm("" : "+v"(p1)); asm("" : "+v"(p2)); asm("" : "+v"(p3));
        psa += p0; psb += p1; psa += p2; psb += p3;
        p[4 * x] = p0; p[4 * x + 1] = p1; p[4 * x + 2] = p2; p[4 * x + 3] = p3; }
    return psa + psb;
}
template <bool MASKED>
DI void tile_step(const LAS bf16* Kb, const LAS bf16* Vb, const bf16x8 (&qf)[2], f32x4 (&acc)[4], float& lp, int d0, float slope2, unsigned lim, bool extra, int l15, int q) {
    f32x4 sc[4]; tile_scores(Kb, qf, l15, q, sc);
    float p[16]; lp += tile_probs<MASKED, 1>(sc, p, d0, slope2, lim, extra);
    tile_pv(Vb, p, acc, l15, q);
}
DI void nsa_attn_phase(const bf16* Y1, const bf16* KCMP, const bf16* VCMPT, const bf16* VST, const bf16* VWT, bf16* MIX, LAS unsigned char* lds) {
    LAS bf16* KB0 = (LAS bf16*)lds;
    LAS bf16* VB0 = KB0 + 4 * 64 * TL;
    LAS float* slab = (LAS float*)(lds + 8 * 64 * TL * 2);
    LAS unsigned* selm = (LAS unsigned*)(slab + 8 * 16 * SLAB_LD);
    LAS unsigned* blist = selm + 64;
    LAS float* invl = (LAS float*)(blist + 132);
    const int tid = threadIdx.x, lane = tid & 63, w = tid >> 6, l15 = lane & 15, q = lane >> 4;
    LAS float* myslab = slab + w * 16 * SLAB_LD;
#define KSLOT(i) (KB0 + ((i) & 3) * 64 * TL)
#define VSLOT(i) (VB0 + ((i) & 3) * 64 * TL)
#define PAIR_PIPE(n, FETCH, COMP1, COMP2) { \
        FETCH(0, kr0, vr0) FETCH(1, kr1, vr1) tile_store(KSLOT(0), VSLOT(0), tid, kr0, vr0); tile_store(KSLOT(1), VSLOT(1), tid, kr1, vr1); \
        FETCH(2, kr0, vr0) FETCH(3, kr1, vr1) \
        LDS_BAR(); \
        int i_ = 0; \
        for (; i_ + 1 < (n); i_ += 2) { \
            COMP2(i_, i_ + 1) \
            tile_store(KSLOT(i_ + 2), VSLOT(i_ + 2), tid, kr0, vr0); tile_store(KSLOT(i_ + 3), VSLOT(i_ + 3), tid, kr1, vr1); \
            FETCH(i_ + 4, kr0, vr0) FETCH(i_ + 5, kr1, vr1) \
            LDS_BAR(); } \
        if (i_ < (n)) { COMP1(i_) LDS_BAR(); } }
    for (int u = blockIdx.x; u < NB * 2 * (T / 16); u += gridDim.x) {
        const int b = u & 3, g = (u >> 2) & 1;
        int tile = u >> 3;
        if ((int)gridDim.x == 256) { const int wq = (int)blockIdx.x >> 3, k = u >> 8; tile = k < 8 ? 8 * wq + k : 512 - 8 * (wq + 1) + (k - 8); }
        const int t0 = tile * 16, qblk = t0 >> 6;
        const int h = g * 8 + w; const float slope = exp2f(-0.5f * (float)(h + 1)), slope2 = slope * LOG2E;
        const int t = t0 + l15; const size_t row = (size_t)b * T + t;
        bf16x8 qf[2];
        qf[0] = *(const bf16x8*)(Y1 + row * OINP + h * 64 + 8 * q); qf[1] = *(const bf16x8*)(Y1 + row * OINP + h * 64 + 32 + 8 * q);
        const bf16* gl = Y1 + row * OINP + 1792 + h * 3;
        const float g0 = sigmoidf_(bf2f(gl[0])), g1 = sigmoidf_(bf2f(gl[1])), g2 = sigmoidf_(bf2f(gl[2]));
        f32x4 ot[4];
        u32x4 kr0, vr0, kr1, vr1;
        {
            const bf16* kc = KCMP + (size_t)(b * 2 + g) * NCP * 64; const bf16* vct = VCMPT + (size_t)(b * 2 + g) * 64 * NCP;
            const int nst = tile >= 1 ? ((tile - 1) >> 6) + 1 : 0;
            const int dc = t - 31 - 64 * q;
            float lp = 0.f, carry = 0.f;
            f32x4 acc[4];
#pragma unroll
            for (int dt = 0; dt < 4; ++dt) acc[dt] = (f32x4){0.f, 0.f, 0.f, 0.f};
            float inv = 0.f;
#define CMP_FETCH(idx, KR, VR) { const int i2_ = (idx) < nst ? (idx) : nst - 1; tile_fetch(kc + (size_t)(64 * i2_) * 64, 64, vct + 64 * i2_, NCP, tid, KR, VR); }
#define CMP_COMP1(s) { \
                f32x4 sc[4]; tile_scores(KSLOT(s), qf, l15, q, sc); \
                float sv[16]; \
                const int d0 = dc - 1024 * (s); \
                if (64 * (s) + 63 <= tile - 2) lp += tile_probs<false, 16>(sc, sv, d0, slope2, 0x7fffffffu, true); \
                else lp += tile_probs<true, 16>(sc, sv, d0, slope2, 0x7fffffffu, true); \
                _Pragma("unroll") for (int x = 0; x < 4; ++x) { const float hf_ = 0.5f * sv[4 * x + 3]; \
                    const float up_ = __shfl(hf_, (lane + 48) & 63);     \
                    myslab[l15 * SLAB_LD + 16 * (s) + 4 * x + q] = ((sv[4 * x] + sv[4 * x + 1]) + (sv[4 * x + 2] + hf_)) + (q > 0 ? up_ : carry); \
                    carry = up_; } \
                tile_pv(VSLOT(s), sv, acc, l15, q); }
#define CMP_COMP2(s, s2) { CMP_COMP1(s) CMP_COMP1(s2) }
            if (nst > 0) PAIR_PIPE(nst, CMP_FETCH, CMP_COMP1, CMP_COMP2)
#undef CMP_FETCH
#undef CMP_COMP1
#undef CMP_COMP2
            { float l = lp; l += __shfl_xor(l, 16); l += __shfl_xor(l, 32); inv = l > 0.f ? 1.0f / l : 0.f;
              if (q == 0) { invl[w * 16 + l15] = inv; myslab[l15 * SLAB_LD + 16 * nst] = carry; } }
            const float gi = g0 * inv;
#pragma unroll
            for (int dt = 0; dt < 4; ++dt) { ot[dt][0] = gi * acc[dt][0]; ot[dt][1] = gi * acc[dt][1]; ot[dt][2] = gi * acc[dt][2]; ot[dt][3] = gi * acc[dt][3]; }
        }
        LDS_BAR();
        unsigned u0 = 0, u1 = 0, u2 = 0, u3 = 0, am0 = 0, am1 = 0, am2 = 0, am3 = 0;
        {
            const int tokA = 2 * w, tokB = 2 * w + 1;
            float sA0 = 0.f, sA1 = 0.f, sB0 = 0.f, sB1 = 0.f;
#pragma unroll
            for (int ww = 0; ww < 8; ++ww) { const float ilA = invl[ww * 16 + tokA], ilB = invl[ww * 16 + tokB];
                sA0 += slab[(ww * 16 + tokA) * SLAB_LD + lane] * ilA; sA1 += slab[(ww * 16 + tokA) * SLAB_LD + lane + 64] * ilA;
                sB0 += slab[(ww * 16 + tokB) * SLAB_LD + lane] * ilB; sB1 += slab[(ww * 16 + tokB) * SLAB_LD + lane + 64] * ilB; }
            const int j0 = lane, j1 = lane + 64;
            const bool v0 = j0 <= qblk, v1 = j1 <= qblk;
            const bool f0 = (j0 == 0) || (j0 == qblk) || (j0 == qblk - 1), f1 = (j1 == qblk) || (j1 == qblk - 1);
            const unsigned kA0 = f0 ? 0x7f000000u : __float_as_uint(sA0), kA1 = f1 ? 0x7f000000u : __float_as_uint(sA1);
            const unsigned kB0 = f0 ? 0x7f000000u : __float_as_uint(sB0), kB1 = f1 ? 0x7f000000u : __float_as_uint(sB1);
            unsigned TA = 0u, TB = 0u;
#pragma unroll 1
            for (int bit = 30; bit >= 0; --bit) { const unsigned trA = TA | (1u << bit), trB = TB | (1u << bit);
                const int cA = __popcll(__ballot(v0 && kA0 >= trA)) + __popcll(__ballot(v1 && kA1 >= trA));
                const int cB = __popcll(__ballot(v0 && kB0 >= trB)) + __popcll(__ballot(v1 && kB1 >= trB));
                if (cA >= 16) TA = trA; if (cB >= 16) TB = trB; }
            const unsigned long long lt = (1ull << lane) - 1ull;
#define SEL_FINISH(tok, k0, k1, Tk) { \
                const bool gt0 = v0 && k0 > Tk, gt1 = v1 && k1 > Tk, eq0 = v0 && k0 == Tk, eq1 = v1 && k1 == Tk; \
                const unsigned long long mq0 = __ballot(eq0), mq1 = __ballot(eq1); \
                const int need = 16 - (__popcll(__ballot(gt0)) + __popcll(__ballot(gt1))); \
                const int r0 = __popcll(mq0 & lt), r1 = __popcll(mq0) + __popcll(mq1 & lt);        \
                const unsigned long long m0 = __ballot(gt0 || (eq0 && r0 < need)), m1 = __ballot(gt1 || (eq1 && r1 < need)); \
                if (lane == 0) { selm[(tok) * 4 + 0] = (unsigned)m0; selm[(tok) * 4 + 1] = (unsigned)(m0 >> 32); selm[(tok) * 4 + 2] = (unsigned)m1; selm[(tok) * 4 + 3] = (unsigned)(m1 >> 32); } }
            SEL_FINISH(tokA, kA0, kA1, TA)
            SEL_FINISH(tokB, kB0, kB1, TB)
#undef SEL_FINISH
        }
        LDS_BAR();
        {
            unsigned om = selm[lane], am = om;
            om |= __shfl_xor(om, 4); om |= __shfl_xor(om, 8); om |= __shfl_xor(om, 16); om |= __shfl_xor(om, 32);
            am &= __shfl_xor(am, 4); am &= __shfl_xor(am, 8); am &= __shfl_xor(am, 16); am &= __shfl_xor(am, 32);
            u0 = __builtin_amdgcn_readlane(om, 0); u1 = __builtin_amdgcn_readlane(om, 1); u2 = __builtin_amdgcn_readlane(om, 2); u3 = __builtin_amdgcn_readlane(om, 3);
            am0 = __builtin_amdgcn_readlane(am, 0); am1 = __builtin_amdgcn_readlane(am, 1); am2 = __builtin_amdgcn_readlane(am, 2); am3 = __builtin_amdgcn_readlane(am, 3);
            if (tid < 128) { const int wd = tid >> 5, bt = tid & 31;
                const unsigned uw = wd == 0 ? u0 : wd == 1 ? u1 : wd == 2 ? u2 : u3;
                if ((uw >> bt) & 1u) { const int pos = (wd > 0 ? __popc(u0) : 0) + (wd > 1 ? __popc(u1) : 0) + (wd > 2 ? __popc(u2) : 0) + __popc(uw & ((1u << bt) - 1u)); blist[pos] = (unsigned)tid; } }
        }
        const int nsel = __popc(u0) + __popc(u1) + __popc(u2) + __popc(u3);
        LDS_BAR();
        {
            const bf16* kb = Y1 + (size_t)b * T * OINP + 1280 + g * 64; const bf16* vt = VST + (size_t)(b * 2 + g) * 64 * T;
            float lp = 0.f; f32x4 acc[4];
#pragma unroll
            for (int dt = 0; dt < 4; ++dt) acc[dt] = (f32x4){0.f, 0.f, 0.f, 0.f};
#define SEL_FETCH(idx, KR, VR) { const int i2_ = (idx) < nsel ? (idx) : nsel - 1; const int j2_ = (int)__builtin_amdgcn_readfirstlane((int)blist[i2_]); tile_fetch(kb + (size_t)(64 * j2_) * OINP, OINP, vt + 64 * j2_, T, tid, KR, VR); }
#define SEL_PREP(i, j, selb, d0) \
                const int j = (int)__builtin_amdgcn_readfirstlane((int)blist[i]); \
                const int wd##j = j >> 5; const unsigned aw##j = wd##j == 0 ? am0 : wd##j == 1 ? am1 : wd##j == 2 ? am2 : am3; \
                const bool selb = (((aw##j >> (j & 31)) & 1u) != 0u) || (((selm[l15 * 4 + wd##j] >> (j & 31)) & 1u) != 0u); \
                const int d0 = t - 64 * j - 4 * q;
#define SEL_COMP1(i) { SEL_PREP(i, ja, sa_, da_) \
                if (ja < qblk) tile_step<false>(KSLOT(i), VSLOT(i), qf, acc, lp, da_, slope2, 0x7fffffffu, sa_, l15, q);        \
                else tile_step<true>(KSLOT(i), VSLOT(i), qf, acc, lp, da_, slope2, 0x7fffffffu, sa_, l15, q); }
#define SEL_COMP2(i, i2) { SEL_PREP(i, ja, sa_, da_) SEL_PREP(i2, jb, sb_, db_) \
                if (ja < qblk && jb < qblk) { tile_step<false>(KSLOT(i), VSLOT(i), qf, acc, lp, da_, slope2, 0x7fffffffu, sa_, l15, q); tile_step<false>(KSLOT(i2), VSLOT(i2), qf, acc, lp, db_, slope2, 0x7fffffffu, sb_, l15, q); } \
                else { tile_step<true>(KSLOT(i), VSLOT(i), qf, acc, lp, da_, slope2, 0x7fffffffu, sa_, l15, q); tile_step<true>(KSLOT(i2), VSLOT(i2), qf, acc, lp, db_, slope2, 0x7fffffffu, sb_, l15, q); } }
            PAIR_PIPE(nsel, SEL_FETCH, SEL_COMP1, SEL_COMP2)
#undef SEL_FETCH
#undef SEL_PREP
#undef SEL_COMP1
#undef SEL_COMP2
            float l = lp; l += __shfl_xor(l, 16); l += __shfl_xor(l, 32);
            const float sc = l > 0.f ? g1 / l : 0.f;
#pragma unroll
            for (int dt = 0; dt < 4; ++dt) { ot[dt][0] += sc * acc[dt][0]; ot[dt][1] += sc * acc[dt][1]; ot[dt][2] += sc * acc[dt][2]; ot[dt][3] += sc * acc[dt][3]; }
        }
        {
            const bf16* kb = Y1 + (size_t)b * T * OINP + 1536 + g * 64; const bf16* vt = VWT + (size_t)(b * 2 + g) * 64 * T;
            float lp = 0.f; f32x4 acc[4];
#pragma unroll
            for (int dt = 0; dt < 4; ++dt) acc[dt] = (f32x4){0.f, 0.f, 0.f, 0.f};
            int kstart = t0 - 511; kstart = kstart < 0 ? 0 : (kstart & ~63);
            const int nw = ((t0 + 15 - kstart) >> 6) + 1;
#define WIN_FETCH(idx, KR, VR) { const int i2_ = (idx) < nw ? (idx) : nw - 1; const int k2_ = kstart + 64 * i2_; tile_fetch(kb + (size_t)k2_ * OINP, OINP, vt + k2_, T, tid, KR, VR); }
#define WIN_INT(i) ((kstart + 64 * (i)) + 63 <= t0 && (kstart + 64 * (i)) >= t0 - 496)
#define WIN_COMP1(i) { const int d0_ = t - (kstart + 64 * (i)) - 4 * q; \
                if (WIN_INT(i)) tile_step<false>(KSLOT(i), VSLOT(i), qf, acc, lp, d0_, slope2, 512u, true, l15, q); \
                else tile_step<true>(KSLOT(i), VSLOT(i), qf, acc, lp, d0_, slope2, 512u, true, l15, q); }
#define WIN_COMP2(i, i2) { const int da_ = t - (kstart + 64 * (i)) - 4 * q, db_ = da_ - 64; \
                if (WIN_INT(i) && WIN_INT(i2)) { tile_step<false>(KSLOT(i), VSLOT(i), qf, acc, lp, da_, slope2, 512u, true, l15, q); tile_step<false>(KSLOT(i2), VSLOT(i2), qf, acc, lp, db_, slope2, 512u, true, l15, q); } \
                else { tile_step<true>(KSLOT(i), VSLOT(i), qf, acc, lp, da_, slope2, 512u, true, l15, q); tile_step<true>(KSLOT(i2), VSLOT(i2), qf, acc, lp, db_, slope2, 512u, true, l15, q); } }
            PAIR_PIPE(nw, WIN_FETCH, WIN_COMP1, WIN_COMP2)
#undef WIN_FETCH
#undef WIN_INT
#undef WIN_COMP1
#undef WIN_COMP2
            float l = lp; l += __shfl_xor(l, 16); l += __shfl_xor(l, 32);
            const float sc = l > 0.f ? g2 / l : 0.f;
#pragma unroll
            for (int dt = 0; dt < 4; ++dt) { ot[dt][0] += sc * acc[dt][0]; ot[dt][1] += sc * acc[dt][1]; ot[dt][2] += sc * acc[dt][2]; ot[dt][3] += sc * acc[dt][3]; }
        }
        bf16* op = MIX + row * D + h * 64 + 4 * q;
#pragma unroll
        for (int dt = 0; dt < 4; ++dt) { u32x2 ow; ow.x = pk2(ot[dt][0], ot[dt][1]); ow.y = pk2(ot[dt][2], ot[dt][3]); *(u32x2*)(op + 16 * dt) = ow; }
    }
#undef KSLOT
#undef VSLOT
#undef PAIR_PIPE
}
struct Args { const float* in[19]; float* out; unsigned char* ws; int ph_lo, ph_hi; };
constexpr int N_PHASES = 18;
template <class Epi>
DI void run_gemm(LAS unsigned char* lds, const bf16* A, const bf16* Bt, int N, int K, const Epi& E) {
    pg8::Gemm g{A, Bt, M, N, K}; pg8::StaticOrder S; S.init(M, N, (int)gridDim.x, (int)blockIdx.x);
    pg8::gemm_phase<Epi, pg8::StaticOrder, true, true>(lds, g, S, E);
}
__global__ void __launch_bounds__(512, 2) mega(Args a) {
    extern __shared__ __attribute__((aligned(16))) unsigned char lds_raw[];
    LAS unsigned char* lds = (LAS unsigned char*)lds_raw;
    cg::grid_group grid = cg::this_grid();
    volatile LAS unsigned* bst = (volatile LAS unsigned*)(lds + LDS_BYTES - 64);
    if (threadIdx.x < 2) bst[threadIdx.x] = 0u;
    __syncthreads();
    XcdBarrier xbar = xcd_barrier_post((unsigned*)(a.ws + WS_CTL), bst);
    const int tid = threadIdx.x, lane = tid & 63, wave = __builtin_amdgcn_readfirstlane(tid >> 6);
    const int gw = blockIdx.x * 8 + wave, ngw = gridDim.x * 8;
#define WSP(off) ((bf16*)(a.ws + (off)))
#define W_EIN WSP(WS_EIN)
#define W_EOUT WSP(WS_EOUT)
#define W_OIN WSP(WS_OIN)
#define W_OOUT WSP(WS_OOUT)
#define W_GU WSP(WS_GU)
#define W_DN WSP(WS_DN)
#define W1K WSP(WS_W1K)
#define W1V WSP(WS_W1V)
#define W2K WSP(WS_W2K)
#define W2V WSP(WS_W2V)
#define DEC ((float*)(a.ws + WS_DEC))
#define KCMP WSP(WS_KCMP)
#define VCMPT WSP(WS_VCMPT)
#define Y WSP(WS_Y)
#define VST WSP(WS_VST)
#define VWT WSP(WS_VWT)
#define HN WSP(WS_HN)
#define ST WSP(WS_ST)
#define RS ((float*)(a.ws + WS_RS))
#define HB WSP(WS_HB)
    const int lo = a.ph_lo, hi = a.ph_hi;
#define PH(k) if (lo <= (k) && (k) < hi)
#define SEAM(k) if (lo <= (k) && (k) + 1 < hi && hi > 0) { if (a.ph_lo < 0) grid.sync();   xcd_barrier(xbar); }
    PH(0) {
        LAS float* scr = (LAS float*)(lds + wave * 8448);
        constexpr int I0 = 2048, I1 = 512, I2 = 1024, I3 = 512, I4 = 2816, I5 = 1408, I6 = 64, I7 = 2;
        constexpr int NIT = I0 + I1 + I2 + I3 + 2 * I4 + 2 * I5 + 2 * I6 + 2 * I7;
        for (int it = gw; it < NIT; it += ngw) {
            int r = it;
            if (r < I0) { transpose_item(a.in[4], 1024, EIN, EIN, W_EIN, 0, scr, r, lane); continue; } r -= I0;
            if (r < I1) { transpose_item(a.in[8], 1024, 1024, 1024, W_EOUT, 0, scr, r, lane); continue; } r -= I1;
            if (r < I2) { transpose_item(a.in[9], 1024, OIN, OINP, W_OIN, 0, scr, r, lane, a.in[1] + D); continue; } r -= I2;
            if (r < I3) { transpose_item(a.in[16], 1024, 1024, 1024, W_OOUT, 0, scr, r, lane); continue; } r -= I3;
            if (r < 2 * I4) { const int l = r / I4; transpose_item(a.in[17] + (size_t)l * D * 2 * FF, 1024, 2 * FF, 2 * FF, W_GU + (size_t)l * GU_STRIDE, 1, scr, r % I4, lane, a.in[2] + l * D); continue; } r -= 2 * I4;
            if (r < 2 * I5) { const int l = r / I5; transpose_item(a.in[18] + (size_t)l * FF * D, FF, 1024, 1024, W_DN + (size_t)l * DN_STRIDE, 0, scr, r % I5, lane); continue; } r -= 2 * I5;
            if (r < I6) { transpose_item(a.in[12], 2048, 64, 64, W1K, 0, scr, r, lane); continue; } r -= I6;
            if (r < I6) { transpose_item(a.in[14], 2048, 64, 64, W1V, 0, scr, r, lane); continue; } r -= I6;
            if (r < I7) { transpose_item(a.in[13], 64, 64, 64, W2K, 0, scr, r, lane); continue; } r -= I7;
            transpose_item(a.in[15], 64, 64, 64, W2V, 0, scr, r, lane);
        }
        norm_rows_bf16(a.in[0], a.in[1], HN, gw, ngw, lane);
    }
    SEAM(0);
    PH(1) { EpiStoreLA E{Y}; run_gemm(lds, HN, W_EIN, EIN, 1024, E); }
    SEAM(1);
    PH(2) { la_state_phase(Y, a.in[5], ST, DEC, lds); }
    SEAM(2);
    PH(3) { la_scan_phase(ST, DEC); }
    SEAM(3);
    PH(4) { la_out_phase(Y, a.in[5], ST, a.in[6], a.in[7], HN, lds); }
    SEAM(4);
    PH(5) { EpiResid<false, false> E{a.in[0], nullptr, nullptr, HB, RS}; run_gemm(lds, HN, W_EOUT, 1024, 1024, E); }
    SEAM(5);
    PH(7) { EpiSwiglu E{Y, RS}; run_gemm(lds, HB, W_GU, 2 * FF, 1024, E); }
    SEAM(7);
    PH(8) { EpiResid<true, false> E{nullptr, HB, nullptr, HB, RS + 16 * M}; run_gemm(lds, Y, W_DN, 1024, FF, E); }
    SEAM(8);
    PH(10) { EpiStore E{Y, OINP, RS + 16 * M}; run_gemm(lds, HB, W_OIN, OINP, 1024, E); }
    SEAM(10);
    PH(11) { nsa_compress_phase(Y, a.in[10], a.in[11], W1K, W1V, W2K, W2V, KCMP, VCMPT, lds, gw, ngw, lane); nsa_vt_phase(Y, VST, VWT, gw, ngw, lane); }
    SEAM(11);
    PH(12) { nsa_attn_phase(Y, KCMP, VCMPT, VST, VWT, HN, lds); }
    SEAM(12);
    PH(13) { EpiResid<true, false> E{nullptr, HB, nullptr, HB, RS + 32 * M}; run_gemm(lds, HN, W_OOUT, 1024, 1024, E); }
    SEAM(13);
    PH(15) { EpiSwiglu E{Y, RS + 32 * M}; run_gemm(lds, HB, W_GU + GU_STRIDE, 2 * FF, 1024, E); }
    SEAM(15);
    PH(16) { EpiResid<true, true> E{nullptr, HB, a.out, nullptr, nullptr}; run_gemm(lds, Y, W_DN + DN_STRIDE, 1024, FF, E); }
    SEAM(16);
    PH(17) { norm_rows_f32_inplace(a.out, a.in[3], gw, ngw, lane); }
#undef PH
#undef SEAM
}

extern "C" void kernel_launch(void* const* d_in, const int* in_sizes, int n_in, void* d_out, int out_size, void* d_ws, size_t ws_size, hipStream_t stream) {
    static int grid = 0;
    if (grid == 0) {
        if (n_in != 19 || in_sizes[0] != M * D || out_size != M * D || ws_size < WS_END) { fprintf(stderr, "kernel_launch: unexpected shapes (n_in %d, in0 %d, out %d, ws %zu)\n", n_in, n_in > 0 ? in_sizes[0] : -1, out_size, ws_size); grid = -1; return; }
        int dev = 0, cus = 0, per_cu = 0;
        (void)hipGetDevice(&dev); (void)hipDeviceGetAttribute(&cus, hipDeviceAttributeMultiprocessorCount, dev);
        if (hipFuncSetAttribute((const void*)mega, hipFuncAttributeMaxDynamicSharedMemorySize, LDS_BYTES) != hipSuccess) { fprintf(stderr, "kernel_launch: hipFuncSetAttribute failed\n"); grid = -1; return; }
        if (hipOccupancyMaxActiveBlocksPerMultiprocessor(&per_cu, (const void*)mega, 512, LDS_BYTES) != hipSuccess || per_cu < 1) { fprintf(stderr, "kernel_launch: occupancy query says %d\n", per_cu); per_cu = 1; }
        (void)hipGetLastError();
        grid = cus * 1;
    }
    if (grid < 0) return;
    if (hipMemsetAsync((char*)d_ws + WS_CTL, 0, CTL_BYTES, stream) != hipSuccess) { fprintf(stderr, "kernel_launch: memset failed\n"); return; }
    Args a{};
    for (int i = 0; i < 19; ++i) a.in[i] = (const float*)d_in[i];
    a.out = (float*)d_out; a.ws = (unsigned char*)d_ws; a.ph_lo = 0; a.ph_hi = N_PHASES;
    void* args[] = {&a};
    hipError_t e = hipLaunchCooperativeKernel((const void*)mega, dim3(grid), dim3(512), args, LDS_BYTES, stream);
    if (e != hipSuccess) fprintf(stderr, "kernel_launch: cooperative launch failed: %s (grid %d)\n", hipGetErrorString(e), grid);
#ifdef PROBE_PHASES
    { const int pp[] = {PROBE_PHASES};
      for (unsigned i = 0; i < sizeof(pp) / sizeof(pp[0]); ++i) { a.ph_lo = pp[i]; a.ph_hi = pp[i] + 1; (void)hipLaunchCooperativeKernel((const void*)mega, dim3(grid), dim3(512), args, LDS_BYTES, stream); } }
#endif
}
```

```cpp
#include <hip/hip_runtime.h>
#include <hip/hip_cooperative_groups.h>
#include <cstdio>
#include <cstdint>
namespace cg = cooperative_groups;
namespace pg8 {
#define PG8_LAS __attribute__((address_space(3)))
typedef unsigned short bf16_t;
typedef short bf16x8 __attribute__((ext_vector_type(8)));
typedef float f32x4 __attribute__((ext_vector_type(4)));
typedef unsigned u32x4 __attribute__((ext_vector_type(4)));
constexpr int BM = 256, BK = 64, HALF = 128, HTB = HALF * BK * 2  , STAGE_BYTES = 8 * HTB, NXCD = 8, WGM = 8;

__host__ __device__ __forceinline__ int lds_byte(int r, int c) { const int st = (r >> 4) * 2 + (c >> 5), rr = r & 15, cc = c & 31, ob = rr * 64 + cc * 2; return st * 1024 + (ob ^ (((ob >> 9) & 1) << 5)); }
__host__ __device__ __forceinline__ void stage_rc(int b, int& R, int& C) { const int st = b / 1024, sb = b % 1024, swz = sb ^ (((sb >> 9) & 1) << 5); R = (st >> 1) * 16 + swz / 64; C = (st & 1) * 32 + (swz % 64) / 2; }
__host__ __device__ __forceinline__ int perm32(int rho) { const int n = rho >> 4, i = rho & 15; return 8 * (i >> 2) + 4 * n + (i & 3); }

struct Unit { int pm, pn; };
struct Gemm { const bf16_t* A; const bf16_t* Bt; int M, N, K; };

struct StaticOrder {
    int nM, nN, nwg, G, c;
    __host__ __device__ void init(int M, int N, int G_, int c_) { nM = M / BM; nN = N / BM; nwg = nM * nN; G = G_; c = c_; }
    __host__ __device__ bool next(int i, Unit& u) const {
        const long L = (long)i * G + c; if (L >= nwg) return false;
        int wgid = (int)L; { const int q = nwg / NXCD, r = nwg % NXCD, xcd = wgid % NXCD, off = wgid / NXCD; wgid = (xcd < r ? xcd * (q + 1) : r * (q + 1) + (xcd - r) * q) + off; }
        const int nig = WGM * nN, gid = wgid / nig, fm = gid * WGM, gsz = (nM - fm) < WGM ? (nM - fm) : WGM;
        u.pm = fm + ((wgid % nig) % gsz); u.pn = (wgid % nig) / gsz; return true;
    }
    __device__ __forceinline__ void a_ready(const Unit&) const {}
    __device__ __forceinline__ void done(const Unit&) const {}
};

__device__ __forceinline__ unsigned cvt_pk_bf16(float lo, float hi) { unsigned r; asm volatile("v_cvt_pk_bf16_f32 %0, %1, %2" : "=v"(r) : "v"(lo), "v"(hi)); return r; }
template <class Epi, class Sched, bool ALIGN_EPI = false, bool SP2 = false>
__device__ __forceinline__ void gemm_phase(PG8_LAS unsigned char* lds, const Gemm g, const Sched& S, const Epi& E) {
    const int tid = threadIdx.x, wid = __builtin_amdgcn_readfirstlane(tid >> 6), lane = tid & 63, wr = wid >> 2, wc = wid & 3, fr = lane & 15, fq = lane >> 4;
    const int K = g.K, nt = K / BK;
    unsigned voffA[2], voffB[2];
#pragma unroll
    for (int i = 0; i < 2; ++i) { int R, C; stage_rc(tid * 16 + i * 8192, R, C); const int Rb = Epi::PERM ? ((R & ~31) + perm32(R & 31)) : R;
        voffA[i] = (unsigned)(R * K + C) * 2u; voffB[i] = (unsigned)(Rb * K + C) * 2u; }
    const size_t kstep = (size_t)(BK * 2);
    const size_t hstep = (size_t)HALF * K * 2;
    const size_t tstep = 2 * hstep;
    const unsigned ldsw = (unsigned)wid * 1024u;
    const int aoff = lds_byte(wr * 64 + fr, fq * 8), boff = lds_byte(wc * 32 + fr, fq * 8);
#define PG8_SA(b, h) (((b) * 2 + (h)) * HTB)
#define PG8_SB(b, h) ((4 + (b) * 2 + (h)) * HTB)
#define PG8_STAGE(bufoff, gbase, voff) do { _Pragma("unroll") for (int _i = 0; _i < 2; ++_i) \
        __builtin_amdgcn_global_load_lds((const unsigned*)((const char*)(gbase) + (voff)[_i]), (PG8_LAS unsigned*)(lds + (bufoff) + ldsw + _i * 8192), 16, 0, 0); } while (0)
#define PG8_LDA(dst, b, h) do { _Pragma("unroll") for (int m = 0; m < 4; ++m) _Pragma("unroll") for (int k = 0; k < 2; ++k) dst[m][k] = *(const PG8_LAS bf16x8*)(lds + PG8_SA(b, h) + aoff + m * 2048 + k * 1024); } while (0)
#define PG8_LDB(dst, b, h) do { _Pragma("unroll") for (int n = 0; n < 2; ++n) _Pragma("unroll") for (int k = 0; k < 2; ++k) dst[n][k] = *(const PG8_LAS bf16x8*)(lds + PG8_SB(b, h) + boff + n * 2048 + k * 1024); } while (0)
#define PG8_MMA(ai, bj, At, Bt) do { __builtin_amdgcn_s_setprio(1); _Pragma("unroll") for (int m = 0; m < 4; ++m) _Pragma("unroll") for (int n = 0; n < 2; ++n) _Pragma("unroll") for (int k = 0; k < 2; ++k) \
        acc[ai][bj][m][n] = __builtin_amdgcn_mfma_f32_16x16x32_bf16(Bt[n][k], At[m][k], acc[ai][bj][m][n], 0, 0, 0); __builtin_amdgcn_s_setprio(0); } while (0)
#define PG8_WAIT_V(n) asm volatile("s_waitcnt vmcnt(" #n ")" ::: "memory")
#define PG8_WAIT_L(n) asm volatile("s_waitcnt lgkmcnt(" #n ")" ::: "memory")
#define PG8_BAR __builtin_amdgcn_s_barrier()
#define PG8_SCHED __builtin_amdgcn_sched_barrier(0)
    Unit cur, nxt; int ui = 0;
    if (!S.next(0, cur)) return;
    f32x4 acc[2][2][4][2];
#pragma unroll
    for (int a = 0; a < 2; ++a)
#pragma unroll
        for (int b = 0; b < 2; ++b)
#pragma unroll
            for (int m = 0; m < 4; ++m)
#pragma unroll
                for (int n = 0; n < 2; ++n) acc[a][b][m][n] = (f32x4){0.f, 0.f, 0.f, 0.f};
    bf16x8 At[4][2], B0[2][2], B1[2][2];
    const char* cA = (const char*)g.A + (size_t)cur.pm * tstep; const char* cB = (const char*)g.Bt + (size_t)cur.pn * tstep;
    S.a_ready(cur);
    if constexpr (SP2) {
        PG8_STAGE(PG8_SB(0, 0), cB, voffB); PG8_STAGE(PG8_SB(0, 1), cB + hstep, voffB); PG8_STAGE(PG8_SA(0, 0), cA, voffA); PG8_STAGE(PG8_SA(0, 1), cA + hstep, voffA);
        if (wr == 1) PG8_BAR;
        PG8_WAIT_V(2); PG8_BAR;
        PG8_STAGE(PG8_SB(1, 0), cB + kstep, voffB); PG8_STAGE(PG8_SA(1, 0), cA + kstep, voffA); PG8_STAGE(PG8_SB(1, 1), cB + hstep + kstep, voffB);
        PG8_WAIT_V(6); PG8_BAR;
    } else {
        PG8_STAGE(PG8_SB(0, 0), cB, voffB); PG8_STAGE(PG8_SA(0, 0), cA, voffA); PG8_STAGE(PG8_SB(0, 1), cB + hstep, voffB); PG8_STAGE(PG8_SA(0, 1), cA + hstep, voffA);
        if (wr == 1) PG8_BAR;
        PG8_WAIT_V(4); PG8_BAR;
        PG8_STAGE(PG8_SB(1, 0), cB + kstep, voffB); PG8_STAGE(PG8_SA(1, 0), cA + kstep, voffA); PG8_STAGE(PG8_SB(1, 1), cB + hstep + kstep, voffB);
        PG8_WAIT_V(6); PG8_BAR;
    }
    for (;;) {
        const bool has_next = S.next(ui + 1, nxt);
        const char* nA = has_next ? (const char*)g.A + (size_t)nxt.pm * tstep : cA; const char* nB = has_next ? (const char*)g.Bt + (size_t)nxt.pn * tstep : cB;
        for (int t = 0; t < nt; t += 2) {
            const bool last = (t == nt - 2);
            const char* a1 = cA + (size_t)(t + 1) * kstep;
            const char* a2 = last ? nA : cA + (size_t)(t + 2) * kstep; const char* b2 = last ? nB : cB + (size_t)(t + 2) * kstep;
            const char* a3 = a2 + kstep; const char* b3 = b2 + kstep;
            if (last && has_next) S.a_ready(nxt);
            if constexpr (SP2) {
            PG8_LDB(B0, 0, 0); PG8_LDB(B1, 0, 1); PG8_SCHED; PG8_LDA(At, 0, 0); PG8_STAGE(PG8_SA(1, 1), a1 + hstep, voffA);
            PG8_WAIT_V(8); PG8_WAIT_L(0); PG8_BAR; PG8_MMA(0, 0, At, B0); PG8_MMA(0, 1, At, B1); PG8_BAR; PG8_SCHED;
            PG8_LDA(At, 0, 1); PG8_STAGE(PG8_SB(0, 0), b2, voffB); PG8_STAGE(PG8_SB(0, 1), b2 + hstep, voffB); PG8_STAGE(PG8_SA(0, 0), a2, voffA);
            PG8_WAIT_V(8); PG8_WAIT_L(0); PG8_BAR; PG8_MMA(1, 0, At, B0); PG8_MMA(1, 1, At, B1); PG8_BAR; PG8_SCHED;
            PG8_LDB(B0, 1, 0); PG8_LDB(B1, 1, 1); PG8_SCHED; PG8_LDA(At, 1, 0); PG8_STAGE(PG8_SA(0, 1), a2 + hstep, voffA);
            PG8_WAIT_V(8); PG8_WAIT_L(0); PG8_BAR; PG8_MMA(0, 0, At, B0); PG8_MMA(0, 1, At, B1); PG8_BAR; PG8_SCHED;
            PG8_LDA(At, 1, 1); PG8_STAGE(PG8_SB(1, 0), b3, voffB); PG8_STAGE(PG8_SB(1, 1), b3 + hstep, voffB); PG8_STAGE(PG8_SA(1, 0), a3, voffA);
            PG8_WAIT_V(8); PG8_WAIT_L(0); PG8_BAR; PG8_MMA(1, 0, At, B0); PG8_MMA(1, 1, At, B1); PG8_BAR; PG8_SCHED;
            } else {
            PG8_LDB(B0, 0, 0); PG8_SCHED; PG8_LDA(At, 0, 0); PG8_STAGE(PG8_SA(1, 1), a1 + hstep, voffA);
            PG8_WAIT_L(8); PG8_BAR; PG8_WAIT_L(0); PG8_MMA(0, 0, At, B0); PG8_BAR; PG8_SCHED;
            PG8_LDB(B1, 0, 1); PG8_STAGE(PG8_SB(0, 0), b2, voffB);
            PG8_BAR; PG8_WAIT_L(0); PG8_MMA(0, 1, At, B1); PG8_BAR;
            PG8_LDA(At, 0, 1); PG8_STAGE(PG8_SA(0, 0), a2, voffA);
            PG8_BAR; PG8_WAIT_L(0); PG8_MMA(1, 0, At, B0); PG8_BAR; PG8_SCHED;
            PG8_STAGE(PG8_SB(0, 1), b2 + hstep, voffB);
            PG8_WAIT_V(6); PG8_BAR; PG8_MMA(1, 1, At, B1); PG8_BAR;
            PG8_LDB(B0, 1, 0); PG8_SCHED; PG8_LDA(At, 1, 0); PG8_STAGE(PG8_SA(0, 1), a2 + hstep, voffA);
            PG8_WAIT_L(8); PG8_BAR; PG8_WAIT_L(0); PG8_MMA(0, 0, At, B0); PG8_BAR; PG8_SCHED;
            PG8_LDB(B1, 1, 1); PG8_STAGE(PG8_SB(1, 0), b3, voffB);
            PG8_BAR; PG8_WAIT_L(0); PG8_MMA(0, 1, At, B1); PG8_BAR;
            PG8_LDA(At, 1, 1); PG8_STAGE(PG8_SA(1, 0), a3, voffA);
            PG8_BAR; PG8_WAIT_L(0); PG8_MMA(1, 0, At, B0); PG8_BAR; PG8_SCHED;
            PG8_STAGE(PG8_SB(1, 1), b3 + hstep, voffB);
            PG8_WAIT_V(6); PG8_BAR; PG8_MMA(1, 1, At, B1); PG8_BAR;
            }
        }
        if constexpr (ALIGN_EPI) { if (wr == 0) PG8_BAR; }
        if constexpr (!Epi::AFTER_DRAIN) { E(acc, cur, wr, wc, fr, fq); S.done(cur); }
        if (!has_next) break;
#pragma unroll
        for (int a = 0; a < 2; ++a)
#pragma unroll
            for (int b = 0; b < 2; ++b)
#pragma unroll
                for (int m = 0; m < 4; ++m)
#pragma unroll
                    for (int n = 0; n < 2; ++n) acc[a][b][m][n] = (f32x4){0.f, 0.f, 0.f, 0.f};
        cur = nxt; cA = nA; cB = nB; ++ui;
        if constexpr (ALIGN_EPI) { if (wr == 1) PG8_BAR; }
    }
    PG8_WAIT_V(0);
    if constexpr (!ALIGN_EPI) { if (wr == 0) PG8_BAR; }
    PG8_BAR;
    if constexpr (Epi::AFTER_DRAIN) { E.fused(acc, cur, wr, wc, fr, fq, lds, wid, lane); S.done(cur); }
#undef PG8_SA
#undef PG8_SB
#undef PG8_STAGE
#undef PG8_LDA
#undef PG8_LDB
#undef PG8_MMA
#undef PG8_WAIT_V
#undef PG8_WAIT_L
#undef PG8_BAR
#undef PG8_SCHED
}
}
#define GAS __attribute__((address_space(1)))
#define LAS __attribute__((address_space(3)))
#define DI __device__ __forceinline__
typedef unsigned short bf16;
typedef short bf16x8 __attribute__((ext_vector_type(8)));
typedef short s16x4 __attribute__((ext_vector_type(4)));
typedef float f32x4 __attribute__((ext_vector_type(4)));
typedef float f32x2 __attribute__((ext_vector_type(2)));
typedef unsigned u32x4 __attribute__((ext_vector_type(4)));
typedef unsigned u32x2 __attribute__((ext_vector_type(2)));
typedef __bf16 bf16x2_t __attribute__((ext_vector_type(2)));
#define MFMA16(a, b, c) __builtin_amdgcn_mfma_f32_16x16x32_bf16((a), (b), (c), 0, 0, 0)

constexpr int NB = 4, T = 8192, D = 1024, M = NB * T, FF = 2816;
constexpr int EIN = 4096, OIN = 1840, OINP = 2048;
constexpr float RMS_EPS = 1e-6f, LOG2E = 1.4426950408889634f;
constexpr size_t MiB = 1u << 20;
constexpr size_t WS_EIN = 0, WS_EOUT = 8 * MiB, WS_OIN = 10 * MiB, WS_OOUT = 14 * MiB, WS_GU = 16 * MiB, WS_DN = 38 * MiB;
constexpr size_t WS_W1K = 49 * MiB, WS_W1V = WS_W1K + 256 * 1024, WS_W2K = WS_W1V + 256 * 1024, WS_W2V = WS_W2K + 8192;
constexpr size_t WS_CTL = 56 * MiB, CTL_BYTES = 16384, WS_RS = 57 * MiB;
constexpr size_t WS_DEC = 52 * MiB, WS_KCMP = 54 * MiB, WS_VCMPT = WS_KCMP + 512 * 1024;
constexpr size_t WS_Y = 64 * MiB;
constexpr size_t WS_VST = 192 * MiB, WS_VWT = 200 * MiB, WS_HB = 240 * MiB;
constexpr size_t WS_HN = 320 * MiB, WS_ST = 384 * MiB, WS_END = 512 * MiB;
constexpr size_t GU_STRIDE = (size_t)2 * FF * D, DN_STRIDE = (size_t)D * FF;
constexpr int LDS_BYTES = 163840;

DI unsigned pk2(float lo, float hi) { f32x2 v = {lo, hi}; return __builtin_bit_cast(unsigned, __builtin_convertvector(v, bf16x2_t)); }
DI bf16 f2bf(float f) { return (bf16)(pk2(f, 0.f) & 0xffffu); }
DI float bf2f(bf16 x) { return __uint_as_float(((unsigned)x) << 16); }
DI float bflo(unsigned w) { return __uint_as_float(w << 16); }
DI float bfhi(unsigned w) { return __uint_as_float(w & 0xffff0000u); }
DI float wave_sum(float v) {
#pragma unroll
    for (int o = 1; o < 64; o <<= 1) v += __shfl_xor(v, o);
    return v;
}
DI float ex2(float x) { return __builtin_amdgcn_exp2f(x); }
DI float sigmoidf_(float x) { return __builtin_amdgcn_rcpf(1.0f + __expf(-x)); }
DI float siluf_(float x) { return x * __builtin_amdgcn_rcpf(1.0f + __expf(-x)); }

DI float rowscale(const float* rs, int row, int fq) {
    const f32x4 p = *(const f32x4*)(rs + (size_t)row * 16 + 4 * fq);
    float s = (p.x + p.y) + (p.z + p.w); s += __shfl_xor(s, 16); s += __shfl_xor(s, 32);
    return rsqrtf(s * (1.f / D) + RMS_EPS);
}
struct EpiStore {
    static constexpr bool PERM = true, AFTER_DRAIN = false;
    bf16* O; int ldc; const float* rs;
    DI void operator()(const pg8::f32x4 (&acc)[2][2][4][2], const pg8::Unit& u, int wr, int wc, int fr, int fq) const {
        const int row0 = u.pm * 256 + wr * 64 + fr, col0 = u.pn * 256 + wc * 32 + 8 * fq;
#pragma unroll
        for (int ai = 0; ai < 2; ++ai)
#pragma unroll
            for (int m = 0; m < 4; ++m) { const int row = row0 + ai * 128 + m * 16; bf16* rowp = O + (size_t)row * ldc + col0;
                const float r = rs ? rowscale(rs, row, fq) : 1.f;
#pragma unroll
                for (int bj = 0; bj < 2; ++bj) { const pg8::f32x4 v0 = acc[ai][bj][m][0] * r, v1 = acc[ai][bj][m][1] * r;
                    u32x4 w; w.x = pk2(v0[0], v0[1]); w.y = pk2(v0[2], v0[3]); w.z = pk2(v1[0], v1[1]); w.w = pk2(v1[2], v1[3]);
                    *(u32x4*)(rowp + bj * 128) = w; } }
    }
};
struct EpiStoreLA {
    static constexpr bool PERM = true, AFTER_DRAIN = false;
    bf16* O;
    DI void operator()(const pg8::f32x4 (&acc)[2][2][4][2], const pg8::Unit& u, int wr, int wc, int fr, int fq) const {
        const int row0 = u.pm * 256 + wr * 64 + fr, col0 = u.pn * 256 + wc * 32 + 8 * fq;
#pragma unroll
        for (int ai = 0; ai < 2; ++ai)
#pragma unroll
            for (int m = 0; m < 4; ++m) { const int row = row0 + ai * 128 + m * 16; const int bb = row >> 13, n = (row >> 6) & 127, r = row & 63;
#pragma unroll
                for (int bj = 0; bj < 2; ++bj) { const int col = col0 + bj * 128; const int arr = (col >> 9) & 3, hh = ((col >> 11) << 2) | ((col >> 7) & 3), c = col & 127;
                    const pg8::f32x4 v0 = acc[ai][bj][m][0], v1 = acc[ai][bj][m][1];
                    u32x4 w; w.x = pk2(v0[0], v0[1]); w.y = pk2(v0[2], v0[3]); w.z = pk2(v1[0], v1[1]); w.w = pk2(v1[2], v1[3]);
                    *(u32x4*)(O + ((size_t)((((bb * 8 + hh) * 128 + n) * 4 + arr)) << 13) + r * 128 + c) = w; } }
    }
};
struct EpiSwiglu {
    static constexpr bool PERM = true, AFTER_DRAIN = false;
    bf16* O; const float* rs;
    DI void operator()(const pg8::f32x4 (&acc)[2][2][4][2], const pg8::Unit& u, int wr, int wc, int fr, int fq) const {
        const int row0 = u.pm * 256 + wr * 64 + fr, col0 = u.pn * 128 + wc * 32 + 8 * fq;
#pragma unroll
        for (int ai = 0; ai < 2; ++ai)
#pragma unroll
            for (int m = 0; m < 4; ++m) { const int row = row0 + ai * 128 + m * 16; bf16* rowp = O + (size_t)row * FF + col0;
                const float rsc = rowscale(rs, row, fq);
                float r[8];
#pragma unroll
                for (int n = 0; n < 2; ++n)
#pragma unroll
                    for (int e = 0; e < 4; ++e) { const float g = acc[ai][0][m][n][e] * rsc, up = acc[ai][1][m][n][e] * rsc; r[n * 4 + e] = g * __builtin_amdgcn_rcpf(1.0f + __expf(-g)) * up; }
                u32x4 w; w.x = pk2(r[0], r[1]); w.y = pk2(r[2], r[3]); w.z = pk2(r[4], r[5]); w.w = pk2(r[6], r[7]);
                *(u32x4*)rowp = w; }
    }
};
template <bool BASE_BF16, bool OUT_F32>
struct EpiResid {
    static constexpr bool PERM = false, AFTER_DRAIN = false;
    const float* basef; const bf16* baseh; float* out; bf16* hb; float* rs;
    DI void operator()(const pg8::f32x4 (&acc)[2][2][4][2], const pg8::Unit& u, int wr, int wc, int fr, int fq) const {
        const int row0 = u.pm * 256 + wr * 64 + fr, col0 = u.pn * 256 + wc * 32 + 4 * fq;
#pragma unroll
        for (int ai = 0; ai < 2; ++ai)
#pragma unroll
            for (int m = 0; m < 4; ++m) { const int row = row0 + ai * 128 + m * 16; const size_t off = (size_t)row * D + col0; float ss = 0.f;
#pragma unroll
                for (int bj = 0; bj < 2; ++bj)
#pragma unroll
                    for (int n = 0; n < 2; ++n) { const size_t o2 = off + bj * 128 + n * 16; const pg8::f32x4 a = acc[ai][bj][m][n];
                        f32x4 bs;
                        if (BASE_BF16) { const u32x2 bw = *(const u32x2*)(baseh + o2); bs = (f32x4){bflo(bw.x), bfhi(bw.x), bflo(bw.y), bfhi(bw.y)}; }
                        else bs = *(const f32x4*)(basef + o2);
                        f32x4 o; o.x = bs.x + a[0]; o.y = bs.y + a[1]; o.z = bs.z + a[2]; o.w = bs.w + a[3];
                        if (OUT_F32) *(f32x4*)(out + o2) = o;
                        else { u32x2 hw; hw.x = pk2(o.x, o.y); hw.y = pk2(o.z, o.w); *(u32x2*)(hb + o2) = hw; ss += (o.x * o.x + o.y * o.y) + (o.z * o.z + o.w * o.w); } }
                if (!OUT_F32) { ss += __shfl_xor(ss, 16); ss += __shfl_xor(ss, 32); if (fq == 0) rs[(size_t)row * 16 + u.pn * 4 + wc] = ss; } }
    }
};

DI void transpose_item(const float* W, int K, int N, int Npad, bf16* WT, int mode, LAS float* scr, int item, int lane, const float* gk = nullptr) {
    const int nblk = Npad / 32, kb = item / nblk, nb = item % nblk, k0 = 64 * kb, n0 = 32 * nb;
    const int nl = n0 + (lane & 31);
#pragma unroll 8
    for (int i = 0; i < 32; ++i) { const int kk = 2 * i + (lane >> 5); const float gv = gk ? gk[k0 + kk] : 1.f; scr[kk * 33 + (lane & 31)] = (nl < N) ? W[(size_t)(k0 + kk) * N + nl] * gv : 0.f; }
    asm volatile("s_waitcnt lgkmcnt(0)" ::: "memory");
    const int c = lane & 7;
    int drow0 = n0;
    if (mode == 1) { drow0 = (n0 < FF) ? (256 * (n0 >> 7) + (n0 & 127)) : (256 * ((n0 - FF) >> 7) + 128 + ((n0 - FF) & 127)); }
#pragma unroll
    for (int j = 0; j < 4; ++j) { const int n = (lane >> 3) + 8 * j; const LAS float* s = scr + (8 * c) * 33 + n;
        u32x4 o; o.x = pk2(s[0 * 33], s[1 * 33]); o.y = pk2(s[2 * 33], s[3 * 33]); o.z = pk2(s[4 * 33], s[5 * 33]); o.w = pk2(s[6 * 33], s[7 * 33]);
        *(u32x4*)(WT + (size_t)(drow0 + n) * K + k0 + 8 * c) = o; }
    asm volatile("s_waitcnt lgkmcnt(0)" ::: "memory");
}
DI void norm_rows_bf16(const float* h, const float* g, bf16* out, int gw, int ngw, int lane) {
    f32x4 gv[4];
#pragma unroll
    for (int j = 0; j < 4; ++j) gv[j] = *((const f32x4*)g + lane + 64 * j);
    for (int m0 = gw; m0 < M; m0 += 4 * ngw) {
        f32x4 v[4][4];
#pragma unroll
        for (int r = 0; r < 4; ++r) { const int m = m0 + r * ngw < M ? m0 + r * ngw : m0; const f32x4* xr = (const f32x4*)(h + (size_t)m * D) + lane;
#pragma unroll
            for (int j = 0; j < 4; ++j) v[r][j] = xr[64 * j]; }
#pragma unroll
        for (int r = 0; r < 4; ++r) { const int m = m0 + r * ngw; float s = 0.f;
#pragma unroll
            for (int j = 0; j < 4; ++j) s += (v[r][j].x * v[r][j].x + v[r][j].y * v[r][j].y) + (v[r][j].z * v[r][j].z + v[r][j].w * v[r][j].w);
            const float rr = rsqrtf(wave_sum(s) * (1.f / D) + RMS_EPS);
            if (m < M) { u32x2* o8 = (u32x2*)(out + (size_t)m * D) + lane;
#pragma unroll
                for (int j = 0; j < 4; ++j) { u32x2 w; w.x = pk2(v[r][j].x * rr * gv[j].x, v[r][j].y * rr * gv[j].y); w.y = pk2(v[r][j].z * rr * gv[j].z, v[r][j].w * rr * gv[j].w); o8[64 * j] = w; } } }
    }
}
DI void norm_final(const bf16* hb, const float* rs, const float* g, float* out, int gw, int ngw, int lane) {
    f32x4 gv[4];
#pragma unroll
    for (int j = 0; j < 4; ++j) gv[j] = *((const f32x4*)g + lane + 64 * j);
    for (int m0 = gw; m0 < M; m0 += 4 * ngw) {
        u32x2 v[4][4]; float pr[4];
#pragma unroll
        for (int r = 0; r < 4; ++r) { const int m = m0 + r * ngw < M ? m0 + r * ngw : m0; const u32x2* xr = (const u32x2*)(hb + (size_t)m * D) + lane;
#pragma unroll
            for (int j = 0; j < 4; ++j) v[r][j] = xr[64 * j];
            pr[r] = rs[(size_t)m * 16 + (lane & 15)]; }
#pragma unroll
        for (int r = 0; r < 4; ++r) { const int m = m0 + r * ngw; float s = pr[r];
            s += __shfl_xor(s, 1); s += __shfl_xor(s, 2); s += __shfl_xor(s, 4); s += __shfl_xor(s, 8);
            const float rr = rsqrtf(s * (1.f / D) + RMS_EPS);
            if (m < M) { f32x4* xo = (f32x4*)(out + (size_t)m * D) + lane;
#pragma unroll
                for (int j = 0; j < 4; ++j) { f32x4 o; o.x = bflo(v[r][j].x) * rr * gv[j].x; o.y = bfhi(v[r][j].x) * rr * gv[j].y; o.z = bflo(v[r][j].y) * rr * gv[j].z; o.w = bfhi(v[r][j].y) * rr * gv[j].w; xo[64 * j] = o; } } }
    }
}
typedef GAS unsigned gu32;
#define XB_TMO      128
#define XB_XCNT(j)  (256  + 64 * (j))
#define XB_XSUB(j)  (1280 + 64 * (j))
#define XB_XGEN(j)  (2304 + 64 * (j))
#define XB_TOP      3328
#define XB_TOPGEN   3392
#define XCD_BAR_WORDS 3456
#define XB_SPIN_CAP (1u << 18)

__device__ __forceinline__ unsigned xb_ld(unsigned* p)              { return __hip_atomic_load(p, __ATOMIC_RELAXED, __HIP_MEMORY_SCOPE_AGENT); }
__device__ __forceinline__ unsigned xb_add(unsigned* p, unsigned v) { return __hip_atomic_fetch_add(p, v, __ATOMIC_RELAXED, __HIP_MEMORY_SCOPE_AGENT); }
__device__ __forceinline__ unsigned xb_xcc_id() { return (unsigned)__builtin_amdgcn_s_getreg((3 << 11) | 20) & 0xFu; }
#define XB_SPIN(cond, bar) do { unsigned _sp = 0; while (cond) { __builtin_amdgcn_s_sleep(1); \
    if ((++_sp & 255u) == 0u) { if (xb_ld(&(bar)[XB_TMO])) break; if (_sp > XB_SPIN_CAP) { atomicAdd(&(bar)[XB_TMO], 1u); break; } } } } while (0)

struct XcdBarrier {
    unsigned* bar; unsigned x;
    volatile LAS unsigned* st;
};

__device__ __forceinline__ XcdBarrier xcd_barrier_post(unsigned* bar, volatile LAS unsigned* st) {
    XcdBarrier b; b.bar = bar; b.x = xb_xcc_id(); b.st = st;
    if (threadIdx.x == 0) (void)xb_add(&bar[XB_XCNT(b.x)], 1u);
    return b;
}
__device__ __forceinline__ void xcd_barrier_complete(unsigned* bar, unsigned x, unsigned& nloc, unsigned& nx) {
    const unsigned G = gridDim.x * gridDim.y * gridDim.z;
    unsigned sum, cnt, mine, sp = 0u;
    for (;;) {
        sum = 0u; cnt = 0u; mine = 0u;
#pragma unroll
        for (unsigned j = 0; j < 16; ++j) { const unsigned c = xb_ld(&bar[XB_XCNT(j)]); sum += c; cnt += (c > 0u) ? 1u : 0u; mine = (j == x) ? c : mine; }
        if (sum == G) break;
        __builtin_amdgcn_s_sleep(1);
        if ((++sp & 255u) == 0u) { if (xb_ld(&bar[XB_TMO])) break; if (sp > XB_SPIN_CAP) { atomicAdd(&bar[XB_TMO], 1u); break; } }
    }
    nloc = mine > 0u ? mine : 1u; nx = cnt > 0u ? cnt : 1u;
}

__device__ __forceinline__ void xcd_barrier(const XcdBarrier& b) {
    asm volatile("s_waitcnt vmcnt(0)" ::: "memory");
    __syncthreads();
    if (threadIdx.x == 0) {
        unsigned* bar = b.bar;
        __builtin_amdgcn_s_waitcnt(0);
        unsigned nloc = b.st[0], nx = b.st[1];
        if (nloc == 0u) { xcd_barrier_complete(bar, b.x, nloc, nx); b.st[0] = nloc; b.st[1] = nx; }
        const unsigned old = xb_add(&bar[XB_XSUB(b.x)], 1u);
        const unsigned gen = old / nloc;
        if (old + 1u == (gen + 1u) * nloc) {
            __builtin_amdgcn_fence(__ATOMIC_RELEASE, "agent");
            asm volatile("s_waitcnt vmcnt(0)" ::: "memory");
            const unsigned og = xb_add(&bar[XB_TOP], 1u);
            const unsigned tg = og / nx;
            if (og + 1u == (tg + 1u) * nx) xb_add(&bar[XB_TOPGEN], 1u);
            else XB_SPIN(xb_ld(&bar[XB_TOPGEN]) == tg, bar);
            __builtin_amdgcn_fence(__ATOMIC_ACQUIRE, "agent");
            xb_add(&bar[XB_XGEN(b.x)], 1u);
            asm volatile("s_waitcnt vmcnt(0)" ::: "memory");
        } else {
            XB_SPIN(xb_ld(&bar[XB_XGEN(b.x)]) == gen, bar);
            __builtin_amdgcn_fence(__ATOMIC_ACQUIRE, "agent");
            asm volatile("s_waitcnt vmcnt(0)" ::: "memory");
        }
    }
    __syncthreads();
}
constexpr int LA_UNITS = NB * 8 * 128;
constexpr int KT_LD = 72, QT_LD = 136;
#define LA_BAR() do { asm volatile("s_waitcnt lgkmcnt(0)" ::: "memory"); __builtin_amdgcn_s_barrier(); asm volatile("" ::: "memory"); } while (0)
struct LaRaw { unsigned f[16], qv[16], v[16]; float lba, lbb; };
DI void la_read_col(const LAS bf16* tile, int d, int rg, unsigned (&out)[16]) {
#pragma unroll
    for (int e = 0; e < 16; ++e) out[e] = tile[(16 * rg + e) * QT_LD + d];
}
template <bool WANT_Q>
DI void la_math(const LaRaw& R, int hh, float (&fd)[16], float (&kk)[16], float (&qq)[16]) {
    if (hh < 4) {
        const float mx = fmaxf(R.lba, R.lbb), ea = __expf(R.lba - mx), eb = __expf(R.lbb - mx), lbv = ea / (ea + eb);
#pragma unroll
        for (int e = 0; e < 16; ++e) { const float x = bf2f((bf16)R.f[e]); const float f = lbv + (1.f - lbv) * sigmoidf_(x); fd[e] = f; kk[e] = 1.f - f;
            if (WANT_Q) qq[e] = siluf_(bf2f((bf16)R.qv[e])); }
    } else {
        const int r = hh - 4; const float gam = 1.f - exp2f(-5.f - (float)r);
#pragma unroll
        for (int e = 0; e < 16; ++e) { fd[e] = gam; kk[e] = bf2f((bf16)R.f[e]) * 0.08838834764831845f; if (WANT_Q) qq[e] = bf2f((bf16)R.qv[e]); }
    }
}
DI void la_store_vt(const LaRaw& R, int d, int rg, LAS bf16* VT) {
    LAS u32x4* dst = (LAS u32x4*)(VT + d * KT_LD + 16 * rg);
    dst[0] = (u32x4){R.v[0] | (R.v[1] << 16), R.v[2] | (R.v[3] << 16), R.v[4] | (R.v[5] << 16), R.v[6] | (R.v[7] << 16)};
    dst[1] = (u32x4){R.v[8] | (R.v[9] << 16), R.v[10] | (R.v[11] << 16), R.v[12] | (R.v[13] << 16), R.v[14] | (R.v[15] << 16)};
}
#define LA_CH_LDS(base, ch) ((LAS u32x4*)((base) + ((ch) >> 4) * QT_LD + ((ch) & 15) * 8))
DI void la_state_phase(const bf16* Y0, const float* lbraw, bf16* ST, float* DEC, LAS unsigned char* lds) {
    LAS bf16* KT = (LAS bf16*)lds; LAS bf16* VT = KT + 128 * KT_LD; LAS float* tot = (LAS float*)(VT + 128 * KT_LD);
    LAS bf16* RF = KT; LAS bf16* RV = VT;
    const int tid = threadIdx.x, lane = tid & 63, w = tid >> 6, l15 = lane & 15, q = lane >> 4, d = tid & 127, rg = tid >> 7;
    u32x4 rf[2], rv[2]; float lba, lbb;
#define A1_FETCH(un) { const bf16* yb_ = Y0 + ((size_t)(un) << 15); const int li_ = ((((un) >> 7) & 3) << 7) + d; \
        _Pragma("unroll") for (int c_ = 0; c_ < 2; ++c_) { rf[c_] = *(const u32x4*)(yb_ + 8192 + (size_t)(tid + 512 * c_) * 8); rv[c_] = *(const u32x4*)(yb_ + 16384 + (size_t)(tid + 512 * c_) * 8); } \
        lba = lbraw[li_]; lbb = lbraw[512 + li_]; asm volatile("" ::: "memory"); }
#define A1_STORE() { _Pragma("unroll") for (int c_ = 0; c_ < 2; ++c_) { *LA_CH_LDS(RF, tid + 512 * c_) = rf[c_]; *LA_CH_LDS(RV, tid + 512 * c_) = rv[c_]; } }
    A1_FETCH(blockIdx.x)
    A1_STORE()
    LaRaw R; R.lba = lba; R.lbb = lbb;
    LA_BAR();
    for (int unit = blockIdx.x; unit < LA_UNITS; unit += gridDim.x) {
        const int hh = (unit >> 7) & 7;
        { const int nx = unit + (int)gridDim.x, un = nx < LA_UNITS ? nx : unit; A1_FETCH(un) }
        la_read_col(RF, d, rg, R.f); la_read_col(RV, d, rg, R.v);
        LA_BAR();
        float fd[16], kk[16], qq[16];
        la_math<false>(R, hh, fd, kk, qq);
        float run = 1.f;
#pragma unroll
        for (int e = 15; e >= 0; --e) { kk[e] *= run; run *= fd[e]; }
        tot[rg * 128 + d] = run;
        la_store_vt(R, d, rg, VT);
        LA_BAR();
        float post = 1.f, last = 1.f;
#pragma unroll
        for (int g2 = 0; g2 < 4; ++g2) { const float tv = tot[g2 * 128 + d]; if (g2 > rg) post *= tv; last *= tv; }
        unsigned wv[8];
#pragma unroll
        for (int e = 0; e < 8; ++e) wv[e] = pk2(kk[2 * e] * post, kk[2 * e + 1] * post);
        LAS u32x4* dst = (LAS u32x4*)(KT + d * KT_LD + 16 * rg);
        dst[0] = (u32x4){wv[0], wv[1], wv[2], wv[3]}; dst[1] = (u32x4){wv[4], wv[5], wv[6], wv[7]};
        if (rg == 0) DEC[(size_t)unit * 128 + d] = last;
        LA_BAR();
        f32x4 acc[8];
#pragma unroll
        for (int dt = 0; dt < 8; ++dt) acc[dt] = (f32x4){0.f, 0.f, 0.f, 0.f};
#pragma unroll
        for (int ks = 0; ks < 2; ++ks) { const bf16x8 bv = *(const LAS bf16x8*)(VT + (16 * w + l15) * KT_LD + 32 * ks + 8 * q);
#pragma unroll
            for (int dt = 0; dt < 8; ++dt) { const bf16x8 ak = *(const LAS bf16x8*)(KT + (16 * dt + l15) * KT_LD + 32 * ks + 8 * q); acc[dt] = MFMA16(ak, bv, acc[dt]); } }
        bf16* so = ST + (size_t)unit * 16384 + (16 * w + l15) * 128 + 4 * q;
#pragma unroll
        for (int dt = 0; dt < 8; ++dt) { u32x2 o; o.x = pk2(acc[dt][0], acc[dt][1]); o.y = pk2(acc[dt][2], acc[dt][3]); *(u32x2*)(so + 16 * dt) = o; }
        LA_BAR();
        A1_STORE()
        R.lba = lba; R.lbb = lbb;
        LA_BAR();
    }
#undef A1_FETCH
#undef A1_STORE
}
DI void la_scan_phase(bf16* ST, const float* DEC) {
    const int gid = blockIdx.x * 512 + threadIdx.x, nth = gridDim.x * 512;
    for (int wk = gid; wk < 32 * 4096; wk += nth) {
        const int bh = wk >> 12, e4 = (wk & 4095) * 4, d = e4 & 127;
        f32x4 s = {0.f, 0.f, 0.f, 0.f};
        bf16* sp = ST + (size_t)bh * 128 * 16384 + e4; const float* dp = DEC + (size_t)bh * 128 * 128 + d;
        for (int n0 = 0; n0 < 128; n0 += 8) {
            u32x2 uv[8]; f32x4 dv[8];
#pragma unroll
            for (int i = 0; i < 8; ++i) { uv[i] = *(const u32x2*)(sp + (size_t)(n0 + i) * 16384); dv[i] = *(const f32x4*)(dp + (size_t)(n0 + i) * 128); }
#pragma unroll
            for (int i = 0; i < 8; ++i) { u32x2 o; o.x = pk2(s.x, s.y); o.y = pk2(s.z, s.w); *(u32x2*)(sp + (size_t)(n0 + i) * 16384) = o;
                s.x = dv[i].x * s.x + bflo(uv[i].x); s.y = dv[i].y * s.y + bfhi(uv[i].x); s.z = dv[i].z * s.z + bflo(uv[i].y); s.w = dv[i].w * s.w + bfhi(uv[i].y); }
        }
    }
}
DI void la_out_phase(const bf16* Y0, const float* lbraw, const bf16* ST, const float* gh, const float* gr, bf16* MIX, LAS unsigned char* lds) {
    LAS bf16* QT = (LAS bf16*)lds; LAS bf16* K2 = QT + 64 * QT_LD; LAS bf16* QS = K2 + 64 * QT_LD; LAS bf16* VT = QS + 64 * QT_LD;
    LAS float* tot = (LAS float*)(VT + 128 * KT_LD); LAS float* ssq = tot + 512; LAS float* gnl = ssq + 128;
    LAS bf16* SB = (LAS bf16*)(gnl + 256);
    LAS bf16* GB = SB + 128 * QT_LD;
    LAS bf16* RQ = QT; LAS bf16* RF = K2; LAS bf16* RV = QS;
    const int tid = threadIdx.x, lane = tid & 63, w = tid >> 6, l15 = lane & 15, q = lane >> 4, d = tid & 127, rg = tid >> 7;
    const int it = w & 3, vh = w >> 2;
    const int irow = 16 * it + l15;
    if (tid < 256) gnl[tid] = tid < 128 ? gh[tid] : gr[tid - 128];
    u32x4 rr[6], s2[4], g2r[2]; float lba, lbb;
#define A3_FETCH(un) { const bf16* yb_ = Y0 + ((size_t)(un) << 15); const bf16* sp_ = ST + ((size_t)(un) << 14); const int li_ = ((((un) >> 7) & 3) << 7) + d; \
        _Pragma("unroll") for (int c_ = 0; c_ < 2; ++c_) { rr[c_] = *(const u32x4*)(yb_ + (size_t)(tid + 512 * c_) * 8); rr[2 + c_] = *(const u32x4*)(yb_ + 8192 + (size_t)(tid + 512 * c_) * 8); \
            rr[4 + c_] = *(const u32x4*)(yb_ + 16384 + (size_t)(tid + 512 * c_) * 8); g2r[c_] = *(const u32x4*)(yb_ + 24576 + (size_t)(tid + 512 * c_) * 8); } \
        _Pragma("unroll") for (int c_ = 0; c_ < 4; ++c_) s2[c_] = *(const u32x4*)(sp_ + (size_t)(tid + 512 * c_) * 8); \
        lba = lbraw[li_]; lbb = lbraw[512 + li_]; asm volatile("" ::: "memory"); }
#define A3_STORE() { _Pragma("unroll") for (int c_ = 0; c_ < 2; ++c_) { const int ch_ = tid + 512 * c_; *LA_CH_LDS(RQ, ch_) = rr[c_]; *LA_CH_LDS(RF, ch_) = rr[2 + c_]; *LA_CH_LDS(RV, ch_) = rr[4 + c_]; *LA_CH_LDS(GB, ch_) = g2r[c_]; } \
        _Pragma("unroll") for (int c_ = 0; c_ < 4; ++c_) *LA_CH_LDS(SB, tid + 512 * c_) = s2[c_]; }
    A3_FETCH(blockIdx.x)
    A3_STORE()
    LaRaw R; R.lba = lba; R.lbb = lbb;
    LA_BAR();
    for (int unit = blockIdx.x; unit < LA_UNITS; unit += gridDim.x) {
        const int b = unit >> 10, hh = (unit >> 7) & 7, n = unit & 127;
        const int row0 = b * T + n * 64;
        { const int nx = unit + (int)gridDim.x, un = nx < LA_UNITS ? nx : unit; A3_FETCH(un) }
        la_read_col(RQ, d, rg, R.qv); la_read_col(RF, d, rg, R.f); la_read_col(RV, d, rg, R.v);
        LA_BAR();
        float fd[16], kk[16], qq[16];
        la_math<true>(R, hh, fd, kk, qq);
        float run = 1.f;
#pragma unroll
        for (int e = 0; e < 16; ++e) { run *= fd[e]; fd[e] = run; }
        tot[rg * 128 + d] = run;
        la_store_vt(R, d, rg, VT);
        LA_BAR();
        float pre = 1.f;
#pragma unroll
        for (int g2 = 0; g2 < 4; ++g2) { const float tv = tot[g2 * 128 + d]; if (g2 < rg) pre *= tv; }
        const float ref = tot[d] * tot[128 + d], iref = __builtin_amdgcn_rcpf(ref);
#pragma unroll
        for (int e = 0; e < 16; ++e) { const float P = pre * fd[e], qP = qq[e] * P; const int j = 16 * rg + e;
            QT[j * QT_LD + d] = f2bf(qP * iref); K2[j * QT_LD + d] = f2bf(kk[e] * ref * __builtin_amdgcn_rcpf(P)); QS[j * QT_LD + d] = f2bf(qP); }
        LA_BAR();
        f32x4 at[4];
#pragma unroll
        for (int jt = 0; jt < 4; ++jt) at[jt] = (f32x4){0.f, 0.f, 0.f, 0.f};
#pragma unroll
        for (int ks = 0; ks < 4; ++ks) { const bf16x8 bq = *(const LAS bf16x8*)(QT + (16 * it + l15) * QT_LD + 32 * ks + 8 * q);
#pragma unroll
            for (int jt = 0; jt < 4; ++jt) { const bf16x8 ak = *(const LAS bf16x8*)(K2 + (16 * jt + l15) * QT_LD + 32 * ks + 8 * q); at[jt] = MFMA16(ak, bq, at[jt]); } }
#pragma unroll
        for (int jt = 0; jt < 4; ++jt)
#pragma unroll
            for (int r = 0; r < 4; ++r) { const int j = 16 * jt + 4 * q + r; if (j > irow) at[jt][r] = 0.f; }
        f32x4 o[4];
#pragma unroll
        for (int vt = 0; vt < 4; ++vt) o[vt] = (f32x4){0.f, 0.f, 0.f, 0.f};
#pragma unroll
        for (int k2 = 0; k2 < 2; ++k2) {
            u32x4 pw; pw.x = pk2(at[2 * k2][0], at[2 * k2][1]); pw.y = pk2(at[2 * k2][2], at[2 * k2][3]); pw.z = pk2(at[2 * k2 + 1][0], at[2 * k2 + 1][1]); pw.w = pk2(at[2 * k2 + 1][2], at[2 * k2 + 1][3]);
            const bf16x8 pf = __builtin_bit_cast(bf16x8, pw);
#pragma unroll
            for (int vt = 0; vt < 4; ++vt) { const LAS bf16* vp = VT + (64 * vh + 16 * vt + l15) * KT_LD + 32 * k2 + 4 * q;
                const u32x2 lo = *(const LAS u32x2*)vp, hi = *(const LAS u32x2*)(vp + 16);
                const bf16x8 av = __builtin_bit_cast(bf16x8, ((u32x4){lo.x, lo.y, hi.x, hi.y})); o[vt] = MFMA16(av, pf, o[vt]); }
        }
#pragma unroll
        for (int ks = 0; ks < 4; ++ks) { const bf16x8 bq = *(const LAS bf16x8*)(QS + (16 * it + l15) * QT_LD + 32 * ks + 8 * q);
#pragma unroll
            for (int vt = 0; vt < 4; ++vt) { const bf16x8 as = *(const LAS bf16x8*)(SB + (64 * vh + 16 * vt + l15) * QT_LD + 32 * ks + 8 * q); o[vt] = MFMA16(as, bq, o[vt]); } }
        float ss = 0.f;
#pragma unroll
        for (int vt = 0; vt < 4; ++vt) ss += (o[vt][0] * o[vt][0] + o[vt][1] * o[vt][1]) + (o[vt][2] * o[vt][2] + o[vt][3] * o[vt][3]);
        ss += __shfl_xor(ss, 16); ss += __shfl_xor(ss, 32);
        if (q == 0) ssq[vh * 64 + irow] = ss;
        LA_BAR();
        const float rs = rsqrtf((ssq[irow] + ssq[64 + irow]) * (1.f / 128.f) + RMS_EPS);
        const LAS float* gn = gnl + (hh < 4 ? 0 : 128);
        bf16* op = MIX + (size_t)(row0 + irow) * D + hh * 128;
#pragma unroll
        for (int vt = 0; vt < 4; ++vt) { const int v0 = 64 * vh + 16 * vt + 4 * q; const f32x4 gv = *(const LAS f32x4*)(gn + v0); const u32x2 gw = *(const LAS u32x2*)(GB + irow * QT_LD + v0);
            u32x2 ow; ow.x = pk2(o[vt][0] * rs * gv.x * siluf_(bflo(gw.x)), o[vt][1] * rs * gv.y * siluf_(bfhi(gw.x)));
            ow.y = pk2(o[vt][2] * rs * gv.z * siluf_(bflo(gw.y)), o[vt][3] * rs * gv.w * siluf_(bfhi(gw.y))); *(u32x2*)(op + v0) = ow; }
        LA_BAR();
        A3_STORE()
        R.lba = lba; R.lbb = lbb;
        LA_BAR();
    }
#undef A3_FETCH
#undef A3_STORE
}
constexpr int NC = 511, NCP = 512;
DI void nsa_compress_phase(const bf16* Y1, const float* posk, const float* posv, const bf16* w1kT, const bf16* w1vT, const bf16* w2kT, const bf16* w2vT,
                           bf16* KCMP, bf16* VCMPT, LAS unsigned char* lds, int gw, int ngw, int lane) {
    const int l15 = lane & 15, q = lane >> 4, wv = (threadIdx.x >> 6), grp = wv >> 2, nt = wv & 3;
    LAS bf16* h1s = (LAS bf16*)lds + grp * 16 * 72;
    for (int base = 0; base < 512; base += ngw / 4) {
        int task = base + (gw >> 2); const bool tvalid = task < 512; if (!tvalid) task = 511;
        const int kv = task & 1, rt = task >> 1;
        int r = rt * 16 + l15; const bool rvalid = tvalid && (r < NB * NC * 2); if (r >= NB * NC * 2) r = NB * NC * 2 - 1;
        const int b = r / (NC * 2), rem = r % (NC * 2), i = rem >> 1, g = rem & 1;
        const bf16* src = Y1 + (size_t)(b * T + 16 * i) * OINP + (kv ? 1152 : 1024) + g * 64;
        const float* pos = kv ? posv : posk; const bf16* w1 = (kv ? w1vT : w1kT) + (size_t)(16 * nt + l15) * 2048; const bf16* w2 = kv ? w2vT : w2kT;
        f32x4 acc = {0.f, 0.f, 0.f, 0.f};
#pragma unroll 8
        for (int ks = 0; ks < 64; ++ks) {
            const int p = ks >> 1, d0 = (ks & 1) * 32 + 8 * q;
            const u32x4 xv = *(const u32x4*)(src + (size_t)p * OINP + d0);
            const f32x4 p0 = *(const f32x4*)(pos + p * 64 + d0), p1 = *(const f32x4*)(pos + p * 64 + d0 + 4);
            u32x4 bw; bw.x = pk2(bflo(xv.x) + p0.x, bfhi(xv.x) + p0.y); bw.y = pk2(bflo(xv.y) + p0.z, bfhi(xv.y) + p0.w);
            bw.z = pk2(bflo(xv.z) + p1.x, bfhi(xv.z) + p1.y); bw.w = pk2(bflo(xv.w) + p1.z, bfhi(xv.w) + p1.w);
            const bf16x8 af = *(const bf16x8*)(w1 + 32 * ks + 8 * q);
            acc = MFMA16(af, __builtin_bit_cast(bf16x8, bw), acc);
        }
        { u32x2 hw; hw.x = pk2(siluf_(acc[0]), siluf_(acc[1])); hw.y = pk2(siluf_(acc[2]), siluf_(acc[3])); *(LAS u32x2*)(h1s + l15 * 72 + 16 * nt + 4 * q) = hw; }
        __syncthreads();
        f32x4 o2 = {0.f, 0.f, 0.f, 0.f};
#pragma unroll
        for (int k2 = 0; k2 < 2; ++k2) { const bf16x8 bf = *(const LAS bf16x8*)(h1s + l15 * 72 + 32 * k2 + 8 * q);
            const bf16x8 av = *(const bf16x8*)(w2 + (16 * nt + l15) * 64 + 32 * k2 + 8 * q); o2 = MFMA16(av, bf, o2); }
        if (rvalid) {
            if (kv == 0) { u32x2 ow; ow.x = pk2(o2[0], o2[1]); ow.y = pk2(o2[2], o2[3]); *(u32x2*)(KCMP + ((size_t)(b * 2 + g) * NCP + i) * 64 + 16 * nt + 4 * q) = ow; }
            else { bf16* op = VCMPT + (size_t)(b * 2 + g) * 64 * NCP + i;
#pragma unroll
                for (int r2 = 0; r2 < 4; ++r2) op[(size_t)(16 * nt + 4 * q + r2) * NCP] = f2bf(o2[r2]); }
        }
        __syncthreads();
    }
    for (int z = gw * 64 + lane; z < NB * 2 * 64; z += ngw * 64) { const int bg = z >> 6, dd = z & 63; KCMP[((size_t)bg * NCP + NC) * 64 + dd] = 0; VCMPT[((size_t)bg * 64 + dd) * NCP + NC] = 0; }
}
DI void nsa_vt_phase(const bf16* Y1, bf16* VST, bf16* VWT, int gw, int ngw, int lane) {
    for (int task = gw; task < 2 * NB * 2 * 128; task += ngw) {
        const int which = task & 1, g = (task >> 1) & 1, b = (task >> 2) & 3, blk = task >> 4;
        const int t = blk * 64 + lane;
        const bf16* src = Y1 + (size_t)(b * T + t) * OINP + (which ? 1664 : 1408) + g * 64;
        bf16* dst = (which ? VWT : VST) + (size_t)(b * 2 + g) * 64 * T + t;
        u32x4 v[8];
#pragma unroll
        for (int c = 0; c < 8; ++c) v[c] = *(const u32x4*)(src + 8 * c);
#pragma unroll
        for (int c = 0; c < 8; ++c) {
            dst[(size_t)(8 * c + 0) * T] = (bf16)(v[c].x & 0xffff); dst[(size_t)(8 * c + 1) * T] = (bf16)(v[c].x >> 16);
            dst[(size_t)(8 * c + 2) * T] = (bf16)(v[c].y & 0xffff); dst[(size_t)(8 * c + 3) * T] = (bf16)(v[c].y >> 16);
            dst[(size_t)(8 * c + 4) * T] = (bf16)(v[c].z & 0xffff); dst[(size_t)(8 * c + 5) * T] = (bf16)(v[c].z >> 16);
            dst[(size_t)(8 * c + 6) * T] = (bf16)(v[c].w & 0xffff); dst[(size_t)(8 * c + 7) * T] = (bf16)(v[c].w >> 16);
        }
    }
}
#define LDS_BAR() do { asm volatile("s_waitcnt lgkmcnt(0)" ::: "memory"); __builtin_amdgcn_s_barrier(); asm volatile("" ::: "memory"); } while (0)
constexpr int TL = 80;
constexpr int SLAB_LD = 132;
constexpr float C1 = 0.125f * LOG2E;
DI void tile_fetch(const bf16* kg, int ldk, const bf16* vg, int ldv, int tid, u32x4& kr, u32x4& vr) {
    const int r = tid >> 3, c = (tid & 7) * 8;
    kr = *(const u32x4*)(kg + (size_t)r * ldk + c); vr = *(const u32x4*)(vg + (size_t)r * ldv + c);
    asm volatile("" ::: "memory");
}
DI void tile_store(LAS bf16* Kb, LAS bf16* Vb, int tid, u32x4 kr, u32x4 vr) {
    const int r = tid >> 3, c = (tid & 7) * 8;
    *(LAS u32x4*)(Kb + r * TL + c) = kr;
    const int g32 = c & 32, k0 = c & 31, k1 = k0 + 4;
    const int p0 = 8 * ((k0 & 15) >> 2) + 4 * (k0 >> 4), p1 = 8 * ((k1 & 15) >> 2) + 4 * (k1 >> 4);
    *(LAS u32x2*)(Vb + r * TL + g32 + p0) = (u32x2){vr.x, vr.y}; *(LAS u32x2*)(Vb + r * TL + g32 + p1) = (u32x2){vr.z, vr.w};
}
DI void tile_scores(const LAS bf16* Kb, const bf16x8 (&qf)[2], int l15, int q, f32x4 (&sc)[4]) {
#pragma unroll
    for (int x = 0; x < 4; ++x) { sc[x] = (f32x4){0.f, 0.f, 0.f, 0.f};
#pragma unroll
        for (int ks = 0; ks < 2; ++ks) { const bf16x8 a = *(const LAS bf16x8*)(Kb + (16 * x + l15) * TL + 32 * ks + 8 * q); sc[x] = MFMA16(a, qf[ks], sc[x]); } }
}
DI void tile_pv(const LAS bf16* Vb, const float (&p)[16], f32x4 (&acc)[4], int l15, int q) {
#pragma unroll
    for (int k2 = 0; k2 < 2; ++k2) {
        u32x4 pw; pw.x = pk2(p[8 * k2], p[8 * k2 + 1]); pw.y = pk2(p[8 * k2 + 2], p[8 * k2 + 3]); pw.z = pk2(p[8 * k2 + 4], p[8 * k2 + 5]); pw.w = pk2(p[8 * k2 + 6], p[8 * k2 + 7]);
        const bf16x8 pf = __builtin_bit_cast(bf16x8, pw);
#pragma unroll
        for (int dt = 0; dt < 4; ++dt) { const bf16x8 av = *(const LAS bf16x8*)(Vb + (16 * dt + l15) * TL + 32 * k2 + 8 * q); acc[dt] = MFMA16(av, pf, acc[dt]); }
    }
}
template <bool MASKED, int KS>
DI float tile_probs(const f32x4 (&sc)[4], float (&p)[16], int d0, float slope2, unsigned lim, bool extra) {
    const float A = (MASKED || extra) ? -slope2 * (float)d0 : -INFINITY;
    const float r1 = slope2 * (float)KS, r2 = slope2 * (float)(2 * KS), r3 = slope2 * (float)(3 * KS);
    float psa = 0.f, psb = 0.f;
#pragma unroll
    for (int x = 0; x < 4; ++x) { const float bx = slope2 * (float)(16 * KS * x) + A;
        float v0 = sc[x][0] * C1 + bx, v1 = sc[x][1] * C1 + (bx + r1), v2 = sc[x][2] * C1 + (bx + r2), v3 = sc[x][3] * C1 + (bx + r3);
        asm("" : "+v"(v0)); asm("" : "+v"(v1)); asm("" : "+v"(v2)); asm("" : "+v"(v3));
        if (MASKED) { const int kb = 16 * KS * x;
            v0 = (extra && ((unsigned)(d0 - kb) < lim)) ? v0 : -INFINITY; v1 = (extra && ((unsigned)(d0 - kb - KS) < lim)) ? v1 : -INFINITY;
            v2 = (extra && ((unsigned)(d0 - kb - 2 * KS) < lim)) ? v2 : -INFINITY; v3 = (extra && ((unsigned)(d0 - kb - 3 * KS) < lim)) ? v3 : -INFINITY; }
        float p0 = ex2(v0), p1 = ex2(v1), p2 = ex2(v2), p3 = ex2(v3);
        asm("" : "+v"(p0)); asm("" : "+v"(p1)); asm("" : "+v"(p2)); asm("" : "+v"(p3));
        psa += p0; psb += p1; psa += p2; psb += p3;
        p[4 * x] = p0; p[4 * x + 1] = p1; p[4 * x + 2] = p2; p[4 * x + 3] = p3; }
    return psa + psb;
}
template <bool MASKED>
DI void tile_step(const LAS bf16* Kb, const LAS bf16* Vb, const bf16x8 (&qf)[2], f32x4 (&acc)[4], float& lp, int d0, float slope2, unsigned lim, bool extra, int l15, int q) {
    f32x4 sc[4]; tile_scores(Kb, qf, l15, q, sc);
    float p[16]; lp += tile_probs<MASKED, 1>(sc, p, d0, slope2, lim, extra);
    tile_pv(Vb, p, acc, l15, q);
}
DI void nsa_attn_phase(const bf16* Y1, const bf16* KCMP, const bf16* VCMPT, const bf16* VST, const bf16* VWT, bf16* MIX, LAS unsigned char* lds) {
    LAS bf16* KB0 = (LAS bf16*)lds;
    LAS bf16* VB0 = KB0 + 4 * 64 * TL;
    LAS float* slab = (LAS float*)(lds + 8 * 64 * TL * 2);
    LAS unsigned* selm = (LAS unsigned*)(slab + 8 * 16 * SLAB_LD);
    LAS unsigned* blist = selm + 64;
    LAS float* invl = (LAS float*)(blist + 132);
    const int tid = threadIdx.x, lane = tid & 63, w = tid >> 6, l15 = lane & 15, q = lane >> 4;
    LAS float* myslab = slab + w * 16 * SLAB_LD;
#define KSLOT(i) (KB0 + ((i) & 3) * 64 * TL)
#define VSLOT(i) (VB0 + ((i) & 3) * 64 * TL)
#define PAIR_PIPE(n, FETCH, COMP1, COMP2) { \
        FETCH(0, kr0, vr0) FETCH(1, kr1, vr1) tile_store(KSLOT(0), VSLOT(0), tid, kr0, vr0); tile_store(KSLOT(1), VSLOT(1), tid, kr1, vr1); \
        FETCH(2, kr0, vr0) FETCH(3, kr1, vr1) \
        LDS_BAR(); \
        int i_ = 0; \
        for (; i_ + 1 < (n); i_ += 2) { \
            COMP2(i_, i_ + 1) \
            tile_store(KSLOT(i_ + 2), VSLOT(i_ + 2), tid, kr0, vr0); tile_store(KSLOT(i_ + 3), VSLOT(i_ + 3), tid, kr1, vr1); \
            FETCH(i_ + 4, kr0, vr0) FETCH(i_ + 5, kr1, vr1) \
            LDS_BAR(); } \
        if (i_ < (n)) { COMP1(i_) LDS_BAR(); } }
    for (int u = blockIdx.x; u < NB * 2 * (T / 16); u += gridDim.x) {
        const int b = u & 3, g = (u >> 2) & 1;
        int tile = u >> 3;
        if ((int)gridDim.x == 256) { const int wq = (int)blockIdx.x >> 3, k = u >> 8; tile = k < 8 ? 8 * wq + k : 512 - 8 * (wq + 1) + (k - 8); }
        const int t0 = tile * 16, qblk = t0 >> 6;
        const int h = g * 8 + w; const float slope = exp2f(-0.5f * (float)(h + 1)), slope2 = slope * LOG2E;
        const int t = t0 + l15; const size_t row = (size_t)b * T + t;
        bf16x8 qf[2];
        qf[0] = *(const bf16x8*)(Y1 + row * OINP + h * 64 + 8 * q); qf[1] = *(const bf16x8*)(Y1 + row * OINP + h * 64 + 32 + 8 * q);
        const bf16* gl = Y1 + row * OINP + 1792 + h * 3;
        const float g0 = sigmoidf_(bf2f(gl[0])), g1 = sigmoidf_(bf2f(gl[1])), g2 = sigmoidf_(bf2f(gl[2]));
        f32x4 ot[4];
        u32x4 kr0, vr0, kr1, vr1;
        {
            const bf16* kc = KCMP + (size_t)(b * 2 + g) * NCP * 64; const bf16* vct = VCMPT + (size_t)(b * 2 + g) * 64 * NCP;
            const int nst = tile >= 1 ? ((tile - 1) >> 6) + 1 : 0;
            const int dc = t - 31 - 64 * q;
            float lp = 0.f, carry = 0.f;
            f32x4 acc[4];
#pragma unroll
            for (int dt = 0; dt < 4; ++dt) acc[dt] = (f32x4){0.f, 0.f, 0.f, 0.f};
            float inv = 0.f;
#define CMP_FETCH(idx, KR, VR) { const int i2_ = (idx) < nst ? (idx) : nst - 1; tile_fetch(kc + (size_t)(64 * i2_) * 64, 64, vct + 64 * i2_, NCP, tid, KR, VR); }
#define CMP_COMP1(s) { \
                f32x4 sc[4]; tile_scores(KSLOT(s), qf, l15, q, sc); \
                float sv[16]; \
                const int d0 = dc - 1024 * (s); \
                if (64 * (s) + 63 <= tile - 2) lp += tile_probs<false, 16>(sc, sv, d0, slope2, 0x7fffffffu, true); \
                else lp += tile_probs<true, 16>(sc, sv, d0, slope2, 0x7fffffffu, true); \
                _Pragma("unroll") for (int x = 0; x < 4; ++x) { const float hf_ = 0.5f * sv[4 * x + 3]; \
                    const float up_ = __shfl(hf_, (lane + 48) & 63);     \
                    myslab[l15 * SLAB_LD + 16 * (s) + 4 * x + q] = ((sv[4 * x] + sv[4 * x + 1]) + (sv[4 * x + 2] + hf_)) + (q > 0 ? up_ : carry); \
                    carry = up_; } \
                tile_pv(VSLOT(s), sv, acc, l15, q); }
#define CMP_COMP2(s, s2) { CMP_COMP1(s) CMP_COMP1(s2) }
            if (nst > 0) PAIR_PIPE(nst, CMP_FETCH, CMP_COMP1, CMP_COMP2)
#undef CMP_FETCH
#undef CMP_COMP1
#undef CMP_COMP2
            { float l = lp; l += __shfl_xor(l, 16); l += __shfl_xor(l, 32); inv = l > 0.f ? 1.0f / l : 0.f;
              if (q == 0) { invl[w * 16 + l15] = inv; myslab[l15 * SLAB_LD + 16 * nst] = carry; } }
            const float gi = g0 * inv;
#pragma unroll
            for (int dt = 0; dt < 4; ++dt) { ot[dt][0] = gi * acc[dt][0]; ot[dt][1] = gi * acc[dt][1]; ot[dt][2] = gi * acc[dt][2]; ot[dt][3] = gi * acc[dt][3]; }
        }
        LDS_BAR();
        unsigned u0 = 0, u1 = 0, u2 = 0, u3 = 0, am0 = 0, am1 = 0, am2 = 0, am3 = 0;
        {
            const int tokA = 2 * w, tokB = 2 * w + 1;
            float sA0 = 0.f, sA1 = 0.f, sB0 = 0.f, sB1 = 0.f;
#pragma unroll
            for (int ww = 0; ww < 8; ++ww) { const float ilA = invl[ww * 16 + tokA], ilB = invl[ww * 16 + tokB];
                sA0 += slab[(ww * 16 + tokA) * SLAB_LD + lane] * ilA; sA1 += slab[(ww * 16 + tokA) * SLAB_LD + lane + 64] * ilA;
                sB0 += slab[(ww * 16 + tokB) * SLAB_LD + lane] * ilB; sB1 += slab[(ww * 16 + tokB) * SLAB_LD + lane + 64] * ilB; }
            const int j0 = lane, j1 = lane + 64;
            const bool v0 = j0 <= qblk, v1 = j1 <= qblk;
            const bool f0 = (j0 == 0) || (j0 == qblk) || (j0 == qblk - 1), f1 = (j1 == qblk) || (j1 == qblk - 1);
            const unsigned kA0 = f0 ? 0x7f000000u : __float_as_uint(sA0), kA1 = f1 ? 0x7f000000u : __float_as_uint(sA1);
            const unsigned kB0 = f0 ? 0x7f000000u : __float_as_uint(sB0), kB1 = f1 ? 0x7f000000u : __float_as_uint(sB1);
            unsigned TA = 0u, TB = 0u;
#pragma unroll 1
            for (int bit = 30; bit >= 0; --bit) { const unsigned trA = TA | (1u << bit), trB = TB | (1u << bit);
                const int cA = __popcll(__ballot(v0 && kA0 >= trA)) + __popcll(__ballot(v1 && kA1 >= trA));
                const int cB = __popcll(__ballot(v0 && kB0 >= trB)) + __popcll(__ballot(v1 && kB1 >= trB));
                if (cA >= 16) TA = trA; if (cB >= 16) TB = trB; }
            const unsigned long long lt = (1ull << lane) - 1ull;
#define SEL_FINISH(tok, k0, k1, Tk) { \
                const bool gt0 = v0 && k0 > Tk, gt1 = v1 && k1 > Tk, eq0 = v0 && k0 == Tk, eq1 = v1 && k1 == Tk; \
                const unsigned long long mq0 = __ballot(eq0), mq1 = __ballot(eq1); \
                const int need = 16 - (__popcll(__ballot(gt0)) + __popcll(__ballot(gt1))); \
                const int r0 = __popcll(mq0 & lt), r1 = __popcll(mq0) + __popcll(mq1 & lt);        \
                const unsigned long long m0 = __ballot(gt0 || (eq0 && r0 < need)), m1 = __ballot(gt1 || (eq1 && r1 < need)); \
                if (lane == 0) { selm[(tok) * 4 + 0] = (unsigned)m0; selm[(tok) * 4 + 1] = (unsigned)(m0 >> 32); selm[(tok) * 4 + 2] = (unsigned)m1; selm[(tok) * 4 + 3] = (unsigned)(m1 >> 32); } }
            SEL_FINISH(tokA, kA0, kA1, TA)
            SEL_FINISH(tokB, kB0, kB1, TB)
#undef SEL_FINISH
        }
        LDS_BAR();
        {
            unsigned om = selm[lane], am = om;
            om |= __shfl_xor(om, 4); om |= __shfl_xor(om, 8); om |= __shfl_xor(om, 16); om |= __shfl_xor(om, 32);
            am &= __shfl_xor(am, 4); am &= __shfl_xor(am, 8); am &= __shfl_xor(am, 16); am &= __shfl_xor(am, 32);
            u0 = __builtin_amdgcn_readlane(om, 0); u1 = __builtin_amdgcn_readlane(om, 1); u2 = __builtin_amdgcn_readlane(om, 2); u3 = __builtin_amdgcn_readlane(om, 3);
            am0 = __builtin_amdgcn_readlane(am, 0); am1 = __builtin_amdgcn_readlane(am, 1); am2 = __builtin_amdgcn_readlane(am, 2); am3 = __builtin_amdgcn_readlane(am, 3);
            if (tid < 128) { const int wd = tid >> 5, bt = tid & 31;
                const unsigned uw = wd == 0 ? u0 : wd == 1 ? u1 : wd == 2 ? u2 : u3;
                if ((uw >> bt) & 1u) { const int pos = (wd > 0 ? __popc(u0) : 0) + (wd > 1 ? __popc(u1) : 0) + (wd > 2 ? __popc(u2) : 0) + __popc(uw & ((1u << bt) - 1u)); blist[pos] = (unsigned)tid; } }
        }
        const int nsel = __popc(u0) + __popc(u1) + __popc(u2) + __popc(u3);
        LDS_BAR();
        {
            const bf16* kb = Y1 + (size_t)b * T * OINP + 1280 + g * 64; const bf16* vt = VST + (size_t)(b * 2 + g) * 64 * T;
            float lp = 0.f; f32x4 acc[4];
#pragma unroll
            for (int dt = 0; dt < 4; ++dt) acc[dt] = (f32x4){0.f, 0.f, 0.f, 0.f};
#define SEL_FETCH(idx, KR, VR) { const int i2_ = (idx) < nsel ? (idx) : nsel - 1; const int j2_ = (int)__builtin_amdgcn_readfirstlane((int)blist[i2_]); tile_fetch(kb + (size_t)(64 * j2_) * OINP, OINP, vt + 64 * j2_, T, tid, KR, VR); }
#define SEL_PREP(i, j, selb, d0) \
                const int j = (int)__builtin_amdgcn_readfirstlane((int)blist[i]); \
                const int wd##j = j >> 5; const unsigned aw##j = wd##j == 0 ? am0 : wd##j == 1 ? am1 : wd##j == 2 ? am2 : am3; \
                const bool selb = (((aw##j >> (j & 31)) & 1u) != 0u) || (((selm[l15 * 4 + wd##j] >> (j & 31)) & 1u) != 0u); \
                const int d0 = t - 64 * j - 4 * q;
#define SEL_COMP1(i) { SEL_PREP(i, ja, sa_, da_) \
                if (ja < qblk) tile_step<false>(KSLOT(i), VSLOT(i), qf, acc, lp, da_, slope2, 0x7fffffffu, sa_, l15, q);        \
                else tile_step<true>(KSLOT(i), VSLOT(i), qf, acc, lp, da_, slope2, 0x7fffffffu, sa_, l15, q); }
#define SEL_COMP2(i, i2) { SEL_PREP(i, ja, sa_, da_) SEL_PREP(i2, jb, sb_, db_) \
                if (ja < qblk && jb < qblk) { tile_step<false>(KSLOT(i), VSLOT(i), qf, acc, lp, da_, slope2, 0x7fffffffu, sa_, l15, q); tile_step<false>(KSLOT(i2), VSLOT(i2), qf, acc, lp, db_, slope2, 0x7fffffffu, sb_, l15, q); } \
                else { tile_step<true>(KSLOT(i), VSLOT(i), qf, acc, lp, da_, slope2, 0x7fffffffu, sa_, l15, q); tile_step<true>(KSLOT(i2), VSLOT(i2), qf, acc, lp, db_, slope2, 0x7fffffffu, sb_, l15, q); } }
            PAIR_PIPE(nsel, SEL_FETCH, SEL_COMP1, SEL_COMP2)
#undef SEL_FETCH
#undef SEL_PREP
#undef SEL_COMP1
#undef SEL_COMP2
            float l = lp; l += __shfl_xor(l, 16); l += __shfl_xor(l, 32);
            const float sc = l > 0.f ? g1 / l : 0.f;
#pragma unroll
            for (int dt = 0; dt < 4; ++dt) { ot[dt][0] += sc * acc[dt][0]; ot[dt][1] += sc * acc[dt][1]; ot[dt][2] += sc * acc[dt][2]; ot[dt][3] += sc * acc[dt][3]; }
        }
        {
            const bf16* kb = Y1 + (size_t)b * T * OINP + 1536 + g * 64; const bf16* vt = VWT + (size_t)(b * 2 + g) * 64 * T;
            float lp = 0.f; f32x4 acc[4];
#pragma unroll
            for (int dt = 0; dt < 4; ++dt) acc[dt] = (f32x4){0.f, 0.f, 0.f, 0.f};
            int kstart = t0 - 511; kstart = kstart < 0 ? 0 : (kstart & ~63);
            const int nw = ((t0 + 15 - kstart) >> 6) + 1;
#define WIN_FETCH(idx, KR, VR) { const int i2_ = (idx) < nw ? (idx) : nw - 1; const int k2_ = kstart + 64 * i2_; tile_fetch(kb + (size_t)k2_ * OINP, OINP, vt + k2_, T, tid, KR, VR); }
#define WIN_INT(i) ((kstart + 64 * (i)) + 63 <= t0 && (kstart + 64 * (i)) >= t0 - 496)
#define WIN_COMP1(i) { const int d0_ = t - (kstart + 64 * (i)) - 4 * q; \
                if (WIN_INT(i)) tile_step<false>(KSLOT(i), VSLOT(i), qf, acc, lp, d0_, slope2, 512u, true, l15, q); \
                else tile_step<true>(KSLOT(i), VSLOT(i), qf, acc, lp, d0_, slope2, 512u, true, l15, q); }
#define WIN_COMP2(i, i2) { const int da_ = t - (kstart + 64 * (i)) - 4 * q, db_ = da_ - 64; \
                if (WIN_INT(i) && WIN_INT(i2)) { tile_step<false>(KSLOT(i), VSLOT(i), qf, acc, lp, da_, slope2, 512u, true, l15, q); tile_step<false>(KSLOT(i2), VSLOT(i2), qf, acc, lp, db_, slope2, 512u, true, l15, q); } \
                else { tile_step<true>(KSLOT(i), VSLOT(i), qf, acc, lp, da_, slope2, 512u, true, l15, q); tile_step<true>(KSLOT(i2), VSLOT(i2), qf, acc, lp, db_, slope2, 512u, true, l15, q); } }
            PAIR_PIPE(nw, WIN_FETCH, WIN_COMP1, WIN_COMP2)
#undef WIN_FETCH
#undef WIN_INT
#undef WIN_COMP1
#undef WIN_COMP2
            float l = lp; l += __shfl_xor(l, 16); l += __shfl_xor(l, 32);
            const float sc = l > 0.f ? g2 / l : 0.f;
#pragma unroll
            for (int dt = 0; dt < 4; ++dt) { ot[dt][0] += sc * acc[dt][0]; ot[dt][1] += sc * acc[dt][1]; ot[dt][2] += sc * acc[dt][2]; ot[dt][3] += sc * acc[dt][3]; }
        }
        bf16* op = MIX + row * D + h * 64 + 4 * q;
#pragma unroll
        for (int dt = 0; dt < 4; ++dt) { u32x2 ow; ow.x = pk2(ot[dt][0], ot[dt][1]); ow.y = pk2(ot[dt][2], ot[dt][3]); *(u32x2*)(op + 16 * dt) = ow; }
    }
#undef KSLOT
#undef VSLOT
#undef PAIR_PIPE
}
struct Args { const float* in[19]; float* out; unsigned char* ws; int ph_lo, ph_hi; };
constexpr int N_PHASES = 18;
template <class Epi>
DI void run_gemm(LAS unsigned char* lds, const bf16* A, const bf16* Bt, int N, int K, const Epi& E) {
    pg8::Gemm g{A, Bt, M, N, K}; pg8::StaticOrder S; S.init(M, N, (int)gridDim.x, (int)blockIdx.x);
    pg8::gemm_phase<Epi, pg8::StaticOrder, true, true>(lds, g, S, E);
}
__global__ void __launch_bounds__(512, 2) mega(Args a) {
    extern __shared__ __attribute__((aligned(16))) unsigned char lds_raw[];
    LAS unsigned char* lds = (LAS unsigned char*)lds_raw;
    cg::grid_group grid = cg::this_grid();
    volatile LAS unsigned* bst = (volatile LAS unsigned*)(lds + LDS_BYTES - 64);
    if (threadIdx.x < 2) bst[threadIdx.x] = 0u;
    __syncthreads();
    XcdBarrier xbar = xcd_barrier_post((unsigned*)(a.ws + WS_CTL), bst);
    const int tid = threadIdx.x, lane = tid & 63, wave = __builtin_amdgcn_readfirstlane(tid >> 6);
    const int gw = blockIdx.x * 8 + wave, ngw = gridDim.x * 8;
#define WSP(off) ((bf16*)(a.ws + (off)))
#define W_EIN WSP(WS_EIN)
#define W_EOUT WSP(WS_EOUT)
#define W_OIN WSP(WS_OIN)
#define W_OOUT WSP(WS_OOUT)
#define W_GU WSP(WS_GU)
#define W_DN WSP(WS_DN)
#define W1K WSP(WS_W1K)
#define W1V WSP(WS_W1V)
#define W2K WSP(WS_W2K)
#define W2V WSP(WS_W2V)
#define DEC ((float*)(a.ws + WS_DEC))
#define KCMP WSP(WS_KCMP)
#define VCMPT WSP(WS_VCMPT)
#define Y WSP(WS_Y)
#define VST WSP(WS_VST)
#define VWT WSP(WS_VWT)
#define HN WSP(WS_HN)
#define ST WSP(WS_ST)
#define RS ((float*)(a.ws + WS_RS))
#define HB WSP(WS_HB)
    const int lo = a.ph_lo, hi = a.ph_hi;
#define PH(k) if (lo <= (k) && (k) < hi)
#define SEAM(k) if (lo <= (k) && (k) + 1 < hi && hi > 0) { if (a.ph_lo < 0) grid.sync();   xcd_barrier(xbar); }
    PH(0) {
        LAS float* scr = (LAS float*)(lds + wave * 8448);
        constexpr int I0 = 2048, I1 = 512, I2 = 1024, I3 = 512, I4 = 2816, I5 = 1408, I6 = 64, I7 = 2;
        constexpr int NIT = I0 + I1 + I2 + I3 + 2 * I4 + 2 * I5 + 2 * I6 + 2 * I7;
        for (int it = gw; it < NIT; it += ngw) {
            int r = it;
            if (r < I0) { transpose_item(a.in[4], 1024, EIN, EIN, W_EIN, 0, scr, r, lane); continue; } r -= I0;
            if (r < I1) { transpose_item(a.in[8], 1024, 1024, 1024, W_EOUT, 0, scr, r, lane); continue; } r -= I1;
            if (r < I2) { transpose_item(a.in[9], 1024, OIN, OINP, W_OIN, 0, scr, r, lane, a.in[1] + D); continue; } r -= I2;
            if (r < I3) { transpose_item(a.in[16], 1024, 1024, 1024, W_OOUT, 0, scr, r, lane); continue; } r -= I3;
            if (r < 2 * I4) { const int l = r / I4; transpose_item(a.in[17] + (size_t)l * D * 2 * FF, 1024, 2 * FF, 2 * FF, W_GU + (size_t)l * GU_STRIDE, 1, scr, r % I4, lane, a.in[2] + l * D); continue; } r -= 2 * I4;
            if (r < 2 * I5) { const int l = r / I5; transpose_item(a.in[18] + (size_t)l * FF * D, FF, 1024, 1024, W_DN + (size_t)l * DN_STRIDE, 0, scr, r % I5, lane); continue; } r -= 2 * I5;
            if (r < I6) { transpose_item(a.in[12], 2048, 64, 64, W1K, 0, scr, r, lane); continue; } r -= I6;
            if (r < I6) { transpose_item(a.in[14], 2048, 64, 64, W1V, 0, scr, r, lane); continue; } r -= I6;
            if (r < I7) { transpose_item(a.in[13], 64, 64, 64, W2K, 0, scr, r, lane); continue; } r -= I7;
            transpose_item(a.in[15], 64, 64, 64, W2V, 0, scr, r, lane);
        }
        norm_rows_bf16(a.in[0], a.in[1], HN, gw, ngw, lane);
    }
    SEAM(0);
    PH(1) { EpiStoreLA E{Y}; run_gemm(lds, HN, W_EIN, EIN, 1024, E); }
    SEAM(1);
    PH(2) { la_state_phase(Y, a.in[5], ST, DEC, lds); }
    SEAM(2);
    PH(3) { la_scan_phase(ST, DEC); }
    SEAM(3);
    PH(4) { la_out_phase(Y, a.in[5], ST, a.in[6], a.in[7], HN, lds); }
    SEAM(4);
    PH(5) { EpiResid<false, false> E{a.in[0], nullptr, nullptr, HB, RS}; run_gemm(lds, HN, W_EOUT, 1024, 1024, E); }
    SEAM(5);
    PH(7) { EpiSwiglu E{Y, RS}; run_gemm(lds, HB, W_GU, 2 * FF, 1024, E); }
    SEAM(7);
    PH(8) { EpiResid<true, false> E{nullptr, HB, nullptr, HB, RS + 16 * M}; run_gemm(lds, Y, W_DN, 1024, FF, E); }
    SEAM(8);
    PH(10) { EpiStore E{Y, OINP, RS + 16 * M}; run_gemm(lds, HB, W_OIN, OINP, 1024, E); }
    SEAM(10);
    PH(11) { nsa_compress_phase(Y, a.in[10], a.in[11], W1K, W1V, W2K, W2V, KCMP, VCMPT, lds, gw, ngw, lane); nsa_vt_phase(Y, VST, VWT, gw, ngw, lane); }
    SEAM(11);
    PH(12) { nsa_attn_phase(Y, KCMP, VCMPT, VST, VWT, HN, lds); }
    SEAM(12);
    PH(13) { EpiResid<true, false> E{nullptr, HB, nullptr, HB, RS + 32 * M}; run_gemm(lds, HN, W_OOUT, 1024, 1024, E); }
    SEAM(13);
    PH(15) { EpiSwiglu E{Y, RS + 32 * M}; run_gemm(lds, HB, W_GU + GU_STRIDE, 2 * FF, 1024, E); }
    SEAM(15);
    PH(16) { EpiResid<true, false> E{nullptr, HB, nullptr, HB, RS}; run_gemm(lds, Y, W_DN + DN_STRIDE, 1024, FF, E); }
    SEAM(16);
    PH(17) { norm_final(HB, RS, a.in[3], a.out, gw, ngw, lane); }
#undef PH
#undef SEAM
}

extern "C" void kernel_launch(void* const* d_in, const int* in_sizes, int n_in, void* d_out, int out_size, void* d_ws, size_t ws_size, hipStream_t stream) {
    static int grid = 0;
    if (grid == 0) {
        if (n_in != 19 || in_sizes[0] != M * D || out_size != M * D || ws_size < WS_END) { fprintf(stderr, "kernel_launch: unexpected shapes (n_in %d, in0 %d, out %d, ws %zu)\n", n_in, n_in > 0 ? in_sizes[0] : -1, out_size, ws_size); grid = -1; return; }
        int dev = 0, cus = 0, per_cu = 0;
        (void)hipGetDevice(&dev); (void)hipDeviceGetAttribute(&cus, hipDeviceAttributeMultiprocessorCount, dev);
        if (hipFuncSetAttribute((const void*)mega, hipFuncAttributeMaxDynamicSharedMemorySize, LDS_BYTES) != hipSuccess) { fprintf(stderr, "kernel_launch: hipFuncSetAttribute failed\n"); grid = -1; return; }
        if (hipOccupancyMaxActiveBlocksPerMultiprocessor(&per_cu, (const void*)mega, 512, LDS_BYTES) != hipSuccess || per_cu < 1) { fprintf(stderr, "kernel_launch: occupancy query says %d\n", per_cu); per_cu = 1; }
        (void)hipGetLastError();
        grid = cus * 1;
    }
    if (grid < 0) return;
    if (hipMemsetAsync((char*)d_ws + WS_CTL, 0, CTL_BYTES, stream) != hipSuccess) { fprintf(stderr, "kernel_launch: memset failed\n"); return; }
    Args a{};
    for (int i = 0; i < 19; ++i) a.in[i] = (const float*)d_in[i];
    a.out = (float*)d_out; a.ws = (unsigned char*)d_ws; a.ph_lo = 0; a.ph_hi = N_PHASES;
    void* args[] = {&a};
    hipError_t e = hipLaunchCooperativeKernel((const void*)mega, dim3(grid), dim3(512), args, LDS_BYTES, stream);
    if (e != hipSuccess) fprintf(stderr, "kernel_launch: cooperative launch failed: %s (grid %d)\n", hipGetErrorString(e), grid);
#ifdef PROBE_PHASES
    { const int pp[] = {PROBE_PHASES};
      for (unsigned i = 0; i < sizeof(pp) / sizeof(pp[0]); ++i) { a.ph_lo = pp[i]; a.ph_hi = pp[i] + 1; (void)hipLaunchCooperativeKernel((const void*)mega, dim3(grid), dim3(512), args, LDS_BYTES, stream); } }
#endif
}
```

```cpp
#include <hip/hip_runtime.h>
#include <hip/hip_cooperative_groups.h>
#include <cstdio>
#include <cstdint>
namespace cg = cooperative_groups;
namespace pg8 {
#define PG8_LAS __attribute__((address_space(3)))
typedef unsigned short bf16_t;
typedef short bf16x8 __attribute__((ext_vector_type(8)));
typedef float f32x4 __attribute__((ext_vector_type(4)));
typedef unsigned u32x4 __attribute__((ext_vector_type(4)));
constexpr int BM = 256, BK = 64, HALF = 128, HTB = HALF * BK * 2  , STAGE_BYTES = 8 * HTB, NXCD = 8, WGM = 8;

__host__ __device__ __forceinline__ int lds_byte(int r, int c) { const int st = (r >> 4) * 2 + (c >> 5), rr = r & 15, cc = c & 31, ob = rr * 64 + cc * 2; return st * 1024 + (ob ^ (((ob >> 9) & 1) << 5)); }
__host__ __device__ __forceinline__ void stage_rc(int b, int& R, int& C) { const int st = b / 1024, sb = b % 1024, swz = sb ^ (((sb >> 9) & 1) << 5); R = (st >> 1) * 16 + swz / 64; C = (st & 1) * 32 + (swz % 64) / 2; }
__host__ __device__ __forceinline__ int perm32(int rho) { const int n = rho >> 4, i = rho & 15; return 8 * (i >> 2) + 4 * n + (i & 3); }

struct Unit { int pm, pn; };
struct Gemm { const bf16_t* A; const bf16_t* Bt; int M, N, K; };

struct StaticOrder {
    int nM, nN, nwg, G, c;
    __host__ __device__ void init(int M, int N, int G_, int c_) { nM = M / BM; nN = N / BM; nwg = nM * nN; G = G_; c = c_; }
    __host__ __device__ bool next(int i, Unit& u) const {
        const long L = (long)i * G + c; if (L >= nwg) return false;
        int wgid = (int)L; { const int q = nwg / NXCD, r = nwg % NXCD, xcd = wgid % NXCD, off = wgid / NXCD; wgid = (xcd < r ? xcd * (q + 1) : r * (q + 1) + (xcd - r) * q) + off; }
        const int nig = WGM * nN, gid = wgid / nig, fm = gid * WGM, gsz = (nM - fm) < WGM ? (nM - fm) : WGM;
        u.pm = fm + ((wgid % nig) % gsz); u.pn = (wgid % nig) / gsz; return true;
    }
    __device__ __forceinline__ void a_ready(const Unit&) const {}
    __device__ __forceinline__ void done(const Unit&) const {}
};

__device__ __forceinline__ unsigned cvt_pk_bf16(float lo, float hi) { unsigned r; asm volatile("v_cvt_pk_bf16_f32 %0, %1, %2" : "=v"(r) : "v"(lo), "v"(hi)); return r; }
template <class Epi, class Sched, bool ALIGN_EPI = false, bool SP2 = false>
__device__ __forceinline__ void gemm_phase(PG8_LAS unsigned char* lds, const Gemm g, const Sched& S, const Epi& E) {
    const int tid = threadIdx.x, wid = __builtin_amdgcn_readfirstlane(tid >> 6), lane = tid & 63, wr = wid >> 2, wc = wid & 3, fr = lane & 15, fq = lane >> 4;
    const int K = g.K, nt = K / BK;
    unsigned voffA[2], voffB[2];
#pragma unroll
    for (int i = 0; i < 2; ++i) { int R, C; stage_rc(tid * 16 + i * 8192, R, C); const int Rb = Epi::PERM ? ((R & ~31) + perm32(R & 31)) : R;
        voffA[i] = (unsigned)(R * K + C) * 2u; voffB[i] = (unsigned)(Rb * K + C) * 2u; }
    const size_t kstep = (size_t)(BK * 2);
    const size_t hstep = (size_t)HALF * K * 2;
    const size_t tstep = 2 * hstep;
    const unsigned ldsw = (unsigned)wid * 1024u;
    const int aoff = lds_byte(wr * 64 + fr, fq * 8), boff = lds_byte(wc * 32 + fr, fq * 8);
#define PG8_SA(b, h) (((b) * 2 + (h)) * HTB)
#define PG8_SB(b, h) ((4 + (b) * 2 + (h)) * HTB)
#define PG8_STAGE(bufoff, gbase, voff) do { _Pragma("unroll") for (int _i = 0; _i < 2; ++_i) \
        __builtin_amdgcn_global_load_lds((const unsigned*)((const char*)(gbase) + (voff)[_i]), (PG8_LAS unsigned*)(lds + (bufoff) + ldsw + _i * 8192), 16, 0, 0); } while (0)
#define PG8_LDA(dst, b, h) do { _Pragma("unroll") for (int m = 0; m < 4; ++m) _Pragma("unroll") for (int k = 0; k < 2; ++k) dst[m][k] = *(const PG8_LAS bf16x8*)(lds + PG8_SA(b, h) + aoff + m * 2048 + k * 1024); } while (0)
#define PG8_LDB(dst, b, h) do { _Pragma("unroll") for (int n = 0; n < 2; ++n) _Pragma("unroll") for (int k = 0; k < 2; ++k) dst[n][k] = *(const PG8_LAS bf16x8*)(lds + PG8_SB(b, h) + boff + n * 2048 + k * 1024); } while (0)
#define PG8_MMA(ai, bj, At, Bt) do { __builtin_amdgcn_s_setprio(1); _Pragma("unroll") for (int m = 0; m < 4; ++m) _Pragma("unroll") for (int n = 0; n < 2; ++n) _Pragma("unroll") for (int k = 0; k < 2; ++k) \
        acc[ai][bj][m][n] = __builtin_amdgcn_mfma_f32_16x16x32_bf16(Bt[n][k], At[m][k], acc[ai][bj][m][n], 0, 0, 0); __builtin_amdgcn_s_setprio(0); } while (0)
#define PG8_WAIT_V(n) asm volatile("s_waitcnt vmcnt(" #n ")" ::: "memory")
#define PG8_WAIT_L(n) asm volatile("s_waitcnt lgkmcnt(" #n ")" ::: "memory")
#define PG8_BAR __builtin_amdgcn_s_barrier()
#define PG8_SCHED __builtin_amdgcn_sched_barrier(0)
    Unit cur, nxt; int ui = 0;
    if (!S.next(0, cur)) return;
    f32x4 acc[2][2][4][2];
#pragma unroll
    for (int a = 0; a < 2; ++a)
#pragma unroll
        for (int b = 0; b < 2; ++b)
#pragma unroll
            for (int m = 0; m < 4; ++m)
#pragma unroll
                for (int n = 0; n < 2; ++n) acc[a][b][m][n] = (f32x4){0.f, 0.f, 0.f, 0.f};
    bf16x8 At[4][2], B0[2][2], B1[2][2];
    const char* cA = (const char*)g.A + (size_t)cur.pm * tstep; const char* cB = (const char*)g.Bt + (size_t)cur.pn * tstep;
    S.a_ready(cur);
    if constexpr (SP2) {
        PG8_STAGE(PG8_SB(0, 0), cB, voffB); PG8_STAGE(PG8_SB(0, 1), cB + hstep, voffB); PG8_STAGE(PG8_SA(0, 0), cA, voffA); PG8_STAGE(PG8_SA(0, 1), cA + hstep, voffA);
        if (wr == 1) PG8_BAR;
        PG8_WAIT_V(2); PG8_BAR;
        PG8_STAGE(PG8_SB(1, 0), cB + kstep, voffB); PG8_STAGE(PG8_SA(1, 0), cA + kstep, voffA); PG8_STAGE(PG8_SB(1, 1), cB + hstep + kstep, voffB);
        PG8_WAIT_V(6); PG8_BAR;
    } else {
        PG8_STAGE(PG8_SB(0, 0), cB, voffB); PG8_STAGE(PG8_SA(0, 0), cA, voffA); PG8_STAGE(PG8_SB(0, 1), cB + hstep, voffB); PG8_STAGE(PG8_SA(0, 1), cA + hstep, voffA);
        if (wr == 1) PG8_BAR;
        PG8_WAIT_V(4); PG8_BAR;
        PG8_STAGE(PG8_SB(1, 0), cB + kstep, voffB); PG8_STAGE(PG8_SA(1, 0), cA + kstep, voffA); PG8_STAGE(PG8_SB(1, 1), cB + hstep + kstep, voffB);
        PG8_WAIT_V(6); PG8_BAR;
    }
    for (;;) {
        const bool has_next = S.next(ui + 1, nxt);
        const char* nA = has_next ? (const char*)g.A + (size_t)nxt.pm * tstep : cA; const char* nB = has_next ? (const char*)g.Bt + (size_t)nxt.pn * tstep : cB;
        for (int t = 0; t < nt; t += 2) {
            const bool last = (t == nt - 2);
            const char* a1 = cA + (size_t)(t + 1) * kstep;
            const char* a2 = last ? nA : cA + (size_t)(t + 2) * kstep; const char* b2 = last ? nB : cB + (size_t)(t + 2) * kstep;
            const char* a3 = a2 + kstep; const char* b3 = b2 + kstep;
            if (last && has_next) S.a_ready(nxt);
            if constexpr (SP2) {
            PG8_LDB(B0, 0, 0); PG8_LDB(B1, 0, 1); PG8_SCHED; PG8_LDA(At, 0, 0); PG8_STAGE(PG8_SA(1, 1), a1 + hstep, voffA);
            PG8_WAIT_V(8); PG8_WAIT_L(0); PG8_BAR; PG8_MMA(0, 0, At, B0); PG8_MMA(0, 1, At, B1); PG8_BAR; PG8_SCHED;
            PG8_LDA(At, 0, 1); PG8_STAGE(PG8_SB(0, 0), b2, voffB); PG8_STAGE(PG8_SB(0, 1), b2 + hstep, voffB); PG8_STAGE(PG8_SA(0, 0), a2, voffA);
            PG8_WAIT_V(8); PG8_WAIT_L(0); PG8_BAR; PG8_MMA(1, 0, At, B0); PG8_MMA(1, 1, At, B1); PG8_BAR; PG8_SCHED;
            PG8_LDB(B0, 1, 0); PG8_LDB(B1, 1, 1); PG8_SCHED; PG8_LDA(At, 1, 0); PG8_STAGE(PG8_SA(0, 1), a2 + hstep, voffA);
            PG8_WAIT_V(8); PG8_WAIT_L(0); PG8_BAR; PG8_MMA(0, 0, At, B0); PG8_MMA(0, 1, At, B1); PG8_BAR; PG8_SCHED;
            PG8_LDA(At, 1, 1); PG8_STAGE(PG8_SB(1, 0), b3, voffB); PG8_STAGE(PG8_SB(1, 1), b3 + hstep, voffB); PG8_STAGE(PG8_SA(1, 0), a3, voffA);
            PG8_WAIT_V(8); PG8_WAIT_L(0); PG8_BAR; PG8_MMA(1, 0, At, B0); PG8_MMA(1, 1, At, B1); PG8_BAR; PG8_SCHED;
            } else {
            PG8_LDB(B0, 0, 0); PG8_SCHED; PG8_LDA(At, 0, 0); PG8_STAGE(PG8_SA(1, 1), a1 + hstep, voffA);
            PG8_WAIT_L(8); PG8_BAR; PG8_WAIT_L(0); PG8_MMA(0, 0, At, B0); PG8_BAR; PG8_SCHED;
            PG8_LDB(B1, 0, 1); PG8_STAGE(PG8_SB(0, 0), b2, voffB);
            PG8_BAR; PG8_WAIT_L(0); PG8_MMA(0, 1, At, B1); PG8_BAR;
            PG8_LDA(At, 0, 1); PG8_STAGE(PG8_SA(0, 0), a2, voffA);
            PG8_BAR; PG8_WAIT_L(0); PG8_MMA(1, 0, At, B0); PG8_BAR; PG8_SCHED;
            PG8_STAGE(PG8_SB(0, 1), b2 + hstep, voffB);
            PG8_WAIT_V(6); PG8_BAR; PG8_MMA(1, 1, At, B1); PG8_BAR;
            PG8_LDB(B0, 1, 0); PG8_SCHED; PG8_LDA(At, 1, 0); PG8_STAGE(PG8_SA(0, 1), a2 + hstep, voffA);
            PG8_WAIT_L(8); PG8_BAR; PG8_WAIT_L(0); PG8_MMA(0, 0, At, B0); PG8_BAR; PG8_SCHED;
            PG8_LDB(B1, 1, 1); PG8_STAGE(PG8_SB(1, 0), b3, voffB);
            PG8_BAR; PG8_WAIT_L(0); PG8_MMA(0, 1, At, B1); PG8_BAR;
            PG8_LDA(At, 1, 1); PG8_STAGE(PG8_SA(1, 0), a3, voffA);
            PG8_BAR; PG8_WAIT_L(0); PG8_MMA(1, 0, At, B0); PG8_BAR; PG8_SCHED;
            PG8_STAGE(PG8_SB(1, 1), b3 + hstep, voffB);
            PG8_WAIT_V(6); PG8_BAR; PG8_MMA(1, 1, At, B1); PG8_BAR;
            }
        }
        if constexpr (ALIGN_EPI) { if (wr == 0) PG8_BAR; }
        if constexpr (!Epi::AFTER_DRAIN) { E(acc, cur, wr, wc, fr, fq); S.done(cur); }
        if (!has_next) break;
#pragma unroll
        for (int a = 0; a < 2; ++a)
#pragma unroll
            for (int b = 0; b < 2; ++b)
#pragma unroll
                for (int m = 0; m < 4; ++m)
#pragma unroll
                    for (int n = 0; n < 2; ++n) acc[a][b][m][n] = (f32x4){0.f, 0.f, 0.f, 0.f};
        cur = nxt; cA = nA; cB = nB; ++ui;
        if constexpr (ALIGN_EPI) { if (wr == 1) PG8_BAR; }
    }
    PG8_WAIT_V(0);
    if constexpr (!ALIGN_EPI) { if (wr == 0) PG8_BAR; }
    PG8_BAR;
    if constexpr (Epi::AFTER_DRAIN) { E.fused(acc, cur, wr, wc, fr, fq, lds, wid, lane); S.done(cur); }
#undef PG8_SA
#undef PG8_SB
#undef PG8_STAGE
#undef PG8_LDA
#undef PG8_LDB
#undef PG8_MMA
#undef PG8_WAIT_V
#undef PG8_WAIT_L
#undef PG8_BAR
#undef PG8_SCHED
}
}
#define GAS __attribute__((address_space(1)))
#define LAS __attribute__((address_space(3)))
#define DI __device__ __forceinline__
typedef unsigned short bf16;
typedef short bf16x8 __attribute__((ext_vector_type(8)));
typedef short s16x4 __attribute__((ext_vector_type(4)));
typedef float f32x4 __attribute__((ext_vector_type(4)));
typedef float f32x2 __attribute__((ext_vector_type(2)));
typedef unsigned u32x4 __attribute__((ext_vector_type(4)));
typedef unsigned u32x2 __attribute__((ext_vector_type(2)));
typedef __bf16 bf16x2_t __attribute__((ext_vector_type(2)));
#define MFMA16(a, b, c) __builtin_amdgcn_mfma_f32_16x16x32_bf16((a), (b), (c), 0, 0, 0)

constexpr int NB = 4, T = 8192, D = 1024, M = NB * T, FF = 2816;
constexpr int EIN = 4096, OIN = 1840, OINP = 2048;
constexpr float RMS_EPS = 1e-6f, LOG2E = 1.4426950408889634f;
constexpr size_t MiB = 1u << 20;
constexpr size_t WS_EIN = 0, WS_EOUT = 8 * MiB, WS_OIN = 10 * MiB, WS_OOUT = 14 * MiB, WS_GU = 16 * MiB, WS_DN = 38 * MiB;
constexpr size_t WS_W1K = 49 * MiB, WS_W1V = WS_W1K + 256 * 1024, WS_W2K = WS_W1V + 256 * 1024, WS_W2V = WS_W2K + 8192;
constexpr size_t WS_CTL = 56 * MiB, CTL_BYTES = 16384, WS_RS = 57 * MiB;
constexpr size_t WS_DEC = 52 * MiB, WS_KCMP = 54 * MiB, WS_VCMPT = WS_KCMP + 512 * 1024;
constexpr size_t WS_Y = 64 * MiB;
constexpr size_t WS_VST = 192 * MiB, WS_VWT = 200 * MiB, WS_HB = 240 * MiB;
constexpr size_t WS_HN = 320 * MiB, WS_ST = 384 * MiB, WS_END = 512 * MiB;
constexpr size_t GU_STRIDE = (size_t)2 * FF * D, DN_STRIDE = (size_t)D * FF;
constexpr int LDS_BYTES = 163840;

DI unsigned pk2(float lo, float hi) { f32x2 v = {lo, hi}; return __builtin_bit_cast(unsigned, __builtin_convertvector(v, bf16x2_t)); }
DI bf16 f2bf(float f) { return (bf16)(pk2(f, 0.f) & 0xffffu); }
DI float bf2f(bf16 x) { return __uint_as_float(((unsigned)x) << 16); }
DI float bflo(unsigned w) { return __uint_as_float(w << 16); }
DI float bfhi(unsigned w) { return __uint_as_float(w & 0xffff0000u); }
DI float wave_sum(float v) {
#pragma unroll
    for (int o = 1; o < 64; o <<= 1) v += __shfl_xor(v, o);
    return v;
}
DI float ex2(float x) { return __builtin_amdgcn_exp2f(x); }
DI float sigmoidf_(float x) { return __builtin_amdgcn_rcpf(1.0f + __expf(-x)); }
DI float siluf_(float x) { return x * __builtin_amdgcn_rcpf(1.0f + __expf(-x)); }

DI float rowscale(const float* rs, int row, int fq) {
    const f32x4 p = *(const f32x4*)(rs + (size_t)row * 16 + 4 * fq);
    float s = (p.x + p.y) + (p.z + p.w); s += __shfl_xor(s, 16); s += __shfl_xor(s, 32);
    return rsqrtf(s * (1.f / D) + RMS_EPS);
}
struct EpiStore {
    static constexpr bool PERM = true, AFTER_DRAIN = false;
    bf16* O; int ldc; const float* rs; int nvalid;
    DI void operator()(const pg8::f32x4 (&acc)[2][2][4][2], const pg8::Unit& u, int wr, int wc, int fr, int fq) const {
        const int row0 = u.pm * 256 + wr * 64 + fr, col0 = u.pn * 256 + wc * 32 + 8 * fq;
#pragma unroll
        for (int ai = 0; ai < 2; ++ai)
#pragma unroll
            for (int m = 0; m < 4; ++m) { const int row = row0 + ai * 128 + m * 16; bf16* rowp = O + (size_t)row * ldc + col0;
                const float r = rs ? rowscale(rs, row, fq) : 1.f;
#pragma unroll
                for (int bj = 0; bj < 2; ++bj) { const pg8::f32x4 v0 = acc[ai][bj][m][0] * r, v1 = acc[ai][bj][m][1] * r;
                    u32x4 w; w.x = pk2(v0[0], v0[1]); w.y = pk2(v0[2], v0[3]); w.z = pk2(v1[0], v1[1]); w.w = pk2(v1[2], v1[3]);
                    if (col0 + bj * 128 < nvalid) *(u32x4*)(rowp + bj * 128) = w; } }
    }
};
struct EpiStoreLA {
    static constexpr bool PERM = true, AFTER_DRAIN = false;
    bf16* O;
    DI void operator()(const pg8::f32x4 (&acc)[2][2][4][2], const pg8::Unit& u, int wr, int wc, int fr, int fq) const {
        const int row0 = u.pm * 256 + wr * 64 + fr, col0 = u.pn * 256 + wc * 32 + 8 * fq;
#pragma unroll
        for (int ai = 0; ai < 2; ++ai)
#pragma unroll
            for (int m = 0; m < 4; ++m) { const int row = row0 + ai * 128 + m * 16; const int bb = row >> 13, n = (row >> 6) & 127, r = row & 63;
#pragma unroll
                for (int bj = 0; bj < 2; ++bj) { const int col = col0 + bj * 128; const int arr = (col >> 9) & 3, hh = ((col >> 11) << 2) | ((col >> 7) & 3), c = col & 127;
                    const pg8::f32x4 v0 = acc[ai][bj][m][0], v1 = acc[ai][bj][m][1];
                    u32x4 w; w.x = pk2(v0[0], v0[1]); w.y = pk2(v0[2], v0[3]); w.z = pk2(v1[0], v1[1]); w.w = pk2(v1[2], v1[3]);
                    *(u32x4*)(O + ((size_t)((((bb * 8 + hh) * 128 + n) * 4 + arr)) << 13) + r * 128 + c) = w; } }
    }
};
struct EpiSwiglu {
    static constexpr bool PERM = true, AFTER_DRAIN = false;
    bf16* O; const float* rs;
    DI void operator()(const pg8::f32x4 (&acc)[2][2][4][2], const pg8::Unit& u, int wr, int wc, int fr, int fq) const {
        const int row0 = u.pm * 256 + wr * 64 + fr, col0 = u.pn * 128 + wc * 32 + 8 * fq;
#pragma unroll
        for (int ai = 0; ai < 2; ++ai)
#pragma unroll
            for (int m = 0; m < 4; ++m) { const int row = row0 + ai * 128 + m * 16; bf16* rowp = O + (size_t)row * FF + col0;
                const float rsc = rowscale(rs, row, fq), c1 = -rsc * LOG2E, c2 = rsc * rsc;
                float r[8];
#pragma unroll
                for (int n = 0; n < 2; ++n)
#pragma unroll
                    for (int e = 0; e < 4; ++e) { const float g = acc[ai][0][m][n][e], up = acc[ai][1][m][n][e];
                        r[n * 4 + e] = (g * up) * (c2 * __builtin_amdgcn_rcpf(1.0f + __builtin_amdgcn_exp2f(g * c1))); }
                u32x4 w; w.x = pk2(r[0], r[1]); w.y = pk2(r[2], r[3]); w.z = pk2(r[4], r[5]); w.w = pk2(r[6], r[7]);
                *(u32x4*)rowp = w; }
    }
};
template <bool BASE_BF16, bool OUT_F32>
struct EpiResid {
    static constexpr bool PERM = true, AFTER_DRAIN = false;
    const float* basef; const bf16* baseh; float* out; bf16* hb; float* rs;
    DI void operator()(const pg8::f32x4 (&acc)[2][2][4][2], const pg8::Unit& u, int wr, int wc, int fr, int fq) const {
        const int row0 = u.pm * 256 + wr * 64 + fr, col0 = u.pn * 256 + wc * 32 + 8 * fq;
#pragma unroll
        for (int ai = 0; ai < 2; ++ai)
#pragma unroll
            for (int m = 0; m < 4; ++m) { const int row = row0 + ai * 128 + m * 16; const size_t off = (size_t)row * D + col0; float ss = 0.f;
#pragma unroll
                for (int bj = 0; bj < 2; ++bj) { const size_t o2 = off + bj * 128; const pg8::f32x4 a0 = acc[ai][bj][m][0], a1 = acc[ai][bj][m][1];
                    f32x4 b0, b1;
                    if (BASE_BF16) { const u32x4 bw = *(const u32x4*)(baseh + o2); b0 = (f32x4){bflo(bw.x), bfhi(bw.x), bflo(bw.y), bfhi(bw.y)}; b1 = (f32x4){bflo(bw.z), bfhi(bw.z), bflo(bw.w), bfhi(bw.w)}; }
                    else { b0 = *(const f32x4*)(basef + o2); b1 = *(const f32x4*)(basef + o2 + 4); }
                    f32x4 o0, o1; o0.x = b0.x + a0[0]; o0.y = b0.y + a0[1]; o0.z = b0.z + a0[2]; o0.w = b0.w + a0[3]; o1.x = b1.x + a1[0]; o1.y = b1.y + a1[1]; o1.z = b1.z + a1[2]; o1.w = b1.w + a1[3];
                    if (OUT_F32) { *(f32x4*)(out + o2) = o0; *(f32x4*)(out + o2 + 4) = o1; }
                    else { u32x4 hw; hw.x = pk2(o0.x, o0.y); hw.y = pk2(o0.z, o0.w); hw.z = pk2(o1.x, o1.y); hw.w = pk2(o1.z, o1.w); *(u32x4*)(hb + o2) = hw;
                        ss += ((o0.x * o0.x + o0.y * o0.y) + (o0.z * o0.z + o0.w * o0.w)) + ((o1.x * o1.x + o1.y * o1.y) + (o1.z * o1.z + o1.w * o1.w)); } }
                if (!OUT_F32) { ss += __shfl_xor(ss, 16); ss += __shfl_xor(ss, 32); if (fq == 0) rs[(size_t)row * 16 + u.pn * 4 + wc] = ss; } }
    }
};

DI void transpose_item(const float* W, int K, int N, int Npad, bf16* WT, int mode, LAS float* scr, int item, int lane, const float* gk = nullptr) {
    const int nblk = Npad / 32, kb = item / nblk, nb = item % nblk, k0 = 64 * kb, n0 = 32 * nb;
    const int n4 = (lane & 7) * 4, nl = n0 + n4;
    f32x4 wv[8];
#pragma unroll
    for (int i = 0; i < 8; ++i) { const int kk = 8 * i + (lane >> 3); wv[i] = (nl < N) ? *(const f32x4*)(W + (size_t)(k0 + kk) * N + nl) : (f32x4){0.f, 0.f, 0.f, 0.f}; }
#pragma unroll
    for (int i = 0; i < 8; ++i) { const int kk = 8 * i + (lane >> 3); const float gv = gk ? gk[k0 + kk] : 1.f; LAS float* sp = scr + kk * 33 + n4;
        sp[0] = wv[i].x * gv; sp[1] = wv[i].y * gv; sp[2] = wv[i].z * gv; sp[3] = wv[i].w * gv; }
    asm volatile("s_waitcnt lgkmcnt(0)" ::: "memory");
    const int c = lane & 7;
    int drow0 = n0;
    if (mode == 1) { drow0 = (n0 < FF) ? (256 * (n0 >> 7) + (n0 & 127)) : (256 * ((n0 - FF) >> 7) + 128 + ((n0 - FF) & 127)); }
#pragma unroll
    for (int j = 0; j < 4; ++j) { const int n = (lane >> 3) + 8 * j; const LAS float* s = scr + (8 * c) * 33 + n;
        u32x4 o; o.x = pk2(s[0 * 33], s[1 * 33]); o.y = pk2(s[2 * 33], s[3 * 33]); o.z = pk2(s[4 * 33], s[5 * 33]); o.w = pk2(s[6 * 33], s[7 * 33]);
        *(u32x4*)(WT + (size_t)(drow0 + n) * K + k0 + 8 * c) = o; }
    asm volatile("s_waitcnt lgkmcnt(0)" ::: "memory");
}
DI void norm_rows_bf16(const float* h, const float* g, bf16* out, int gw, int ngw, int lane) {
    f32x4 gv[4];
#pragma unroll
    for (int j = 0; j < 4; ++j) gv[j] = *((const f32x4*)g + 2 * lane + 128 * (j >> 1) + (j & 1));
    for (int m0 = gw; m0 < M; m0 += 4 * ngw) {
        f32x4 v[4][4];
#pragma unroll
        for (int r = 0; r < 4; ++r) { const int m = m0 + r * ngw < M ? m0 + r * ngw : m0; const f32x4* xr = (const f32x4*)(h + (size_t)m * D) + 2 * lane;
#pragma unroll
            for (int j = 0; j < 4; ++j) v[r][j] = xr[128 * (j >> 1) + (j & 1)]; }
#pragma unroll
        for (int r = 0; r < 4; ++r) { const int m = m0 + r * ngw; float s = 0.f;
#pragma unroll
            for (int j = 0; j < 4; ++j) s += (v[r][j].x * v[r][j].x + v[r][j].y * v[r][j].y) + (v[r][j].z * v[r][j].z + v[r][j].w * v[r][j].w);
            const float rr = rsqrtf(wave_sum(s) * (1.f / D) + RMS_EPS);
            if (m < M) { u32x4* o16 = (u32x4*)(out + (size_t)m * D) + lane;
#pragma unroll
                for (int jj = 0; jj < 2; ++jj) { const f32x4 a = v[r][2 * jj], c = v[r][2 * jj + 1]; const f32x4 ga = gv[2 * jj], gc = gv[2 * jj + 1]; u32x4 w;
                    w.x = pk2(a.x * rr * ga.x, a.y * rr * ga.y); w.y = pk2(a.z * rr * ga.z, a.w * rr * ga.w); w.z = pk2(c.x * rr * gc.x, c.y * rr * gc.y); w.w = pk2(c.z * rr * gc.z, c.w * rr * gc.w);
                    o16[64 * jj] = w; } } }
    }
}
DI void norm_final(const bf16* hb, const float* rs, const float* g, float* out, int gw, int ngw, int lane) {
    f32x4 gv[4];
#pragma unroll
    for (int j = 0; j < 4; ++j) gv[j] = *((const f32x4*)g + lane + 64 * j);
    for (int m0 = gw; m0 < M; m0 += 4 * ngw) {
        u32x2 v[4][4]; float pr[4];
#pragma unroll
        for (int r = 0; r < 4; ++r) { const int m = m0 + r * ngw < M ? m0 + r * ngw : m0; const u32x2* xr = (const u32x2*)(hb + (size_t)m * D) + lane;
#pragma unroll
            for (int j = 0; j < 4; ++j) v[r][j] = xr[64 * j];
            pr[r] = rs[(size_t)m * 16 + (lane & 15)]; }
#pragma unroll
        for (int r = 0; r < 4; ++r) { const int m = m0 + r * ngw; float s = pr[r];
            s += __shfl_xor(s, 1); s += __shfl_xor(s, 2); s += __shfl_xor(s, 4); s += __shfl_xor(s, 8);
            const float rr = rsqrtf(s * (1.f / D) + RMS_EPS);
            if (m < M) { f32x4* xo = (f32x4*)(out + (size_t)m * D) + lane;
#pragma unroll
                for (int j = 0; j < 4; ++j) { f32x4 o; o.x = bflo(v[r][j].x) * rr * gv[j].x; o.y = bfhi(v[r][j].x) * rr * gv[j].y; o.z = bflo(v[r][j].y) * rr * gv[j].z; o.w = bfhi(v[r][j].y) * rr * gv[j].w; xo[64 * j] = o; } } }
    }
}
typedef GAS unsigned gu32;
#define XB_TMO      128
#define XB_XCNT(j)  (256  + 64 * (j))
#define XB_XSUB(j)  (1280 + 64 * (j))
#define XB_XGEN(j)  (2304 + 64 * (j))
#define XB_TOP      3328
#define XB_TOPGEN   3392
#define XCD_BAR_WORDS 3456
#define XB_SPIN_CAP (1u << 18)

__device__ __forceinline__ unsigned xb_ld(unsigned* p)              { return __hip_atomic_load(p, __ATOMIC_RELAXED, __HIP_MEMORY_SCOPE_AGENT); }
__device__ __forceinline__ unsigned xb_add(unsigned* p, unsigned v) { return __hip_atomic_fetch_add(p, v, __ATOMIC_RELAXED, __HIP_MEMORY_SCOPE_AGENT); }
__device__ __forceinline__ unsigned xb_xcc_id() { return (unsigned)__builtin_amdgcn_s_getreg((3 << 11) | 20) & 0xFu; }
#define XB_SPIN(cond, bar) do { unsigned _sp = 0; while (cond) { __builtin_amdgcn_s_sleep(1); \
    if ((++_sp & 255u) == 0u) { if (xb_ld(&(bar)[XB_TMO])) break; if (_sp > XB_SPIN_CAP) { atomicAdd(&(bar)[XB_TMO], 1u); break; } } } } while (0)

struct XcdBarrier {
    unsigned* bar; unsigned x;
    volatile LAS unsigned* st;
};

__device__ __forceinline__ XcdBarrier xcd_barrier_post(unsigned* bar, volatile LAS unsigned* st) {
    XcdBarrier b; b.bar = bar; b.x = xb_xcc_id(); b.st = st;
    if (threadIdx.x == 0) (void)xb_add(&bar[XB_XCNT(b.x)], 1u);
    return b;
}
__device__ __forceinline__ void xcd_barrier_complete(unsigned* bar, unsigned x, unsigned& nloc, unsigned& nx) {
    const unsigned G = gridDim.x * gridDim.y * gridDim.z;
    unsigned sum, cnt, mine, sp = 0u;
    for (;;) {
        sum = 0u; cnt = 0u; mine = 0u;
#pragma unroll
        for (unsigned j = 0; j < 16; ++j) { const unsigned c = xb_ld(&bar[XB_XCNT(j)]); sum += c; cnt += (c > 0u) ? 1u : 0u; mine = (j == x) ? c : mine; }
        if (sum == G) break;
        __builtin_amdgcn_s_sleep(1);
        if ((++sp & 255u) == 0u) { if (xb_ld(&bar[XB_TMO])) break; if (sp > XB_SPIN_CAP) { atomicAdd(&bar[XB_TMO], 1u); break; } }
    }
    nloc = mine > 0u ? mine : 1u; nx = cnt > 0u ? cnt : 1u;
}

__device__ __forceinline__ void xcd_barrier(const XcdBarrier& b) {
    asm volatile("s_waitcnt vmcnt(0)" ::: "memory");
    __syncthreads();
    if (threadIdx.x == 0) {
        unsigned* bar = b.bar;
        __builtin_amdgcn_s_waitcnt(0);
        unsigned nloc = b.st[0], nx = b.st[1];
        if (nloc == 0u) { xcd_barrier_complete(bar, b.x, nloc, nx); b.st[0] = nloc; b.st[1] = nx; }
        const unsigned old = xb_add(&bar[XB_XSUB(b.x)], 1u);
        const unsigned gen = old / nloc;
        if (old + 1u == (gen + 1u) * nloc) {
            __builtin_amdgcn_fence(__ATOMIC_RELEASE, "agent");
            asm volatile("s_waitcnt vmcnt(0)" ::: "memory");
            const unsigned og = xb_add(&bar[XB_TOP], 1u);
            const unsigned tg = og / nx;
            if (og + 1u == (tg + 1u) * nx) xb_add(&bar[XB_TOPGEN], 1u);
            else XB_SPIN(xb_ld(&bar[XB_TOPGEN]) == tg, bar);
            __builtin_amdgcn_fence(__ATOMIC_ACQUIRE, "agent");
            xb_add(&bar[XB_XGEN(b.x)], 1u);
            asm volatile("s_waitcnt vmcnt(0)" ::: "memory");
        } else {
            XB_SPIN(xb_ld(&bar[XB_XGEN(b.x)]) == gen, bar);
            __builtin_amdgcn_fence(__ATOMIC_ACQUIRE, "agent");
            asm volatile("s_waitcnt vmcnt(0)" ::: "memory");
        }
    }
    __syncthreads();
}
constexpr int LA_UNITS = NB * 8 * 128;
constexpr int KT_LD = 80, QT_LD = 144;
#define LA_BAR() do { asm volatile("s_waitcnt lgkmcnt(0)" ::: "memory"); __builtin_amdgcn_s_barrier(); asm volatile("" ::: "memory"); } while (0)
struct LaRaw { unsigned f[16], qv[16], v[16]; float lba, lbb; };
DI void la_read_col(const LAS bf16* tile, int d, int rg, unsigned (&out)[16]) {
#pragma unroll
    for (int e = 0; e < 16; ++e) out[e] = tile[(16 * rg + e) * QT_LD + d];
}
template <bool WANT_Q>
DI void la_math(const LaRaw& R, int hh, float (&fd)[16], float (&kk)[16], float (&qq)[16]) {
    if (hh < 4) {
        const float mx = fmaxf(R.lba, R.lbb), ea = __expf(R.lba - mx), eb = __expf(R.lbb - mx), lbv = ea / (ea + eb);
#pragma unroll
        for (int e = 0; e < 16; ++e) { const float x = bf2f((bf16)R.f[e]); const float f = lbv + (1.f - lbv) * sigmoidf_(x); fd[e] = f; kk[e] = 1.f - f;
            if (WANT_Q) qq[e] = siluf_(bf2f((bf16)R.qv[e])); }
    } else {
        const int r = hh - 4; const float gam = 1.f - exp2f(-5.f - (float)r);
#pragma unroll
        for (int e = 0; e < 16; ++e) { fd[e] = gam; kk[e] = bf2f((bf16)R.f[e]) * 0.08838834764831845f; if (WANT_Q) qq[e] = bf2f((bf16)R.qv[e]); }
    }
}
DI void la_store_vt(const LaRaw& R, int d, int rg, LAS bf16* VT) {
    LAS u32x4* dst = (LAS u32x4*)(VT + d * KT_LD + 16 * rg);
    dst[0] = (u32x4){R.v[0] | (R.v[1] << 16), R.v[2] | (R.v[3] << 16), R.v[4] | (R.v[5] << 16), R.v[6] | (R.v[7] << 16)};
    dst[1] = (u32x4){R.v[8] | (R.v[9] << 16), R.v[10] | (R.v[11] << 16), R.v[12] | (R.v[13] << 16), R.v[14] | (R.v[15] << 16)};
}
#define LA_CH_LDS(base, ch) ((LAS u32x4*)((base) + ((ch) >> 4) * QT_LD + ((ch) & 15) * 8))
DI void la_state_phase(const bf16* Y0, const float* lbraw, bf16* ST, float* DEC, LAS unsigned char* lds) {
    LAS bf16* KT = (LAS bf16*)lds; LAS bf16* VT = KT + 128 * KT_LD; LAS float* tot = (LAS float*)(VT + 128 * KT_LD);
    LAS bf16* RF = KT; LAS bf16* RV = VT;
    const int tid = threadIdx.x, lane = tid & 63, w = tid >> 6, l15 = lane & 15, q = lane >> 4, d = tid & 127, rg = tid >> 7;
    u32x4 rf[2], rv[2]; float lba, lbb;
#define A1_FETCH(un) { const bf16* yb_ = Y0 + ((size_t)(un) << 15); const int li_ = ((((un) >> 7) & 3) << 7) + d; \
        _Pragma("unroll") for (int c_ = 0; c_ < 2; ++c_) { rf[c_] = *(const u32x4*)(yb_ + 8192 + (size_t)(tid + 512 * c_) * 8); rv[c_] = *(const u32x4*)(yb_ + 16384 + (size_t)(tid + 512 * c_) * 8); } \
        lba = lbraw[li_]; lbb = lbraw[512 + li_]; asm volatile("" ::: "memory"); }
#define A1_STORE() { _Pragma("unroll") for (int c_ = 0; c_ < 2; ++c_) { *LA_CH_LDS(RF, tid + 512 * c_) = rf[c_]; *LA_CH_LDS(RV, tid + 512 * c_) = rv[c_]; } }
    A1_FETCH(blockIdx.x)
    A1_STORE()
    LaRaw R; R.lba = lba; R.lbb = lbb;
    LA_BAR();
    for (int unit = blockIdx.x; unit < LA_UNITS; unit += gridDim.x) {
        const int hh = (unit >> 7) & 7;
        { const int nx = unit + (int)gridDim.x, un = nx < LA_UNITS ? nx : unit; A1_FETCH(un) }
        la_read_col(RF, d, rg, R.f); la_read_col(RV, d, rg, R.v);
        LA_BAR();
        float fd[16], kk[16], qq[16];
        la_math<false>(R, hh, fd, kk, qq);
        float run = 1.f;
#pragma unroll
        for (int e = 15; e >= 0; --e) { kk[e] *= run; run *= fd[e]; }
        tot[rg * 128 + d] = run;
        la_store_vt(R, d, rg, VT);
        LA_BAR();
        float post = 1.f, last = 1.f;
#pragma unroll
        for (int g2 = 0; g2 < 4; ++g2) { const float tv = tot[g2 * 128 + d]; if (g2 > rg) post *= tv; last *= tv; }
        unsigned wv[8];
#pragma unroll
        for (int e = 0; e < 8; ++e) wv[e] = pk2(kk[2 * e] * post, kk[2 * e + 1] * post);
        LAS u32x4* dst = (LAS u32x4*)(KT + d * KT_LD + 16 * rg);
        dst[0] = (u32x4){wv[0], wv[1], wv[2], wv[3]}; dst[1] = (u32x4){wv[4], wv[5], wv[6], wv[7]};
        if (rg == 0) DEC[(size_t)unit * 128 + d] = last;
        LA_BAR();
        f32x4 acc[8];
#pragma unroll
        for (int dt = 0; dt < 8; ++dt) acc[dt] = (f32x4){0.f, 0.f, 0.f, 0.f};
#pragma unroll
        for (int ks = 0; ks < 2; ++ks) { const bf16x8 bv = *(const LAS bf16x8*)(VT + (16 * w + l15) * KT_LD + 32 * ks + 8 * q);
#pragma unroll
            for (int dt = 0; dt < 8; ++dt) { const bf16x8 ak = *(const LAS bf16x8*)(KT + (16 * dt + l15) * KT_LD + 32 * ks + 8 * q); acc[dt] = MFMA16(ak, bv, acc[dt]); } }
        bf16* so = ST + (size_t)unit * 16384 + (16 * w + l15) * 128 + 4 * q;
#pragma unroll
        for (int dt = 0; dt < 8; ++dt) { u32x2 o; o.x = pk2(acc[dt][0], acc[dt][1]); o.y = pk2(acc[dt][2], acc[dt][3]); *(u32x2*)(so + 16 * dt) = o; }
        LA_BAR();
        A1_STORE()
        R.lba = lba; R.lbb = lbb;
        LA_BAR();
    }
#undef A1_FETCH
#undef A1_STORE
}
DI void la_scan_phase(bf16* ST, const float* DEC) {
    const int gid = blockIdx.x * 512 + threadIdx.x, nth = gridDim.x * 512;
    for (int wk = gid; wk < 32 * 4096; wk += nth) {
        const int bh = wk >> 12, e4 = (wk & 4095) * 4, d = e4 & 127;
        f32x4 s = {0.f, 0.f, 0.f, 0.f};
        bf16* sp = ST + (size_t)bh * 128 * 16384 + e4; const float* dp = DEC + (size_t)bh * 128 * 128 + d;
        for (int n0 = 0; n0 < 128; n0 += 8) {
            u32x2 uv[8]; f32x4 dv[8];
#pragma unroll
            for (int i = 0; i < 8; ++i) { uv[i] = *(const u32x2*)(sp + (size_t)(n0 + i) * 16384); dv[i] = *(const f32x4*)(dp + (size_t)(n0 + i) * 128); }
#pragma unroll
            for (int i = 0; i < 8; ++i) { u32x2 o; o.x = pk2(s.x, s.y); o.y = pk2(s.z, s.w); *(u32x2*)(sp + (size_t)(n0 + i) * 16384) = o;
                s.x = dv[i].x * s.x + bflo(uv[i].x); s.y = dv[i].y * s.y + bfhi(uv[i].x); s.z = dv[i].z * s.z + bflo(uv[i].y); s.w = dv[i].w * s.w + bfhi(uv[i].y); }
        }
    }
}
DI void la_out_phase(const bf16* Y0, const float* lbraw, const bf16* ST, const float* gh, const float* gr, bf16* MIX, LAS unsigned char* lds) {
    LAS bf16* QT = (LAS bf16*)lds; LAS bf16* K2 = QT + 64 * QT_LD; LAS bf16* QS = K2 + 64 * QT_LD; LAS bf16* VT = QS + 64 * QT_LD;
    LAS float* tot = (LAS float*)(VT + 128 * KT_LD); LAS float* ssq = tot + 512; LAS float* gnl = ssq + 128;
    LAS bf16* SB = (LAS bf16*)(gnl + 256);
    LAS bf16* GB = SB + 128 * QT_LD;
    LAS bf16* RQ = QT; LAS bf16* RF = K2; LAS bf16* RV = QS;
    const int tid = threadIdx.x, lane = tid & 63, w = tid >> 6, l15 = lane & 15, q = lane >> 4, d = tid & 127, rg = tid >> 7;
    const int it = w & 3, vh = w >> 2;
    const int irow = 16 * it + l15;
    if (tid < 256) gnl[tid] = tid < 128 ? gh[tid] : gr[tid - 128];
    u32x4 rr[6], s2[4], g2r[2]; float lba, lbb;
#define A3_FETCH(un) { const bf16* yb_ = Y0 + ((size_t)(un) << 15); const bf16* sp_ = ST + ((size_t)(un) << 14); const int li_ = ((((un) >> 7) & 3) << 7) + d; \
        _Pragma("unroll") for (int c_ = 0; c_ < 2; ++c_) { rr[c_] = *(const u32x4*)(yb_ + (size_t)(tid + 512 * c_) * 8); rr[2 + c_] = *(const u32x4*)(yb_ + 8192 + (size_t)(tid + 512 * c_) * 8); \
            rr[4 + c_] = *(const u32x4*)(yb_ + 16384 + (size_t)(tid + 512 * c_) * 8); g2r[c_] = *(const u32x4*)(yb_ + 24576 + (size_t)(tid + 512 * c_) * 8); } \
        _Pragma("unroll") for (int c_ = 0; c_ < 4; ++c_) s2[c_] = *(const u32x4*)(sp_ + (size_t)(tid + 512 * c_) * 8); \
        lba = lbraw[li_]; lbb = lbraw[512 + li_]; asm volatile("" ::: "memory"); }
#define A3_STORE() { _Pragma("unroll") for (int c_ = 0; c_ < 2; ++c_) { const int ch_ = tid + 512 * c_; *LA_CH_LDS(RQ, ch_) = rr[c_]; *LA_CH_LDS(RF, ch_) = rr[2 + c_]; *LA_CH_LDS(RV, ch_) = rr[4 + c_]; *LA_CH_LDS(GB, ch_) = g2r[c_]; } \
        _Pragma("unroll") for (int c_ = 0; c_ < 4; ++c_) *LA_CH_LDS(SB, tid + 512 * c_) = s2[c_]; }
    A3_FETCH(blockIdx.x)
    A3_STORE()
    LaRaw R; R.lba = lba; R.lbb = lbb;
    LA_BAR();
    for (int unit = blockIdx.x; unit < LA_UNITS; unit += gridDim.x) {
        const int b = unit >> 10, hh = (unit >> 7) & 7, n = unit & 127;
        const int row0 = b * T + n * 64;
        { const int nx = unit + (int)gridDim.x, un = nx < LA_UNITS ? nx : unit; A3_FETCH(un) }
        la_read_col(RQ, d, rg, R.qv); la_read_col(RF, d, rg, R.f); la_read_col(RV, d, rg, R.v);
        LA_BAR();
        float fd[16], kk[16], qq[16];
        la_math<true>(R, hh, fd, kk, qq);
        float run = 1.f;
#pragma unroll
        for (int e = 0; e < 16; ++e) { run *= fd[e]; fd[e] = run; }
        tot[rg * 128 + d] = run;
        la_store_vt(R, d, rg, VT);
        LA_BAR();
        float pre = 1.f;
#pragma unroll
        for (int g2 = 0; g2 < 4; ++g2) { const float tv = tot[g2 * 128 + d]; if (g2 < rg) pre *= tv; }
        const float ref = tot[d] * tot[128 + d], iref = __builtin_amdgcn_rcpf(ref);
#pragma unroll
        for (int e = 0; e < 16; ++e) { const float P = pre * fd[e], qP = qq[e] * P; const int j = 16 * rg + e;
            QT[j * QT_LD + d] = f2bf(qP * iref); K2[j * QT_LD + d] = f2bf(kk[e] * ref * __builtin_amdgcn_rcpf(P)); QS[j * QT_LD + d] = f2bf(qP); }
        LA_BAR();
        f32x4 at[4];
#pragma unroll
        for (int jt = 0; jt < 4; ++jt) at[jt] = (f32x4){0.f, 0.f, 0.f, 0.f};
#pragma unroll
        for (int ks = 0; ks < 4; ++ks) { const bf16x8 bq = *(const LAS bf16x8*)(QT + (16 * it + l15) * QT_LD + 32 * ks + 8 * q);
#pragma unroll
            for (int jt = 0; jt < 4; ++jt) { const bf16x8 ak = *(const LAS bf16x8*)(K2 + (16 * jt + l15) * QT_LD + 32 * ks + 8 * q); at[jt] = MFMA16(ak, bq, at[jt]); } }
#pragma unroll
        for (int jt = 0; jt < 4; ++jt)
#pragma unroll
            for (int r = 0; r < 4; ++r) { const int j = 16 * jt + 4 * q + r; if (j > irow) at[jt][r] = 0.f; }
        f32x4 o[4];
#pragma unroll
        for (int vt = 0; vt < 4; ++vt) o[vt] = (f32x4){0.f, 0.f, 0.f, 0.f};
#pragma unroll
        for (int k2 = 0; k2 < 2; ++k2) {
            u32x4 pw; pw.x = pk2(at[2 * k2][0], at[2 * k2][1]); pw.y = pk2(at[2 * k2][2], at[2 * k2][3]); pw.z = pk2(at[2 * k2 + 1][0], at[2 * k2 + 1][1]); pw.w = pk2(at[2 * k2 + 1][2], at[2 * k2 + 1][3]);
            const bf16x8 pf = __builtin_bit_cast(bf16x8, pw);
#pragma unroll
            for (int vt = 0; vt < 4; ++vt) { const LAS bf16* vp = VT + (64 * vh + 16 * vt + l15) * KT_LD + 32 * k2 + 4 * q;
                const u32x2 lo = *(const LAS u32x2*)vp, hi = *(const LAS u32x2*)(vp + 16);
                const bf16x8 av = __builtin_bit_cast(bf16x8, ((u32x4){lo.x, lo.y, hi.x, hi.y})); o[vt] = MFMA16(av, pf, o[vt]); }
        }
#pragma unroll
        for (int ks = 0; ks < 4; ++ks) { const bf16x8 bq = *(const LAS bf16x8*)(QS + (16 * it + l15) * QT_LD + 32 * ks + 8 * q);
#pragma unroll
            for (int vt = 0; vt < 4; ++vt) { const bf16x8 as = *(const LAS bf16x8*)(SB + (64 * vh + 16 * vt + l15) * QT_LD + 32 * ks + 8 * q); o[vt] = MFMA16(as, bq, o[vt]); } }
        float ss = 0.f;
#pragma unroll
        for (int vt = 0; vt < 4; ++vt) ss += (o[vt][0] * o[vt][0] + o[vt][1] * o[vt][1]) + (o[vt][2] * o[vt][2] + o[vt][3] * o[vt][3]);
        ss += __shfl_xor(ss, 16); ss += __shfl_xor(ss, 32);
        if (q == 0) ssq[vh * 64 + irow] = ss;
        LA_BAR();
        const float rs = rsqrtf((ssq[irow] + ssq[64 + irow]) * (1.f / 128.f) + RMS_EPS);
        const LAS float* gn = gnl + (hh < 4 ? 0 : 128);
        bf16* op = MIX + (size_t)(row0 + irow) * D + hh * 128;
#pragma unroll
        for (int vt = 0; vt < 4; ++vt) { const int v0 = 64 * vh + 16 * vt + 4 * q; const f32x4 gv = *(const LAS f32x4*)(gn + v0); const u32x2 gw = *(const LAS u32x2*)(GB + irow * QT_LD + v0);
            u32x2 ow; ow.x = pk2(o[vt][0] * rs * gv.x * siluf_(bflo(gw.x)), o[vt][1] * rs * gv.y * siluf_(bfhi(gw.x)));
            ow.y = pk2(o[vt][2] * rs * gv.z * siluf_(bflo(gw.y)), o[vt][3] * rs * gv.w * siluf_(bfhi(gw.y))); *(u32x2*)(op + v0) = ow; }
        LA_BAR();
        A3_STORE()
        R.lba = lba; R.lbb = lbb;
        LA_BAR();
    }
#undef A3_FETCH
#undef A3_STORE
}

DI void la_range_state(const bf16* Y0, const float* lbraw, float* SR, float* DT, LAS unsigned char* lds) {
    LAS bf16* KT = (LAS bf16*)lds; LAS bf16* VT = KT + 128 * KT_LD; LAS float* tot = (LAS float*)(VT + 128 * KT_LD); LAS float* decl = tot + 512;
    LAS bf16* RF = KT; LAS bf16* RV = VT;
    const int tid = threadIdx.x, lane = tid & 63, w = tid >> 6, l15 = lane & 15, q = lane >> 4, d = tid & 127, rg = tid >> 7;
    const int wgi = blockIdx.x, unit0 = (wgi >> 3) * 128 + (wgi & 7) * 16;
    u32x4 rf[2], rv[2]; float lba, lbb;
#define R1_FETCH(un) { const bf16* yb_ = Y0 + ((size_t)(un) << 15); const int li_ = ((((un) >> 7) & 3) << 7) + d; \
        _Pragma("unroll") for (int c_ = 0; c_ < 2; ++c_) { rf[c_] = *(const u32x4*)(yb_ + 8192 + (size_t)(tid + 512 * c_) * 8); rv[c_] = *(const u32x4*)(yb_ + 16384 + (size_t)(tid + 512 * c_) * 8); } \
        lba = lbraw[li_]; lbb = lbraw[512 + li_]; asm volatile("" ::: "memory"); }
#define R1_STORE() { _Pragma("unroll") for (int c_ = 0; c_ < 2; ++c_) { *LA_CH_LDS(RF, tid + 512 * c_) = rf[c_]; *LA_CH_LDS(RV, tid + 512 * c_) = rv[c_]; } }
    R1_FETCH(unit0)
    R1_STORE()
    LaRaw R; R.lba = lba; R.lbb = lbb;
    f32x4 acc[8];
#pragma unroll
    for (int dt = 0; dt < 8; ++dt) acc[dt] = (f32x4){0.f, 0.f, 0.f, 0.f};
    float dtot = 1.f;
    LA_BAR();
    for (int c = 0; c < 16; ++c) {
        const int unit = unit0 + c, hh = (unit >> 7) & 7;
        { const int un = c + 1 < 16 ? unit + 1 : unit; R1_FETCH(un) }
        la_read_col(RF, d, rg, R.f); la_read_col(RV, d, rg, R.v);
        LA_BAR();
        float fd[16], kk[16], qq[16];
        la_math<false>(R, hh, fd, kk, qq);
        float run = 1.f;
#pragma unroll
        for (int e = 15; e >= 0; --e) { kk[e] *= run; run *= fd[e]; }
        tot[rg * 128 + d] = run;
        la_store_vt(R, d, rg, VT);
        LA_BAR();
        float post = 1.f, last = 1.f;
#pragma unroll
        for (int g2 = 0; g2 < 4; ++g2) { const float tv = tot[g2 * 128 + d]; if (g2 > rg) post *= tv; last *= tv; }
        unsigned wv[8];
#pragma unroll
        for (int e = 0; e < 8; ++e) wv[e] = pk2(kk[2 * e] * post, kk[2 * e + 1] * post);
        LAS u32x4* dst = (LAS u32x4*)(KT + d * KT_LD + 16 * rg);
        dst[0] = (u32x4){wv[0], wv[1], wv[2], wv[3]}; dst[1] = (u32x4){wv[4], wv[5], wv[6], wv[7]};
        if (rg == 0) { decl[d] = last; dtot *= last; }
        LA_BAR();
#pragma unroll
        for (int dt = 0; dt < 8; ++dt) { const f32x4 dv = *(const LAS f32x4*)(decl + 16 * dt + 4 * q); acc[dt][0] *= dv.x; acc[dt][1] *= dv.y; acc[dt][2] *= dv.z; acc[dt][3] *= dv.w; }
#pragma unroll
        for (int ks = 0; ks < 2; ++ks) { const bf16x8 bv = *(const LAS bf16x8*)(VT + (16 * w + l15) * KT_LD + 32 * ks + 8 * q);
#pragma unroll
            for (int dt = 0; dt < 8; ++dt) { const bf16x8 ak = *(const LAS bf16x8*)(KT + (16 * dt + l15) * KT_LD + 32 * ks + 8 * q); acc[dt] = MFMA16(ak, bv, acc[dt]); } }
        LA_BAR();
        R1_STORE()
        R.lba = lba; R.lbb = lbb;
        LA_BAR();
    }
    float* so = SR + (size_t)wgi * 16384 + (16 * w + l15) * 128 + 4 * q;
#pragma unroll
    for (int dt = 0; dt < 8; ++dt) *(f32x4*)(so + 16 * dt) = acc[dt];
    if (rg == 0) DT[(size_t)wgi * 128 + d] = dtot;
#undef R1_FETCH
#undef R1_STORE
}
DI void la_range_scan(float* SR, const float* DT) {
    const int gid = blockIdx.x * 512 + threadIdx.x;
    const int bh = gid >> 12, e4 = (gid & 4095) * 4, d = e4 & 127;
    f32x4 s = {0.f, 0.f, 0.f, 0.f};
    float* sp = SR + (size_t)bh * 8 * 16384 + e4; const float* dp = DT + (size_t)bh * 8 * 128 + d;
    f32x4 uv[8], dv[8];
#pragma unroll
    for (int i = 0; i < 8; ++i) { uv[i] = *(const f32x4*)(sp + (size_t)i * 16384); dv[i] = *(const f32x4*)(dp + (size_t)i * 128); }
#pragma unroll
    for (int i = 0; i < 8; ++i) { *(f32x4*)(sp + (size_t)i * 16384) = s; s = dv[i] * s + uv[i]; }
}
DI void la_range_out(const bf16* Y0, const float* lbraw, const float* SR, const float* gh, const float* gr, bf16* MIX, LAS unsigned char* lds) {
    LAS bf16* QT = (LAS bf16*)lds; LAS bf16* K2 = QT + 64 * QT_LD; LAS bf16* QS = K2 + 64 * QT_LD; LAS bf16* VT = QS + 64 * QT_LD;
    LAS float* tot = (LAS float*)(VT + 128 * KT_LD); LAS float* ssq = tot + 512; LAS float* gnl = ssq + 128;
    LAS bf16* SB = (LAS bf16*)(gnl + 256);
    LAS bf16* GB = SB + 128 * QT_LD;
    LAS bf16* KT = GB + 64 * QT_LD;
    LAS float* decl = (LAS float*)(KT + 128 * KT_LD);
    LAS bf16* RQ = QT; LAS bf16* RF = K2; LAS bf16* RV = QS;
    const int tid = threadIdx.x, lane = tid & 63, w = tid >> 6, l15 = lane & 15, q = lane >> 4, d = tid & 127, rg = tid >> 7;
    const int it = w & 3, vh = w >> 2;
    const int irow = 16 * it + l15;
    const int wgi = blockIdx.x, unit0 = (wgi >> 3) * 128 + (wgi & 7) * 16;
    if (tid < 256) gnl[tid] = tid < 128 ? gh[tid] : gr[tid - 128];
    u32x4 rr[6], g2r[2]; float lba, lbb;
#define R3_FETCH(un) { const bf16* yb_ = Y0 + ((size_t)(un) << 15); const int li_ = ((((un) >> 7) & 3) << 7) + d; \
        _Pragma("unroll") for (int c_ = 0; c_ < 2; ++c_) { rr[c_] = *(const u32x4*)(yb_ + (size_t)(tid + 512 * c_) * 8); rr[2 + c_] = *(const u32x4*)(yb_ + 8192 + (size_t)(tid + 512 * c_) * 8); \
            rr[4 + c_] = *(const u32x4*)(yb_ + 16384 + (size_t)(tid + 512 * c_) * 8); g2r[c_] = *(const u32x4*)(yb_ + 24576 + (size_t)(tid + 512 * c_) * 8); } \
        lba = lbraw[li_]; lbb = lbraw[512 + li_]; asm volatile("" ::: "memory"); }
#define R3_STORE() { _Pragma("unroll") for (int c_ = 0; c_ < 2; ++c_) { const int ch_ = tid + 512 * c_; *LA_CH_LDS(RQ, ch_) = rr[c_]; *LA_CH_LDS(RF, ch_) = rr[2 + c_]; *LA_CH_LDS(RV, ch_) = rr[4 + c_]; *LA_CH_LDS(GB, ch_) = g2r[c_]; } }
    R3_FETCH(unit0)
    R3_STORE()
    LaRaw R; R.lba = lba; R.lbb = lbb;
    f32x4 sacc[8];
    { const float* si = SR + (size_t)wgi * 16384 + (16 * w + l15) * 128 + 4 * q;
#pragma unroll
      for (int dt = 0; dt < 8; ++dt) sacc[dt] = *(const f32x4*)(si + 16 * dt); }
    LA_BAR();
    for (int c = 0; c < 16; ++c) {
        const int unit = unit0 + c;
        const int b = unit >> 10, hh = (unit >> 7) & 7, n = unit & 127;
        const int row0 = b * T + n * 64;
        { const int un = c + 1 < 16 ? unit + 1 : unit; R3_FETCH(un) }
        la_read_col(RQ, d, rg, R.qv); la_read_col(RF, d, rg, R.f); la_read_col(RV, d, rg, R.v);
        LA_BAR();
        float fd[16], kk[16], qq[16];
        la_math<true>(R, hh, fd, kk, qq);
        float run = 1.f;
#pragma unroll
        for (int e = 0; e < 16; ++e) { run *= fd[e]; fd[e] = run; }
        tot[rg * 128 + d] = run;
        la_store_vt(R, d, rg, VT);
#pragma unroll
        for (int dt = 0; dt < 8; ++dt) { u32x2 o; o.x = pk2(sacc[dt][0], sacc[dt][1]); o.y = pk2(sacc[dt][2], sacc[dt][3]); *(LAS u32x2*)(SB + (16 * w + l15) * QT_LD + 16 * dt + 4 * q) = o; }
        LA_BAR();
        float pre = 1.f;
#pragma unroll
        for (int g2 = 0; g2 < 4; ++g2) { const float tv = tot[g2 * 128 + d]; if (g2 < rg) pre *= tv; }
        const float ref = tot[d] * tot[128 + d], iref = __builtin_amdgcn_rcpf(ref), plast = ref * (tot[256 + d] * tot[384 + d]);
        unsigned ktw[8];
#pragma unroll
        for (int e = 0; e < 16; ++e) { const float P = pre * fd[e], qP = qq[e] * P, kiP = kk[e] * __builtin_amdgcn_rcpf(P); const int j = 16 * rg + e;
            QT[j * QT_LD + d] = f2bf(qP * iref); K2[j * QT_LD + d] = f2bf(kiP * ref); QS[j * QT_LD + d] = f2bf(qP);
            const unsigned kb_ = (unsigned)f2bf(kiP * plast); if (e & 1) ktw[e >> 1] |= kb_ << 16; else ktw[e >> 1] = kb_; }
        { LAS u32x4* dst = (LAS u32x4*)(KT + d * KT_LD + 16 * rg); dst[0] = (u32x4){ktw[0], ktw[1], ktw[2], ktw[3]}; dst[1] = (u32x4){ktw[4], ktw[5], ktw[6], ktw[7]}; }
        if (rg == 0) decl[d] = plast;
        LA_BAR();
        f32x4 at[4];
#pragma unroll
        for (int jt = 0; jt < 4; ++jt) at[jt] = (f32x4){0.f, 0.f, 0.f, 0.f};
#pragma unroll
        for (int ks = 0; ks < 4; ++ks) { const bf16x8 bq = *(const LAS bf16x8*)(QT + (16 * it + l15) * QT_LD + 32 * ks + 8 * q);
#pragma unroll
            for (int jt = 0; jt < 4; ++jt) { const bf16x8 ak = *(const LAS bf16x8*)(K2 + (16 * jt + l15) * QT_LD + 32 * ks + 8 * q); at[jt] = MFMA16(ak, bq, at[jt]); } }
#pragma unroll
        for (int jt = 0; jt < 4; ++jt)
#pragma unroll
            for (int r = 0; r < 4; ++r) { const int j = 16 * jt + 4 * q + r; if (j > irow) at[jt][r] = 0.f; }
        f32x4 o[4];
#pragma unroll
        for (int vt = 0; vt < 4; ++vt) o[vt] = (f32x4){0.f, 0.f, 0.f, 0.f};
#pragma unroll
        for (int k2 = 0; k2 < 2; ++k2) {
            u32x4 pw; pw.x = pk2(at[2 * k2][0], at[2 * k2][1]); pw.y = pk2(at[2 * k2][2], at[2 * k2][3]); pw.z = pk2(at[2 * k2 + 1][0], at[2 * k2 + 1][1]); pw.w = pk2(at[2 * k2 + 1][2], at[2 * k2 + 1][3]);
            const bf16x8 pf = __builtin_bit_cast(bf16x8, pw);
#pragma unroll
            for (int vt = 0; vt < 4; ++vt) { const LAS bf16* vp = VT + (64 * vh + 16 * vt + l15) * KT_LD + 32 * k2 + 4 * q;
                const u32x2 lo = *(const LAS u32x2*)vp, hi = *(const LAS u32x2*)(vp + 16);
                const bf16x8 av = __builtin_bit_cast(bf16x8, ((u32x4){lo.x, lo.y, hi.x, hi.y})); o[vt] = MFMA16(av, pf, o[vt]); }
        }
#pragma unroll
        for (int ks = 0; ks < 4; ++ks) { const bf16x8 bq = *(const LAS bf16x8*)(QS + (16 * it + l15) * QT_LD + 32 * ks + 8 * q);
#pragma unroll
            for (int vt = 0; vt < 4; ++vt) { const bf16x8 as = *(const LAS bf16x8*)(SB + (64 * vh + 16 * vt + l15) * QT_LD + 32 * ks + 8 * q); o[vt] = MFMA16(as, bq, o[vt]); } }
        float ss = 0.f;
#pragma unroll
        for (int vt = 0; vt < 4; ++vt) ss += (o[vt][0] * o[vt][0] + o[vt][1] * o[vt][1]) + (o[vt][2] * o[vt][2] + o[vt][3] * o[vt][3]);
        ss += __shfl_xor(ss, 16); ss += __shfl_xor(ss, 32);
        if (q == 0) ssq[vh * 64 + irow] = ss;
#pragma unroll
        for (int dt = 0; dt < 8; ++dt) { const f32x4 dv = *(const LAS f32x4*)(decl + 16 * dt + 4 * q); sacc[dt][0] *= dv.x; sacc[dt][1] *= dv.y; sacc[dt][2] *= dv.z; sacc[dt][3] *= dv.w; }
#pragma unroll
        for (int ks = 0; ks < 2; ++ks) { const bf16x8 bv = *(const LAS bf16x8*)(VT + (16 * w + l15) * KT_LD + 32 * ks + 8 * q);
#pragma unroll
            for (int dt = 0; dt < 8; ++dt) { const bf16x8 ak = *(const LAS bf16x8*)(KT + (16 * dt + l15) * KT_LD + 32 * ks + 8 * q); sacc[dt] = MFMA16(ak, bv, sacc[dt]); } }
        LA_BAR();
        const float rs = rsqrtf((ssq[irow] + ssq[64 + irow]) * (1.f / 128.f) + RMS_EPS);
        const LAS float* gn = gnl + (hh < 4 ? 0 : 128);
        bf16* op = MIX + (size_t)(row0 + irow) * D + hh * 128;
#pragma unroll
        for (int vt = 0; vt < 4; ++vt) { const int v0 = 64 * vh + 16 * vt + 4 * q; const f32x4 gv = *(const LAS f32x4*)(gn + v0); const u32x2 gw = *(const LAS u32x2*)(GB + irow * QT_LD + v0);
            u32x2 ow; ow.x = pk2(o[vt][0] * rs * gv.x * siluf_(bflo(gw.x)), o[vt][1] * rs * gv.y * siluf_(bfhi(gw.x)));
            ow.y = pk2(o[vt][2] * rs * gv.z * siluf_(bflo(gw.y)), o[vt][3] * rs * gv.w * siluf_(bfhi(gw.y))); *(u32x2*)(op + v0) = ow; }
        LA_BAR();
        R3_STORE()
        R.lba = lba; R.lbb = lbb;
        LA_BAR();
    }
#undef R3_FETCH
#undef R3_STORE
}
constexpr int NC = 511, NCP = 512;
DI void nsa_compress_phase(const bf16* Y1, const float* posk, const float* posv, const bf16* w1kT, const bf16* w1vT, const bf16* w2kT, const bf16* w2vT,
                           bf16* KCMP, bf16* VCMPT, LAS unsigned char* lds, int gw, int ngw, int lane) {
    const int l15 = lane & 15, q = lane >> 4, wv = (threadIdx.x >> 6), grp = wv >> 2, nt = wv & 3;
    LAS bf16* h1s = (LAS bf16*)lds + grp * 16 * 72;
    for (int base = 0; base < 512; base += ngw / 4) {
        int task = base + (gw >> 2); const bool tvalid = task < 512; if (!tvalid) task = 511;
        const int kv = task & 1, rt = task >> 1;
        int r = rt * 16 + l15; const bool rvalid = tvalid && (r < NB * NC * 2); if (r >= NB * NC * 2) r = NB * NC * 2 - 1;
        const int b = r / (NC * 2), rem = r % (NC * 2), i = rem >> 1, g = rem & 1;
        const bf16* src = Y1 + (size_t)(b * T + 16 * i) * OINP + (kv ? 1152 : 1024) + g * 64;
        const float* pos = kv ? posv : posk; const bf16* w1 = (kv ? w1vT : w1kT) + (size_t)(16 * nt + l15) * 2048; const bf16* w2 = kv ? w2vT : w2kT;
        f32x4 acc = {0.f, 0.f, 0.f, 0.f};
#pragma unroll 8
        for (int ks = 0; ks < 64; ++ks) {
            const int p = ks >> 1, d0 = (ks & 1) * 32 + 8 * q;
            const u32x4 xv = *(const u32x4*)(src + (size_t)p * OINP + d0);
            const f32x4 p0 = *(const f32x4*)(pos + p * 64 + d0), p1 = *(const f32x4*)(pos + p * 64 + d0 + 4);
            u32x4 bw; bw.x = pk2(bflo(xv.x) + p0.x, bfhi(xv.x) + p0.y); bw.y = pk2(bflo(xv.y) + p0.z, bfhi(xv.y) + p0.w);
            bw.z = pk2(bflo(xv.z) + p1.x, bfhi(xv.z) + p1.y); bw.w = pk2(bflo(xv.w) + p1.z, bfhi(xv.w) + p1.w);
            const bf16x8 af = *(const bf16x8*)(w1 + 32 * ks + 8 * q);
            acc = MFMA16(af, __builtin_bit_cast(bf16x8, bw), acc);
        }
        { u32x2 hw; hw.x = pk2(siluf_(acc[0]), siluf_(acc[1])); hw.y = pk2(siluf_(acc[2]), siluf_(acc[3])); *(LAS u32x2*)(h1s + l15 * 72 + 16 * nt + 4 * q) = hw; }
        __syncthreads();
        f32x4 o2 = {0.f, 0.f, 0.f, 0.f};
#pragma unroll
        for (int k2 = 0; k2 < 2; ++k2) { const bf16x8 bf = *(const LAS bf16x8*)(h1s + l15 * 72 + 32 * k2 + 8 * q);
            const bf16x8 av = *(const bf16x8*)(w2 + (16 * nt + l15) * 64 + 32 * k2 + 8 * q); o2 = MFMA16(av, bf, o2); }
        if (rvalid) {
            if (kv == 0) { u32x2 ow; ow.x = pk2(o2[0], o2[1]); ow.y = pk2(o2[2], o2[3]); *(u32x2*)(KCMP + ((size_t)(b * 2 + g) * NCP + i) * 64 + 16 * nt + 4 * q) = ow; }
            else { bf16* op = VCMPT + (size_t)(b * 2 + g) * 64 * NCP + i;
#pragma unroll
                for (int r2 = 0; r2 < 4; ++r2) op[(size_t)(16 * nt + 4 * q + r2) * NCP] = f2bf(o2[r2]); }
        }
        __syncthreads();
    }
    for (int z = gw * 64 + lane; z < NB * 2 * 64; z += ngw * 64) { const int bg = z >> 6, dd = z & 63; KCMP[((size_t)bg * NCP + NC) * 64 + dd] = 0; VCMPT[((size_t)bg * 64 + dd) * NCP + NC] = 0; }
}
DI void nsa_vt_phase(const bf16* Y1, bf16* VST, bf16* VWT, int gw, int ngw, int lane) {
    for (int task = gw; task < 2 * NB * 2 * 128; task += ngw) {
        const int which = task & 1, g = (task >> 1) & 1, b = (task >> 2) & 3, blk = task >> 4;
        const int t = blk * 64 + lane;
        const bf16* src = Y1 + (size_t)(b * T + t) * OINP + (which ? 1664 : 1408) + g * 64;
        bf16* dst = (which ? VWT : VST) + (size_t)(b * 2 + g) * 64 * T + (t & ~1);
        u32x4 v[8];
#pragma unroll
        for (int c = 0; c < 8; ++c) v[c] = *(const u32x4*)(src + 8 * c);
        const bool odd = lane & 1;
#pragma unroll
        for (int c = 0; c < 8; ++c)
#pragma unroll
            for (int i = 0; i < 4; ++i) { const unsigned wd = v[c][i]; const int w = 4 * c + i;
                const unsigned recv = (unsigned)__shfl_xor((int)(odd ? (wd & 0xffffu) : (wd >> 16)), 1);
                const unsigned outw = odd ? (recv | (wd & 0xffff0000u)) : ((wd & 0xffffu) | (recv << 16));
                *(unsigned*)(dst + (size_t)(2 * w + (odd ? 1 : 0)) * T) = outw; }
    }
}
#define LDS_BAR() do { asm volatile("s_waitcnt lgkmcnt(0)" ::: "memory"); __builtin_amdgcn_s_barrier(); asm volatile("" ::: "memory"); } while (0)
constexpr int TL = 80;
constexpr int SLAB_LD = 132;
constexpr float C1 = 0.125f * LOG2E;
DI void tile_fetch(const bf16* kg, int ldk, const bf16* vg, int ldv, int tid, u32x4& kr, u32x4& vr) {
    const int r = tid >> 3, c = (tid & 7) * 8;
    kr = *(const u32x4*)(kg + (size_t)r * ldk + c); vr = *(const u32x4*)(vg + (size_t)r * ldv + c);
    asm volatile("" ::: "memory");
}
DI void tile_store(LAS bf16* Kb, LAS bf16* Vb, int tid, u32x4 kr, u32x4 vr) {
    const int r = tid >> 3, c = (tid & 7) * 8;
    *(LAS u32x4*)(Kb + r * TL + c) = kr;
    const int g32 = c & 32, k0 = c & 31, k1 = k0 + 4;
    const int p0 = 8 * ((k0 & 15) >> 2) + 4 * (k0 >> 4), p1 = 8 * ((k1 & 15) >> 2) + 4 * (k1 >> 4);
    *(LAS u32x2*)(Vb + r * TL + g32 + p0) = (u32x2){vr.x, vr.y}; *(LAS u32x2*)(Vb + r * TL + g32 + p1) = (u32x2){vr.z, vr.w};
}
DI void tile_scores(const LAS bf16* Kb, const bf16x8 (&qf)[2], int l15, int q, f32x4 (&sc)[4]) {
    bf16x8 a[4][2];
#pragma unroll
    for (int x = 0; x < 4; ++x)
#pragma unroll
        for (int ks = 0; ks < 2; ++ks) a[x][ks] = *(const LAS bf16x8*)(Kb + (16 * x + l15) * TL + 32 * ks + 8 * q);
    __builtin_amdgcn_s_setprio(1);
#pragma unroll
    for (int x = 0; x < 4; ++x) { sc[x] = (f32x4){0.f, 0.f, 0.f, 0.f};
#pragma unroll
        for (int ks = 0; ks < 2; ++ks) sc[x] = MFMA16(a[x][ks], qf[ks], sc[x]); }
    __builtin_amdgcn_s_setprio(0);
}
template <bool ROWSUM = false>
DI void tile_pv(const LAS bf16* Vb, const float (&p)[16], f32x4 (&acc)[4], int l15, int q, f32x4* accs = nullptr) {
#pragma unroll
    for (int k2 = 0; k2 < 2; ++k2) {
        u32x4 pw; pw.x = pk2(p[8 * k2], p[8 * k2 + 1]); pw.y = pk2(p[8 * k2 + 2], p[8 * k2 + 3]); pw.z = pk2(p[8 * k2 + 4], p[8 * k2 + 5]); pw.w = pk2(p[8 * k2 + 6], p[8 * k2 + 7]);
        const bf16x8 pf = __builtin_bit_cast(bf16x8, pw);
        bf16x8 av[4];
#pragma unroll
        for (int dt = 0; dt < 4; ++dt) av[dt] = *(const LAS bf16x8*)(Vb + (16 * dt + l15) * TL + 32 * k2 + 8 * q);
        __builtin_amdgcn_s_setprio(1);
#pragma unroll
        for (int dt = 0; dt < 4; ++dt) acc[dt] = MFMA16(av[dt], pf, acc[dt]);
        if (ROWSUM) { const u32x4 ow = {0x3f803f80u, 0x3f803f80u, 0x3f803f80u, 0x3f803f80u};
            *accs = MFMA16(__builtin_bit_cast(bf16x8, ow), pf, *accs); }
        __builtin_amdgcn_s_setprio(0);
    }
}
template <bool MASKED, int KS>
DI float tile_probs(const f32x4 (&sc)[4], float (&p)[16], int d0, float slope2, unsigned lim, bool extra) {
    const float A = (MASKED || extra) ? -slope2 * (float)d0 : -INFINITY;
    const float r1 = slope2 * (float)KS, r2 = slope2 * (float)(2 * KS), r3 = slope2 * (float)(3 * KS);
    float psa = 0.f, psb = 0.f;
#pragma unroll
    for (int x = 0; x < 4; ++x) { const float bx = slope2 * (float)(16 * KS * x) + A;
        float v0 = sc[x][0] * C1 + bx, v1 = sc[x][1] * C1 + (bx + r1), v2 = sc[x][2] * C1 + (bx + r2), v3 = sc[x][3] * C1 + (bx + r3);
        asm("" : "+v"(v0)); asm("" : "+v"(v1)); asm("" : "+v"(v2)); asm("" : "+v"(v3));
        if (MASKED) { const int kb = 16 * KS * x;
            v0 = (extra && ((unsigned)(d0 - kb) < lim)) ? v0 : -INFINITY; v1 = (extra && ((unsigned)(d0 - kb - KS) < lim)) ? v1 : -INFINITY;
            v2 = (extra && ((unsigned)(d0 - kb - 2 * KS) < lim)) ? v2 : -INFINITY; v3 = (extra && ((unsigned)(d0 - kb - 3 * KS) < lim)) ? v3 : -INFINITY; }
        float p0 = ex2(v0), p1 = ex2(v1), p2 = ex2(v2), p3 = ex2(v3);
        asm("" : "+v"(p0)); asm("" : "+v"(p1)); asm("" : "+v"(p2)); asm("" : "+v"(p3));
        psa += p0; psb += p1; psa += p2; psb += p3;
        p[4 * x] = p0; p[4 * x + 1] = p1; p[4 * x + 2] = p2; p[4 * x + 3] = p3; }
    return psa + psb;
}
template <bool MASKED>
DI void tile_step(const LAS bf16* Kb, const LAS bf16* Vb, const bf16x8 (&qf)[2], f32x4 (&acc)[4], f32x4& lp, int d0, float slope2, unsigned lim, bool extra, int l15, int q) {
    f32x4 sc[4]; tile_scores(Kb, qf, l15, q, sc);
    float p[16]; (void)tile_probs<MASKED, 1>(sc, p, d0, slope2, lim, extra);
    tile_pv<true>(Vb, p, acc, l15, q, &lp);
}
DI void nsa_attn_phase(const bf16* Y1, const bf16* KCMP, const bf16* VCMPT, const bf16* VST, const bf16* VWT, bf16* MIX, LAS unsigned char* lds) {
    LAS bf16* KB0 = (LAS bf16*)lds;
    LAS bf16* VB0 = KB0 + 4 * 64 * TL;
    LAS float* slab = (LAS float*)(lds + 8 * 64 * TL * 2);
    LAS unsigned* selm = (LAS unsigned*)(slab + 8 * 16 * SLAB_LD);
    LAS unsigned* blist = selm + 64;
    LAS float* invl = (LAS float*)(blist + 132);
    const int tid = threadIdx.x, lane = tid & 63, w = tid >> 6, l15 = lane & 15, q = lane >> 4;
    LAS float* myslab = slab + w * 16 * SLAB_LD;
#define KSLOT(i) (KB0 + ((i) & 3) * 64 * TL)
#define VSLOT(i) (VB0 + ((i) & 3) * 64 * TL)
#define PAIR_PIPE(n, FETCH, COMP1, COMP2) { \
        FETCH(0, kr0, vr0) FETCH(1, kr1, vr1) tile_store(KSLOT(0), VSLOT(0), tid, kr0, vr0); tile_store(KSLOT(1), VSLOT(1), tid, kr1, vr1); \
        FETCH(2, kr0, vr0) FETCH(3, kr1, vr1) \
        LDS_BAR(); \
        int i_ = 0; \
        for (; i_ + 1 < (n); i_ += 2) { \
            COMP2(i_, i_ + 1) \
            tile_store(KSLOT(i_ + 2), VSLOT(i_ + 2), tid, kr0, vr0); tile_store(KSLOT(i_ + 3), VSLOT(i_ + 3), tid, kr1, vr1); \
            FETCH(i_ + 4, kr0, vr0) FETCH(i_ + 5, kr1, vr1) \
            LDS_BAR(); } \
        if (i_ < (n)) { COMP1(i_) LDS_BAR(); } }
    constexpr int NUNITS = NB * 2 * (T / 16);
#define NSA_TILE(u_, tile_) { tile_ = (u_) >> 3; \
        if ((int)gridDim.x == 256) { const int wq_ = (int)blockIdx.x >> 3, k_ = (u_) >> 8;        \
            tile_ = k_ < 2 ? 2 * wq_ + k_ : (k_ < 9 ? 64 + 7 * wq_ + (k_ - 2) : 511 - (7 * wq_ + (k_ - 9))); } }
    bf16x8 qfN[2]; unsigned glN[3];
#define NSA_FETCH_Q(u_) { const int b_ = (u_) & 3, g_ = ((u_) >> 2) & 1; int tile_; NSA_TILE(u_, tile_) const size_t row_ = (size_t)b_ * T + tile_ * 16 + l15; const int h_ = g_ * 8 + w; \
        qfN[0] = *(const bf16x8*)(Y1 + row_ * OINP + h_ * 64 + 8 * q); qfN[1] = *(const bf16x8*)(Y1 + row_ * OINP + h_ * 64 + 32 + 8 * q); \
        const bf16* gl_ = Y1 + row_ * OINP + 1792 + h_ * 3; glN[0] = gl_[0]; glN[1] = gl_[1]; glN[2] = gl_[2]; asm volatile("" ::: "memory"); }
    if ((int)blockIdx.x < NUNITS) NSA_FETCH_Q((int)blockIdx.x)
    for (int u = blockIdx.x; u < NUNITS; u += gridDim.x) {
        const int b = u & 3, g = (u >> 2) & 1;
        int tile; NSA_TILE(u, tile)
        const int t0 = tile * 16, qblk = t0 >> 6;
        const int h = g * 8 + w; const float slope = exp2f(-0.5f * (float)(h + 1)), slope2 = slope * LOG2E;
        const int t = t0 + l15; const size_t row = (size_t)b * T + t;
        bf16x8 qf[2]; qf[0] = qfN[0]; qf[1] = qfN[1];
        const float g0 = sigmoidf_(bf2f((bf16)glN[0])), g1 = sigmoidf_(bf2f((bf16)glN[1])), g2 = sigmoidf_(bf2f((bf16)glN[2]));
        { const int un_ = u + (int)gridDim.x < NUNITS ? u + (int)gridDim.x : u; NSA_FETCH_Q(un_) }
        f32x4 ot[4];
        u32x4 kr0, vr0, kr1, vr1;
        {
            const bf16* kc = KCMP + (size_t)(b * 2 + g) * NCP * 64; const bf16* vct = VCMPT + (size_t)(b * 2 + g) * 64 * NCP;
            const int nst = tile >= 1 ? ((tile - 1) >> 6) + 1 : 0;
            const int dc = t - 31 - 64 * q;
            float lp = 0.f, carry = 0.f;
            f32x4 acc[4];
#pragma unroll
            for (int dt = 0; dt < 4; ++dt) acc[dt] = (f32x4){0.f, 0.f, 0.f, 0.f};
            float inv = 0.f;
#define CMP_FETCH(idx, KR, VR) { const int i2_ = (idx) < nst ? (idx) : nst - 1; tile_fetch(kc + (size_t)(64 * i2_) * 64, 64, vct + 64 * i2_, NCP, tid, KR, VR); }
#define CMP_COMP1(s) { \
                f32x4 sc[4]; tile_scores(KSLOT(s), qf, l15, q, sc); \
                float sv[16]; \
                const int d0 = dc - 1024 * (s); \
                if (64 * (s) + 63 <= tile - 2) lp += tile_probs<false, 16>(sc, sv, d0, slope2, 0x7fffffffu, true); \
                else lp += tile_probs<true, 16>(sc, sv, d0, slope2, 0x7fffffffu, true); \
                _Pragma("unroll") for (int x = 0; x < 4; ++x) { const float hf_ = 0.5f * sv[4 * x + 3]; \
                    const float up_ = __shfl(hf_, (lane + 48) & 63);     \
                    myslab[l15 * SLAB_LD + 16 * (s) + 4 * x + q] = ((sv[4 * x] + sv[4 * x + 1]) + (sv[4 * x + 2] + hf_)) + (q > 0 ? up_ : carry); \
                    carry = up_; } \
                tile_pv(VSLOT(s), sv, acc, l15, q); }
#define CMP_COMP2(s, s2) { CMP_COMP1(s) CMP_COMP1(s2) }
            if (nst > 0) PAIR_PIPE(nst, CMP_FETCH, CMP_COMP1, CMP_COMP2)
#undef CMP_FETCH
#undef CMP_COMP1
#undef CMP_COMP2
            { float l = lp; l += __shfl_xor(l, 16); l += __shfl_xor(l, 32); inv = l > 0.f ? 1.0f / l : 0.f;
              if (q == 0) { invl[w * 16 + l15] = inv; myslab[l15 * SLAB_LD + 16 * nst] = carry; } }
            const float gi = g0 * inv;
#pragma unroll
            for (int dt = 0; dt < 4; ++dt) { ot[dt][0] = gi * acc[dt][0]; ot[dt][1] = gi * acc[dt][1]; ot[dt][2] = gi * acc[dt][2]; ot[dt][3] = gi * acc[dt][3]; }
        }
        LDS_BAR();
        unsigned u0 = 0, u1 = 0, u2 = 0, u3 = 0, am0 = 0, am1 = 0, am2 = 0, am3 = 0;
        {
            const int tokA = 2 * w, tokB = 2 * w + 1;
            float sA0 = 0.f, sA1 = 0.f, sB0 = 0.f, sB1 = 0.f;
#pragma unroll
            for (int ww = 0; ww < 8; ++ww) { const float ilA = invl[ww * 16 + tokA], ilB = invl[ww * 16 + tokB];
                sA0 += slab[(ww * 16 + tokA) * SLAB_LD + lane] * ilA; sA1 += slab[(ww * 16 + tokA) * SLAB_LD + lane + 64] * ilA;
                sB0 += slab[(ww * 16 + tokB) * SLAB_LD + lane] * ilB; sB1 += slab[(ww * 16 + tokB) * SLAB_LD + lane + 64] * ilB; }
            const int j0 = lane, j1 = lane + 64;
            const bool v0 = j0 <= qblk, v1 = j1 <= qblk;
            const bool f0 = (j0 == 0) || (j0 == qblk) || (j0 == qblk - 1), f1 = (j1 == qblk) || (j1 == qblk - 1);
            const unsigned kA0 = f0 ? 0x7f000000u : __float_as_uint(sA0), kA1 = f1 ? 0x7f000000u : __float_as_uint(sA1);
            const unsigned kB0 = f0 ? 0x7f000000u : __float_as_uint(sB0), kB1 = f1 ? 0x7f000000u : __float_as_uint(sB1);
            unsigned TA = 0u, TB = 0u;
#pragma unroll 1
            for (int bit = 30; bit >= 0; --bit) { const unsigned trA = TA | (1u << bit), trB = TB | (1u << bit);
                const int cA = __popcll(__ballot(v0 && kA0 >= trA)) + __popcll(__ballot(v1 && kA1 >= trA));
                const int cB = __popcll(__ballot(v0 && kB0 >= trB)) + __popcll(__ballot(v1 && kB1 >= trB));
                if (cA >= 16) TA = trA; if (cB >= 16) TB = trB; }
            const unsigned long long lt = (1ull << lane) - 1ull;
#define SEL_FINISH(tok, k0, k1, Tk) { \
                const bool gt0 = v0 && k0 > Tk, gt1 = v1 && k1 > Tk, eq0 = v0 && k0 == Tk, eq1 = v1 && k1 == Tk; \
                const unsigned long long mq0 = __ballot(eq0), mq1 = __ballot(eq1); \
                const int need = 16 - (__popcll(__ballot(gt0)) + __popcll(__ballot(gt1))); \
                const int r0 = __popcll(mq0 & lt), r1 = __popcll(mq0) + __popcll(mq1 & lt);        \
                const unsigned long long m0 = __ballot(gt0 || (eq0 && r0 < need)), m1 = __ballot(gt1 || (eq1 && r1 < need)); \
                if (lane == 0) { selm[(tok) * 4 + 0] = (unsigned)m0; selm[(tok) * 4 + 1] = (unsigned)(m0 >> 32); selm[(tok) * 4 + 2] = (unsigned)m1; selm[(tok) * 4 + 3] = (unsigned)(m1 >> 32); } }
            SEL_FINISH(tokA, kA0, kA1, TA)
            SEL_FINISH(tokB, kB0, kB1, TB)
#undef SEL_FINISH
        }
        LDS_BAR();
        {
            unsigned om = selm[lane], am = om;
            om |= __shfl_xor(om, 4); om |= __shfl_xor(om, 8); om |= __shfl_xor(om, 16); om |= __shfl_xor(om, 32);
            am &= __shfl_xor(am, 4); am &= __shfl_xor(am, 8); am &= __shfl_xor(am, 16); am &= __shfl_xor(am, 32);
            u0 = __builtin_amdgcn_readlane(om, 0); u1 = __builtin_amdgcn_readlane(om, 1); u2 = __builtin_amdgcn_readlane(om, 2); u3 = __builtin_amdgcn_readlane(om, 3);
            am0 = __builtin_amdgcn_readlane(am, 0); am1 = __builtin_amdgcn_readlane(am, 1); am2 = __builtin_amdgcn_readlane(am, 2); am3 = __builtin_amdgcn_readlane(am, 3);
            if (tid < 128) { const int wd = tid >> 5, bt = tid & 31;
                const unsigned uw = wd == 0 ? u0 : wd == 1 ? u1 : wd == 2 ? u2 : u3;
                if ((uw >> bt) & 1u) { const int pos = (wd > 0 ? __popc(u0) : 0) + (wd > 1 ? __popc(u1) : 0) + (wd > 2 ? __popc(u2) : 0) + __popc(uw & ((1u << bt) - 1u)); blist[pos] = (unsigned)tid; } }
        }
        const int nsel = __popc(u0) + __popc(u1) + __popc(u2) + __popc(u3);
        LDS_BAR();
        {
            const bf16* kb = Y1 + (size_t)b * T * OINP + 1280 + g * 64; const bf16* vt = VST + (size_t)(b * 2 + g) * 64 * T;
            f32x4 lp = {0.f, 0.f, 0.f, 0.f}; f32x4 acc[4];
#pragma unroll
            for (int dt = 0; dt < 4; ++dt) acc[dt] = (f32x4){0.f, 0.f, 0.f, 0.f};
#define SEL_FETCH(idx, KR, VR) { const int i2_ = (idx) < nsel ? (idx) : nsel - 1; const int j2_ = (int)__builtin_amdgcn_readfirstlane((int)blist[i2_]); tile_fetch(kb + (size_t)(64 * j2_) * OINP, OINP, vt + 64 * j2_, T, tid, KR, VR); }
#define SEL_PREP(i, j, selb, d0) \
                const int j = (int)__builtin_amdgcn_readfirstlane((int)blist[i]); \
                const int wd##j = j >> 5; const unsigned aw##j = wd##j == 0 ? am0 : wd##j == 1 ? am1 : wd##j == 2 ? am2 : am3; \
                const bool selb = (((aw##j >> (j & 31)) & 1u) != 0u) || (((selm[l15 * 4 + wd##j] >> (j & 31)) & 1u) != 0u); \
                const int d0 = t - 64 * j - 4 * q;
#define SEL_COMP1(i) { SEL_PREP(i, ja, sa_, da_) \
                if (ja < qblk) tile_step<false>(KSLOT(i), VSLOT(i), qf, acc, lp, da_, slope2, 0x7fffffffu, sa_, l15, q);        \
                else tile_step<true>(KSLOT(i), VSLOT(i), qf, acc, lp, da_, slope2, 0x7fffffffu, sa_, l15, q); }
#define SEL_COMP2(i, i2) { SEL_PREP(i, ja, sa_, da_) SEL_PREP(i2, jb, sb_, db_) \
                if (ja < qblk && jb < qblk) { tile_step<false>(KSLOT(i), VSLOT(i), qf, acc, lp, da_, slope2, 0x7fffffffu, sa_, l15, q); tile_step<false>(KSLOT(i2), VSLOT(i2), qf, acc, lp, db_, slope2, 0x7fffffffu, sb_, l15, q); } \
                else { tile_step<true>(KSLOT(i), VSLOT(i), qf, acc, lp, da_, slope2, 0x7fffffffu, sa_, l15, q); tile_step<true>(KSLOT(i2), VSLOT(i2), qf, acc, lp, db_, slope2, 0x7fffffffu, sb_, l15, q); } }
            PAIR_PIPE(nsel, SEL_FETCH, SEL_COMP1, SEL_COMP2)
#undef SEL_FETCH
#undef SEL_PREP
#undef SEL_COMP1
#undef SEL_COMP2
            const float l = lp[0];
            const float sc = l > 0.f ? g1 / l : 0.f;
#pragma unroll
            for (int dt = 0; dt < 4; ++dt) { ot[dt][0] += sc * acc[dt][0]; ot[dt][1] += sc * acc[dt][1]; ot[dt][2] += sc * acc[dt][2]; ot[dt][3] += sc * acc[dt][3]; }
        }
        {
            const bf16* kb = Y1 + (size_t)b * T * OINP + 1536 + g * 64; const bf16* vt = VWT + (size_t)(b * 2 + g) * 64 * T;
            f32x4 lp = {0.f, 0.f, 0.f, 0.f}; f32x4 acc[4];
#pragma unroll
            for (int dt = 0; dt < 4; ++dt) acc[dt] = (f32x4){0.f, 0.f, 0.f, 0.f};
            int kstart = t0 - 511; kstart = kstart < 0 ? 0 : (kstart & ~63);
            const int nw = ((t0 + 15 - kstart) >> 6) + 1;
#define WIN_FETCH(idx, KR, VR) { const int i2_ = (idx) < nw ? (idx) : nw - 1; const int k2_ = kstart + 64 * i2_; tile_fetch(kb + (size_t)k2_ * OINP, OINP, vt + k2_, T, tid, KR, VR); }
#define WIN_INT(i) ((kstart + 64 * (i)) + 63 <= t0 && (kstart + 64 * (i)) >= t0 - 496)
#define WIN_COMP1(i) { const int d0_ = t - (kstart + 64 * (i)) - 4 * q; \
                if (WIN_INT(i)) tile_step<false>(KSLOT(i), VSLOT(i), qf, acc, lp, d0_, slope2, 512u, true, l15, q); \
                else tile_step<true>(KSLOT(i), VSLOT(i), qf, acc, lp, d0_, slope2, 512u, true, l15, q); }
#define WIN_COMP2(i, i2) { const int da_ = t - (kstart + 64 * (i)) - 4 * q, db_ = da_ - 64; \
                if (WIN_INT(i) && WIN_INT(i2)) { tile_step<false>(KSLOT(i), VSLOT(i), qf, acc, lp, da_, slope2, 512u, true, l15, q); tile_step<false>(KSLOT(i2), VSLOT(i2), qf, acc, lp, db_, slope2, 512u, true, l15, q); } \
                else { tile_step<true>(KSLOT(i), VSLOT(i), qf, acc, lp, da_, slope2, 512u, true, l15, q); tile_step<true>(KSLOT(i2), VSLOT(i2), qf, acc, lp, db_, slope2, 512u, true, l15, q); } }
            PAIR_PIPE(nw, WIN_FETCH, WIN_COMP1, WIN_COMP2)
#undef WIN_FETCH
#undef WIN_INT
#undef WIN_COMP1
#undef WIN_COMP2
            const float l = lp[0];
            const float sc = l > 0.f ? g2 / l : 0.f;
#pragma unroll
            for (int dt = 0; dt < 4; ++dt) { ot[dt][0] += sc * acc[dt][0]; ot[dt][1] += sc * acc[dt][1]; ot[dt][2] += sc * acc[dt][2]; ot[dt][3] += sc * acc[dt][3]; }
        }
        bf16* op = MIX + row * D + h * 64 + 4 * q;
#pragma unroll
        for (int dt = 0; dt < 4; ++dt) { u32x2 ow; ow.x = pk2(ot[dt][0], ot[dt][1]); ow.y = pk2(ot[dt][2], ot[dt][3]); *(u32x2*)(op + 16 * dt) = ow; }
    }
#undef KSLOT
#undef VSLOT
#undef PAIR_PIPE
#undef NSA_TILE
#undef NSA_FETCH_Q
}
struct Args { const float* in[19]; float* out; unsigned char* ws; int ph_lo, ph_hi; };
constexpr int N_PHASES = 18;
template <class Epi, bool ALIGN = true>
DI void run_gemm(LAS unsigned char* lds, const bf16* A, const bf16* Bt, int N, int K, const Epi& E) {
    pg8::Gemm g{A, Bt, M, N, K}; pg8::StaticOrder S; S.init(M, N, (int)gridDim.x, (int)blockIdx.x);
    pg8::gemm_phase<Epi, pg8::StaticOrder, ALIGN, true>(lds, g, S, E);
}
__global__ void __launch_bounds__(512, 2) mega(Args a) {
    extern __shared__ __attribute__((aligned(16))) unsigned char lds_raw[];
    LAS unsigned char* lds = (LAS unsigned char*)lds_raw;
    cg::grid_group grid = cg::this_grid();
    volatile LAS unsigned* bst = (volatile LAS unsigned*)(lds + LDS_BYTES - 64);
    if (threadIdx.x < 2) bst[threadIdx.x] = 0u;
    __syncthreads();
    XcdBarrier xbar = xcd_barrier_post((unsigned*)(a.ws + WS_CTL), bst);
    const int tid = threadIdx.x, lane = tid & 63, wave = __builtin_amdgcn_readfirstlane(tid >> 6);
    const int gw = blockIdx.x * 8 + wave, ngw = gridDim.x * 8;
#define WSP(off) ((bf16*)(a.ws + (off)))
#define W_EIN WSP(WS_EIN)
#define W_EOUT WSP(WS_EOUT)
#define W_OIN WSP(WS_OIN)
#define W_OOUT WSP(WS_OOUT)
#define W_GU WSP(WS_GU)
#define W_DN WSP(WS_DN)
#define W1K WSP(WS_W1K)
#define W1V WSP(WS_W1V)
#define W2K WSP(WS_W2K)
#define W2V WSP(WS_W2V)
#define DEC ((float*)(a.ws + WS_DEC))
#define KCMP WSP(WS_KCMP)
#define VCMPT WSP(WS_VCMPT)
#define Y WSP(WS_Y)
#define VST WSP(WS_VST)
#define VWT WSP(WS_VWT)
#define HN WSP(WS_HN)
#define ST WSP(WS_ST)
#define RS ((float*)(a.ws + WS_RS))
#define HB WSP(WS_HB)
    const int lo = a.ph_lo, hi = a.ph_hi;
#define PH(k) if (lo <= (k) && (k) < hi)
#define SEAM(k) if (lo <= (k) && (k) + 1 < hi && hi > 0) { if ((k) == 0 && a.ph_lo < 0) grid.sync();   xcd_barrier(xbar); }
    PH(0) {
        LAS float* scr = (LAS float*)(lds + wave * 8448);
        constexpr int I0 = 2048, I1 = 512, I2 = 1024, I3 = 512, I4 = 2816, I5 = 1408, I6 = 64, I7 = 2;
        constexpr int NIT = I0 + I1 + I2 + I3 + 2 * I4 + 2 * I5 + 2 * I6 + 2 * I7;
        for (int it = gw; it < NIT; it += ngw) {
            int r = it;
            if (r < I0) { transpose_item(a.in[4], 1024, EIN, EIN, W_EIN, 0, scr, r, lane); continue; } r -= I0;
            if (r < I1) { transpose_item(a.in[8], 1024, 1024, 1024, W_EOUT, 0, scr, r, lane); continue; } r -= I1;
            if (r < I2) { transpose_item(a.in[9], 1024, OIN, OINP, W_OIN, 0, scr, r, lane, a.in[1] + D); continue; } r -= I2;
            if (r < I3) { transpose_item(a.in[16], 1024, 1024, 1024, W_OOUT, 0, scr, r, lane); continue; } r -= I3;
            if (r < 2 * I4) { const int l = r / I4; transpose_item(a.in[17] + (size_t)l * D * 2 * FF, 1024, 2 * FF, 2 * FF, W_GU + (size_t)l * GU_STRIDE, 1, scr, r % I4, lane, a.in[2] + l * D); continue; } r -= 2 * I4;
            if (r < 2 * I5) { const int l = r / I5; transpose_item(a.in[18] + (size_t)l * FF * D, FF, 1024, 1024, W_DN + (size_t)l * DN_STRIDE, 0, scr, r % I5, lane); continue; } r -= 2 * I5;
            if (r < I6) { transpose_item(a.in[12], 2048, 64, 64, W1K, 0, scr, r, lane); continue; } r -= I6;
            if (r < I6) { transpose_item(a.in[14], 2048, 64, 64, W1V, 0, scr, r, lane); continue; } r -= I6;
            if (r < I7) { transpose_item(a.in[13], 64, 64, 64, W2K, 0, scr, r, lane); continue; } r -= I7;
            transpose_item(a.in[15], 64, 64, 64, W2V, 0, scr, r, lane);
        }
        norm_rows_bf16(a.in[0], a.in[1], HN, gw, ngw, lane);
    }
    SEAM(0);
    PH(1) { EpiStoreLA E{Y}; run_gemm(lds, HN, W_EIN, EIN, 1024, E); }
    SEAM(1);
    PH(2) { if (gridDim.x == 256) la_range_state(Y, a.in[5], (float*)ST, DEC, lds); else la_state_phase(Y, a.in[5], ST, DEC, lds); }
    SEAM(2);
    PH(3) { if (gridDim.x == 256) la_range_scan((float*)ST, DEC); else la_scan_phase(ST, DEC); }
    SEAM(3);
    PH(4) { if (gridDim.x == 256) la_range_out(Y, a.in[5], (const float*)ST, a.in[6], a.in[7], HN, lds); else la_out_phase(Y, a.in[5], ST, a.in[6], a.in[7], HN, lds); }
    SEAM(4);
    PH(5) { EpiResid<false, false> E{a.in[0], nullptr, nullptr, HB, RS}; run_gemm(lds, HN, W_EOUT, 1024, 1024, E); }
    SEAM(5);
    PH(7) { EpiSwiglu E{Y, RS}; run_gemm(lds, HB, W_GU, 2 * FF, 1024, E); }
    SEAM(7);
    PH(8) { EpiResid<true, false> E{nullptr, HB, nullptr, HB, RS + 16 * M}; run_gemm(lds, Y, W_DN, 1024, FF, E); }
    SEAM(8);
    PH(10) { EpiStore E{Y, OINP, RS + 16 * M, OIN}; run_gemm(lds, HB, W_OIN, OINP, 1024, E); }
    SEAM(10);
    PH(11) { nsa_compress_phase(Y, a.in[10], a.in[11], W1K, W1V, W2K, W2V, KCMP, VCMPT, lds, gw, ngw, lane); nsa_vt_phase(Y, VST, VWT, gw, ngw, lane); }
    SEAM(11);
    PH(12) { nsa_attn_phase(Y, KCMP, VCMPT, VST, VWT, HN, lds); }
    SEAM(12);
    PH(13) { EpiResid<true, false> E{nullptr, HB, nullptr, HB, RS + 32 * M}; run_gemm(lds, HN, W_OOUT, 1024, 1024, E); }
    SEAM(13);
    PH(15) { EpiSwiglu E{Y, RS + 32 * M}; run_gemm(lds, HB, W_GU + GU_STRIDE, 2 * FF, 1024, E); }
    SEAM(15);
    PH(16) { EpiResid<true, false> E{nullptr, HB, nullptr, HB, RS}; run_gemm(lds, Y, W_DN + DN_STRIDE, 1024, FF, E); }
    SEAM(16);
    PH(17) { norm_final(HB, RS, a.in[3], a.out, gw, ngw, lane); }
#undef PH
#undef SEAM
}

extern "C" void kernel_launch(void* const* d_in, const int* in_sizes, int n_in, void* d_out, int out_size, void* d_ws, size_t ws_size, hipStream_t stream) {
    static int grid = 0;
    if (grid == 0) {
        if (n_in != 19 || in_sizes[0] != M * D || out_size != M * D || ws_size < WS_END) { fprintf(stderr, "kernel_launch: unexpected shapes (n_in %d, in0 %d, out %d, ws %zu)\n", n_in, n_in > 0 ? in_sizes[0] : -1, out_size, ws_size); grid = -1; return; }
        int dev = 0, cus = 0, per_cu = 0;
        (void)hipGetDevice(&dev); (void)hipDeviceGetAttribute(&cus, hipDeviceAttributeMultiprocessorCount, dev);
        if (hipFuncSetAttribute((const void*)mega, hipFuncAttributeMaxDynamicSharedMemorySize, LDS_BYTES) != hipSuccess) { fprintf(stderr, "kernel_launch: hipFuncSetAttribute failed\n"); grid = -1; return; }
        if (hipOccupancyMaxActiveBlocksPerMultiprocessor(&per_cu, (const void*)mega, 512, LDS_BYTES) != hipSuccess || per_cu < 1) { fprintf(stderr, "kernel_launch: occupancy query says %d\n", per_cu); per_cu = 1; }
        (void)hipGetLastError();
        grid = cus * 1;
    }
    if (grid < 0) return;
    if (hipMemsetAsync((char*)d_ws + WS_CTL, 0, CTL_BYTES, stream) != hipSuccess) { fprintf(stderr, "kernel_launch: memset failed\n"); return; }
    Args a{};
    for (int i = 0; i < 19; ++i) a.in[i] = (const float*)d_in[i];
    a.out = (float*)d_out; a.ws = (unsigned char*)d_ws; a.ph_lo = 0; a.ph_hi = N_PHASES;
    void* args[] = {&a};
    hipError_t e = hipLaunchCooperativeKernel((const void*)mega, dim3(grid), dim3(512), args, LDS_BYTES, stream);
    if (e != hipSuccess) fprintf(stderr, "kernel_launch: cooperative launch failed: %s (grid %d)\n", hipGetErrorString(e), grid);
#ifdef PROBE_PHASES
    { const int pp[] = {PROBE_PHASES};
      for (unsigned i = 0; i < sizeof(pp) / sizeof(pp[0]); ++i) { a.ph_lo = pp[i]; a.ph_hi = pp[i] + 1; (void)hipLaunchCooperativeKernel((const void*)mega, dim3(grid), dim3(512), args, LDS_BYTES, stream); } }
#endif
}
```

```cpp
#include <hip/hip_runtime.h>
#include <hip/hip_cooperative_groups.h>
#include <cstdio>
#include <cstdint>
namespace cg = cooperative_groups;
namespace pg8 {
#define PG8_LAS __attribute__((address_space(3)))
typedef unsigned short bf16_t;
typedef short bf16x8 __attribute__((ext_vector_type(8)));
typedef float f32x4 __attribute__((ext_vector_type(4)));
typedef unsigned u32x4 __attribute__((ext_vector_type(4)));
constexpr int BM = 256, BK = 64, HALF = 128, HTB = HALF * BK * 2  , STAGE_BYTES = 8 * HTB, NXCD = 8, WGM = 8;

__host__ __device__ __forceinline__ int lds_byte(int r, int c) { const int st = (r >> 4) * 2 + (c >> 5), rr = r & 15, cc = c & 31, ob = rr * 64 + cc * 2; return st * 1024 + (ob ^ (((ob >> 9) & 1) << 5)); }
__host__ __device__ __forceinline__ void stage_rc(int b, int& R, int& C) { const int st = b / 1024, sb = b % 1024, swz = sb ^ (((sb >> 9) & 1) << 5); R = (st >> 1) * 16 + swz / 64; C = (st & 1) * 32 + (swz % 64) / 2; }
__host__ __device__ __forceinline__ int perm32(int rho) { const int n = rho >> 4, i = rho & 15; return 8 * (i >> 2) + 4 * n + (i & 3); }

struct Unit { int pm, pn; };
struct Gemm { const bf16_t* A; const bf16_t* Bt; int M, N, K; };

struct StaticOrder {
    int nM, nN, nwg, G, c;
    __host__ __device__ void init(int M, int N, int G_, int c_) { nM = M / BM; nN = N / BM; nwg = nM * nN; G = G_; c = c_; }
    __host__ __device__ bool next(int i, Unit& u) const {
        const long L = (long)i * G + c; if (L >= nwg) return false;
        int wgid = (int)L; { const int q = nwg / NXCD, r = nwg % NXCD, xcd = wgid % NXCD, off = wgid / NXCD; wgid = (xcd < r ? xcd * (q + 1) : r * (q + 1) + (xcd - r) * q) + off; }
        const int nig = WGM * nN, gid = wgid / nig, fm = gid * WGM, gsz = (nM - fm) < WGM ? (nM - fm) : WGM;
        u.pm = fm + ((wgid % nig) % gsz); u.pn = (wgid % nig) / gsz; return true;
    }
    __device__ __forceinline__ void a_ready(const Unit&) const {}
    __device__ __forceinline__ void done(const Unit&) const {}
};

__device__ __forceinline__ unsigned cvt_pk_bf16(float lo, float hi) { unsigned r; asm volatile("v_cvt_pk_bf16_f32 %0, %1, %2" : "=v"(r) : "v"(lo), "v"(hi)); return r; }
template <class Epi, class Sched, bool ALIGN_EPI = false, bool SP2 = false>
__device__ __forceinline__ void gemm_phase(PG8_LAS unsigned char* lds, const Gemm g, const Sched& S, const Epi& E) {
    const int tid = threadIdx.x, wid = __builtin_amdgcn_readfirstlane(tid >> 6), lane = tid & 63, wr = wid >> 2, wc = wid & 3, fr = lane & 15, fq = lane >> 4;
    const int K = g.K, nt = K / BK;
    unsigned voffA[2], voffB[2];
#pragma unroll
    for (int i = 0; i < 2; ++i) { int R, C; stage_rc(tid * 16 + i * 8192, R, C); const int Rb = Epi::PERM ? ((R & ~31) + perm32(R & 31)) : R;
        voffA[i] = (unsigned)(R * K + C) * 2u; voffB[i] = (unsigned)(Rb * K + C) * 2u; }
    const size_t kstep = (size_t)(BK * 2);
    const size_t hstep = (size_t)HALF * K * 2;
    const size_t tstep = 2 * hstep;
    const unsigned ldsw = (unsigned)wid * 1024u;
    const int aoff = lds_byte(wr * 64 + fr, fq * 8), boff = lds_byte(wc * 32 + fr, fq * 8);
#define PG8_SA(b, h) (((b) * 2 + (h)) * HTB)
#define PG8_SB(b, h) ((4 + (b) * 2 + (h)) * HTB)
#define PG8_STAGE(bufoff, gbase, voff) do { _Pragma("unroll") for (int _i = 0; _i < 2; ++_i) \
        __builtin_amdgcn_global_load_lds((const unsigned*)((const char*)(gbase) + (voff)[_i]), (PG8_LAS unsigned*)(lds + (bufoff) + ldsw + _i * 8192), 16, 0, 0); } while (0)
#define PG8_LDA(dst, b, h) do { _Pragma("unroll") for (int m = 0; m < 4; ++m) _Pragma("unroll") for (int k = 0; k < 2; ++k) dst[m][k] = *(const PG8_LAS bf16x8*)(lds + PG8_SA(b, h) + aoff + m * 2048 + k * 1024); } while (0)
#define PG8_LDB(dst, b, h) do { _Pragma("unroll") for (int n = 0; n < 2; ++n) _Pragma("unroll") for (int k = 0; k < 2; ++k) dst[n][k] = *(const PG8_LAS bf16x8*)(lds + PG8_SB(b, h) + boff + n * 2048 + k * 1024); } while (0)
#define PG8_MMA(ai, bj, At, Bt) do { __builtin_amdgcn_s_setprio(1); _Pragma("unroll") for (int m = 0; m < 4; ++m) _Pragma("unroll") for (int n = 0; n < 2; ++n) _Pragma("unroll") for (int k = 0; k < 2; ++k) \
        acc[ai][bj][m][n] = __builtin_amdgcn_mfma_f32_16x16x32_bf16(Bt[n][k], At[m][k], acc[ai][bj][m][n], 0, 0, 0); __builtin_amdgcn_s_setprio(0); } while (0)
#define PG8_WAIT_V(n) asm volatile("s_waitcnt vmcnt(" #n ")" ::: "memory")
#define PG8_WAIT_L(n) asm volatile("s_waitcnt lgkmcnt(" #n ")" ::: "memory")
#define PG8_BAR __builtin_amdgcn_s_barrier()
#define PG8_SCHED __builtin_amdgcn_sched_barrier(0)
    Unit cur, nxt; int ui = 0;
    if (!S.next(0, cur)) return;
    f32x4 acc[2][2][4][2];
#pragma unroll
    for (int a = 0; a < 2; ++a)
#pragma unroll
        for (int b = 0; b < 2; ++b)
#pragma unroll
            for (int m = 0; m < 4; ++m)
#pragma unroll
                for (int n = 0; n < 2; ++n) acc[a][b][m][n] = (f32x4){0.f, 0.f, 0.f, 0.f};
    bf16x8 At[4][2], B0[2][2], B1[2][2];
    const char* cA = (const char*)g.A + (size_t)cur.pm * tstep; const char* cB = (const char*)g.Bt + (size_t)cur.pn * tstep;
    S.a_ready(cur);
    if constexpr (SP2) {
        PG8_STAGE(PG8_SB(0, 0), cB, voffB); PG8_STAGE(PG8_SB(0, 1), cB + hstep, voffB); PG8_STAGE(PG8_SA(0, 0), cA, voffA); PG8_STAGE(PG8_SA(0, 1), cA + hstep, voffA);
        if (wr == 1) PG8_BAR;
        PG8_WAIT_V(2); PG8_BAR;
        PG8_STAGE(PG8_SB(1, 0), cB + kstep, voffB); PG8_STAGE(PG8_SA(1, 0), cA + kstep, voffA); PG8_STAGE(PG8_SB(1, 1), cB + hstep + kstep, voffB);
        PG8_WAIT_V(6); PG8_BAR;
    } else {
        PG8_STAGE(PG8_SB(0, 0), cB, voffB); PG8_STAGE(PG8_SA(0, 0), cA, voffA); PG8_STAGE(PG8_SB(0, 1), cB + hstep, voffB); PG8_STAGE(PG8_SA(0, 1), cA + hstep, voffA);
        if (wr == 1) PG8_BAR;
        PG8_WAIT_V(4); PG8_BAR;
        PG8_STAGE(PG8_SB(1, 0), cB + kstep, voffB); PG8_STAGE(PG8_SA(1, 0), cA + kstep, voffA); PG8_STAGE(PG8_SB(1, 1), cB + hstep + kstep, voffB);
        PG8_WAIT_V(6); PG8_BAR;
    }
    for (;;) {
        const bool has_next = S.next(ui + 1, nxt);
        const char* nA = has_next ? (const char*)g.A + (size_t)nxt.pm * tstep : cA; const char* nB = has_next ? (const char*)g.Bt + (size_t)nxt.pn * tstep : cB;
        for (int t = 0; t < nt; t += 2) {
            const bool last = (t == nt - 2);
            const char* a1 = cA + (size_t)(t + 1) * kstep;
            const char* a2 = last ? nA : cA + (size_t)(t + 2) * kstep; const char* b2 = last ? nB : cB + (size_t)(t + 2) * kstep;
            const char* a3 = a2 + kstep; const char* b3 = b2 + kstep;
            if (last && has_next) S.a_ready(nxt);
            if constexpr (SP2) {
            PG8_LDB(B0, 0, 0); PG8_LDB(B1, 0, 1); PG8_SCHED; PG8_LDA(At, 0, 0); PG8_STAGE(PG8_SA(1, 1), a1 + hstep, voffA);
            PG8_WAIT_V(8); PG8_WAIT_L(0); PG8_BAR; PG8_MMA(0, 0, At, B0); PG8_MMA(0, 1, At, B1); PG8_BAR; PG8_SCHED;
            PG8_LDA(At, 0, 1); PG8_STAGE(PG8_SB(0, 0), b2, voffB); PG8_STAGE(PG8_SB(0, 1), b2 + hstep, voffB); PG8_STAGE(PG8_SA(0, 0), a2, voffA);
            PG8_WAIT_V(8); PG8_WAIT_L(0); PG8_BAR; PG8_MMA(1, 0, At, B0); PG8_MMA(1, 1, At, B1); PG8_BAR; PG8_SCHED;
            PG8_LDB(B0, 1, 0); PG8_LDB(B1, 1, 1); PG8_SCHED; PG8_LDA(At, 1, 0); PG8_STAGE(PG8_SA(0, 1), a2 + hstep, voffA);
            PG8_WAIT_V(8); PG8_WAIT_L(0); PG8_BAR; PG8_MMA(0, 0, At, B0); PG8_MMA(0, 1, At, B1); PG8_BAR; PG8_SCHED;
            PG8_LDA(At, 1, 1); PG8_STAGE(PG8_SB(1, 0), b3, voffB); PG8_STAGE(PG8_SB(1, 1), b3 + hstep, voffB); PG8_STAGE(PG8_SA(1, 0), a3, voffA);
            PG8_WAIT_V(8); PG8_WAIT_L(0); PG8_BAR; PG8_MMA(1, 0, At, B0); PG8_MMA(1, 1, At, B1); PG8_BAR; PG8_SCHED;
            } else {
            PG8_LDB(B0, 0, 0); PG8_SCHED; PG8_LDA(At, 0, 0); PG8_STAGE(PG8_SA(1, 1), a1 + hstep, voffA);
            PG8_WAIT_L(8); PG8_BAR; PG8_WAIT_L(0); PG8_MMA(0, 0, At, B0); PG8_BAR; PG8_SCHED;
            PG8_LDB(B1, 0, 1); PG8_STAGE(PG8_SB(0, 0), b2, voffB);
            PG8_BAR; PG8_WAIT_L(0); PG8_MMA(0, 1, At, B1); PG8_BAR;
            PG8_LDA(At, 0, 1); PG8_STAGE(PG8_SA(0, 0), a2, voffA);
            PG8_BAR; PG8_WAIT_L(0); PG8_MMA(1, 0, At, B0); PG8_BAR; PG8_SCHED;
            PG8_STAGE(PG8_SB(0, 1), b2 + hstep, voffB);
            PG8_WAIT_V(6); PG8_BAR; PG8_MMA(1, 1, At, B1); PG8_BAR;
            PG8_LDB(B0, 1, 0); PG8_SCHED; PG8_LDA(At, 1, 0); PG8_STAGE(PG8_SA(0, 1), a2 + hstep, voffA);
            PG8_WAIT_L(8); PG8_BAR; PG8_WAIT_L(0); PG8_MMA(0, 0, At, B0); PG8_BAR; PG8_SCHED;
            PG8_LDB(B1, 1, 1); PG8_STAGE(PG8_SB(1, 0), b3, voffB);
            PG8_BAR; PG8_WAIT_L(0); PG8_MMA(0, 1, At, B1); PG8_BAR;
            PG8_LDA(At, 1, 1); PG8_STAGE(PG8_SA(1, 0), a3, voffA);
            PG8_BAR; PG8_WAIT_L(0); PG8_MMA(1, 0, At, B0); PG8_BAR; PG8_SCHED;
            PG8_STAGE(PG8_SB(1, 1), b3 + hstep, voffB);
            PG8_WAIT_V(6); PG8_BAR; PG8_MMA(1, 1, At, B1); PG8_BAR;
            }
        }
        if constexpr (ALIGN_EPI) { if (wr == 0) PG8_BAR; }
        if constexpr (!Epi::AFTER_DRAIN) { E(acc, cur, wr, wc, fr, fq); S.done(cur); }
        if (!has_next) break;
#pragma unroll
        for (int a = 0; a < 2; ++a)
#pragma unroll
            for (int b = 0; b < 2; ++b)
#pragma unroll
                for (int m = 0; m < 4; ++m)
#pragma unroll
                    for (int n = 0; n < 2; ++n) acc[a][b][m][n] = (f32x4){0.f, 0.f, 0.f, 0.f};
        cur = nxt; cA = nA; cB = nB; ++ui;
        if constexpr (ALIGN_EPI) { if (wr == 1) PG8_BAR; }
    }
    PG8_WAIT_V(0);
    if constexpr (!ALIGN_EPI) { if (wr == 0) PG8_BAR; }
    PG8_BAR;
    if constexpr (Epi::AFTER_DRAIN) { E.fused(acc, cur, wr, wc, fr, fq, lds, wid, lane); S.done(cur); }
#undef PG8_SA
#undef PG8_SB
#undef PG8_STAGE
#undef PG8_LDA
#undef PG8_LDB
#undef PG8_MMA
#undef PG8_WAIT_V
#undef PG8_WAIT_L
#undef PG8_BAR
#undef PG8_SCHED
}
}
#define GAS __attribute__((address_space(1)))
#define LAS __attribute__((address_space(3)))
#define DI __device__ __forceinline__
typedef unsigned short bf16;
typedef short bf16x8 __attribute__((ext_vector_type(8)));
typedef short s16x4 __attribute__((ext_vector_type(4)));
typedef float f32x4 __attribute__((ext_vector_type(4)));
typedef float f32x2 __attribute__((ext_vector_type(2)));
typedef unsigned u32x4 __attribute__((ext_vector_type(4)));
typedef unsigned u32x2 __attribute__((ext_vector_type(2)));
typedef __bf16 bf16x2_t __attribute__((ext_vector_type(2)));
#define MFMA16(a, b, c) __builtin_amdgcn_mfma_f32_16x16x32_bf16((a), (b), (c), 0, 0, 0)

constexpr int NB = 4, T = 8192, D = 1024, M = NB * T, FF = 2816;
constexpr int EIN = 4096, OIN = 1840, OINP = 2048;
constexpr float RMS_EPS = 1e-6f, LOG2E = 1.4426950408889634f;
constexpr size_t MiB = 1u << 20;
constexpr size_t WS_EIN = 0, WS_EOUT = 8 * MiB, WS_OIN = 10 * MiB, WS_OOUT = 14 * MiB, WS_GU = 16 * MiB, WS_DN = 38 * MiB;
constexpr size_t WS_W1K = 49 * MiB, WS_W1V = WS_W1K + 256 * 1024, WS_W2K = WS_W1V + 256 * 1024, WS_W2V = WS_W2K + 8192;
constexpr size_t WS_CTL = 56 * MiB, CTL_BYTES = 16384, WS_RS = 57 * MiB;
constexpr size_t WS_DEC = 52 * MiB, WS_KCMP = 54 * MiB, WS_VCMPT = WS_KCMP + 512 * 1024;
constexpr size_t WS_Y = 64 * MiB;
constexpr size_t WS_VST = 192 * MiB, WS_VWT = 200 * MiB, WS_HB = 240 * MiB;
constexpr size_t WS_HN = 320 * MiB, WS_ST = 384 * MiB, WS_END = 512 * MiB;
constexpr size_t GU_STRIDE = (size_t)2 * FF * D, DN_STRIDE = (size_t)D * FF;
constexpr int LDS_BYTES = 163840;

DI unsigned pk2(float lo, float hi) { f32x2 v = {lo, hi}; return __builtin_bit_cast(unsigned, __builtin_convertvector(v, bf16x2_t)); }
DI bf16 f2bf(float f) { return (bf16)(pk2(f, 0.f) & 0xffffu); }
DI float bf2f(bf16 x) { return __uint_as_float(((unsigned)x) << 16); }
DI float bflo(unsigned w) { return __uint_as_float(w << 16); }
DI float bfhi(unsigned w) { return __uint_as_float(w & 0xffff0000u); }
DI float wave_sum(float v) {
#pragma unroll
    for (int o = 1; o < 64; o <<= 1) v += __shfl_xor(v, o);
    return v;
}
DI float ex2(float x) { return __builtin_amdgcn_exp2f(x); }
DI float sigmoidf_(float x) { return __builtin_amdgcn_rcpf(1.0f + __expf(-x)); }
DI float siluf_(float x) { return x * __builtin_amdgcn_rcpf(1.0f + __expf(-x)); }

DI float rowscale(const float* rs, int row, int fq) {
    const f32x4 p = *(const f32x4*)(rs + (size_t)row * 16 + 4 * fq);
    float s = (p.x + p.y) + (p.z + p.w); s += __shfl_xor(s, 16); s += __shfl_xor(s, 32);
    return rsqrtf(s * (1.f / D) + RMS_EPS);
}
struct EpiStore {
    static constexpr bool PERM = true, AFTER_DRAIN = false;
    bf16* O; int ldc; const float* rs; int nvalid;
    DI void operator()(const pg8::f32x4 (&acc)[2][2][4][2], const pg8::Unit& u, int wr, int wc, int fr, int fq) const {
        const int row0 = u.pm * 256 + wr * 64 + fr, col0 = u.pn * 256 + wc * 32 + 8 * fq;
#pragma unroll
        for (int ai = 0; ai < 2; ++ai)
#pragma unroll
            for (int m = 0; m < 4; ++m) { const int row = row0 + ai * 128 + m * 16; bf16* rowp = O + (size_t)row * ldc + col0;
                const float r = rs ? rowscale(rs, row, fq) : 1.f;
#pragma unroll
                for (int bj = 0; bj < 2; ++bj) { const pg8::f32x4 v0 = acc[ai][bj][m][0] * r, v1 = acc[ai][bj][m][1] * r;
                    u32x4 w; w.x = pk2(v0[0], v0[1]); w.y = pk2(v0[2], v0[3]); w.z = pk2(v1[0], v1[1]); w.w = pk2(v1[2], v1[3]);
                    if (col0 + bj * 128 < nvalid) *(u32x4*)(rowp + bj * 128) = w; } }
    }
};
struct EpiStoreLA {
    static constexpr bool PERM = true, AFTER_DRAIN = false;
    bf16* O;
    DI void operator()(const pg8::f32x4 (&acc)[2][2][4][2], const pg8::Unit& u, int wr, int wc, int fr, int fq) const {
        const int row0 = u.pm * 256 + wr * 64 + fr, col0 = u.pn * 256 + wc * 32 + 8 * fq;
#pragma unroll
        for (int ai = 0; ai < 2; ++ai)
#pragma unroll
            for (int m = 0; m < 4; ++m) { const int row = row0 + ai * 128 + m * 16; const int bb = row >> 13, n = (row >> 6) & 127, r = row & 63;
#pragma unroll
                for (int bj = 0; bj < 2; ++bj) { const int col = col0 + bj * 128; const int arr = (col >> 9) & 3, hh = ((col >> 11) << 2) | ((col >> 7) & 3), c = col & 127;
                    const pg8::f32x4 v0 = acc[ai][bj][m][0], v1 = acc[ai][bj][m][1];
                    u32x4 w; w.x = pk2(v0[0], v0[1]); w.y = pk2(v0[2], v0[3]); w.z = pk2(v1[0], v1[1]); w.w = pk2(v1[2], v1[3]);
                    *(u32x4*)(O + ((size_t)((((bb * 8 + hh) * 128 + n) * 4 + arr)) << 13) + r * 128 + c) = w; } }
    }
};
struct EpiSwiglu {
    static constexpr bool PERM = true, AFTER_DRAIN = false;
    bf16* O; const float* rs;
    DI void operator()(const pg8::f32x4 (&acc)[2][2][4][2], const pg8::Unit& u, int wr, int wc, int fr, int fq) const {
        const int row0 = u.pm * 256 + wr * 64 + fr, col0 = u.pn * 128 + wc * 32 + 8 * fq;
#pragma unroll
        for (int ai = 0; ai < 2; ++ai)
#pragma unroll
            for (int m = 0; m < 4; ++m) { const int row = row0 + ai * 128 + m * 16; bf16* rowp = O + (size_t)row * FF + col0;
                const float rsc = rowscale(rs, row, fq), c1 = -rsc * LOG2E, c2 = rsc * rsc;
                float r[8];
#pragma unroll
                for (int n = 0; n < 2; ++n)
#pragma unroll
                    for (int e = 0; e < 4; ++e) { const float g = acc[ai][0][m][n][e], up = acc[ai][1][m][n][e];
                        r[n * 4 + e] = (g * up) * (c2 * __builtin_amdgcn_rcpf(1.0f + __builtin_amdgcn_exp2f(g * c1))); }
                u32x4 w; w.x = pk2(r[0], r[1]); w.y = pk2(r[2], r[3]); w.z = pk2(r[4], r[5]); w.w = pk2(r[6], r[7]);
                *(u32x4*)rowp = w; }
    }
};
template <bool BASE_BF16, bool OUT_F32>
struct EpiResid {
    static constexpr bool PERM = true, AFTER_DRAIN = false;
    const float* basef; const bf16* baseh; float* out; bf16* hb; float* rs;
    DI void operator()(const pg8::f32x4 (&acc)[2][2][4][2], const pg8::Unit& u, int wr, int wc, int fr, int fq) const {
        const int row0 = u.pm * 256 + wr * 64 + fr, col0 = u.pn * 256 + wc * 32 + 8 * fq;
#pragma unroll
        for (int ai = 0; ai < 2; ++ai)
#pragma unroll
            for (int m = 0; m < 4; ++m) { const int row = row0 + ai * 128 + m * 16; const size_t off = (size_t)row * D + col0; float ss = 0.f;
#pragma unroll
                for (int bj = 0; bj < 2; ++bj) { const size_t o2 = off + bj * 128; const pg8::f32x4 a0 = acc[ai][bj][m][0], a1 = acc[ai][bj][m][1];
                    f32x4 b0, b1;
                    if (BASE_BF16) { const u32x4 bw = *(const u32x4*)(baseh + o2); b0 = (f32x4){bflo(bw.x), bfhi(bw.x), bflo(bw.y), bfhi(bw.y)}; b1 = (f32x4){bflo(bw.z), bfhi(bw.z), bflo(bw.w), bfhi(bw.w)}; }
                    else { b0 = *(const f32x4*)(basef + o2); b1 = *(const f32x4*)(basef + o2 + 4); }
                    f32x4 o0, o1; o0.x = b0.x + a0[0]; o0.y = b0.y + a0[1]; o0.z = b0.z + a0[2]; o0.w = b0.w + a0[3]; o1.x = b1.x + a1[0]; o1.y = b1.y + a1[1]; o1.z = b1.z + a1[2]; o1.w = b1.w + a1[3];
                    if (OUT_F32) { *(f32x4*)(out + o2) = o0; *(f32x4*)(out + o2 + 4) = o1; }
                    else { u32x4 hw; hw.x = pk2(o0.x, o0.y); hw.y = pk2(o0.z, o0.w); hw.z = pk2(o1.x, o1.y); hw.w = pk2(o1.z, o1.w); *(u32x4*)(hb + o2) = hw;
                        ss += ((o0.x * o0.x + o0.y * o0.y) + (o0.z * o0.z + o0.w * o0.w)) + ((o1.x * o1.x + o1.y * o1.y) + (o1.z * o1.z + o1.w * o1.w)); } }
                if (!OUT_F32) { ss += __shfl_xor(ss, 16); ss += __shfl_xor(ss, 32); if (fq == 0) rs[(size_t)row * 16 + u.pn * 4 + wc] = ss; } }
    }
};

DI void transpose_item(const float* W, int K, int N, int Npad, bf16* WT, int mode, LAS float* scr, int item, int lane, const float* gk = nullptr) {
    const int nblk = Npad / 32, kb = item / nblk, nb = item % nblk, k0 = 64 * kb, n0 = 32 * nb;
    const int n4 = (lane & 7) * 4, nl = n0 + n4;
    f32x4 wv[8];
#pragma unroll
    for (int i = 0; i < 8; ++i) { const int kk = 8 * i + (lane >> 3); wv[i] = (nl < N) ? __builtin_nontemporal_load((const f32x4*)(W + (size_t)(k0 + kk) * N + nl)) : (f32x4){0.f, 0.f, 0.f, 0.f}; }
#pragma unroll
    for (int i = 0; i < 8; ++i) { const int kk = 8 * i + (lane >> 3); const float gv = gk ? gk[k0 + kk] : 1.f; LAS float* sp = scr + kk * 33 + n4;
        sp[0] = wv[i].x * gv; sp[1] = wv[i].y * gv; sp[2] = wv[i].z * gv; sp[3] = wv[i].w * gv; }
    asm volatile("s_waitcnt lgkmcnt(0)" ::: "memory");
    const int c = lane & 7;
    int drow0 = n0;
    if (mode == 1) { drow0 = (n0 < FF) ? (256 * (n0 >> 7) + (n0 & 127)) : (256 * ((n0 - FF) >> 7) + 128 + ((n0 - FF) & 127)); }
#pragma unroll
    for (int j = 0; j < 4; ++j) { const int n = (lane >> 3) + 8 * j; const LAS float* s = scr + (8 * c) * 33 + n;
        u32x4 o; o.x = pk2(s[0 * 33], s[1 * 33]); o.y = pk2(s[2 * 33], s[3 * 33]); o.z = pk2(s[4 * 33], s[5 * 33]); o.w = pk2(s[6 * 33], s[7 * 33]);
        *(u32x4*)(WT + (size_t)(drow0 + n) * K + k0 + 8 * c) = o; }
    asm volatile("s_waitcnt lgkmcnt(0)" ::: "memory");
}
DI void norm_rows_bf16(const float* h, const float* g, bf16* out, int gw, int ngw, int lane) {
    f32x4 gv[4];
#pragma unroll
    for (int j = 0; j < 4; ++j) gv[j] = *((const f32x4*)g + lane + 64 * j);
    for (int m0 = gw; m0 < M; m0 += 4 * ngw) {
        f32x4 v[4][4];
#pragma unroll
        for (int r = 0; r < 4; ++r) { const int m = m0 + r * ngw < M ? m0 + r * ngw : m0; const f32x4* xr = (const f32x4*)(h + (size_t)m * D) + lane;
#pragma unroll
            for (int j = 0; j < 4; ++j) v[r][j] = __builtin_nontemporal_load(xr + 64 * j); }
#pragma unroll
        for (int r = 0; r < 4; ++r) { const int m = m0 + r * ngw; float s = 0.f;
#pragma unroll
            for (int j = 0; j < 4; ++j) s += (v[r][j].x * v[r][j].x + v[r][j].y * v[r][j].y) + (v[r][j].z * v[r][j].z + v[r][j].w * v[r][j].w);
            const float rr = rsqrtf(wave_sum(s) * (1.f / D) + RMS_EPS);
            if (m < M) { u32x2* o8 = (u32x2*)(out + (size_t)m * D) + lane;
#pragma unroll
                for (int j = 0; j < 4; ++j) { u32x2 w; w.x = pk2(v[r][j].x * rr * gv[j].x, v[r][j].y * rr * gv[j].y); w.y = pk2(v[r][j].z * rr * gv[j].z, v[r][j].w * rr * gv[j].w); o8[64 * j] = w; } } }
    }
}
DI void norm_final(const bf16* hb, const float* rs, const float* g, float* out, int gw, int ngw, int lane) {
    f32x4 gv[4];
#pragma unroll
    for (int j = 0; j < 4; ++j) gv[j] = *((const f32x4*)g + lane + 64 * j);
    for (int m0 = gw; m0 < M; m0 += 4 * ngw) {
        u32x2 v[4][4]; float pr[4];
#pragma unroll
        for (int r = 0; r < 4; ++r) { const int m = m0 + r * ngw < M ? m0 + r * ngw : m0; const u32x2* xr = (const u32x2*)(hb + (size_t)m * D) + lane;
#pragma unroll
            for (int j = 0; j < 4; ++j) v[r][j] = xr[64 * j];
            pr[r] = rs[(size_t)m * 16 + (lane & 15)]; }
#pragma unroll
        for (int r = 0; r < 4; ++r) { const int m = m0 + r * ngw; float s = pr[r];
            s += __shfl_xor(s, 1); s += __shfl_xor(s, 2); s += __shfl_xor(s, 4); s += __shfl_xor(s, 8);
            const float rr = rsqrtf(s * (1.f / D) + RMS_EPS);
            if (m < M) { f32x4* xo = (f32x4*)(out + (size_t)m * D) + lane;
#pragma unroll
                for (int j = 0; j < 4; ++j) { f32x4 o; o.x = bflo(v[r][j].x) * rr * gv[j].x; o.y = bfhi(v[r][j].x) * rr * gv[j].y; o.z = bflo(v[r][j].y) * rr * gv[j].z; o.w = bfhi(v[r][j].y) * rr * gv[j].w; __builtin_nontemporal_store(o, xo + 64 * j); } } }
    }
}
typedef GAS unsigned gu32;
#define XB_TMO      128
#define XB_XCNT(j)  (256  + 64 * (j))
#define XB_XSUB(j)  (1280 + 64 * (j))
#define XB_XGEN(j)  (2304 + 64 * (j))
#define XB_TOP      3328
#define XB_TOPGEN   3392
#define XCD_BAR_WORDS 3456
#define XB_SPIN_CAP (1u << 18)

__device__ __forceinline__ unsigned xb_ld(unsigned* p)              { return __hip_atomic_load(p, __ATOMIC_RELAXED, __HIP_MEMORY_SCOPE_AGENT); }
__device__ __forceinline__ unsigned xb_add(unsigned* p, unsigned v) { return __hip_atomic_fetch_add(p, v, __ATOMIC_RELAXED, __HIP_MEMORY_SCOPE_AGENT); }
__device__ __forceinline__ unsigned xb_xcc_id() { return (unsigned)__builtin_amdgcn_s_getreg((3 << 11) | 20) & 0xFu; }
#define XB_SPIN(cond, bar) do { unsigned _sp = 0; while (cond) { __builtin_amdgcn_s_sleep(1); \
    if ((++_sp & 255u) == 0u) { if (xb_ld(&(bar)[XB_TMO])) break; if (_sp > XB_SPIN_CAP) { atomicAdd(&(bar)[XB_TMO], 1u); break; } } } } while (0)

struct XcdBarrier {
    unsigned* bar; unsigned x;
    volatile LAS unsigned* st;
};

__device__ __forceinline__ XcdBarrier xcd_barrier_post(unsigned* bar, volatile LAS unsigned* st) {
    XcdBarrier b; b.bar = bar; b.x = xb_xcc_id(); b.st = st;
    if (threadIdx.x == 0) (void)xb_add(&bar[XB_XCNT(b.x)], 1u);
    return b;
}
__device__ __forceinline__ void xcd_barrier_complete(unsigned* bar, unsigned x, unsigned& nloc, unsigned& nx) {
    const unsigned G = gridDim.x * gridDim.y * gridDim.z;
    unsigned sum, cnt, mine, sp = 0u;
    for (;;) {
        sum = 0u; cnt = 0u; mine = 0u;
#pragma unroll
        for (unsigned j = 0; j < 16; ++j) { const unsigned c = xb_ld(&bar[XB_XCNT(j)]); sum += c; cnt += (c > 0u) ? 1u : 0u; mine = (j == x) ? c : mine; }
        if (sum == G) break;
        __builtin_amdgcn_s_sleep(1);
        if ((++sp & 255u) == 0u) { if (xb_ld(&bar[XB_TMO])) break; if (sp > XB_SPIN_CAP) { atomicAdd(&bar[XB_TMO], 1u); break; } }
    }
    nloc = mine > 0u ? mine : 1u; nx = cnt > 0u ? cnt : 1u;
}

__device__ __forceinline__ void xcd_barrier(const XcdBarrier& b) {
    asm volatile("s_waitcnt vmcnt(0)" ::: "memory");
    __syncthreads();
    if (threadIdx.x == 0) {
        unsigned* bar = b.bar;
        __builtin_amdgcn_s_waitcnt(0);
        unsigned nloc = b.st[0], nx = b.st[1];
        if (nloc == 0u) { xcd_barrier_complete(bar, b.x, nloc, nx); b.st[0] = nloc; b.st[1] = nx; }
        const unsigned old = xb_add(&bar[XB_XSUB(b.x)], 1u);
        const unsigned gen = old / nloc;
        if (old + 1u == (gen + 1u) * nloc) {
            __builtin_amdgcn_fence(__ATOMIC_RELEASE, "agent");
            asm volatile("s_waitcnt vmcnt(0)" ::: "memory");
            const unsigned og = xb_add(&bar[XB_TOP], 1u);
            const unsigned tg = og / nx;
            if (og + 1u == (tg + 1u) * nx) xb_add(&bar[XB_TOPGEN], 1u);
            else XB_SPIN(xb_ld(&bar[XB_TOPGEN]) == tg, bar);
            __builtin_amdgcn_fence(__ATOMIC_ACQUIRE, "agent");
            xb_add(&bar[XB_XGEN(b.x)], 1u);
            asm volatile("s_waitcnt vmcnt(0)" ::: "memory");
        } else {
            XB_SPIN(xb_ld(&bar[XB_XGEN(b.x)]) == gen, bar);
            __builtin_amdgcn_fence(__ATOMIC_ACQUIRE, "agent");
            asm volatile("s_waitcnt vmcnt(0)" ::: "memory");
        }
    }
    __syncthreads();
}
constexpr int LA_UNITS = NB * 8 * 128;
constexpr int KT_LD = 80, QT_LD = 144;
#define LA_BAR() do { asm volatile("s_waitcnt lgkmcnt(0)" ::: "memory"); __builtin_amdgcn_s_barrier(); asm volatile("" ::: "memory"); } while (0)
struct LaRaw { unsigned f[16], qv[16], v[16]; float lba, lbb; };
DI void la_read_col(const LAS bf16* tile, int d, int rg, unsigned (&out)[16]) {
#pragma unroll
    for (int e = 0; e < 16; ++e) out[e] = tile[(16 * rg + e) * QT_LD + d];
}
template <bool WANT_Q>
DI void la_math(const LaRaw& R, int hh, float (&fd)[16], float (&kk)[16], float (&qq)[16]) {
    if (hh < 4) {
        const float mx = fmaxf(R.lba, R.lbb), ea = __expf(R.lba - mx), eb = __expf(R.lbb - mx), lbv = ea / (ea + eb);
#pragma unroll
        for (int e = 0; e < 16; ++e) { const float x = bf2f((bf16)R.f[e]); const float f = lbv + (1.f - lbv) * sigmoidf_(x); fd[e] = f; kk[e] = 1.f - f;
            if (WANT_Q) qq[e] = siluf_(bf2f((bf16)R.qv[e])); }
    } else {
        const int r = hh - 4; const float gam = 1.f - exp2f(-5.f - (float)r);
#pragma unroll
        for (int e = 0; e < 16; ++e) { fd[e] = gam; kk[e] = bf2f((bf16)R.f[e]) * 0.08838834764831845f; if (WANT_Q) qq[e] = bf2f((bf16)R.qv[e]); }
    }
}
DI void la_store_vt(const LaRaw& R, int d, int rg, LAS bf16* VT) {
    LAS u32x4* dst = (LAS u32x4*)(VT + d * KT_LD + 16 * rg);
    dst[0] = (u32x4){R.v[0] | (R.v[1] << 16), R.v[2] | (R.v[3] << 16), R.v[4] | (R.v[5] << 16), R.v[6] | (R.v[7] << 16)};
    dst[1] = (u32x4){R.v[8] | (R.v[9] << 16), R.v[10] | (R.v[11] << 16), R.v[12] | (R.v[13] << 16), R.v[14] | (R.v[15] << 16)};
}
#define LA_CH_LDS(base, ch) ((LAS u32x4*)((base) + ((ch) >> 4) * QT_LD + ((ch) & 15) * 8))
DI void la_state_phase(const bf16* Y0, const float* lbraw, bf16* ST, float* DEC, LAS unsigned char* lds) {
    LAS bf16* KT = (LAS bf16*)lds; LAS bf16* VT = KT + 128 * KT_LD; LAS float* tot = (LAS float*)(VT + 128 * KT_LD);
    LAS bf16* RF = KT; LAS bf16* RV = VT;
    const int tid = threadIdx.x, lane = tid & 63, w = tid >> 6, l15 = lane & 15, q = lane >> 4, d = tid & 127, rg = tid >> 7;
    u32x4 rf[2], rv[2]; float lba, lbb;
#define A1_FETCH(un) { const bf16* yb_ = Y0 + ((size_t)(un) << 15); const int li_ = ((((un) >> 7) & 3) << 7) + d; \
        _Pragma("unroll") for (int c_ = 0; c_ < 2; ++c_) { rf[c_] = *(const u32x4*)(yb_ + 8192 + (size_t)(tid + 512 * c_) * 8); rv[c_] = *(const u32x4*)(yb_ + 16384 + (size_t)(tid + 512 * c_) * 8); } \
        lba = lbraw[li_]; lbb = lbraw[512 + li_]; asm volatile("" ::: "memory"); }
#define A1_STORE() { _Pragma("unroll") for (int c_ = 0; c_ < 2; ++c_) { *LA_CH_LDS(RF, tid + 512 * c_) = rf[c_]; *LA_CH_LDS(RV, tid + 512 * c_) = rv[c_]; } }
    A1_FETCH(blockIdx.x)
    A1_STORE()
    LaRaw R; R.lba = lba; R.lbb = lbb;
    LA_BAR();
    for (int unit = blockIdx.x; unit < LA_UNITS; unit += gridDim.x) {
        const int hh = (unit >> 7) & 7;
        { const int nx = unit + (int)gridDim.x, un = nx < LA_UNITS ? nx : unit; A1_FETCH(un) }
        la_read_col(RF, d, rg, R.f); la_read_col(RV, d, rg, R.v);
        LA_BAR();
        float fd[16], kk[16], qq[16];
        la_math<false>(R, hh, fd, kk, qq);
        float run = 1.f;
#pragma unroll
        for (int e = 15; e >= 0; --e) { kk[e] *= run; run *= fd[e]; }
        tot[rg * 128 + d] = run;
        la_store_vt(R, d, rg, VT);
        LA_BAR();
        float post = 1.f, last = 1.f;
#pragma unroll
        for (int g2 = 0; g2 < 4; ++g2) { const float tv = tot[g2 * 128 + d]; if (g2 > rg) post *= tv; last *= tv; }
        unsigned wv[8];
#pragma unroll
        for (int e = 0; e < 8; ++e) wv[e] = pk2(kk[2 * e] * post, kk[2 * e + 1] * post);
        LAS u32x4* dst = (LAS u32x4*)(KT + d * KT_LD + 16 * rg);
        dst[0] = (u32x4){wv[0], wv[1], wv[2], wv[3]}; dst[1] = (u32x4){wv[4], wv[5], wv[6], wv[7]};
        if (rg == 0) DEC[(size_t)unit * 128 + d] = last;
        LA_BAR();
        f32x4 acc[8];
#pragma unroll
        for (int dt = 0; dt < 8; ++dt) acc[dt] = (f32x4){0.f, 0.f, 0.f, 0.f};
#pragma unroll
        for (int ks = 0; ks < 2; ++ks) { const bf16x8 bv = *(const LAS bf16x8*)(VT + (16 * w + l15) * KT_LD + 32 * ks + 8 * q);
#pragma unroll
            for (int dt = 0; dt < 8; ++dt) { const bf16x8 ak = *(const LAS bf16x8*)(KT + (16 * dt + l15) * KT_LD + 32 * ks + 8 * q); acc[dt] = MFMA16(ak, bv, acc[dt]); } }
        bf16* so = ST + (size_t)unit * 16384 + (16 * w + l15) * 128 + 4 * q;
#pragma unroll
        for (int dt = 0; dt < 8; ++dt) { u32x2 o; o.x = pk2(acc[dt][0], acc[dt][1]); o.y = pk2(acc[dt][2], acc[dt][3]); *(u32x2*)(so + 16 * dt) = o; }
        LA_BAR();
        A1_STORE()
        R.lba = lba; R.lbb = lbb;
        LA_BAR();
    }
#undef A1_FETCH
#undef A1_STORE
}
DI void la_scan_phase(bf16* ST, const float* DEC) {
    const int gid = blockIdx.x * 512 + threadIdx.x, nth = gridDim.x * 512;
    for (int wk = gid; wk < 32 * 4096; wk += nth) {
        const int bh = wk >> 12, e4 = (wk & 4095) * 4, d = e4 & 127;
        f32x4 s = {0.f, 0.f, 0.f, 0.f};
        bf16* sp = ST + (size_t)bh * 128 * 16384 + e4; const float* dp = DEC + (size_t)bh * 128 * 128 + d;
        for (int n0 = 0; n0 < 128; n0 += 8) {
            u32x2 uv[8]; f32x4 dv[8];
#pragma unroll
            for (int i = 0; i < 8; ++i) { uv[i] = *(const u32x2*)(sp + (size_t)(n0 + i) * 16384); dv[i] = *(const f32x4*)(dp + (size_t)(n0 + i) * 128); }
#pragma unroll
            for (int i = 0; i < 8; ++i) { u32x2 o; o.x = pk2(s.x, s.y); o.y = pk2(s.z, s.w); *(u32x2*)(sp + (size_t)(n0 + i) * 16384) = o;
                s.x = dv[i].x * s.x + bflo(uv[i].x); s.y = dv[i].y * s.y + bfhi(uv[i].x); s.z = dv[i].z * s.z + bflo(uv[i].y); s.w = dv[i].w * s.w + bfhi(uv[i].y); }
        }
    }
}
DI void la_out_phase(const bf16* Y0, const float* lbraw, const bf16* ST, const float* gh, const float* gr, bf16* MIX, LAS unsigned char* lds) {
    LAS bf16* QT = (LAS bf16*)lds; LAS bf16* K2 = QT + 64 * QT_LD; LAS bf16* QS = K2 + 64 * QT_LD; LAS bf16* VT = QS + 64 * QT_LD;
    LAS float* tot = (LAS float*)(VT + 128 * KT_LD); LAS float* ssq = tot + 512; LAS float* gnl = ssq + 128;
    LAS bf16* SB = (LAS bf16*)(gnl + 256);
    LAS bf16* GB = SB + 128 * QT_LD;
    LAS bf16* RQ = QT; LAS bf16* RF = K2; LAS bf16* RV = QS;
    const int tid = threadIdx.x, lane = tid & 63, w = tid >> 6, l15 = lane & 15, q = lane >> 4, d = tid & 127, rg = tid >> 7;
    const int it = w & 3, vh = w >> 2;
    const int irow = 16 * it + l15;
    if (tid < 256) gnl[tid] = tid < 128 ? gh[tid] : gr[tid - 128];
    u32x4 rr[6], s2[4], g2r[2]; float lba, lbb;
#define A3_FETCH(un) { const bf16* yb_ = Y0 + ((size_t)(un) << 15); const bf16* sp_ = ST + ((size_t)(un) << 14); const int li_ = ((((un) >> 7) & 3) << 7) + d; \
        _Pragma("unroll") for (int c_ = 0; c_ < 2; ++c_) { rr[c_] = *(const u32x4*)(yb_ + (size_t)(tid + 512 * c_) * 8); rr[2 + c_] = *(const u32x4*)(yb_ + 8192 + (size_t)(tid + 512 * c_) * 8); \
            rr[4 + c_] = *(const u32x4*)(yb_ + 16384 + (size_t)(tid + 512 * c_) * 8); g2r[c_] = *(const u32x4*)(yb_ + 24576 + (size_t)(tid + 512 * c_) * 8); } \
        _Pragma("unroll") for (int c_ = 0; c_ < 4; ++c_) s2[c_] = *(const u32x4*)(sp_ + (size_t)(tid + 512 * c_) * 8); \
        lba = lbraw[li_]; lbb = lbraw[512 + li_]; asm volatile("" ::: "memory"); }
#define A3_STORE() { _Pragma("unroll") for (int c_ = 0; c_ < 2; ++c_) { const int ch_ = tid + 512 * c_; *LA_CH_LDS(RQ, ch_) = rr[c_]; *LA_CH_LDS(RF, ch_) = rr[2 + c_]; *LA_CH_LDS(RV, ch_) = rr[4 + c_]; *LA_CH_LDS(GB, ch_) = g2r[c_]; } \
        _Pragma("unroll") for (int c_ = 0; c_ < 4; ++c_) *LA_CH_LDS(SB, tid + 512 * c_) = s2[c_]; }
    A3_FETCH(blockIdx.x)
    A3_STORE()
    LaRaw R; R.lba = lba; R.lbb = lbb;
    LA_BAR();
    for (int unit = blockIdx.x; unit < LA_UNITS; unit += gridDim.x) {
        const int b = unit >> 10, hh = (unit >> 7) & 7, n = unit & 127;
        const int row0 = b * T + n * 64;
        { const int nx = unit + (int)gridDim.x, un = nx < LA_UNITS ? nx : unit; A3_FETCH(un) }
        la_read_col(RQ, d, rg, R.qv); la_read_col(RF, d, rg, R.f); la_read_col(RV, d, rg, R.v);
        LA_BAR();
        float fd[16], kk[16], qq[16];
        la_math<true>(R, hh, fd, kk, qq);
        float run = 1.f;
#pragma unroll
        for (int e = 0; e < 16; ++e) { run *= fd[e]; fd[e] = run; }
        tot[rg * 128 + d] = run;
        la_store_vt(R, d, rg, VT);
        LA_BAR();
        float pre = 1.f;
#pragma unroll
        for (int g2 = 0; g2 < 4; ++g2) { const float tv = tot[g2 * 128 + d]; if (g2 < rg) pre *= tv; }
        const float ref = tot[d] * tot[128 + d], iref = __builtin_amdgcn_rcpf(ref);
#pragma unroll
        for (int e = 0; e < 16; ++e) { const float P = pre * fd[e], qP = qq[e] * P; const int j = 16 * rg + e;
            QT[j * QT_LD + d] = f2bf(qP * iref); K2[j * QT_LD + d] = f2bf(kk[e] * ref * __builtin_amdgcn_rcpf(P)); QS[j * QT_LD + d] = f2bf(qP); }
        LA_BAR();
        f32x4 at[4];
#pragma unroll
        for (int jt = 0; jt < 4; ++jt) at[jt] = (f32x4){0.f, 0.f, 0.f, 0.f};
#pragma unroll
        for (int ks = 0; ks < 4; ++ks) { const bf16x8 bq = *(const LAS bf16x8*)(QT + (16 * it + l15) * QT_LD + 32 * ks + 8 * q);
#pragma unroll
            for (int jt = 0; jt < 4; ++jt) { const bf16x8 ak = *(const LAS bf16x8*)(K2 + (16 * jt + l15) * QT_LD + 32 * ks + 8 * q); at[jt] = MFMA16(ak, bq, at[jt]); } }
#pragma unroll
        for (int jt = 0; jt < 4; ++jt)
#pragma unroll
            for (int r = 0; r < 4; ++r) { const int j = 16 * jt + 4 * q + r; if (j > irow) at[jt][r] = 0.f; }
        f32x4 o[4];
#pragma unroll
        for (int vt = 0; vt < 4; ++vt) o[vt] = (f32x4){0.f, 0.f, 0.f, 0.f};
#pragma unroll
        for (int k2 = 0; k2 < 2; ++k2) {
            u32x4 pw; pw.x = pk2(at[2 * k2][0], at[2 * k2][1]); pw.y = pk2(at[2 * k2][2], at[2 * k2][3]); pw.z = pk2(at[2 * k2 + 1][0], at[2 * k2 + 1][1]); pw.w = pk2(at[2 * k2 + 1][2], at[2 * k2 + 1][3]);
            const bf16x8 pf = __builtin_bit_cast(bf16x8, pw);
#pragma unroll
            for (int vt = 0; vt < 4; ++vt) { const LAS bf16* vp = VT + (64 * vh + 16 * vt + l15) * KT_LD + 32 * k2 + 4 * q;
                const u32x2 lo = *(const LAS u32x2*)vp, hi = *(const LAS u32x2*)(vp + 16);
                const bf16x8 av = __builtin_bit_cast(bf16x8, ((u32x4){lo.x, lo.y, hi.x, hi.y})); o[vt] = MFMA16(av, pf, o[vt]); }
        }
#pragma unroll
        for (int ks = 0; ks < 4; ++ks) { const bf16x8 bq = *(const LAS bf16x8*)(QS + (16 * it + l15) * QT_LD + 32 * ks + 8 * q);
#pragma unroll
            for (int vt = 0; vt < 4; ++vt) { const bf16x8 as = *(const LAS bf16x8*)(SB + (64 * vh + 16 * vt + l15) * QT_LD + 32 * ks + 8 * q); o[vt] = MFMA16(as, bq, o[vt]); } }
        float ss = 0.f;
#pragma unroll
        for (int vt = 0; vt < 4; ++vt) ss += (o[vt][0] * o[vt][0] + o[vt][1] * o[vt][1]) + (o[vt][2] * o[vt][2] + o[vt][3] * o[vt][3]);
        ss += __shfl_xor(ss, 16); ss += __shfl_xor(ss, 32);
        if (q == 0) ssq[vh * 64 + irow] = ss;
        LA_BAR();
        const float rs = rsqrtf((ssq[irow] + ssq[64 + irow]) * (1.f / 128.f) + RMS_EPS);
        const LAS float* gn = gnl + (hh < 4 ? 0 : 128);
        bf16* op = MIX + (size_t)(row0 + irow) * D + hh * 128;
#pragma unroll
        for (int vt = 0; vt < 4; ++vt) { const int v0 = 64 * vh + 16 * vt + 4 * q; const f32x4 gv = *(const LAS f32x4*)(gn + v0); const u32x2 gw = *(const LAS u32x2*)(GB + irow * QT_LD + v0);
            u32x2 ow; ow.x = pk2(o[vt][0] * rs * gv.x * siluf_(bflo(gw.x)), o[vt][1] * rs * gv.y * siluf_(bfhi(gw.x)));
            ow.y = pk2(o[vt][2] * rs * gv.z * siluf_(bflo(gw.y)), o[vt][3] * rs * gv.w * siluf_(bfhi(gw.y))); *(u32x2*)(op + v0) = ow; }
        LA_BAR();
        A3_STORE()
        R.lba = lba; R.lbb = lbb;
        LA_BAR();
    }
#undef A3_FETCH
#undef A3_STORE
}

DI void la_range_state(const bf16* Y0, const float* lbraw, float* SR, float* DT, LAS unsigned char* lds) {
    LAS bf16* KT = (LAS bf16*)lds; LAS bf16* VT = KT + 128 * KT_LD; LAS float* tot = (LAS float*)(VT + 128 * KT_LD); LAS float* decl = tot + 512;
    LAS bf16* RF = KT; LAS bf16* RV = VT;
    const int tid = threadIdx.x, lane = tid & 63, w = tid >> 6, l15 = lane & 15, q = lane >> 4, d = tid & 127, rg = tid >> 7;
    const int wgi = blockIdx.x, unit0 = (wgi >> 3) * 128 + (wgi & 7) * 16;
    u32x4 rf[2], rv[2]; float lba, lbb;
#define R1_FETCH(un) { const bf16* yb_ = Y0 + ((size_t)(un) << 15); const int li_ = ((((un) >> 7) & 3) << 7) + d; \
        _Pragma("unroll") for (int c_ = 0; c_ < 2; ++c_) { rf[c_] = *(const u32x4*)(yb_ + 8192 + (size_t)(tid + 512 * c_) * 8); rv[c_] = *(const u32x4*)(yb_ + 16384 + (size_t)(tid + 512 * c_) * 8); } \
        lba = lbraw[li_]; lbb = lbraw[512 + li_]; asm volatile("" ::: "memory"); }
#define R1_STORE() { _Pragma("unroll") for (int c_ = 0; c_ < 2; ++c_) { *LA_CH_LDS(RF, tid + 512 * c_) = rf[c_]; *LA_CH_LDS(RV, tid + 512 * c_) = rv[c_]; } }
    R1_FETCH(unit0)
    R1_STORE()
    LaRaw R; R.lba = lba; R.lbb = lbb;
    f32x4 acc[8];
#pragma unroll
    for (int dt = 0; dt < 8; ++dt) acc[dt] = (f32x4){0.f, 0.f, 0.f, 0.f};
    float dtot = 1.f;
    LA_BAR();
    for (int c = 0; c < 16; ++c) {
        const int unit = unit0 + c, hh = (unit >> 7) & 7;
        { const int un = c + 1 < 16 ? unit + 1 : unit; R1_FETCH(un) }
        la_read_col(RF, d, rg, R.f); la_read_col(RV, d, rg, R.v);
        LA_BAR();
        float fd[16], kk[16], qq[16];
        la_math<false>(R, hh, fd, kk, qq);
        float run = 1.f;
#pragma unroll
        for (int e = 15; e >= 0; --e) { kk[e] *= run; run *= fd[e]; }
        tot[rg * 128 + d] = run;
        la_store_vt(R, d, rg, VT);
        LA_BAR();
        float post = 1.f, last = 1.f;
#pragma unroll
        for (int g2 = 0; g2 < 4; ++g2) { const float tv = tot[g2 * 128 + d]; if (g2 > rg) post *= tv; last *= tv; }
        unsigned wv[8];
#pragma unroll
        for (int e = 0; e < 8; ++e) wv[e] = pk2(kk[2 * e] * post, kk[2 * e + 1] * post);
        LAS u32x4* dst = (LAS u32x4*)(KT + d * KT_LD + 16 * rg);
        dst[0] = (u32x4){wv[0], wv[1], wv[2], wv[3]}; dst[1] = (u32x4){wv[4], wv[5], wv[6], wv[7]};
        if (rg == 0) { decl[d] = last; dtot *= last; }
        LA_BAR();
#pragma unroll
        for (int dt = 0; dt < 8; ++dt) { const f32x4 dv = *(const LAS f32x4*)(decl + 16 * dt + 4 * q); acc[dt][0] *= dv.x; acc[dt][1] *= dv.y; acc[dt][2] *= dv.z; acc[dt][3] *= dv.w; }
#pragma unroll
        for (int ks = 0; ks < 2; ++ks) { const bf16x8 bv = *(const LAS bf16x8*)(VT + (16 * w + l15) * KT_LD + 32 * ks + 8 * q);
#pragma unroll
            for (int dt = 0; dt < 8; ++dt) { const bf16x8 ak = *(const LAS bf16x8*)(KT + (16 * dt + l15) * KT_LD + 32 * ks + 8 * q); acc[dt] = MFMA16(ak, bv, acc[dt]); } }
        LA_BAR();
        R1_STORE()
        R.lba = lba; R.lbb = lbb;
        LA_BAR();
    }
    float* so = SR + (size_t)wgi * 16384 + (16 * w + l15) * 128 + 4 * q;
#pragma unroll
    for (int dt = 0; dt < 8; ++dt) *(f32x4*)(so + 16 * dt) = acc[dt];
    if (rg == 0) DT[(size_t)wgi * 128 + d] = dtot;
#undef R1_FETCH
#undef R1_STORE
}
DI void la_range_scan(float* SR, const float* DT) {
    const int gid = blockIdx.x * 512 + threadIdx.x;
    const int bh = gid >> 12, e4 = (gid & 4095) * 4, d = e4 & 127;
    f32x4 s = {0.f, 0.f, 0.f, 0.f};
    float* sp = SR + (size_t)bh * 8 * 16384 + e4; const float* dp = DT + (size_t)bh * 8 * 128 + d;
    f32x4 uv[8], dv[8];
#pragma unroll
    for (int i = 0; i < 8; ++i) { uv[i] = *(const f32x4*)(sp + (size_t)i * 16384); dv[i] = *(const f32x4*)(dp + (size_t)i * 128); }
#pragma unroll
    for (int i = 0; i < 8; ++i) { *(f32x4*)(sp + (size_t)i * 16384) = s; s = dv[i] * s + uv[i]; }
}
DI void la_range_out(const bf16* Y0, const float* lbraw, const float* SR, const float* gh, const float* gr, bf16* MIX, LAS unsigned char* lds) {
    LAS bf16* QT = (LAS bf16*)lds; LAS bf16* K2 = QT + 64 * QT_LD; LAS bf16* QS = K2 + 64 * QT_LD; LAS bf16* VT = QS + 64 * QT_LD;
    LAS float* tot = (LAS float*)(VT + 128 * KT_LD); LAS float* ssq = tot + 512; LAS float* gnl = ssq + 128;
    LAS bf16* SB = (LAS bf16*)(gnl + 256);
    LAS bf16* GB = SB + 128 * QT_LD;
    LAS bf16* KT = GB + 64 * QT_LD;
    LAS float* decl = (LAS float*)(KT + 128 * KT_LD);
    LAS bf16* RQ = QT; LAS bf16* RF = K2; LAS bf16* RV = QS;
    const int tid = threadIdx.x, lane = tid & 63, w = tid >> 6, l15 = lane & 15, q = lane >> 4, d = tid & 127, rg = tid >> 7;
    const int it = w & 3, vh = w >> 2;
    const int irow = 16 * it + l15;
    const int wgi = blockIdx.x, unit0 = (wgi >> 3) * 128 + (wgi & 7) * 16;
    if (tid < 256) gnl[tid] = tid < 128 ? gh[tid] : gr[tid - 128];
    u32x4 rr[6], g2r[2]; float lba, lbb;
#define R3_FETCH(un) { const bf16* yb_ = Y0 + ((size_t)(un) << 15); const int li_ = ((((un) >> 7) & 3) << 7) + d; \
        _Pragma("unroll") for (int c_ = 0; c_ < 2; ++c_) { rr[c_] = *(const u32x4*)(yb_ + (size_t)(tid + 512 * c_) * 8); rr[2 + c_] = *(const u32x4*)(yb_ + 8192 + (size_t)(tid + 512 * c_) * 8); \
            rr[4 + c_] = *(const u32x4*)(yb_ + 16384 + (size_t)(tid + 512 * c_) * 8); g2r[c_] = *(const u32x4*)(yb_ + 24576 + (size_t)(tid + 512 * c_) * 8); } \
        lba = lbraw[li_]; lbb = lbraw[512 + li_]; asm volatile("" ::: "memory"); }
#define R3_STORE() { _Pragma("unroll") for (int c_ = 0; c_ < 2; ++c_) { const int ch_ = tid + 512 * c_; *LA_CH_LDS(RQ, ch_) = rr[c_]; *LA_CH_LDS(RF, ch_) = rr[2 + c_]; *LA_CH_LDS(RV, ch_) = rr[4 + c_]; *LA_CH_LDS(GB, ch_) = g2r[c_]; } }
    R3_FETCH(unit0)
    R3_STORE()
    LaRaw R; R.lba = lba; R.lbb = lbb;
    f32x4 sacc[8];
    { const float* si = SR + (size_t)wgi * 16384 + (16 * w + l15) * 128 + 4 * q;
#pragma unroll
      for (int dt = 0; dt < 8; ++dt) sacc[dt] = *(const f32x4*)(si + 16 * dt); }
    LA_BAR();
    for (int c = 0; c < 16; ++c) {
        const int unit = unit0 + c;
        const int b = unit >> 10, hh = (unit >> 7) & 7, n = unit & 127;
        const int row0 = b * T + n * 64;
        { const int un = c + 1 < 16 ? unit + 1 : unit; R3_FETCH(un) }
        la_read_col(RQ, d, rg, R.qv); la_read_col(RF, d, rg, R.f); la_read_col(RV, d, rg, R.v);
        LA_BAR();
        float fd[16], kk[16], qq[16];
        la_math<true>(R, hh, fd, kk, qq);
        float run = 1.f;
#pragma unroll
        for (int e = 0; e < 16; ++e) { run *= fd[e]; fd[e] = run; }
        tot[rg * 128 + d] = run;
        la_store_vt(R, d, rg, VT);
#pragma unroll
        for (int dt = 0; dt < 8; ++dt) { u32x2 o; o.x = pk2(sacc[dt][0], sacc[dt][1]); o.y = pk2(sacc[dt][2], sacc[dt][3]); *(LAS u32x2*)(SB + (16 * w + l15) * QT_LD + 16 * dt + 4 * q) = o; }
        LA_BAR();
        float pre = 1.f;
#pragma unroll
        for (int g2 = 0; g2 < 4; ++g2) { const float tv = tot[g2 * 128 + d]; if (g2 < rg) pre *= tv; }
        const float ref = tot[d] * tot[128 + d], iref = __builtin_amdgcn_rcpf(ref), plast = ref * (tot[256 + d] * tot[384 + d]);
        unsigned ktw[8];
#pragma unroll
        for (int e = 0; e < 16; ++e) { const float P = pre * fd[e], qP = qq[e] * P, kiP = kk[e] * __builtin_amdgcn_rcpf(P); const int j = 16 * rg + e;
            QT[j * QT_LD + d] = f2bf(qP * iref); K2[j * QT_LD + d] = f2bf(kiP * ref); QS[j * QT_LD + d] = f2bf(qP);
            const unsigned kb_ = (unsigned)f2bf(kiP * plast); if (e & 1) ktw[e >> 1] |= kb_ << 16; else ktw[e >> 1] = kb_; }
        { LAS u32x4* dst = (LAS u32x4*)(KT + d * KT_LD + 16 * rg); dst[0] = (u32x4){ktw[0], ktw[1], ktw[2], ktw[3]}; dst[1] = (u32x4){ktw[4], ktw[5], ktw[6], ktw[7]}; }
        if (rg == 0) decl[d] = plast;
        LA_BAR();
        f32x4 at[4];
#pragma unroll
        for (int jt = 0; jt < 4; ++jt) at[jt] = (f32x4){0.f, 0.f, 0.f, 0.f};
#pragma unroll
        for (int ks = 0; ks < 4; ++ks) { const bf16x8 bq = *(const LAS bf16x8*)(QT + (16 * it + l15) * QT_LD + 32 * ks + 8 * q);
#pragma unroll
            for (int jt = 0; jt < 4; ++jt) { const bf16x8 ak = *(const LAS bf16x8*)(K2 + (16 * jt + l15) * QT_LD + 32 * ks + 8 * q); at[jt] = MFMA16(ak, bq, at[jt]); } }
#pragma unroll
        for (int jt = 0; jt < 4; ++jt)
#pragma unroll
            for (int r = 0; r < 4; ++r) { const int j = 16 * jt + 4 * q + r; if (j > irow) at[jt][r] = 0.f; }
        f32x4 o[4];
#pragma unroll
        for (int vt = 0; vt < 4; ++vt) o[vt] = (f32x4){0.f, 0.f, 0.f, 0.f};
#pragma unroll
        for (int k2 = 0; k2 < 2; ++k2) {
            u32x4 pw; pw.x = pk2(at[2 * k2][0], at[2 * k2][1]); pw.y = pk2(at[2 * k2][2], at[2 * k2][3]); pw.z = pk2(at[2 * k2 + 1][0], at[2 * k2 + 1][1]); pw.w = pk2(at[2 * k2 + 1][2], at[2 * k2 + 1][3]);
            const bf16x8 pf = __builtin_bit_cast(bf16x8, pw);
#pragma unroll
            for (int vt = 0; vt < 4; ++vt) { const LAS bf16* vp = VT + (64 * vh + 16 * vt + l15) * KT_LD + 32 * k2 + 4 * q;
                const u32x2 lo = *(const LAS u32x2*)vp, hi = *(const LAS u32x2*)(vp + 16);
                const bf16x8 av = __builtin_bit_cast(bf16x8, ((u32x4){lo.x, lo.y, hi.x, hi.y})); o[vt] = MFMA16(av, pf, o[vt]); }
        }
#pragma unroll
        for (int ks = 0; ks < 4; ++ks) { const bf16x8 bq = *(const LAS bf16x8*)(QS + (16 * it + l15) * QT_LD + 32 * ks + 8 * q);
#pragma unroll
            for (int vt = 0; vt < 4; ++vt) { const bf16x8 as = *(const LAS bf16x8*)(SB + (64 * vh + 16 * vt + l15) * QT_LD + 32 * ks + 8 * q); o[vt] = MFMA16(as, bq, o[vt]); } }
        float ss = 0.f;
#pragma unroll
        for (int vt = 0; vt < 4; ++vt) ss += (o[vt][0] * o[vt][0] + o[vt][1] * o[vt][1]) + (o[vt][2] * o[vt][2] + o[vt][3] * o[vt][3]);
        ss += __shfl_xor(ss, 16); ss += __shfl_xor(ss, 32);
        if (q == 0) ssq[vh * 64 + irow] = ss;
#pragma unroll
        for (int dt = 0; dt < 8; ++dt) { const f32x4 dv = *(const LAS f32x4*)(decl + 16 * dt + 4 * q); sacc[dt][0] *= dv.x; sacc[dt][1] *= dv.y; sacc[dt][2] *= dv.z; sacc[dt][3] *= dv.w; }
#pragma unroll
        for (int ks = 0; ks < 2; ++ks) { const bf16x8 bv = *(const LAS bf16x8*)(VT + (16 * w + l15) * KT_LD + 32 * ks + 8 * q);
#pragma unroll
            for (int dt = 0; dt < 8; ++dt) { const bf16x8 ak = *(const LAS bf16x8*)(KT + (16 * dt + l15) * KT_LD + 32 * ks + 8 * q); sacc[dt] = MFMA16(ak, bv, sacc[dt]); } }
        LA_BAR();
        const float rs = rsqrtf((ssq[irow] + ssq[64 + irow]) * (1.f / 128.f) + RMS_EPS);
        const LAS float* gn = gnl + (hh < 4 ? 0 : 128);
        bf16* op = MIX + (size_t)(row0 + irow) * D + hh * 128;
#pragma unroll
        for (int vt = 0; vt < 4; ++vt) { const int v0 = 64 * vh + 16 * vt + 4 * q; const f32x4 gv = *(const LAS f32x4*)(gn + v0); const u32x2 gw = *(const LAS u32x2*)(GB + irow * QT_LD + v0);
            u32x2 ow; ow.x = pk2(o[vt][0] * rs * gv.x * siluf_(bflo(gw.x)), o[vt][1] * rs * gv.y * siluf_(bfhi(gw.x)));
            ow.y = pk2(o[vt][2] * rs * gv.z * siluf_(bflo(gw.y)), o[vt][3] * rs * gv.w * siluf_(bfhi(gw.y))); *(u32x2*)(op + v0) = ow; }
        LA_BAR();
        R3_STORE()
        R.lba = lba; R.lbb = lbb;
        LA_BAR();
    }
#undef R3_FETCH
#undef R3_STORE
}
constexpr int NC = 511, NCP = 512;
DI void nsa_compress_phase(const bf16* Y1, const float* posk, const float* posv, const bf16* w1kT, const bf16* w1vT, const bf16* w2kT, const bf16* w2vT,
                           bf16* KCMP, bf16* VCMPT, LAS unsigned char* lds, int gw, int ngw, int lane) {
    const int l15 = lane & 15, q = lane >> 4, wv = (threadIdx.x >> 6), grp = wv >> 2, nt = wv & 3;
    LAS bf16* h1s = (LAS bf16*)lds + grp * 16 * 72;
    for (int base = 0; base < 512; base += ngw / 4) {
        int task = base + (gw >> 2); const bool tvalid = task < 512; if (!tvalid) task = 511;
        const int kv = task & 1, rt = task >> 1;
        int r = rt * 16 + l15; const bool rvalid = tvalid && (r < NB * NC * 2); if (r >= NB * NC * 2) r = NB * NC * 2 - 1;
        const int b = r / (NC * 2), rem = r % (NC * 2), i = rem >> 1, g = rem & 1;
        const bf16* src = Y1 + (size_t)(b * T + 16 * i) * OINP + (kv ? 1152 : 1024) + g * 64;
        const float* pos = kv ? posv : posk; const bf16* w1 = (kv ? w1vT : w1kT) + (size_t)(16 * nt + l15) * 2048; const bf16* w2 = kv ? w2vT : w2kT;
        f32x4 acc = {0.f, 0.f, 0.f, 0.f};
#pragma unroll 8
        for (int ks = 0; ks < 64; ++ks) {
            const int p = ks >> 1, d0 = (ks & 1) * 32 + 8 * q;
            const u32x4 xv = *(const u32x4*)(src + (size_t)p * OINP + d0);
            const f32x4 p0 = *(const f32x4*)(pos + p * 64 + d0), p1 = *(const f32x4*)(pos + p * 64 + d0 + 4);
            u32x4 bw; bw.x = pk2(bflo(xv.x) + p0.x, bfhi(xv.x) + p0.y); bw.y = pk2(bflo(xv.y) + p0.z, bfhi(xv.y) + p0.w);
            bw.z = pk2(bflo(xv.z) + p1.x, bfhi(xv.z) + p1.y); bw.w = pk2(bflo(xv.w) + p1.z, bfhi(xv.w) + p1.w);
            const bf16x8 af = *(const bf16x8*)(w1 + 32 * ks + 8 * q);
            acc = MFMA16(af, __builtin_bit_cast(bf16x8, bw), acc);
        }
        { u32x2 hw; hw.x = pk2(siluf_(acc[0]), siluf_(acc[1])); hw.y = pk2(siluf_(acc[2]), siluf_(acc[3])); *(LAS u32x2*)(h1s + l15 * 72 + 16 * nt + 4 * q) = hw; }
        __syncthreads();
        f32x4 o2 = {0.f, 0.f, 0.f, 0.f};
#pragma unroll
        for (int k2 = 0; k2 < 2; ++k2) { const bf16x8 bf = *(const LAS bf16x8*)(h1s + l15 * 72 + 32 * k2 + 8 * q);
            const bf16x8 av = *(const bf16x8*)(w2 + (16 * nt + l15) * 64 + 32 * k2 + 8 * q); o2 = MFMA16(av, bf, o2); }
        if (rvalid) {
            if (kv == 0) { u32x2 ow; ow.x = pk2(o2[0], o2[1]); ow.y = pk2(o2[2], o2[3]); *(u32x2*)(KCMP + ((size_t)(b * 2 + g) * NCP + i) * 64 + 16 * nt + 4 * q) = ow; }
            else { bf16* op = VCMPT + (size_t)(b * 2 + g) * 64 * NCP + i;
#pragma unroll
                for (int r2 = 0; r2 < 4; ++r2) op[(size_t)(16 * nt + 4 * q + r2) * NCP] = f2bf(o2[r2]); }
        }
        __syncthreads();
    }
    for (int z = gw * 64 + lane; z < NB * 2 * 64; z += ngw * 64) { const int bg = z >> 6, dd = z & 63; KCMP[((size_t)bg * NCP + NC) * 64 + dd] = 0; VCMPT[((size_t)bg * 64 + dd) * NCP + NC] = 0; }
}
DI void nsa_vt_phase(const bf16* Y1, bf16* VST, bf16* VWT, int gw, int ngw, int lane) {
    for (int task = gw; task < 2 * NB * 2 * 128; task += ngw) {
        const int which = task & 1, g = (task >> 1) & 1, b = (task >> 2) & 3, blk = task >> 4;
        const int t = blk * 64 + lane;
        const bf16* src = Y1 + (size_t)(b * T + t) * OINP + (which ? 1664 : 1408) + g * 64;
        bf16* dst = (which ? VWT : VST) + (size_t)(b * 2 + g) * 64 * T + (t & ~1);
        u32x4 v[8];
#pragma unroll
        for (int c = 0; c < 8; ++c) v[c] = *(const u32x4*)(src + 8 * c);
        const bool odd = lane & 1;
#pragma unroll
        for (int c = 0; c < 8; ++c)
#pragma unroll
            for (int i = 0; i < 4; ++i) { const unsigned wd = v[c][i]; const int w = 4 * c + i;
                const unsigned recv = (unsigned)__shfl_xor((int)(odd ? (wd & 0xffffu) : (wd >> 16)), 1);
                const unsigned outw = odd ? (recv | (wd & 0xffff0000u)) : ((wd & 0xffffu) | (recv << 16));
                *(unsigned*)(dst + (size_t)(2 * w + (odd ? 1 : 0)) * T) = outw; }
    }
}
#define LDS_BAR() do { asm volatile("s_waitcnt lgkmcnt(0)" ::: "memory"); __builtin_amdgcn_s_barrier(); asm volatile("" ::: "memory"); } while (0)
constexpr int TL = 80;
constexpr int SLAB_LD = 132;
constexpr float C1 = 0.125f * LOG2E;
DI void tile_fetch(const bf16* kg, int ldk, const bf16* vg, int ldv, int tid, u32x4& kr, u32x4& vr) {
    const int r = tid >> 3, c = (tid & 7) * 8;
    kr = *(const u32x4*)(kg + (size_t)r * ldk + c); vr = *(const u32x4*)(vg + (size_t)r * ldv + c);
    asm volatile("" ::: "memory");
}
DI void tile_store(LAS bf16* Kb, LAS bf16* Vb, int tid, u32x4 kr, u32x4 vr) {
    const int r = tid >> 3, c = (tid & 7) * 8;
    *(LAS u32x4*)(Kb + r * TL + c) = kr;
    const int g32 = c & 32, k0 = c & 31, k1 = k0 + 4;
    const int p0 = 8 * ((k0 & 15) >> 2) + 4 * (k0 >> 4), p1 = 8 * ((k1 & 15) >> 2) + 4 * (k1 >> 4);
    *(LAS u32x2*)(Vb + r * TL + g32 + p0) = (u32x2){vr.x, vr.y}; *(LAS u32x2*)(Vb + r * TL + g32 + p1) = (u32x2){vr.z, vr.w};
}
DI void tile_scores(const LAS bf16* Kb, const bf16x8 (&qf)[2], int l15, int q, f32x4 (&sc)[4]) {
    bf16x8 a[4][2];
#pragma unroll
    for (int x = 0; x < 4; ++x)
#pragma unroll
        for (int ks = 0; ks < 2; ++ks) a[x][ks] = *(const LAS bf16x8*)(Kb + (16 * x + l15) * TL + 32 * ks + 8 * q);
    __builtin_amdgcn_s_setprio(1);
#pragma unroll
    for (int x = 0; x < 4; ++x) { sc[x] = (f32x4){0.f, 0.f, 0.f, 0.f};
#pragma unroll
        for (int ks = 0; ks < 2; ++ks) sc[x] = MFMA16(a[x][ks], qf[ks], sc[x]); }
    __builtin_amdgcn_s_setprio(0);
}
template <bool ROWSUM = false>
DI void tile_pv(const LAS bf16* Vb, const float (&p)[16], f32x4 (&acc)[4], int l15, int q, f32x4* accs = nullptr) {
#pragma unroll
    for (int k2 = 0; k2 < 2; ++k2) {
        u32x4 pw; pw.x = pk2(p[8 * k2], p[8 * k2 + 1]); pw.y = pk2(p[8 * k2 + 2], p[8 * k2 + 3]); pw.z = pk2(p[8 * k2 + 4], p[8 * k2 + 5]); pw.w = pk2(p[8 * k2 + 6], p[8 * k2 + 7]);
        const bf16x8 pf = __builtin_bit_cast(bf16x8, pw);
        bf16x8 av[4];
#pragma unroll
        for (int dt = 0; dt < 4; ++dt) av[dt] = *(const LAS bf16x8*)(Vb + (16 * dt + l15) * TL + 32 * k2 + 8 * q);
        __builtin_amdgcn_s_setprio(1);
#pragma unroll
        for (int dt = 0; dt < 4; ++dt) acc[dt] = MFMA16(av[dt], pf, acc[dt]);
        if (ROWSUM) { const u32x4 ow = {0x3f803f80u, 0x3f803f80u, 0x3f803f80u, 0x3f803f80u};
            *accs = MFMA16(__builtin_bit_cast(bf16x8, ow), pf, *accs); }
        __builtin_amdgcn_s_setprio(0);
    }
}
template <bool MASKED, int KS>
DI float tile_probs(const f32x4 (&sc)[4], float (&p)[16], int d0, float slope2, unsigned lim, bool extra) {
    const float A = (MASKED || extra) ? -slope2 * (float)d0 : -INFINITY;
    const float r1 = slope2 * (float)KS, r2 = slope2 * (float)(2 * KS), r3 = slope2 * (float)(3 * KS);
    float psa = 0.f, psb = 0.f;
#pragma unroll
    for (int x = 0; x < 4; ++x) { const float bx = slope2 * (float)(16 * KS * x) + A;
        float v0 = sc[x][0] * C1 + bx, v1 = sc[x][1] * C1 + (bx + r1), v2 = sc[x][2] * C1 + (bx + r2), v3 = sc[x][3] * C1 + (bx + r3);
        asm("" : "+v"(v0)); asm("" : "+v"(v1)); asm("" : "+v"(v2)); asm("" : "+v"(v3));
        if (MASKED) { const int kb = 16 * KS * x;
            v0 = (extra && ((unsigned)(d0 - kb) < lim)) ? v0 : -INFINITY; v1 = (extra && ((unsigned)(d0 - kb - KS) < lim)) ? v1 : -INFINITY;
            v2 = (extra && ((unsigned)(d0 - kb - 2 * KS) < lim)) ? v2 : -INFINITY; v3 = (extra && ((unsigned)(d0 - kb - 3 * KS) < lim)) ? v3 : -INFINITY; }
        float p0 = ex2(v0), p1 = ex2(v1), p2 = ex2(v2), p3 = ex2(v3);
        asm("" : "+v"(p0)); asm("" : "+v"(p1)); asm("" : "+v"(p2)); asm("" : "+v"(p3));
        psa += p0; psb += p1; psa += p2; psb += p3;
        p[4 * x] = p0; p[4 * x + 1] = p1; p[4 * x + 2] = p2; p[4 * x + 3] = p3; }
    return psa + psb;
}
template <bool MASKED>
DI void tile_step(const LAS bf16* Kb, const LAS bf16* Vb, const bf16x8 (&qf)[2], f32x4 (&acc)[4], f32x4& lp, int d0, float slope2, unsigned lim, bool extra, int l15, int q) {
    f32x4 sc[4]; tile_scores(Kb, qf, l15, q, sc);
    float p[16]; (void)tile_probs<MASKED, 1>(sc, p, d0, slope2, lim, extra);
    tile_pv<true>(Vb, p, acc, l15, q, &lp);
}
DI void nsa_attn_phase(const bf16* Y1, const bf16* KCMP, const bf16* VCMPT, const bf16* VST, const bf16* VWT, bf16* MIX, LAS unsigned char* lds) {
    LAS bf16* KB0 = (LAS bf16*)lds;
    LAS bf16* VB0 = KB0 + 4 * 64 * TL;
    LAS float* slab = (LAS float*)(lds + 8 * 64 * TL * 2);
    LAS unsigned* selm = (LAS unsigned*)(slab + 8 * 16 * SLAB_LD);
    LAS unsigned* blist = selm + 64;
    LAS float* invl = (LAS float*)(blist + 132);
    const int tid = threadIdx.x, lane = tid & 63, w = tid >> 6, l15 = lane & 15, q = lane >> 4;
    LAS float* myslab = slab + w * 16 * SLAB_LD;
#define KSLOT(i) (KB0 + ((i) & 3) * 64 * TL)
#define VSLOT(i) (VB0 + ((i) & 3) * 64 * TL)
#define PAIR_PIPE(n, FETCH, COMP1, COMP2) { \
        FETCH(0, kr0, vr0) FETCH(1, kr1, vr1) tile_store(KSLOT(0), VSLOT(0), tid, kr0, vr0); tile_store(KSLOT(1), VSLOT(1), tid, kr1, vr1); \
        FETCH(2, kr0, vr0) FETCH(3, kr1, vr1) \
        LDS_BAR(); \
        int i_ = 0; \
        for (; i_ + 1 < (n); i_ += 2) { \
            COMP2(i_, i_ + 1) \
            tile_store(KSLOT(i_ + 2), VSLOT(i_ + 2), tid, kr0, vr0); tile_store(KSLOT(i_ + 3), VSLOT(i_ + 3), tid, kr1, vr1); \
            FETCH(i_ + 4, kr0, vr0) FETCH(i_ + 5, kr1, vr1) \
            LDS_BAR(); } \
        if (i_ < (n)) { COMP1(i_) LDS_BAR(); } }
    constexpr int NUNITS = NB * 2 * (T / 16);
#define NSA_TILE(u_, tile_) { tile_ = (u_) >> 3; \
        if ((int)gridDim.x == 256) { const int wq_ = (int)blockIdx.x >> 3, k_ = (u_) >> 8;        \
            tile_ = k_ < 2 ? 2 * wq_ + k_ : (k_ < 9 ? 64 + 7 * wq_ + (k_ - 2) : 511 - (7 * wq_ + (k_ - 9))); } }
    bf16x8 qfN[2]; unsigned glN[3];
#define NSA_FETCH_Q(u_) { const int b_ = (u_) & 3, g_ = ((u_) >> 2) & 1; int tile_; NSA_TILE(u_, tile_) const size_t row_ = (size_t)b_ * T + tile_ * 16 + l15; const int h_ = g_ * 8 + w; \
        qfN[0] = *(const bf16x8*)(Y1 + row_ * OINP + h_ * 64 + 8 * q); qfN[1] = *(const bf16x8*)(Y1 + row_ * OINP + h_ * 64 + 32 + 8 * q); \
        const bf16* gl_ = Y1 + row_ * OINP + 1792 + h_ * 3; glN[0] = gl_[0]; glN[1] = gl_[1]; glN[2] = gl_[2]; asm volatile("" ::: "memory"); }
    if ((int)blockIdx.x < NUNITS) NSA_FETCH_Q((int)blockIdx.x)
    for (int u = blockIdx.x; u < NUNITS; u += gridDim.x) {
        const int b = u & 3, g = (u >> 2) & 1;
        int tile; NSA_TILE(u, tile)
        const int t0 = tile * 16, qblk = t0 >> 6;
        const int h = g * 8 + w; const float slope = exp2f(-0.5f * (float)(h + 1)), slope2 = slope * LOG2E;
        const int t = t0 + l15; const size_t row = (size_t)b * T + t;
        bf16x8 qf[2]; qf[0] = qfN[0]; qf[1] = qfN[1];
        const float g0 = sigmoidf_(bf2f((bf16)glN[0])), g1 = sigmoidf_(bf2f((bf16)glN[1])), g2 = sigmoidf_(bf2f((bf16)glN[2]));
        { const int un_ = u + (int)gridDim.x < NUNITS ? u + (int)gridDim.x : u; NSA_FETCH_Q(un_) }
        f32x4 ot[4];
        u32x4 kr0, vr0, kr1, vr1;
        {
            const bf16* kc = KCMP + (size_t)(b * 2 + g) * NCP * 64; const bf16* vct = VCMPT + (size_t)(b * 2 + g) * 64 * NCP;
            const int nst = tile >= 1 ? ((tile - 1) >> 6) + 1 : 0;
            const int dc = t - 31 - 64 * q;
            float lp = 0.f, carry = 0.f;
            f32x4 acc[4];
#pragma unroll
            for (int dt = 0; dt < 4; ++dt) acc[dt] = (f32x4){0.f, 0.f, 0.f, 0.f};
            float inv = 0.f;
#define CMP_FETCH(idx, KR, VR) { const int i2_ = (idx) < nst ? (idx) : nst - 1; tile_fetch(kc + (size_t)(64 * i2_) * 64, 64, vct + 64 * i2_, NCP, tid, KR, VR); }
#define CMP_COMP1(s) { \
                f32x4 sc[4]; tile_scores(KSLOT(s), qf, l15, q, sc); \
                float sv[16]; \
                const int d0 = dc - 1024 * (s); \
                if (64 * (s) + 63 <= tile - 2) lp += tile_probs<false, 16>(sc, sv, d0, slope2, 0x7fffffffu, true); \
                else lp += tile_probs<true, 16>(sc, sv, d0, slope2, 0x7fffffffu, true); \
                _Pragma("unroll") for (int x = 0; x < 4; ++x) { const float hf_ = 0.5f * sv[4 * x + 3]; \
                    const float up_ = __shfl(hf_, (lane + 48) & 63);     \
                    myslab[l15 * SLAB_LD + 16 * (s) + 4 * x + q] = ((sv[4 * x] + sv[4 * x + 1]) + (sv[4 * x + 2] + hf_)) + (q > 0 ? up_ : carry); \
                    carry = up_; } \
                tile_pv(VSLOT(s), sv, acc, l15, q); }
#define CMP_COMP2(s, s2) { CMP_COMP1(s) CMP_COMP1(s2) }
            if (nst > 0) PAIR_PIPE(nst, CMP_FETCH, CMP_COMP1, CMP_COMP2)
#undef CMP_FETCH
#undef CMP_COMP1
#undef CMP_COMP2
            { float l = lp; l += __shfl_xor(l, 16); l += __shfl_xor(l, 32); inv = l > 0.f ? 1.0f / l : 0.f;
              if (q == 0) { invl[w * 16 + l15] = inv; myslab[l15 * SLAB_LD + 16 * nst] = carry; } }
            const float gi = g0 * inv;
#pragma unroll
            for (int dt = 0; dt < 4; ++dt) { ot[dt][0] = gi * acc[dt][0]; ot[dt][1] = gi * acc[dt][1]; ot[dt][2] = gi * acc[dt][2]; ot[dt][3] = gi * acc[dt][3]; }
        }
        LDS_BAR();
        unsigned u0 = 0, u1 = 0, u2 = 0, u3 = 0, am0 = 0, am1 = 0, am2 = 0, am3 = 0;
        {
            const int tokA = 2 * w, tokB = 2 * w + 1;
            float sA0 = 0.f, sA1 = 0.f, sB0 = 0.f, sB1 = 0.f;
#pragma unroll
            for (int ww = 0; ww < 8; ++ww) { const float ilA = invl[ww * 16 + tokA], ilB = invl[ww * 16 + tokB];
                sA0 += slab[(ww * 16 + tokA) * SLAB_LD + lane] * ilA; sA1 += slab[(ww * 16 + tokA) * SLAB_LD + lane + 64] * ilA;
                sB0 += slab[(ww * 16 + tokB) * SLAB_LD + lane] * ilB; sB1 += slab[(ww * 16 + tokB) * SLAB_LD + lane + 64] * ilB; }
            const int j0 = lane, j1 = lane + 64;
            const bool v0 = j0 <= qblk, v1 = j1 <= qblk;
            const bool f0 = (j0 == 0) || (j0 == qblk) || (j0 == qblk - 1), f1 = (j1 == qblk) || (j1 == qblk - 1);
            const unsigned kA0 = f0 ? 0x7f000000u : __float_as_uint(sA0), kA1 = f1 ? 0x7f000000u : __float_as_uint(sA1);
            const unsigned kB0 = f0 ? 0x7f000000u : __float_as_uint(sB0), kB1 = f1 ? 0x7f000000u : __float_as_uint(sB1);
            unsigned TA = 0u, TB = 0u;
#pragma unroll 1
            for (int bit = 30; bit >= 0; --bit) { const unsigned trA = TA | (1u << bit), trB = TB | (1u << bit);
                const int cA = __popcll(__ballot(v0 && kA0 >= trA)) + __popcll(__ballot(v1 && kA1 >= trA));
                const int cB = __popcll(__ballot(v0 && kB0 >= trB)) + __popcll(__ballot(v1 && kB1 >= trB));
                if (cA >= 16) TA = trA; if (cB >= 16) TB = trB; }
            const unsigned long long lt = (1ull << lane) - 1ull;
#define SEL_FINISH(tok, k0, k1, Tk) { \
                const bool gt0 = v0 && k0 > Tk, gt1 = v1 && k1 > Tk, eq0 = v0 && k0 == Tk, eq1 = v1 && k1 == Tk; \
                const unsigned long long mq0 = __ballot(eq0), mq1 = __ballot(eq1); \
                const int need = 16 - (__popcll(__ballot(gt0)) + __popcll(__ballot(gt1))); \
                const int r0 = __popcll(mq0 & lt), r1 = __popcll(mq0) + __popcll(mq1 & lt);        \
                const unsigned long long m0 = __ballot(gt0 || (eq0 && r0 < need)), m1 = __ballot(gt1 || (eq1 && r1 < need)); \
                if (lane == 0) { selm[(tok) * 4 + 0] = (unsigned)m0; selm[(tok) * 4 + 1] = (unsigned)(m0 >> 32); selm[(tok) * 4 + 2] = (unsigned)m1; selm[(tok) * 4 + 3] = (unsigned)(m1 >> 32); } }
            SEL_FINISH(tokA, kA0, kA1, TA)
            SEL_FINISH(tokB, kB0, kB1, TB)
#undef SEL_FINISH
        }
        LDS_BAR();
        {
            unsigned om = selm[lane], am = om;
            om |= __shfl_xor(om, 4); om |= __shfl_xor(om, 8); om |= __shfl_xor(om, 16); om |= __shfl_xor(om, 32);
            am &= __shfl_xor(am, 4); am &= __shfl_xor(am, 8); am &= __shfl_xor(am, 16); am &= __shfl_xor(am, 32);
            u0 = __builtin_amdgcn_readlane(om, 0); u1 = __builtin_amdgcn_readlane(om, 1); u2 = __builtin_amdgcn_readlane(om, 2); u3 = __builtin_amdgcn_readlane(om, 3);
            am0 = __builtin_amdgcn_readlane(am, 0); am1 = __builtin_amdgcn_readlane(am, 1); am2 = __builtin_amdgcn_readlane(am, 2); am3 = __builtin_amdgcn_readlane(am, 3);
            if (tid < 128) { const int wd = tid >> 5, bt = tid & 31;
                const unsigned uw = wd == 0 ? u0 : wd == 1 ? u1 : wd == 2 ? u2 : u3;
                if ((uw >> bt) & 1u) { const int pos = (wd > 0 ? __popc(u0) : 0) + (wd > 1 ? __popc(u1) : 0) + (wd > 2 ? __popc(u2) : 0) + __popc(uw & ((1u << bt) - 1u)); blist[pos] = (unsigned)tid; } }
        }
        const int nsel = __popc(u0) + __popc(u1) + __popc(u2) + __popc(u3);
        LDS_BAR();
        {
            const bf16* kb = Y1 + (size_t)b * T * OINP + 1280 + g * 64; const bf16* vt = VST + (size_t)(b * 2 + g) * 64 * T;
            f32x4 lp = {0.f, 0.f, 0.f, 0.f}; f32x4 acc[4];
#pragma unroll
            for (int dt = 0; dt < 4; ++dt) acc[dt] = (f32x4){0.f, 0.f, 0.f, 0.f};
#define SEL_FETCH(idx, KR, VR) { const int i2_ = (idx) < nsel ? (idx) : nsel - 1; const int j2_ = (int)__builtin_amdgcn_readfirstlane((int)blist[i2_]); tile_fetch(kb + (size_t)(64 * j2_) * OINP, OINP, vt + 64 * j2_, T, tid, KR, VR); }
#define SEL_PREP(i, j, selb, d0) \
                const int j = (int)__builtin_amdgcn_readfirstlane((int)blist[i]); \
                const int wd##j = j >> 5; const unsigned aw##j = wd##j == 0 ? am0 : wd##j == 1 ? am1 : wd##j == 2 ? am2 : am3; \
                const bool selb = (((aw##j >> (j & 31)) & 1u) != 0u) || (((selm[l15 * 4 + wd##j] >> (j & 31)) & 1u) != 0u); \
                const int d0 = t - 64 * j - 4 * q;
#define SEL_COMP1(i) { SEL_PREP(i, ja, sa_, da_) \
                if (ja < qblk) tile_step<false>(KSLOT(i), VSLOT(i), qf, acc, lp, da_, slope2, 0x7fffffffu, sa_, l15, q);        \
                else tile_step<true>(KSLOT(i), VSLOT(i), qf, acc, lp, da_, slope2, 0x7fffffffu, sa_, l15, q); }
#define SEL_COMP2(i, i2) { SEL_PREP(i, ja, sa_, da_) SEL_PREP(i2, jb, sb_, db_) \
                if (ja < qblk && jb < qblk) { tile_step<false>(KSLOT(i), VSLOT(i), qf, acc, lp, da_, slope2, 0x7fffffffu, sa_, l15, q); tile_step<false>(KSLOT(i2), VSLOT(i2), qf, acc, lp, db_, slope2, 0x7fffffffu, sb_, l15, q); } \
                else { tile_step<true>(KSLOT(i), VSLOT(i), qf, acc, lp, da_, slope2, 0x7fffffffu, sa_, l15, q); tile_step<true>(KSLOT(i2), VSLOT(i2), qf, acc, lp, db_, slope2, 0x7fffffffu, sb_, l15, q); } }
            PAIR_PIPE(nsel, SEL_FETCH, SEL_COMP1, SEL_COMP2)
#undef SEL_FETCH
#undef SEL_PREP
#undef SEL_COMP1
#undef SEL_COMP2
            const float l = lp[0];
            const float sc = l > 0.f ? g1 / l : 0.f;
#pragma unroll
            for (int dt = 0; dt < 4; ++dt) { ot[dt][0] += sc * acc[dt][0]; ot[dt][1] += sc * acc[dt][1]; ot[dt][2] += sc * acc[dt][2]; ot[dt][3] += sc * acc[dt][3]; }
        }
        {
            const bf16* kb = Y1 + (size_t)b * T * OINP + 1536 + g * 64; const bf16* vt = VWT + (size_t)(b * 2 + g) * 64 * T;
            f32x4 lp = {0.f, 0.f, 0.f, 0.f}; f32x4 acc[4];
#pragma unroll
            for (int dt = 0; dt < 4; ++dt) acc[dt] = (f32x4){0.f, 0.f, 0.f, 0.f};
            int kstart = t0 - 511; kstart = kstart < 0 ? 0 : (kstart & ~63);
            const int nw = ((t0 + 15 - kstart) >> 6) + 1;
#define WIN_FETCH(idx, KR, VR) { const int i2_ = (idx) < nw ? (idx) : nw - 1; const int k2_ = kstart + 64 * i2_; tile_fetch(kb + (size_t)k2_ * OINP, OINP, vt + k2_, T, tid, KR, VR); }
#define WIN_INT(i) ((kstart + 64 * (i)) + 63 <= t0 && (kstart + 64 * (i)) >= t0 - 496)
#define WIN_COMP1(i) { const int d0_ = t - (kstart + 64 * (i)) - 4 * q; \
                if (WIN_INT(i)) tile_step<false>(KSLOT(i), VSLOT(i), qf, acc, lp, d0_, slope2, 512u, true, l15, q); \
                else tile_step<true>(KSLOT(i), VSLOT(i), qf, acc, lp, d0_, slope2, 512u, true, l15, q); }
#define WIN_COMP2(i, i2) { const int da_ = t - (kstart + 64 * (i)) - 4 * q, db_ = da_ - 64; \
                if (WIN_INT(i) && WIN_INT(i2)) { tile_step<false>(KSLOT(i), VSLOT(i), qf, acc, lp, da_, slope2, 512u, true, l15, q); tile_step<false>(KSLOT(i2), VSLOT(i2), qf, acc, lp, db_, slope2, 512u, true, l15, q); } \
                else { tile_step<true>(KSLOT(i), VSLOT(i), qf, acc, lp, da_, slope2, 512u, true, l15, q); tile_step<true>(KSLOT(i2), VSLOT(i2), qf, acc, lp, db_, slope2, 512u, true, l15, q); } }
            PAIR_PIPE(nw, WIN_FETCH, WIN_COMP1, WIN_COMP2)
#undef WIN_FETCH
#undef WIN_INT
#undef WIN_COMP1
#undef WIN_COMP2
            const float l = lp[0];
            const float sc = l > 0.f ? g2 / l : 0.f;
#pragma unroll
            for (int dt = 0; dt < 4; ++dt) { ot[dt][0] += sc * acc[dt][0]; ot[dt][1] += sc * acc[dt][1]; ot[dt][2] += sc * acc[dt][2]; ot[dt][3] += sc * acc[dt][3]; }
        }
        bf16* op = MIX + row * D + h * 64 + 4 * q;
#pragma unroll
        for (int dt = 0; dt < 4; ++dt) { u32x2 ow; ow.x = pk2(ot[dt][0], ot[dt][1]); ow.y = pk2(ot[dt][2], ot[dt][3]); *(u32x2*)(op + 16 * dt) = ow; }
    }
#undef KSLOT
#undef VSLOT
#undef PAIR_PIPE
#undef NSA_TILE
#undef NSA_FETCH_Q
}
struct Args { const float* in[19]; float* out; unsigned char* ws; int ph_lo, ph_hi; };
constexpr int N_PHASES = 18;
template <class Epi, bool ALIGN = true>
DI void run_gemm(LAS unsigned char* lds, const bf16* A, const bf16* Bt, int N, int K, const Epi& E) {
    pg8::Gemm g{A, Bt, M, N, K}; pg8::StaticOrder S; S.init(M, N, (int)gridDim.x, (int)blockIdx.x);
    pg8::gemm_phase<Epi, pg8::StaticOrder, ALIGN, true>(lds, g, S, E);
}
__global__ void __launch_bounds__(512, 2) mega(Args a) {
    extern __shared__ __attribute__((aligned(16))) unsigned char lds_raw[];
    LAS unsigned char* lds = (LAS unsigned char*)lds_raw;
    cg::grid_group grid = cg::this_grid();
    volatile LAS unsigned* bst = (volatile LAS unsigned*)(lds + LDS_BYTES - 64);
    if (threadIdx.x < 2) bst[threadIdx.x] = 0u;
    __syncthreads();
    XcdBarrier xbar = xcd_barrier_post((unsigned*)(a.ws + WS_CTL), bst);
    const int tid = threadIdx.x, lane = tid & 63, wave = __builtin_amdgcn_readfirstlane(tid >> 6);
    const int gw = blockIdx.x * 8 + wave, ngw = gridDim.x * 8;
#define WSP(off) ((bf16*)(a.ws + (off)))
#define W_EIN WSP(WS_EIN)
#define W_EOUT WSP(WS_EOUT)
#define W_OIN WSP(WS_OIN)
#define W_OOUT WSP(WS_OOUT)
#define W_GU WSP(WS_GU)
#define W_DN WSP(WS_DN)
#define W1K WSP(WS_W1K)
#define W1V WSP(WS_W1V)
#define W2K WSP(WS_W2K)
#define W2V WSP(WS_W2V)
#define DEC ((float*)(a.ws + WS_DEC))
#define KCMP WSP(WS_KCMP)
#define VCMPT WSP(WS_VCMPT)
#define Y WSP(WS_Y)
#define VST WSP(WS_VST)
#define VWT WSP(WS_VWT)
#define HN WSP(WS_HN)
#define ST WSP(WS_ST)
#define RS ((float*)(a.ws + WS_RS))
#define HB WSP(WS_HB)
    const int lo = a.ph_lo, hi = a.ph_hi;
#define PH(k) if (lo <= (k) && (k) < hi)
#define SEAM(k) if (lo <= (k) && (k) + 1 < hi && hi > 0) { if ((k) == 0 && a.ph_lo < 0) grid.sync();   xcd_barrier(xbar); }
    PH(0) {
        LAS float* scr = (LAS float*)(lds + wave * 8448);
        constexpr int I0 = 2048, I1 = 512, I2 = 1024, I3 = 512, I4 = 2816, I5 = 1408, I6 = 64, I7 = 2;
        constexpr int NIT = I0 + I1 + I2 + I3 + 2 * I4 + 2 * I5 + 2 * I6 + 2 * I7;
        for (int it = gw; it < NIT; it += ngw) {
            int r = it;
            if (r < I0) { transpose_item(a.in[4], 1024, EIN, EIN, W_EIN, 0, scr, r, lane); continue; } r -= I0;
            if (r < I1) { transpose_item(a.in[8], 1024, 1024, 1024, W_EOUT, 0, scr, r, lane); continue; } r -= I1;
            if (r < I2) { transpose_item(a.in[9], 1024, OIN, OINP, W_OIN, 0, scr, r, lane, a.in[1] + D); continue; } r -= I2;
            if (r < I3) { transpose_item(a.in[16], 1024, 1024, 1024, W_OOUT, 0, scr, r, lane); continue; } r -= I3;
            if (r < 2 * I4) { const int l = r / I4; transpose_item(a.in[17] + (size_t)l * D * 2 * FF, 1024, 2 * FF, 2 * FF, W_GU + (size_t)l * GU_STRIDE, 1, scr, r % I4, lane, a.in[2] + l * D); continue; } r -= 2 * I4;
            if (r < 2 * I5) { const int l = r / I5; transpose_item(a.in[18] + (size_t)l * FF * D, FF, 1024, 1024, W_DN + (size_t)l * DN_STRIDE, 0, scr, r % I5, lane); continue; } r -= 2 * I5;
            if (r < I6) { transpose_item(a.in[12], 2048, 64, 64, W1K, 0, scr, r, lane); continue; } r -= I6;
            if (r < I6) { transpose_item(a.in[14], 2048, 64, 64, W1V, 0, scr, r, lane); continue; } r -= I6;
            if (r < I7) { transpose_item(a.in[13], 64, 64, 64, W2K, 0, scr, r, lane); continue; } r -= I7;
            transpose_item(a.in[15], 64, 64, 64, W2V, 0, scr, r, lane);
        }
        norm_rows_bf16(a.in[0], a.in[1], HN, gw, ngw, lane);
    }
    SEAM(0);
    PH(1) { EpiStoreLA E{Y}; run_gemm(lds, HN, W_EIN, EIN, 1024, E); }
    SEAM(1);
    PH(2) { if (gridDim.x == 256) la_range_state(Y, a.in[5], (float*)ST, DEC, lds); else la_state_phase(Y, a.in[5], ST, DEC, lds); }
    SEAM(2);
    PH(3) { if (gridDim.x == 256) la_range_scan((float*)ST, DEC); else la_scan_phase(ST, DEC); }
    SEAM(3);
    PH(4) { if (gridDim.x == 256) la_range_out(Y, a.in[5], (const float*)ST, a.in[6], a.in[7], HN, lds); else la_out_phase(Y, a.in[5], ST, a.in[6], a.in[7], HN, lds); }
    SEAM(4);
    PH(5) { EpiResid<false, false> E{a.in[0], nullptr, nullptr, HB, RS}; run_gemm(lds, HN, W_EOUT, 1024, 1024, E); }
    SEAM(5);
    PH(7) { EpiSwiglu E{Y, RS}; run_gemm(lds, HB, W_GU, 2 * FF, 1024, E); }
    SEAM(7);
    PH(8) { EpiResid<true, false> E{nullptr, HB, nullptr, HB, RS + 16 * M}; run_gemm(lds, Y, W_DN, 1024, FF, E); }
    SEAM(8);
    PH(10) { EpiStore E{Y, OINP, RS + 16 * M, OIN}; run_gemm(lds, HB, W_OIN, OINP, 1024, E); }
    SEAM(10);
    PH(11) { nsa_compress_phase(Y, a.in[10], a.in[11], W1K, W1V, W2K, W2V, KCMP, VCMPT, lds, gw, ngw, lane); nsa_vt_phase(Y, VST, VWT, gw, ngw, lane); }
    SEAM(11);
    PH(12) { nsa_attn_phase(Y, KCMP, VCMPT, VST, VWT, HN, lds); }
    SEAM(12);
    PH(13) { EpiResid<true, false> E{nullptr, HB, nullptr, HB, RS + 32 * M}; run_gemm(lds, HN, W_OOUT, 1024, 1024, E); }
    SEAM(13);
    PH(15) { EpiSwiglu E{Y, RS + 32 * M}; run_gemm(lds, HB, W_GU + GU_STRIDE, 2 * FF, 1024, E); }
    SEAM(15);
    PH(16) { EpiResid<true, false> E{nullptr, HB, nullptr, HB, RS}; run_gemm(lds, Y, W_DN + DN_STRIDE, 1024, FF, E); }
    SEAM(16);
    PH(17) { norm_final(HB, RS, a.in[3], a.out, gw, ngw, lane); }
#undef PH
#undef SEAM
}

extern "C" void kernel_launch(void* const* d_in, const int* in_sizes, int n_in, void* d_out, int out_size, void* d_ws, size_t ws_size, hipStream_t stream) {
    static int grid = 0;
    if (grid == 0) {
        if (n_in != 19 || in_sizes[0] != M * D || out_size != M * D || ws_size < WS_END) { fprintf(stderr, "kernel_launch: unexpected shapes (n_in %d, in0 %d, out %d, ws %zu)\n", n_in, n_in > 0 ? in_sizes[0] : -1, out_size, ws_size); grid = -1; return; }
        int dev = 0, cus = 0, per_cu = 0;
        (void)hipGetDevice(&dev); (void)hipDeviceGetAttribute(&cus, hipDeviceAttributeMultiprocessorCount, dev);
        if (hipFuncSetAttribute((const void*)mega, hipFuncAttributeMaxDynamicSharedMemorySize, LDS_BYTES) != hipSuccess) { fprintf(stderr, "kernel_launch: hipFuncSetAttribute failed\n"); grid = -1; return; }
        if (hipOccupancyMaxActiveBlocksPerMultiprocessor(&per_cu, (const void*)mega, 512, LDS_BYTES) != hipSuccess || per_cu < 1) { fprintf(stderr, "kernel_launch: occupancy query says %d\n", per_cu); per_cu = 1; }
        (void)hipGetLastError();
        grid = cus * 1;
    }
    if (grid < 0) return;
    if (hipMemsetAsync((char*)d_ws + WS_CTL, 0, CTL_BYTES, stream) != hipSuccess) { fprintf(stderr, "kernel_launch: memset failed\n"); return; }
    Args a{};
    for (int i = 0; i < 19; ++i) a.in[i] = (const float*)d_in[i];
    a.out = (float*)d_out; a.ws = (unsigned char*)d_ws; a.ph_lo = 0; a.ph_hi = N_PHASES;
    void* args[] = {&a};
    hipError_t e = hipLaunchCooperativeKernel((const void*)mega, dim3(grid), dim3(512), args, LDS_BYTES, stream);
    if (e != hipSuccess) fprintf(stderr, "kernel_launch: cooperative launch failed: %s (grid %d)\n", hipGetErrorString(e), grid);
#ifdef PROBE_PHASES
    { const int pp[] = {PROBE_PHASES};
      for (unsigned i = 0; i < sizeof(pp) / sizeof(pp[0]); ++i) { a.ph_lo = pp[i]; a.ph_hi = pp[i] + 1; (void)hipLaunchCooperativeKernel((const void*)mega, dim3(grid), dim3(512), args, LDS_BYTES, stream); } }
#endif
}
```
